# Optimizing an MI355X kernel written in HIP

```python
import math, functools
import jax, jax.numpy as jnp
from jax import lax
import numpy as np

D_MODEL = 1024
BATCH = 4
SEQ = 4096
DEPTH = 1
DEC_BATCH = 32
DEC_SEQ = 1
PAST_LEN = 8192
PAGE_SIZE = 128

N_META = 16
NORM_EPS = 1e-6
RW_HEAD = 64
RW_DIM = D_MODEL // 2
RW_HEADS = RW_DIM // RW_HEAD
W_LORA = 64
A_LORA = 64
G_LORA = 128
RW_PROJ = 3 * RW_DIM + W_LORA + A_LORA + G_LORA
RW_LN_EPS = 64e-5
DA_DK = 64
DA_DV = 2 * DA_DK
DA_DIM = D_MODEL // 2
DA_HEADS = DA_DIM // DA_DV
DA_QK = DA_HEADS * 2 * DA_DK
DA_V = DA_HEADS * DA_DV
Q_BLOCK = 128
IN_WIDTH = RW_PROJ + 2 * DA_QK + DA_V + 2 * D_MODEL
N_KEYS = 128
N_EXPERTS = N_KEYS * N_KEYS
PEER_HEADS = 8
PEER_TOPK = 16
PEER_DQ = 256
PEER_DHALF = PEER_DQ // 2
PEER_BLOCK = 256

kernel_name = "rwkv7_diffattn_peer_hybrid_step"

F32 = jnp.float32


def rms_norm(x, g, eps=NORM_EPS):
    xf = x.astype(F32)
    y = xf * lax.rsqrt(jnp.mean(xf * xf, axis=-1, keepdims=True) + eps)
    return (y * g.astype(F32)).astype(x.dtype)


def alibi_slopes(n):
    return jnp.exp2(-8.0 * jnp.arange(1, n + 1, dtype=F32) / n)


def rwkv_branch(p, shift_prev, S0, lp):
    B, T, _ = p.shape
    p_prev = jnp.concatenate([shift_prev[:, None, :].astype(p.dtype), p[:, :-1]], axis=1)
    ps = (p + (p_prev - p) * lp['rw_mu']).astype(F32)
    r, k, v, wl, al, gl = jnp.split(ps, [RW_DIM, 2 * RW_DIM, 3 * RW_DIM, 3 * RW_DIM + W_LORA,
                                        3 * RW_DIM + W_LORA + A_LORA], axis=-1)
    w = -jax.nn.softplus(-(lp['rw_w0'] + jnp.tanh(wl) @ lp['rw_w2'])) - 0.5
    decay = jnp.exp(-jnp.exp(w))
    a = jax.nn.sigmoid(lp['rw_a0'] + al @ lp['rw_a2'])
    g = jax.nn.sigmoid(gl) @ lp['rw_g2']
    heads = lambda t: t.reshape(B, T, RW_HEADS, RW_HEAD)
    kk = heads(k * lp['rw_kk'])
    kk = kk / jnp.maximum(jnp.sqrt(jnp.sum(kk * kk, axis=-1, keepdims=True)), 1e-12)
    k = k * (1.0 + (a - 1.0) * lp['rw_ka'])
    rh, kh, vh, wh, ah = heads(r), heads(k), heads(v), heads(decay), heads(a)
    a_vec, b_vec = -kk, kk * ah

    def step(S, inp):
        r_t, w_t, k_t, v_t, a_t, b_t = inp
        sa = jnp.einsum('bhvk,bhk->bhv', S, a_t)
        S = S * w_t[:, :, None, :] + sa[..., None] * b_t[:, :, None, :] + v_t[..., None] * k_t[:, :, None, :]
        return S, jnp.einsum('bhvk,bhk->bhv', S, r_t)

    seq = tuple(jnp.moveaxis(t, 1, 0) for t in (rh, wh, kh, vh, a_vec, b_vec))
    S_fin, ys = lax.scan(step, S0.astype(F32), seq)
    y = jnp.moveaxis(ys, 0, 1)
    mu = jnp.mean(y, axis=-1, keepdims=True)
    var = jnp.mean(jnp.square(y - mu), axis=-1, keepdims=True)
    y = ((y - mu) * lax.rsqrt(var + RW_LN_EPS)).reshape(B, T, RW_DIM) * lp['rw_ln_g'] + lp['rw_ln_b']
    bonus = (jnp.sum(rh * kh * lp['rw_rk'], axis=-1, keepdims=True) * vh).reshape(B, T, RW_DIM)
    y = ((y + bonus) * g).astype(p.dtype)
    return y @ lp['w_rw_br'], p[:, -1], S_fin.astype(p.dtype)


def diff_attn_prompt(q, k, v, lam):
    B, T = q.shape[:2]
    nb = -(-T // Q_BLOCK)
    Tp = nb * Q_BLOCK
    pad = ((0, 0), (0, Tp - T), (0, 0), (0, 0), (0, 0))
    qp, kp, vp = jnp.pad(q, pad), jnp.pad(k, pad), jnp.pad(v, pad[:4])
    slopes = alibi_slopes(DA_HEADS)[None, :, None, None, None]
    kpos = jnp.arange(Tp)
    qblocks = jnp.moveaxis(qp.reshape(B, nb, Q_BLOCK, DA_HEADS, 2, DA_DK), 1, 0)
    starts = jnp.arange(nb) * Q_BLOCK

    def block(args):
        qb, start = args
        qpos = start + jnp.arange(Q_BLOCK)
        s = jnp.einsum('bqhcd,bkhcd->bhcqk', qb, kp).astype(F32) * (DA_DK ** -0.5)
        dist = (qpos[:, None] - kpos[None, :]).astype(F32)
        s = jnp.where(dist >= 0, s - slopes * dist, -jnp.inf)
        pr = jax.nn.softmax(s, axis=-1)
        att = pr[:, :, 0] - lam * pr[:, :, 1]
        return jnp.einsum('bhqk,bkhv->bqhv', att.astype(vp.dtype), vp)

    o = lax.map(block, (qblocks, starts))
    return jnp.moveaxis(o, 0, 1).reshape(B, Tp, DA_HEADS, DA_DV)[:, :T]


def diff_attn_sample(q, k, v, lam, k_past, v_past):
    S = q.shape[1]
    P = k_past.shape[1]
    scale = DA_DK ** -0.5
    slopes = alibi_slopes(DA_HEADS)[None, :, None, None, None]
    qpos = P + jnp.arange(S)
    s_past = jnp.einsum('bqhcd,bkhcd->bhcqk', q, k_past).astype(F32) * scale
    d_past = (qpos[:, None] - jnp.arange(P)[None, :]).astype(F32)
    s_past = s_past - slopes * d_past
    s_new = jnp.einsum('bqhcd,bkhcd->bhcqk', q, k).astype(F32) * scale
    d_new = (qpos[:, None] - (P + jnp.arange(S))[None, :]).astype(F32)
    s_new = jnp.where(d_new >= 0, s_new - slopes * d_new, -jnp.inf)
    pr = jax.nn.softmax(jnp.concatenate([s_past, s_new], axis=-1), axis=-1)
    att = (pr[:, :, 0] - lam * pr[:, :, 1]).astype(v.dtype)
    return (jnp.einsum('bhqk,bkhv->bqhv', att[..., :P], v_past)
            + jnp.einsum('bhqk,bkhv->bqhv', att[..., P:], v))


def peer_ffn(xn, lp):
    lead = xn.shape[:-1]
    x = xn.reshape(-1, D_MODEL)
    N = x.shape[0]
    q = (x @ lp['peer_wq']).reshape(N, PEER_HEADS, 2, PEER_DHALF)
    s = jnp.einsum('nhcd,ckd->nhck', q, lp['peer_subkeys']).astype(F32)
    v1, i1 = lax.top_k(s[:, :, 0], PEER_TOPK)
    v2, i2 = lax.top_k(s[:, :, 1], PEER_TOPK)
    cand = (v1[..., :, None] + v2[..., None, :]).reshape(N, PEER_HEADS, PEER_TOPK * PEER_TOPK)
    sc, ci = lax.top_k(cand, PEER_TOPK)
    e1 = jnp.take_along_axis(i1, ci // PEER_TOPK, axis=-1)
    e2 = jnp.take_along_axis(i2, ci % PEER_TOPK, axis=-1)
    idx = e1 * N_KEYS + e2
    gate = jax.nn.softmax(sc, axis=-1)
    nb = -(-N // PEER_BLOCK)
    npad = nb * PEER_BLOCK - N
    xr = jnp.pad(x, ((0, npad), (0, 0))).reshape(nb, PEER_BLOCK, D_MODEL)
    ir = jnp.pad(idx, ((0, npad), (0, 0), (0, 0))).reshape(nb, PEER_BLOCK, PEER_HEADS, PEER_TOPK)
    gr = jnp.pad(gate, ((0, npad), (0, 0), (0, 0))).reshape(nb, PEER_BLOCK, PEER_HEADS, PEER_TOPK)
    u_tab, v_tab = lp['peer_u'], lp['peer_v']

    def block(args):
        xb, ib, gb = args
        hid = jnp.einsum('td,thkd->thk', xb, u_tab[ib]).astype(F32)
        hid = jax.nn.gelu(hid, approximate=False) * gb
        return jnp.einsum('thk,thkd->td', hid.astype(xb.dtype), v_tab[ib])

    out = lax.map(block, (xr, ir, gr)).reshape(-1, D_MODEL)[:N]
    return out.reshape(*lead, D_MODEL)


def layer_forward(h, attn_core, shift0, S0, lp, lam_init):
    B, T, _ = h.shape
    xn = rms_norm(h, lp['norm1_g'])
    proj = xn @ lp['w_in']
    o1 = RW_PROJ
    o2 = o1 + DA_QK
    o3 = o2 + DA_QK
    o4 = o3 + DA_V
    o5 = o4 + D_MODEL
    p_rw, q, k, v, g_a, g_b = jnp.split(proj, [o1, o2, o3, o4, o5], axis=-1)
    y_rw, shift_last, S_fin = rwkv_branch(p_rw, shift0, S0, lp)
    q = rms_norm(q.reshape(B, T, DA_HEADS, 2, DA_DK), lp['da_qn_g'])
    k = rms_norm(k.reshape(B, T, DA_HEADS, 2, DA_DK), lp['da_kn_g'])
    v = v.reshape(B, T, DA_HEADS, DA_DV)
    lv = lp['da_lam'].astype(F32)
    lam = jnp.exp(jnp.sum(lv[0] * lv[1])) - jnp.exp(jnp.sum(lv[2] * lv[3])) + lam_init
    o = attn_core(q, k, v, lam)
    o = rms_norm(o, lp['da_subln_g']) * (1.0 - lam_init)
    y_da = o.reshape(B, T, DA_V) @ lp['w_da_br']
    mix = jax.nn.sigmoid(g_a) * y_rw + jax.nn.sigmoid(g_b) * y_da
    h = h + mix @ lp['w_out']
    h = h + peer_ffn(rms_norm(h, lp['norm2_g']), lp)
    return h, k, v, shift_last, S_fin


def setup_inputs(seed: int = 0) -> dict:
    key = jax.random.key(seed)
    ks = iter(jax.random.split(key, 48))
    nrm = lambda shape, scale: jax.random.normal(next(ks), shape, F32) * scale
    uni = lambda shape, lo, hi: jax.random.uniform(next(ks), shape, F32, lo, hi)
    n_pages = PAST_LEN // PAGE_SIZE
    n_used = DEC_BATCH * n_pages
    n_phys = n_used + max(1, n_used // 4)
    page_table = jax.random.permutation(next(ks), n_phys)[:n_used].reshape(DEC_BATCH, n_pages).astype(jnp.int32)
    return {
        'x_prompt': nrm((BATCH, SEQ, D_MODEL), 1.0),
        'x_sample': nrm((DEC_BATCH, DEC_SEQ, D_MODEL), 1.0),
        'cache_k': nrm((DEPTH, n_phys, PAGE_SIZE, DA_HEADS, 2, DA_DK), 1.0),
        'cache_v': nrm((DEPTH, n_phys, PAGE_SIZE, DA_HEADS, DA_DV), 1.0),
        'state_wkv': nrm((DEPTH, DEC_BATCH, RW_HEADS, RW_HEAD, RW_HEAD), 0.1),
        'state_shift': nrm((DEPTH, DEC_BATCH, RW_PROJ), 1.0),
        'page_table': page_table,
        'meta': nrm((N_META, D_MODEL), 1.0),
        'norm1_g': 1.0 + nrm((DEPTH, D_MODEL), 0.02),
        'w_in': nrm((DEPTH, D_MODEL, IN_WIDTH), D_MODEL ** -0.5),
        'rw_mu': uni((DEPTH, RW_PROJ), 0.0, 1.0),
        'rw_w0': uni((DEPTH, RW_DIM), -6.0, 1.0),
        'rw_w2': nrm((DEPTH, W_LORA, RW_DIM), 0.1 * W_LORA ** -0.5),
        'rw_a0': nrm((DEPTH, RW_DIM), 0.1),
        'rw_a2': nrm((DEPTH, A_LORA, RW_DIM), 0.1 * A_LORA ** -0.5),
        'rw_g2': nrm((DEPTH, G_LORA, RW_DIM), G_LORA ** -0.5),
        'rw_kk': 0.85 + nrm((DEPTH, RW_DIM), 0.02),
        'rw_ka': 1.0 + nrm((DEPTH, RW_DIM), 0.02),
        'rw_rk': nrm((DEPTH, RW_HEADS, RW_HEAD), 0.1),
        'rw_ln_g': 1.0 + nrm((DEPTH, RW_DIM), 0.02),
        'rw_ln_b': nrm((DEPTH, RW_DIM), 0.02),
        'w_rw_br': nrm((DEPTH, RW_DIM, D_MODEL), RW_DIM ** -0.5),
        'da_qn_g': 1.0 + nrm((DEPTH, DA_DK), 0.02),
        'da_kn_g': 1.0 + nrm((DEPTH, DA_DK), 0.02),
        'da_lam': nrm((DEPTH, 4, DA_DK), 0.1),
        'da_subln_g': 1.0 + nrm((DEPTH, DA_DV), 0.02),
        'w_da_br': nrm((DEPTH, DA_DIM, D_MODEL), DA_DIM ** -0.5),
        'w_out': nrm((DEPTH, D_MODEL, D_MODEL), D_MODEL ** -0.5),
        'norm2_g': 1.0 + nrm((DEPTH, D_MODEL), 0.02),
        'peer_wq': nrm((DEPTH, D_MODEL, PEER_HEADS * PEER_DQ), D_MODEL ** -0.5),
        'peer_subkeys': nrm((DEPTH, 2, N_KEYS, PEER_DHALF), PEER_DHALF ** -0.5),
        'peer_u': nrm((DEPTH, N_EXPERTS, D_MODEL), D_MODEL ** -0.5),
        'peer_v': nrm((DEPTH, N_EXPERTS, D_MODEL), (PEER_HEADS * PEER_TOPK) ** -0.5),
    }


def reference(x_prompt, x_sample, cache_k, cache_v, state_wkv, state_shift, page_table,
              meta, norm1_g, w_in, rw_mu, rw_w0, rw_w2, rw_a0, rw_a2, rw_g2, rw_kk, rw_ka, rw_rk,
              rw_ln_g, rw_ln_b, w_rw_br, da_qn_g, da_kn_g, da_lam, da_subln_g, w_da_br, w_out,
              norm2_g, peer_wq, peer_subkeys, peer_u, peer_v):
    B = x_prompt.shape[0]
    Bd = x_sample.shape[0]
    hp = jnp.concatenate([jnp.broadcast_to(meta.astype(x_prompt.dtype)[None], (B, N_META, D_MODEL)),
                          x_prompt], axis=1)
    hs = x_sample
    kp_l, vp_l, ks_l, vs_l, Sp_l, Ss_l, shp_l, shs_l = [], [], [], [], [], [], [], []
    for l in range(DEPTH):
        lp = dict(norm1_g=norm1_g[l], w_in=w_in[l], rw_mu=rw_mu[l], rw_w0=rw_w0[l], rw_w2=rw_w2[l],
                  rw_a0=rw_a0[l], rw_a2=rw_a2[l], rw_g2=rw_g2[l], rw_kk=rw_kk[l], rw_ka=rw_ka[l],
                  rw_rk=rw_rk[l], rw_ln_g=rw_ln_g[l], rw_ln_b=rw_ln_b[l], w_rw_br=w_rw_br[l],
                  da_qn_g=da_qn_g[l], da_kn_g=da_kn_g[l], da_lam=da_lam[l], da_subln_g=da_subln_g[l],
                  w_da_br=w_da_br[l], w_out=w_out[l], norm2_g=norm2_g[l], peer_wq=peer_wq[l],
                  peer_subkeys=peer_subkeys[l], peer_u=peer_u[l], peer_v=peer_v[l])
        lam_init = 0.8 - 0.6 * math.exp(-0.3 * l)
        hp, k_p, v_p, sh_p, S_p = layer_forward(
            hp, diff_attn_prompt, jnp.zeros((B, RW_PROJ), hp.dtype),
            jnp.zeros((B, RW_HEADS, RW_HEAD, RW_HEAD), F32), lp, lam_init)
        k_past = cache_k[l][page_table].reshape(Bd, -1, DA_HEADS, 2, DA_DK)
        v_past = cache_v[l][page_table].reshape(Bd, -1, DA_HEADS, DA_DV)
        attn_s = functools.partial(diff_attn_sample, k_past=k_past, v_past=v_past)
        hs, k_s, v_s, sh_s, S_s = layer_forward(hs, attn_s, state_shift[l], state_wkv[l], lp, lam_init)
        kp_l.append(k_p); vp_l.append(v_p); ks_l.append(k_s); vs_l.append(v_s)
        Sp_l.append(S_p); Ss_l.append(S_s); shp_l.append(sh_p); shs_l.append(sh_s)
    y_prompt = hp[:, N_META:]
    y_sample = hs
    return (y_prompt, y_sample, jnp.stack(kp_l), jnp.stack(vp_l), jnp.stack(ks_l), jnp.stack(vs_l),
            jnp.stack(Sp_l), jnp.stack(Ss_l), jnp.stack(shp_l), jnp.stack(shs_l))
```

```cpp
#include <hip/hip_runtime.h>
#include <stdint.h>
#include <stdio.h>

#define DI __device__ __forceinline__
#define LAS __attribute__((address_space(3)))
typedef unsigned short bf16_t;
typedef short bf16x8 __attribute__((ext_vector_type(8)));
typedef short s16x4 __attribute__((ext_vector_type(4)));
typedef float f32x2 __attribute__((ext_vector_type(2)));
typedef float f32x4 __attribute__((ext_vector_type(4)));
typedef float f32x16 __attribute__((ext_vector_type(16)));
typedef unsigned u32x2 __attribute__((ext_vector_type(2)));
typedef unsigned u32x4 __attribute__((ext_vector_type(4)));
typedef __bf16 bf16v2 __attribute__((ext_vector_type(2)));

constexpr int DM = 1024, NB = 4, SEQ = 4096, NMETA = 16, TT = SEQ + NMETA  ;
constexpr int MPR = NB * TT  , MS = 32, MTOT = MPR + MS  , MP = 16640  ;
constexpr int RWP = 1792, INW = 5376;
constexpr int O_Q = 1792, O_K = 2304, O_V = 2816, O_GA = 3328, O_GB = 4352;
constexpr int NPAGES = 64, PAGE = 128, PAST = 8192;
constexpr float LOG2E = 1.4426950408889634f;
constexpr float LAM_INIT = 0.2f;
constexpr size_t OUT_YP = 0, OUT_YS = OUT_YP + (size_t)NB * SEQ * DM, OUT_KP = OUT_YS + (size_t)MS * DM, OUT_VP = OUT_KP + (size_t)MPR * 512,
                 OUT_KS = OUT_VP + (size_t)MPR * 512, OUT_VS = OUT_KS + (size_t)MS * 512, OUT_WP = OUT_VS + (size_t)MS * 512,
                 OUT_WS = OUT_WP + (size_t)NB * 8 * 4096, OUT_SP = OUT_WS + (size_t)MS * 8 * 4096, OUT_SS = OUT_SP + (size_t)NB * RWP,
                 OUT_END = OUT_SS + (size_t)MS * RWP;

constexpr int SA_SPLITS = 16, SA_UNITS = MS * 4 * SA_SPLITS;
constexpr int CK_N = 65, CK_UNITS = 32 * CK_N;
constexpr int TTP = CK_N * 64;
constexpr int CTL_WORDS = 8192, CTL_Q_ATTN = 4096, CTL_Q_SATTN = 4096 + 64;
constexpr size_t ws_al(size_t b) { return (b + 255) & ~(size_t)255; }
constexpr size_t WO_ctl = 0;
constexpr size_t WO_XB = WO_ctl + ws_al(CTL_WORDS * 4);
constexpr size_t WO_WIN_T = WO_XB + ws_al((size_t)MP * DM * 2);
constexpr size_t WO_WRW_T = WO_WIN_T + ws_al((size_t)INW * DM * 2);
constexpr size_t WO_WDA_T = WO_WRW_T + ws_al((size_t)1024 * 512 * 2);
constexpr size_t WO_WOUT_T = WO_WDA_T + ws_al((size_t)1024 * 512 * 2);
constexpr size_t WO_WQ_T = WO_WOUT_T + ws_al((size_t)1024 * 1024 * 2);
constexpr size_t WO_W2_T = WO_WQ_T + ws_al((size_t)2048 * 1024 * 2);
constexpr size_t WO_A2_T = WO_W2_T + ws_al(512 * 64 * 2);
constexpr size_t WO_G2_T = WO_A2_T + ws_al(512 * 64 * 2);
constexpr size_t WO_SK = WO_G2_T + ws_al(512 * 128 * 2);
constexpr size_t WO_U16 = WO_SK + ws_al(2 * 128 * 128 * 2);
constexpr size_t WO_V16 = WO_U16 + ws_al((size_t)16384 * DM * 2);
constexpr size_t WO_PROJ = WO_V16 + ws_al((size_t)16384 * DM * 2);
constexpr size_t WO_QN = WO_PROJ + ws_al((size_t)MP * INW * 2);
constexpr size_t WO_KN = WO_QN + ws_al((size_t)MP * 512 * 2);
constexpr size_t WO_SCAN = WO_KN + ws_al((size_t)MP * 512 * 2);
constexpr size_t WO_G = WO_SCAN + ws_al((size_t)32 * 6 * 64 * TTP * 2);
constexpr size_t WO_YO = WO_G + ws_al((size_t)MP * 512 * 2);
constexpr size_t WO_MIX = WO_YO + ws_al((size_t)MP * DM * 2);
constexpr size_t WO_HB = WO_MIX + ws_al((size_t)MP * DM * 2);
constexpr size_t WO_QP = WO_HB + ws_al((size_t)MP * DM * 2);
constexpr size_t WO_RSTD1 = WO_QP + ws_al((size_t)MP * 2048 * 2);
constexpr size_t WO_BONUS = WO_RSTD1 + ws_al((size_t)MP * 4);
constexpr size_t WO_Y = WO_BONUS + ws_al((size_t)MP * 8 * 4);
constexpr size_t WO_MIXF = WO_Y + ws_al((size_t)MP * 512 * 4);
constexpr size_t WO_H1 = WO_MIXF + ws_al((size_t)MP * DM * 4);
constexpr size_t WO_SS2 = WO_H1 + ws_al((size_t)MP * DM * 4);
constexpr size_t WO_GATE = WO_SS2 + ws_al((size_t)MP * 4);
constexpr size_t WO_PART = WO_GATE + ws_al((size_t)MP * 128 * 4);
constexpr size_t WO_SCAN_S = WO_PART + ws_al((size_t)SA_UNITS * 2 * 130 * 4);
constexpr size_t WO_IDX = WO_SCAN_S + ws_al((size_t)MS * 8 * 384 * 4);
constexpr size_t WO_XPTR = WO_IDX + ws_al((size_t)MP * 128 * 4);
constexpr size_t WO_ZROW = WO_XPTR + ws_al((size_t)MP * 8);
constexpr size_t WO_MYT = WO_ZROW + ws_al(4096);
constexpr size_t WO_MST = WO_MYT + ws_al((size_t)CK_UNITS * 4096 * 2);
constexpr size_t WO_PLV = WO_MST + ws_al((size_t)CK_UNITS * 4096 * 2);
constexpr size_t WO_WYT = WO_PLV + ws_al((size_t)CK_UNITS * 64 * 4);
constexpr size_t WO_WST = WO_WYT + ws_al((size_t)CK_UNITS * 4096 * 4);
constexpr size_t WO_SCF = WO_WST + ws_al((size_t)CK_UNITS * 4096 * 4);
constexpr size_t WS_END = WO_SCF + ws_al((size_t)CK_UNITS * 16 * 64 * 16);
struct Params {
    const float *x_prompt, *x_sample, *cache_k, *cache_v, *state_wkv, *state_shift; const int* page_table;
    const float *meta, *norm1_g, *w_in, *rw_mu, *rw_w0, *rw_w2, *rw_a0, *rw_a2, *rw_g2, *rw_kk, *rw_ka, *rw_rk, *rw_ln_g, *rw_ln_b, *w_rw_br,
        *da_qn_g, *da_kn_g, *da_lam, *da_subln_g, *w_da_br, *w_out, *norm2_g, *peer_wq, *peer_subkeys, *peer_u, *peer_v;
    float* out; char* ws;
    DI unsigned* ctl() const { return (unsigned*)(ws + WO_ctl); }
    DI bf16_t* XB() const { return (bf16_t*)(ws + WO_XB); }
    DI bf16_t* WIN_T() const { return (bf16_t*)(ws + WO_WIN_T); }
    DI bf16_t* WRW_T() const { return (bf16_t*)(ws + WO_WRW_T); }
    DI bf16_t* WDA_T() const { return (bf16_t*)(ws + WO_WDA_T); }
    DI bf16_t* WOUT_T() const { return (bf16_t*)(ws + WO_WOUT_T); }
    DI bf16_t* WQ_T() const { return (bf16_t*)(ws + WO_WQ_T); }
    DI bf16_t* W2_T() const { return (bf16_t*)(ws + WO_W2_T); }
    DI bf16_t* A2_T() const { return (bf16_t*)(ws + WO_A2_T); }
    DI bf16_t* G2_T() const { return (bf16_t*)(ws + WO_G2_T); }
    DI bf16_t* SK() const { return (bf16_t*)(ws + WO_SK); }
    DI bf16_t* U16() const { return (bf16_t*)(ws + WO_U16); }
    DI bf16_t* V16() const { return (bf16_t*)(ws + WO_V16); }
    DI float* USC() const { return (float*)(ws + WO_U16 + ((size_t)16 << 20)); }
    DI float* VSC() const { return (float*)(ws + WO_V16 + ((size_t)16 << 20)); }
    DI bf16_t* PROJ() const { return (bf16_t*)(ws + WO_PROJ); }
    DI bf16_t* QN() const { return (bf16_t*)(ws + WO_QN); }
    DI bf16_t* KN() const { return (bf16_t*)(ws + WO_KN); }
    DI bf16_t* SCAN() const { return (bf16_t*)(ws + WO_SCAN); }
    DI bf16_t* G() const { return (bf16_t*)(ws + WO_G); }
    DI bf16_t* YO() const { return (bf16_t*)(ws + WO_YO); }
    DI bf16_t* MIX() const { return (bf16_t*)(ws + WO_MIX); }
    DI bf16_t* HB() const { return (bf16_t*)(ws + WO_HB); }
    DI bf16_t* QP() const { return (bf16_t*)(ws + WO_QP); }
    DI float* RSTD1() const { return (float*)(ws + WO_RSTD1); }
    DI float* BONUS() const { return (float*)(ws + WO_BONUS); }
    DI float* Y() const { return (float*)(ws + WO_Y); }
    DI float* MIXF() const { return (float*)(ws + WO_MIXF); }
    DI float* H1() const { return (float*)(ws + WO_H1); }
    DI float* SS2() const { return (float*)(ws + WO_SS2); }
    DI float* GATE() const { return (float*)(ws + WO_GATE); }
    DI float* PART() const { return (float*)(ws + WO_PART); }
    DI float* SCAN_S() const { return (float*)(ws + WO_SCAN_S); }
    DI int* IDX() const { return (int*)(ws + WO_IDX); }
    DI const float** XPTR() const { return (const float**)(ws + WO_XPTR); }
    DI float* ZROW() const { return (float*)(ws + WO_ZROW); }
    DI bf16_t* MYT() const { return (bf16_t*)(ws + WO_MYT); }
    DI bf16_t* MST() const { return (bf16_t*)(ws + WO_MST); }
    DI float* PLV() const { return (float*)(ws + WO_PLV); }
    DI float* WYT() const { return (float*)(ws + WO_WYT); }
    DI float* WST() const { return (float*)(ws + WO_WST); }
    DI unsigned* SCF() const { return (unsigned*)(ws + WO_SCF); }
};


DI size_t scan_addr(int chain, int vec, int d, int t) { return (((size_t)chain * 6 + vec) * 64 + d) * TTP + t; }
DI float bf2f(unsigned h) { return __uint_as_float(h << 16); }
DI float bflo(unsigned w) { return __uint_as_float(w << 16); }
DI float bfhi(unsigned w) { return __uint_as_float(w & 0xffff0000u); }
DI unsigned pk2(float lo, float hi) { f32x2 v = {lo, hi}; bf16v2 b = __builtin_convertvector(v, bf16v2); return __builtin_bit_cast(unsigned, b); }
DI unsigned short bf16_1_(float x) { return (unsigned short)(pk2(x, 0.f) & 0xffffu); }
DI float wave_sum(float v) {
#pragma unroll
    for (int o = 1; o < 64; o <<= 1) v += __shfl_xor(v, o);
    return v;
}
DI float sigmoidf_(float x) { return __builtin_amdgcn_rcpf(1.f + __expf(-x)); }
DI void unpack8(const u32x4& w, float (&f)[8]) {
    f[0] = bflo(w.x); f[1] = bfhi(w.x); f[2] = bflo(w.y); f[3] = bfhi(w.y); f[4] = bflo(w.z); f[5] = bfhi(w.z); f[6] = bflo(w.w); f[7] = bfhi(w.w);
}
DI const float* xrow_ptr(const Params& p, int row) {
    if (row < MPR) { const int b = row / TT, t = row - b * TT; return t < NMETA ? p.meta + (size_t)t * DM : p.x_prompt + ((size_t)b * SEQ + (t - NMETA)) * DM; }
    if (row < MTOT) return p.x_sample + (size_t)(row - MPR) * DM;
    return nullptr;
}

DI void transpose_item(const float* __restrict__ W, int K, int N, const float* __restrict__ gain, bf16_t* __restrict__ WT, LAS float* scr, int item, int lane) {
    const int nblk = N / 32, kb = item / nblk, nb = item - kb * nblk, k0 = 64 * kb, n0 = 32 * nb;
#pragma unroll 8
    for (int i = 0; i < 32; ++i) { const int kk = 2 * i + (lane >> 5); float g = gain ? gain[k0 + kk] : 1.f; scr[kk * 33 + (lane & 31)] = g * W[(size_t)(k0 + kk) * N + n0 + (lane & 31)]; }
    __builtin_amdgcn_s_waitcnt(0xc07f); asm volatile("" ::: "memory");
    const int c = lane & 7;
#pragma unroll
    for (int j = 0; j < 4; ++j) { const int n = (lane >> 3) + 8 * j; const LAS float* s = scr + (8 * c) * 33 + n;
        u32x4 o; o.x = pk2(s[0 * 33], s[1 * 33]); o.y = pk2(s[2 * 33], s[3 * 33]); o.z = pk2(s[4 * 33], s[5 * 33]); o.w = pk2(s[6 * 33], s[7 * 33]);
        *(u32x4*)(WT + (size_t)(n0 + n) * K + k0 + 8 * c) = o; }
    __builtin_amdgcn_s_waitcnt(0xc07f); asm volatile("" ::: "memory");
}
DI void convert_chunk(const float* __restrict__ src, bf16_t* __restrict__ dst, int item, int lane) {
    const size_t base = (size_t)item * 4096;
#pragma unroll
    for (int j = 0; j < 8; ++j) { const size_t o = base + (size_t)(j * 64 + lane) * 8;
        const f32x4 a = *(const f32x4*)(src + o), b = *(const f32x4*)(src + o + 4);
        u32x4 w; w.x = pk2(a.x, a.y); w.y = pk2(a.z, a.w); w.z = pk2(b.x, b.y); w.w = pk2(b.z, b.w);
        *(u32x4*)(dst + o) = w; }
}
constexpr float U8_SCALE = 256.f, V8_SCALE = 64.f;
DI void convert_chunk_fp8(const float* __restrict__ src, unsigned char* __restrict__ dst, float scale, int item, int lane) {
    const size_t base = (size_t)item * 4096;
#pragma unroll
    for (int j = 0; j < 4; ++j) { const size_t o = base + (size_t)(j * 64 + lane) * 16;
        u32x4 w;
#pragma unroll
        for (int q = 0; q < 4; ++q) { const f32x4 a = *(const f32x4*)(src + o + 4 * q);
            int pk = __builtin_amdgcn_cvt_pk_fp8_f32(a.x * scale, a.y * scale, 0, false); pk = __builtin_amdgcn_cvt_pk_fp8_f32(a.z * scale, a.w * scale, pk, true); w[q] = (unsigned)pk; }
        *(u32x4*)(dst + o) = w; }
}
DI unsigned fp6_code(float x, float s) {
    const float a = fminf(fabsf(x) * s, 7.5f);
    const float c = a < 2.f ? rintf(a * 8.f) : (a < 4.f ? 16.f + rintf((a - 2.f) * 4.f) : 24.f + rintf((a - 4.f) * 2.f));
    return (unsigned)c | (x < 0.f ? 32u : 0u);
}
DI void convert_row_fp6(const float* __restrict__ src, unsigned char* __restrict__ dst, float* __restrict__ sc, int row, int lane) {
    const float* sp = src + (size_t)row * DM + lane * 16;
    f32x4 v[4]; float am = 0.f;
#pragma unroll
    for (int q = 0; q < 4; ++q) { v[q] = *(const f32x4*)(sp + 4 * q); am = fmaxf(am, fmaxf(fmaxf(fabsf(v[q].x), fabsf(v[q].y)), fmaxf(fabsf(v[q].z), fabsf(v[q].w)))); }
#pragma unroll
    for (int o = 32; o; o >>= 1) am = fmaxf(am, __shfl_xor(am, o));
    const float s = am > 0.f ? 7.5f / am : 0.f;
    if (lane == 0) sc[row] = am * (1.f / 7.5f);
    unsigned long long lo = 0; unsigned hi = 0;
#pragma unroll
    for (int i = 0; i < 16; ++i) {
        const unsigned c = fp6_code(v[i >> 2][i & 3], s);
        if (i < 10) lo |= (unsigned long long)c << (6 * i);
        else if (i == 10) { lo |= (unsigned long long)(c & 15u) << 60; hi |= c >> 4; }
        else hi |= c << (6 * i - 64);
    }
    unsigned* dp = (unsigned*)(dst + (size_t)row * 768 + lane * 12);
    dp[0] = (unsigned)lo; dp[1] = (unsigned)(lo >> 32); dp[2] = hi;
}
DI void phase_convert(const Params& p, char* smem, int part, int gw, int ngw, int wave, int lane) {
    LAS float* scr = (LAS float*)(smem) + wave * (64 * 33);
    constexpr int I_ROWS = MP;
    constexpr int I_WIN = 16 * (INW / 32), I_RW = 8 * 32, I_DA = 8 * 32, I_OUT = 16 * 32, I_WQ = 16 * 64, I_W2 = 16, I_A2 = 16, I_G2 = 32;
    constexpr int I_SK = 8, I_Z = MP / 256;
    if (part == 0) {
        constexpr int NIT = I_ROWS + I_WIN + I_Z;
        for (int it = gw; it < NIT; it += ngw) {
            int r = it;
            if (r < I_ROWS) {
                const float* src = xrow_ptr(p, r);
                f32x4 v[4]; float ss = 0.f;
#pragma unroll
                for (int j = 0; j < 4; ++j) { v[j] = src ? *(const f32x4*)(src + (j * 64 + lane) * 4) : (f32x4){0.f, 0.f, 0.f, 0.f}; ss += v[j].x * v[j].x + v[j].y * v[j].y + v[j].z * v[j].z + v[j].w * v[j].w; }
                ss = wave_sum(ss);
#pragma unroll
                for (int j = 0; j < 4; ++j) { u32x2 o; o.x = pk2(v[j].x, v[j].y); o.y = pk2(v[j].z, v[j].w); *(u32x2*)(p.XB() + (size_t)r * DM + (j * 64 + lane) * 4) = o; }
                if (lane == 0) { p.RSTD1()[r] = rsqrtf(ss * (1.f / DM) + 1e-6f); p.XPTR()[r] = src ? src : p.ZROW(); }
                continue;
            }
            r -= I_ROWS;
            if (r < I_WIN) { transpose_item(p.w_in, 1024, INW, p.norm1_g, p.WIN_T(), scr, r, lane); continue; } r -= I_WIN;
            { *(f32x4*)(p.SS2() + (size_t)r * 256 + lane * 4) = (f32x4){0.f, 0.f, 0.f, 0.f}; if (r < 4) *(f32x4*)(p.ZROW() + (size_t)r * 256 + lane * 4) = (f32x4){0.f, 0.f, 0.f, 0.f}; }
        }
    } else {
        constexpr int NIT = I_RW + I_DA + I_OUT + I_WQ + I_W2 + I_A2 + I_G2 + I_SK;
        for (int it = gw; it < NIT; it += ngw) {
            int r = it;
            if (r < I_W2) { transpose_item(p.rw_w2, 64, 512, nullptr, p.W2_T(), scr, r, lane); continue; } r -= I_W2;
            if (r < I_A2) { transpose_item(p.rw_a2, 64, 512, nullptr, p.A2_T(), scr, r, lane); continue; } r -= I_A2;
            if (r < I_G2) { transpose_item(p.rw_g2, 128, 512, nullptr, p.G2_T(), scr, r, lane); continue; } r -= I_G2;
            if (r < I_RW) { transpose_item(p.w_rw_br, 512, 1024, nullptr, p.WRW_T(), scr, r, lane); continue; } r -= I_RW;
            if (r < I_DA) { transpose_item(p.w_da_br, 512, 1024, nullptr, p.WDA_T(), scr, r, lane); continue; } r -= I_DA;
            if (r < I_OUT) { transpose_item(p.w_out, 1024, 1024, nullptr, p.WOUT_T(), scr, r, lane); continue; } r -= I_OUT;
            if (r < I_WQ) { transpose_item(p.peer_wq, 1024, 2048, p.norm2_g, p.WQ_T(), scr, r, lane); continue; } r -= I_WQ;
            convert_chunk(p.peer_subkeys, p.SK(), r, lane);
        }
    }
}

DI void convert_row_fp4(const float* __restrict__ src, unsigned char* __restrict__ dst, float* __restrict__ sc, int row, int lane) {
    const float* sp = src + (size_t)row * DM + lane * 16;
    f32x4 v[4]; float am = 0.f;
#pragma unroll
    for (int q = 0; q < 4; ++q) { v[q] = *(const f32x4*)(sp + 4 * q); am = fmaxf(am, fmaxf(fmaxf(fabsf(v[q].x), fabsf(v[q].y)), fmaxf(fabsf(v[q].z), fabsf(v[q].w)))); }
#pragma unroll
    for (int o = 32; o; o >>= 1) am = fmaxf(am, __shfl_xor(am, o));
    const float s = am > 0.f ? 6.f / am : 0.f;
    if (lane == 0) sc[row] = am * (1.f / 6.f);
    unsigned w0 = 0u, w1 = 0u;
    w0 = __builtin_amdgcn_cvt_scalef32_pk_fp4_f32(w0, v[0].x * s, v[0].y * s, 1.0f, 0); w0 = __builtin_amdgcn_cvt_scalef32_pk_fp4_f32(w0, v[0].z * s, v[0].w * s, 1.0f, 1);
    w0 = __builtin_amdgcn_cvt_scalef32_pk_fp4_f32(w0, v[1].x * s, v[1].y * s, 1.0f, 2); w0 = __builtin_amdgcn_cvt_scalef32_pk_fp4_f32(w0, v[1].z * s, v[1].w * s, 1.0f, 3);
    w1 = __builtin_amdgcn_cvt_scalef32_pk_fp4_f32(w1, v[2].x * s, v[2].y * s, 1.0f, 0); w1 = __builtin_amdgcn_cvt_scalef32_pk_fp4_f32(w1, v[2].z * s, v[2].w * s, 1.0f, 1);
    w1 = __builtin_amdgcn_cvt_scalef32_pk_fp4_f32(w1, v[3].x * s, v[3].y * s, 1.0f, 2); w1 = __builtin_amdgcn_cvt_scalef32_pk_fp4_f32(w1, v[3].z * s, v[3].w * s, 1.0f, 3);
    *(u32x2*)(dst + (size_t)row * 512 + lane * 8) = (u32x2){w0, w1};
}

namespace g8 {
constexpr int BM = 256, BK = 64, HALF = 128, HT = HALF * BK, SHM_B = 8 * HT * 2, NXCD = 8, WGM = 8;
DI int lds_byte(int r, int c) { int st = (r >> 4) * 2 + (c >> 5), rr = r & 15, cc = c & 31, ob = rr * 64 + cc * 2; return st * 1024 + (ob ^ (((ob >> 9) & 1) << 5)); }
DI void stage_rc(int b, int& R, int& C) { int st = b / 1024, sb = b % 1024, swz = sb ^ (((sb >> 9) & 1) << 5); R = (st >> 1) * 16 + swz / 64; C = (st & 1) * 32 + (swz % 64) / 2; }
DI void unit_map(int L, int nM, int nN, int& pm, int& pn) {
    const int nwg = nM * nN; int wgid = L;
    { const int q = nwg / NXCD, r = nwg % NXCD, xcd = wgid % NXCD, off = wgid / NXCD; wgid = (xcd < r ? xcd * (q + 1) : r * (q + 1) + (xcd - r) * q) + off; }
    const int nig = WGM * nN, gid = wgid / nig, fm = gid * WGM, gsz = (nM - fm) < WGM ? (nM - fm) : WGM;
    pm = fm + ((wgid % nig) % gsz); pn = (wgid % nig) / gsz;
}
template <class Epi>
DI void gemm_tile(const bf16_t* __restrict__ A, const int lda, const bf16_t* __restrict__ Bt, const int K, const int brow, const int bcol, bf16_t* shm, const Epi& epi) {
#define SA(b, h) (shm + ((b) * 2 + (h)) * HT)
#define SB(b, h) (shm + (4 + (b) * 2 + (h)) * HT)
#define STAGE_X(T, P, BASE, LD, br, kt) do { long _g = (long)(br) * (LD) + (long)(kt) * BK; \
    for (int _i = 0; _i < 2; ++_i) { int _b = (T) * 16 + _i * 8192; int _r, _c; stage_rc(_b, _r, _c); \
      __builtin_amdgcn_global_load_lds((const unsigned*)(BASE + _g + (long)_r * (LD) + _c), (LAS unsigned*)((LAS char*)(P) + _b), 16, 0, 0); } } while (0)
#define STAGEA(P, BASE, br, kt) STAGE_X(tz0, P, BASE, lda, br, kt)
#define STAGEB(P, BASE, br, kt) STAGE_X(tz0, P, BASE, K, br, kt)
#define LDA(dst, b, h) for (int m = 0; m < 4; ++m) for (int k = 0; k < 2; ++k) \
    dst[m][k] = *reinterpret_cast<const bf16x8*>((char*)SA(b, h) + lds_byte(wr * 64 + m * 16 + fr, k * 32 + fq * 8))
#define LDB(dst, b, h) for (int n = 0; n < 2; ++n) for (int k = 0; k < 2; ++k) \
    dst[n][k] = *reinterpret_cast<const bf16x8*>((char*)SB(b, h) + lds_byte(wc * 32 + n * 16 + fr, k * 32 + fq * 8))
#define MMA(ai, bj, At, Bf) do { __builtin_amdgcn_s_setprio(1); \
    for (int m = 0; m < 4; ++m) for (int n = 0; n < 2; ++n) for (int k = 0; k < 2; ++k) \
      acc[ai][bj][m][n] = __builtin_amdgcn_mfma_f32_16x16x32_bf16(Bf[n][k], At[m][k], acc[ai][bj][m][n], 0, 0, 0); \
    __builtin_amdgcn_s_setprio(0); } while (0)
#define WAIT_V(n) asm volatile("s_waitcnt vmcnt(" #n ")" ::: "memory")
#define WAIT_L(n) asm volatile("s_waitcnt lgkmcnt(" #n ")" ::: "memory")
#define BAR __builtin_amdgcn_s_barrier()
#define SCHED __builtin_amdgcn_sched_barrier(0)
    int tz0 = threadIdx.x; asm volatile("" : "+v"(tz0));
    int wid = tz0 >> 6, lane = tz0 & 63, wr = wid >> 2, wc = wid & 3, fr = lane & 15, fq = lane >> 4;
    f32x4 acc[2][2][4][2] = {};
    bf16x8 At[4][2], B0[2][2], B1[2][2];
    const int nt = K / BK;
    STAGEB(SB(0, 0), Bt, bcol, 0); STAGEA(SA(0, 0), A, brow, 0);
    STAGEB(SB(0, 1), Bt, bcol + HALF, 0); STAGEA(SA(0, 1), A, brow + HALF, 0);
    if (wr == 1) BAR;
    WAIT_V(4); BAR;
    STAGEB(SB(1, 0), Bt, bcol, 1); STAGEA(SA(1, 0), A, brow, 1); STAGEB(SB(1, 1), Bt, bcol + HALF, 1);
    WAIT_V(6); BAR;
    for (int t = 0; t < nt - 2; t += 2) {
        LDB(B0, 0, 0); SCHED; LDA(At, 0, 0); STAGEA(SA(1, 1), A, brow + HALF, t + 1);
        WAIT_L(8); BAR; WAIT_L(0); MMA(0, 0, At, B0); BAR; SCHED;
        LDB(B1, 0, 1); STAGEB(SB(0, 0), Bt, bcol, t + 2);
        BAR; WAIT_L(0); MMA(0, 1, At, B1); BAR;
        LDA(At, 0, 1); STAGEA(SA(0, 0), A, brow, t + 2);
        BAR; WAIT_L(0); MMA(1, 0, At, B0); BAR; SCHED;
        STAGEB(SB(0, 1), Bt, bcol + HALF, t + 2);
        WAIT_V(6); BAR; MMA(1, 1, At, B1); BAR;
        LDB(B0, 1, 0); SCHED; LDA(At, 1, 0); STAGEA(SA(0, 1), A, brow + HALF, t + 2);
        WAIT_L(8); BAR; WAIT_L(0); MMA(0, 0, At, B0); BAR; SCHED;
        LDB(B1, 1, 1); STAGEB(SB(1, 0), Bt, bcol, t + 3);
        BAR; WAIT_L(0); MMA(0, 1, At, B1); BAR;
        LDA(At, 1, 1); STAGEA(SA(1, 0), A, brow, t + 3);
        BAR; WAIT_L(0); MMA(1, 0, At, B0); BAR; SCHED;
        STAGEB(SB(1, 1), Bt, bcol + HALF, t + 3);
        WAIT_V(6); BAR; MMA(1, 1, At, B1); BAR;
    }
    int tz = tz0; asm volatile("" : "+v"(tz)); wid = tz >> 6; lane = tz & 63; wr = wid >> 2; wc = wid & 3; fr = lane & 15; fq = lane >> 4;
    { LDB(B0, 0, 0); WAIT_V(0); LDA(At, 0, 0); STAGE_X(tz, SA(1, 1), A, lda, brow + HALF, nt - 1);
      BAR; WAIT_L(0); MMA(0, 0, At, B0); BAR;
      LDB(B1, 0, 1); BAR; WAIT_L(0); MMA(0, 1, At, B1); BAR;
      LDA(At, 0, 1); WAIT_V(4); BAR; WAIT_L(0); MMA(1, 0, At, B0); MMA(1, 1, At, B1); BAR; }
    { LDB(B0, 1, 0); LDA(At, 1, 0); WAIT_V(2); BAR; WAIT_L(0); MMA(0, 0, At, B0); BAR;
      LDB(B1, 1, 1); WAIT_V(0); BAR; WAIT_L(0); MMA(0, 1, At, B1); BAR;
      LDA(At, 1, 1); BAR; WAIT_L(0); MMA(1, 0, At, B0); MMA(1, 1, At, B1); BAR; }
    if (wr == 0) BAR;
    epi(acc, brow, bcol, wr, wc, fr, fq);
#undef SA
#undef SB
#undef STAGE_X
#undef STAGEA
#undef STAGEB
#undef LDA
#undef LDB
#undef MMA
}
template <bool REMAP, class Epi>
DI void gemm_phase(const bf16_t* A, int lda, const bf16_t* Bt, int K, int nM, int nN, bf16_t* shm, const Epi& epi, int bid, int nblk) {
    const int nwg = nM * nN;
    for (int L = bid; L < nwg; L += nblk) {
        int pm, pn; unit_map(L, nM, nN, pm, pn);
        const int brow = REMAP ? (pm >> 4) * TT + NMETA + (pm & 15) * BM : pm * BM;
        gemm_tile(A, lda, Bt, K, brow, pn * BM, shm, epi);
        __syncthreads();
    }
}
}
typedef f32x4 AccT[2][2][4][2];
#define EPI_ROWS_BEGIN _Pragma("unroll") for (int ai = 0; ai < 2; ++ai) _Pragma("unroll") for (int m = 0; m < 4; ++m) { __builtin_amdgcn_sched_barrier(0); asm volatile("" ::: "memory"); const int row = brow + ai * 128 + wr * 64 + m * 16 + fr;
#define EPI_COLS_BEGIN _Pragma("unroll") for (int bj = 0; bj < 2; ++bj) _Pragma("unroll") for (int n = 0; n < 2; ++n) { const int col = bcol + bj * 128 + wc * 32 + n * 16 + fq * 4; const f32x4 a = acc[ai][bj][m][n];

struct EpiProj {
    const float* rstd; bf16_t* PROJ; float* out;
    DI void operator()(const AccT& acc, int brow, int bcol, int wr, int wc, int fr, int fq) const {
        EPI_ROWS_BEGIN
            const float rs = rstd[row];
            float* sh = nullptr;
            if (bcol < RWP) {
                if (row < MPR) { const int b = row / TT; if (row - b * TT == TT - 1) sh = out + OUT_SP + (size_t)b * RWP; }
                else if (row < MTOT) sh = out + OUT_SS + (size_t)(row - MPR) * RWP;
            }
            EPI_COLS_BEGIN
                const f32x4 v = a * rs;
                u32x2 o; o.x = pk2(v.x, v.y); o.y = pk2(v.z, v.w);
                *(u32x2*)(PROJ + (size_t)row * INW + col) = o;
                if (sh) *(f32x4*)(sh + col) = v;
            }
        }
    }
};

DI void prep_qkv_row(const Params& p, int row, int lane) {
    const bf16_t* pr = p.PROJ() + (size_t)row * INW;
    const u32x4 w0 = *(const u32x4*)(pr + O_Q + lane * 16), w1 = *(const u32x4*)(pr + O_Q + lane * 16 + 8);
    float f[16]; { float t0[8], t1[8]; unpack8(w0, t0); unpack8(w1, t1);
#pragma unroll
        for (int i = 0; i < 8; ++i) { f[i] = t0[i]; f[8 + i] = t1[i]; } }
    float ss = 0.f;
#pragma unroll
    for (int i = 0; i < 16; ++i) ss += f[i] * f[i];
    ss += __shfl_xor(ss, 1); ss += __shfl_xor(ss, 2);
    const float rs = rsqrtf(ss * (1.f / 64.f) + 1e-6f);
    const bool isk = lane >= 32;
    const float* gp = (isk ? p.da_kn_g : p.da_qn_g) + (lane & 3) * 16;
#pragma unroll
    for (int i = 0; i < 16; ++i) f[i] = f[i] * rs * gp[i];
    u32x4 o0, o1; o0.x = pk2(f[0], f[1]); o0.y = pk2(f[2], f[3]); o0.z = pk2(f[4], f[5]); o0.w = pk2(f[6], f[7]);
    o1.x = pk2(f[8], f[9]); o1.y = pk2(f[10], f[11]); o1.z = pk2(f[12], f[13]); o1.w = pk2(f[14], f[15]);
    bf16_t* dst = (isk ? p.KN() : p.QN()) + (size_t)row * 512 + (lane & 31) * 16;
    *(u32x4*)dst = o0; *(u32x4*)(dst + 8) = o1;
    float* kout = row < MPR ? p.out + OUT_KP + (size_t)row * 512 : p.out + OUT_KS + (size_t)(row - MPR) * 512;
    float* vout = row < MPR ? p.out + OUT_VP + (size_t)row * 512 : p.out + OUT_VS + (size_t)(row - MPR) * 512;
    if (isk) {
#pragma unroll
        for (int i = 0; i < 4; ++i) *(f32x4*)(kout + (lane - 32) * 16 + 4 * i) = (f32x4){f[4 * i], f[4 * i + 1], f[4 * i + 2], f[4 * i + 3]};
    }
    const u32x4 wv = *(const u32x4*)(pr + O_V + lane * 8);
    float v8[8]; unpack8(wv, v8);
    *(f32x4*)(vout + lane * 8) = (f32x4){v8[0], v8[1], v8[2], v8[3]};
    *(f32x4*)(vout + lane * 8 + 4) = (f32x4){v8[4], v8[5], v8[6], v8[7]};
}

template <int N>
DI void ps_load(const LAS float* pl, const bf16_t* cur, const bf16_t* prevb, const float* prevf, int col0, float (&o)[N]) {
    float c[N], pv[N];
    if (N == 8) { float t[8]; unpack8(*(const u32x4*)(cur + col0), t);
#pragma unroll
        for (int i = 0; i < N; ++i) c[i] = t[i]; }
    else { const u32x2 w = *(const u32x2*)(cur + col0); c[0] = bflo(w.x); c[1] = bfhi(w.x); c[2] = bflo(w.y); c[3] = bfhi(w.y); }
    if (prevb) {
        if (N == 8) { float t[8]; unpack8(*(const u32x4*)(prevb + col0), t);
#pragma unroll
            for (int i = 0; i < N; ++i) pv[i] = t[i]; }
        else { const u32x2 w = *(const u32x2*)(prevb + col0); pv[0] = bflo(w.x); pv[1] = bfhi(w.x); pv[2] = bflo(w.y); pv[3] = bfhi(w.y); }
    } else if (prevf) {
#pragma unroll
        for (int i = 0; i < N; i += 4) { const f32x4 t = *(const f32x4*)(prevf + col0 + i); pv[i] = t.x; pv[i + 1] = t.y; pv[i + 2] = t.z; pv[i + 3] = t.w; }
    } else {
#pragma unroll
        for (int i = 0; i < N; ++i) pv[i] = 0.f;
    }
#pragma unroll
    for (int i = 0; i < N; i += 4) { const f32x4 mu = *(const LAS f32x4*)(pl + col0 + i);
        o[i] = c[i] + (pv[i] - c[i]) * mu.x; o[i + 1] = c[i + 1] + (pv[i + 1] - c[i + 1]) * mu.y;
        o[i + 2] = c[i + 2] + (pv[i + 2] - c[i + 2]) * mu.z; o[i + 3] = c[i + 3] + (pv[i + 3] - c[i + 3]) * mu.w; }
}
DI bf16x8 pack8(const float (&f)[8]) { u32x4 w; w.x = pk2(f[0], f[1]); w.y = pk2(f[2], f[3]); w.z = pk2(f[4], f[5]); w.w = pk2(f[6], f[7]); return __builtin_bit_cast(bf16x8, w); }
#define MFMA32(a, b, c) __builtin_amdgcn_mfma_f32_32x32x16_bf16((a), (b), (c), 0, 0, 0)

DI float tanh_fast(float x) { const float e = __expf(2.f * x); return 1.f - 2.f * __builtin_amdgcn_rcpf(e + 1.f); }
constexpr int PL_W0 = 1792, PL_A0 = 2304, PL_KK = 2816, PL_KA = 3328, PL_RK = 3840, PL_N = 4352;
DI void prep_rwkv_tile(const Params& p, const LAS float* pl, int tile, int lane) {
    const int tk = lane & 31, hh = lane >> 5, row = tile * 32 + tk;
    const bool samp = row >= MPR;
    int b = 0, t = 0;
    if (!samp) { b = row / TT; t = row - b * TT; }
    const bf16_t* cur = p.PROJ() + (size_t)row * INW;
    const bf16_t* prevb = (!samp && t > 0) ? cur - INW : nullptr;
    const float* prevf = samp ? p.state_shift + (size_t)(row - MPR) * RWP : nullptr;
    {
        bf16x8 Bw[4], Ba[4];
#pragma unroll
        for (int s = 0; s < 4; ++s) { float x[8]; ps_load<8>(pl, cur, prevb, prevf, 1536 + 16 * s + 8 * hh, x);
#pragma unroll
            for (int i = 0; i < 8; ++i) x[i] = tanh_fast(x[i]);
            Bw[s] = pack8(x); }
#pragma unroll
        for (int s = 0; s < 4; ++s) { float x[8]; ps_load<8>(pl, cur, prevb, prevf, 1600 + 16 * s + 8 * hh, x); Ba[s] = pack8(x); }
#pragma unroll 1
        for (int hd = 0; hd < 8; ++hd) {
            float kk2 = 0.f;
#pragma unroll 2
            for (int q8 = 0; q8 < 8; ++q8) { const int n = hd * 64 + (q8 >> 2) * 32 + 8 * (q8 & 3) + 4 * hh;
                float k4[4]; ps_load<4>(pl, cur, prevb, prevf, 512 + n, k4); const f32x4 kkp = *(const LAS f32x4*)(pl + PL_KK + n);
                const float a0 = k4[0] * kkp.x, a1 = k4[1] * kkp.y, a2 = k4[2] * kkp.z, a3 = k4[3] * kkp.w; kk2 += a0 * a0 + a1 * a1 + a2 * a2 + a3 * a3; }
            kk2 += __shfl_xor(kk2, 32);
            const float kinv = __builtin_amdgcn_rcpf(fmaxf(__builtin_amdgcn_sqrtf(kk2), 1e-12f));
            float bon = 0.f;
#pragma unroll 1
            for (int nt2 = 0; nt2 < 2; ++nt2) {
                const int n0 = hd * 64 + nt2 * 32;
                f32x16 dW = {}, dA = {};
#pragma unroll
                for (int s = 0; s < 4; ++s) { const bf16x8 aw = *(const bf16x8*)(p.W2_T() + (size_t)(n0 + tk) * 64 + 16 * s + 8 * hh); dW = MFMA32(aw, Bw[s], dW); }
#pragma unroll
                for (int s = 0; s < 4; ++s) { const bf16x8 aa = *(const bf16x8*)(p.A2_T() + (size_t)(n0 + tk) * 64 + 16 * s + 8 * hh); dA = MFMA32(aa, Ba[s], dA); }
#pragma unroll 1
                for (int q4 = 0; q4 < 4; ++q4) {
                    const int d0 = nt2 * 32 + 8 * q4 + 4 * hh, n = hd * 64 + d0;
                    float r4[4], k4[4], v4[4];
                    ps_load<4>(pl, cur, prevb, prevf, n, r4); ps_load<4>(pl, cur, prevb, prevf, 512 + n, k4); ps_load<4>(pl, cur, prevb, prevf, 1024 + n, v4);
                    const f32x4 w0 = *(const LAS f32x4*)(pl + PL_W0 + n), a0 = *(const LAS f32x4*)(pl + PL_A0 + n), kkp = *(const LAS f32x4*)(pl + PL_KK + n), ka = *(const LAS f32x4*)(pl + PL_KA + n), rk = *(const LAS f32x4*)(pl + PL_RK + n);
                    float dl[4], kp[4], av[4], bv[4];
#pragma unroll
                    for (int e = 0; e < 4; ++e) {
                        const float zw = w0[e] + dW[e];
                        const float ez = __expf(-zw);
                        const float sp = (zw > 15.f) ? ez : __logf(1.f + ez);
                        const float ew = __expf(-sp - 0.5f);
                        dl[e] = 1.f - __expf(-ew);
                        const float a = sigmoidf_(a0[e] + dA[e]);
                        const float kkn = k4[e] * kkp[e] * kinv;
                        kp[e] = k4[e] * (1.f + (a - 1.f) * ka[e]);
                        av[e] = -kkn; bv[e] = kkn * a;
                        bon += r4[e] * kp[e] * rk[e];
                    }
                    if (!samp) {
                        bf16_t* so = p.SCAN() + scan_addr(b * 8 + hd, 0, d0, t);
#pragma unroll
                        for (int e = 0; e < 4; ++e) { bf16_t* se = so + (size_t)e * TTP;
                            se[(size_t)0 * 64 * TTP] = bf16_1_(dl[e]); se[(size_t)1 * 64 * TTP] = bf16_1_(kp[e]); se[(size_t)2 * 64 * TTP] = bf16_1_(v4[e]);
                            se[(size_t)3 * 64 * TTP] = bf16_1_(av[e]); se[(size_t)4 * 64 * TTP] = bf16_1_(bv[e]); se[(size_t)5 * 64 * TTP] = bf16_1_(r4[e]); }
                    } else {
                        float* so = p.SCAN_S() + (((size_t)(row - MPR) * 8 + hd) * 6) * 64 + d0;
                        *(f32x4*)(so + 0 * 64) = (f32x4){1.f - dl[0], 1.f - dl[1], 1.f - dl[2], 1.f - dl[3]};
                        *(f32x4*)(so + 1 * 64) = (f32x4){kp[0], kp[1], kp[2], kp[3]};
                        *(f32x4*)(so + 2 * 64) = (f32x4){v4[0], v4[1], v4[2], v4[3]};
                        *(f32x4*)(so + 3 * 64) = (f32x4){av[0], av[1], av[2], av[3]};
                        *(f32x4*)(so + 4 * 64) = (f32x4){bv[0], bv[1], bv[2], bv[3]};
                        *(f32x4*)(so + 5 * 64) = (f32x4){r4[0], r4[1], r4[2], r4[3]};
                    }
                    dW = __builtin_shufflevector(dW, dW, 4, 5, 6, 7, 8, 9, 10, 11, 12, 13, 14, 15, 0, 1, 2, 3);
                    dA = __builtin_shufflevector(dA, dA, 4, 5, 6, 7, 8, 9, 10, 11, 12, 13, 14, 15, 0, 1, 2, 3);
                }
            }
            bon += __shfl_xor(bon, 32);
            if (hh == 0) p.BONUS()[(size_t)row * 8 + hd] = bon;
        }
    }
    __builtin_amdgcn_sched_barrier(0);
    {
        bf16x8 Bg[8];
#pragma unroll
        for (int s = 0; s < 8; ++s) { float x[8]; ps_load<8>(pl, cur, prevb, prevf, 1664 + 16 * s + 8 * hh, x);
#pragma unroll
            for (int i = 0; i < 8; ++i) x[i] = sigmoidf_(x[i]);
            Bg[s] = pack8(x); }
#pragma unroll 1
        for (int nt = 0; nt < 16; ++nt) {
            f32x16 dG = {};
#pragma unroll
            for (int s = 0; s < 8; ++s) { const bf16x8 ag = *(const bf16x8*)(p.G2_T() + (size_t)(nt * 32 + tk) * 128 + 16 * s + 8 * hh); dG = MFMA32(ag, Bg[s], dG); }
#pragma unroll
            for (int q4 = 0; q4 < 4; ++q4) { u32x2 og; og.x = pk2(dG[4 * q4], dG[4 * q4 + 1]); og.y = pk2(dG[4 * q4 + 2], dG[4 * q4 + 3]);
                *(u32x2*)(p.G() + (size_t)row * 512 + nt * 32 + 8 * q4 + 4 * hh) = og; }
        }
    }
}
constexpr int PV_ROWB = 3600, PV_STAGE_OFF = PL_N * 4  , PV_LDS = PV_STAGE_OFF + 33 * PV_ROWB;
template <int N>
DI void ps_lds(const LAS float* pl, const LAS char* curp, const LAS char* prevp, bool pz, int col0, float (&o)[N]) {
    float c[N], pv[N];
    if (N == 8) { const u32x4 wc = *(const LAS u32x4*)(curp + col0 * 2), wp = *(const LAS u32x4*)(prevp + col0 * 2); float t[8]; unpack8(wc, t); float u[8]; unpack8(wp, u);
#pragma unroll
        for (int i = 0; i < N; ++i) { c[i] = t[i]; pv[i] = pz ? 0.f : u[i]; } }
    else { const u32x2 w = *(const LAS u32x2*)(curp + col0 * 2), x = *(const LAS u32x2*)(prevp + col0 * 2);
        c[0] = bflo(w.x); c[1] = bfhi(w.x); c[2] = bflo(w.y); c[3] = bfhi(w.y);
        pv[0] = pz ? 0.f : bflo(x.x); pv[1] = pz ? 0.f : bfhi(x.x); pv[2] = pz ? 0.f : bflo(x.y); pv[3] = pz ? 0.f : bfhi(x.y); }
#pragma unroll
    for (int i = 0; i < N; i += 4) { const f32x4 mu = *(const LAS f32x4*)(pl + col0 + i);
        o[i] = c[i] + (pv[i] - c[i]) * mu.x; o[i + 1] = c[i + 1] + (pv[i + 1] - c[i + 1]) * mu.y;
        o[i + 2] = c[i + 2] + (pv[i + 2] - c[i + 2]) * mu.z; o[i + 3] = c[i + 3] + (pv[i + 3] - c[i + 3]) * mu.w; }
}
DI void prep_block(const Params& p, char* smem, int unit, int tid) {
    const LAS float* pl = (const LAS float*)smem;
    LAS char* stage = (LAS char*)smem + PV_STAGE_OFF;
    const bool samp = unit >= 514;
    const int row0 = samp ? MPR + (unit - 514) * 16 : unit * 32;
    __syncthreads();
#pragma unroll 1
    for (int i0 = 0; i0 < 16; i0 += 8) {
        u32x4 w[8];
#pragma unroll
        for (int i = 0; i < 8; ++i) {
            const int c = tid + 512 * (i0 + i), sl = c / 224, ch = c - sl * 224;
            w[i] = (u32x4){0u, 0u, 0u, 0u};
            if (c < 33 * 224) {
                if (!samp) { int gr = row0 - 1 + sl; gr = gr < 0 ? 0 : gr; w[i] = *(const u32x4*)(p.PROJ() + (size_t)gr * INW + ch * 8); }
                else if (sl < 16) w[i] = *(const u32x4*)(p.PROJ() + (size_t)(row0 + sl) * INW + ch * 8);
                else if (sl < 32) { const float* sp = p.state_shift + (size_t)(row0 - MPR + sl - 16) * RWP + ch * 8; const f32x4 a = *(const f32x4*)sp, b2 = *(const f32x4*)(sp + 4);
                    w[i].x = pk2(a.x, a.y); w[i].y = pk2(a.z, a.w); w[i].z = pk2(b2.x, b2.y); w[i].w = pk2(b2.z, b2.w); }
            }
        }
#pragma unroll
        for (int i = 0; i < 8; ++i) { const int c = tid + 512 * (i0 + i), sl = c / 224, ch = c - sl * 224; if (c < 33 * 224) *(LAS u32x4*)(stage + sl * PV_ROWB + ch * 16) = w[i]; }
    }
    __syncthreads();
    const int hd = tid >> 6, lane = tid & 63, tk = lane & 31, hh = lane >> 5;
    const int ntk = samp ? 16 : 32;
    const int tkc = tk < ntk ? tk : ntk - 1;
    const bool act = tk < ntk;
    const int row = row0 + tkc;
    int b = 0, t = 0; if (!samp) { b = row / TT; t = row - b * TT; }
    const LAS char* curp = stage + (samp ? tkc : tkc + 1) * PV_ROWB;
    const LAS char* prevp = stage + (samp ? 16 + tkc : tkc) * PV_ROWB;
    const bool pz = !samp && t == 0;
    {
        bf16x8 Bw[4], Ba[4];
#pragma unroll
        for (int s2 = 0; s2 < 4; ++s2) { float x[8]; ps_lds<8>(pl, curp, prevp, pz, 1536 + 16 * s2 + 8 * hh, x);
#pragma unroll
            for (int i = 0; i < 8; ++i) x[i] = tanh_fast(x[i]);
            Bw[s2] = pack8(x); }
#pragma unroll
        for (int s2 = 0; s2 < 4; ++s2) { float x[8]; ps_lds<8>(pl, curp, prevp, pz, 1600 + 16 * s2 + 8 * hh, x); Ba[s2] = pack8(x); }
        float kk2 = 0.f;
#pragma unroll 2
        for (int q8 = 0; q8 < 8; ++q8) { const int n = hd * 64 + (q8 >> 2) * 32 + 8 * (q8 & 3) + 4 * hh;
            float k4[4]; ps_lds<4>(pl, curp, prevp, pz, 512 + n, k4); const f32x4 kkp = *(const LAS f32x4*)(pl + PL_KK + n);
            const float a0 = k4[0] * kkp.x, a1 = k4[1] * kkp.y, a2 = k4[2] * kkp.z, a3 = k4[3] * kkp.w; kk2 += a0 * a0 + a1 * a1 + a2 * a2 + a3 * a3; }
        kk2 += __shfl_xor(kk2, 32);
        const float kinv = __builtin_amdgcn_rcpf(fmaxf(__builtin_amdgcn_sqrtf(kk2), 1e-12f));
        float bon = 0.f;
#pragma unroll 1
        for (int nt2 = 0; nt2 < 2; ++nt2) {
            const int n0 = hd * 64 + nt2 * 32;
            f32x16 dW = {}, dA = {};
            {
                bf16x8 aw[4], aa[4];
#pragma unroll
                for (int s2 = 0; s2 < 4; ++s2) { aw[s2] = *(const bf16x8*)(p.W2_T() + (size_t)(n0 + tk) * 64 + 16 * s2 + 8 * hh); aa[s2] = *(const bf16x8*)(p.A2_T() + (size_t)(n0 + tk) * 64 + 16 * s2 + 8 * hh); }
                __builtin_amdgcn_sched_barrier(0);
#pragma unroll
                for (int s2 = 0; s2 < 4; ++s2) { dW = MFMA32(aw[s2], Bw[s2], dW); dA = MFMA32(aa[s2], Ba[s2], dA); }
                __builtin_amdgcn_sched_barrier(0);
            }
#pragma unroll
            for (int q4 = 0; q4 < 4; ++q4) {
                const int d0 = nt2 * 32 + 8 * q4 + 4 * hh, n = hd * 64 + d0;
                float r4[4], k4[4], v4[4];
                ps_lds<4>(pl, curp, prevp, pz, n, r4); ps_lds<4>(pl, curp, prevp, pz, 512 + n, k4); ps_lds<4>(pl, curp, prevp, pz, 1024 + n, v4);
                const f32x4 w0 = *(const LAS f32x4*)(pl + PL_W0 + n), a0 = *(const LAS f32x4*)(pl + PL_A0 + n), kkp = *(const LAS f32x4*)(pl + PL_KK + n), ka = *(const LAS f32x4*)(pl + PL_KA + n), rk = *(const LAS f32x4*)(pl + PL_RK + n);
                float dl[4], kp[4], av[4], bv[4];
#pragma unroll
                for (int e = 0; e < 4; ++e) {
                    const float zw = w0[e] + dW[e];
                    const float ez = __expf(-zw);
                    const float sp = (zw > 15.f) ? ez : __logf(1.f + ez);
                    const float ew = __expf(-sp - 0.5f);
                    dl[e] = 1.f - __expf(-ew);
                    const float a = sigmoidf_(a0[e] + dA[e]);
                    const float kkn = k4[e] * kkp[e] * kinv;
                    kp[e] = k4[e] * (1.f + (a - 1.f) * ka[e]);
                    av[e] = -kkn; bv[e] = kkn * a;
                    bon += r4[e] * kp[e] * rk[e];
                }
                if (act) {
                    if (!samp) {
                        bf16_t* so = p.SCAN() + scan_addr(b * 8 + hd, 0, d0, t);
#pragma unroll
                        for (int e = 0; e < 4; ++e) { bf16_t* se = so + (size_t)e * TTP;
                            se[(size_t)0 * 64 * TTP] = bf16_1_(dl[e]); se[(size_t)1 * 64 * TTP] = bf16_1_(kp[e]); se[(size_t)2 * 64 * TTP] = bf16_1_(v4[e]);
                            se[(size_t)3 * 64 * TTP] = bf16_1_(av[e]); se[(size_t)4 * 64 * TTP] = bf16_1_(bv[e]); se[(size_t)5 * 64 * TTP] = bf16_1_(r4[e]); }
                    } else {
                        float* so = p.SCAN_S() + (((size_t)(row - MPR) * 8 + hd) * 6) * 64 + d0;
                        *(f32x4*)(so + 0 * 64) = (f32x4){1.f - dl[0], 1.f - dl[1], 1.f - dl[2], 1.f - dl[3]};
                        *(f32x4*)(so + 1 * 64) = (f32x4){kp[0], kp[1], kp[2], kp[3]};
                        *(f32x4*)(so + 2 * 64) = (f32x4){v4[0], v4[1], v4[2], v4[3]};
                        *(f32x4*)(so + 3 * 64) = (f32x4){av[0], av[1], av[2], av[3]};
                        *(f32x4*)(so + 4 * 64) = (f32x4){bv[0], bv[1], bv[2], bv[3]};
                        *(f32x4*)(so + 5 * 64) = (f32x4){r4[0], r4[1], r4[2], r4[3]};
                    }
                }
                dW = __builtin_shufflevector(dW, dW, 4, 5, 6, 7, 8, 9, 10, 11, 12, 13, 14, 15, 0, 1, 2, 3);
                dA = __builtin_shufflevector(dA, dA, 4, 5, 6, 7, 8, 9, 10, 11, 12, 13, 14, 15, 0, 1, 2, 3);
            }
        }
        bon += __shfl_xor(bon, 32);
        if (hh == 0 && act) p.BONUS()[(size_t)row * 8 + hd] = bon;
    }
    __builtin_amdgcn_sched_barrier(0);
    {
        bf16x8 Bg[8];
#pragma unroll
        for (int s2 = 0; s2 < 8; ++s2) { float x[8]; ps_lds<8>(pl, curp, prevp, pz, 1664 + 16 * s2 + 8 * hh, x);
#pragma unroll
            for (int i = 0; i < 8; ++i) x[i] = sigmoidf_(x[i]);
            Bg[s2] = pack8(x); }
#pragma unroll 1
        for (int nt = 2 * hd; nt < 2 * hd + 2; ++nt) {
            f32x16 dG = {};
            {
                bf16x8 ag[8];
#pragma unroll
                for (int s2 = 0; s2 < 8; ++s2) ag[s2] = *(const bf16x8*)(p.G2_T() + (size_t)(nt * 32 + tk) * 128 + 16 * s2 + 8 * hh);
                __builtin_amdgcn_sched_barrier(0);
#pragma unroll
                for (int s2 = 0; s2 < 8; ++s2) dG = MFMA32(ag[s2], Bg[s2], dG);
                __builtin_amdgcn_sched_barrier(0);
            }
            if (act) {
#pragma unroll
                for (int q4 = 0; q4 < 4; ++q4) { u32x2 og; og.x = pk2(dG[4 * q4], dG[4 * q4 + 1]); og.y = pk2(dG[4 * q4 + 2], dG[4 * q4 + 3]);
                    *(u32x2*)(p.G() + (size_t)row * 512 + nt * 32 + 8 * q4 + 4 * hh) = og; }
            }
        }
    }
}
DI void phase_prep(const Params& p, char* smem, int bid, int nblk, int gw, int ngw, int tid, int lane) {
    LAS float* pl = (LAS float*)smem;
    for (int i = tid; i < PL_N; i += 512) {
        float v;
        if (i < PL_W0) v = p.rw_mu[i]; else if (i < PL_A0) v = p.rw_w0[i - PL_W0]; else if (i < PL_KK) v = p.rw_a0[i - PL_A0];
        else if (i < PL_KA) v = p.rw_kk[i - PL_KK]; else if (i < PL_RK) v = p.rw_ka[i - PL_KA]; else v = p.rw_rk[i - PL_RK];
        pl[i] = v;
    }
    for (int u = bid; u < 512; u += nblk) prep_block(p, smem, u, tid);
    if (bid < 4 && nblk >= 8) prep_block(p, smem, 512 + bid, tid);
    else if (nblk < 8) { for (int u = 512 + bid; u < 516; u += nblk) prep_block(p, smem, u, tid); }
    {
        const int rb = (nblk >= 8) ? bid - 4 : bid, rn = (nblk >= 8) ? nblk - 4 : nblk;
        if (rb >= 0) for (int r = rb * 8 + (tid >> 6); r < MTOT; r += rn * 8) prep_qkv_row(p, r, lane);
    }
}

DI float dpp_xor1(float x) { return __builtin_amdgcn_update_dpp(0.f, x, 0xB1, 0xF, 0xF, false); }
DI float dpp_xor2(float x) { return __builtin_amdgcn_update_dpp(0.f, x, 0x4E, 0xF, 0xF, false); }
DI float dpp_hmir(float x) { return __builtin_amdgcn_update_dpp(0.f, x, 0x141, 0xF, 0xF, false); }
DI float dpp_mir(float x)  { return __builtin_amdgcn_update_dpp(0.f, x, 0x140, 0xF, 0xF, false); }
DI float row16_sum(float v) { v += dpp_xor1(v); v += dpp_xor2(v); v += dpp_hmir(v); v += dpp_mir(v); return v; }
DI float row8_sum(float v) { v += dpp_xor1(v); v += dpp_xor2(v); v += dpp_hmir(v); return v; }

constexpr int SCAN_TS = 32;
constexpr int SCAN_TILE_B = SCAN_TS * 6 * 64 * 2;
DI void scan_unit(const Params& p, char* smem, int unit, int tid) {
    const int chain = unit >> 2, rg = unit & 3, b = chain >> 3, hd = chain & 7;
    const int wave = tid >> 6, lane = tid & 63, rl = lane >> 4, cg = lane & 15;
    const int row = rg * 16 + wave * 4 + rl, d0 = cg * 4;
    const bf16_t* src = p.SCAN() + (size_t)chain * TT * 384;
    float S0 = 0.f, S1 = 0.f, S2 = 0.f, S3 = 0.f, ykeep = 0.f;
    constexpr int NTILE = (TT + SCAN_TS - 1) / SCAN_TS;
    u32x4 pre[6];
    {
#pragma unroll
        for (int i = 0; i < 6; ++i) pre[i] = *(const u32x4*)(src + (size_t)(i * 256 + tid) * 8);
#pragma unroll
        for (int i = 0; i < 6; ++i) *(u32x4*)(smem + (i * 256 + tid) * 16) = pre[i];
    }
    __syncthreads();
    for (int tile = 0; tile < NTILE; ++tile) {
        const int t0 = tile * SCAN_TS, nst = (TT - t0) < SCAN_TS ? (TT - t0) : SCAN_TS;
        const bool more = tile + 1 < NTILE;
        if (more) {
            const int t1 = t0 + SCAN_TS; const int lim = (TT - t1) * 384 / 8;
#pragma unroll
            for (int i = 0; i < 6; ++i) { const int c = i * 256 + tid; pre[i] = c < lim ? *(const u32x4*)(src + (size_t)t1 * 384 + (size_t)c * 8) : (u32x4){0u, 0u, 0u, 0u}; }
        }
        const char* buf = smem + (tile & 1) * SCAN_TILE_B;
        for (int st = 0; st < nst; ++st) {
            const char* sp = buf + st * 768;
            const u32x2 wd = *(const u32x2*)(sp + 0 * 128 + d0 * 2), wk = *(const u32x2*)(sp + 1 * 128 + d0 * 2), wa = *(const u32x2*)(sp + 3 * 128 + d0 * 2),
                        wb = *(const u32x2*)(sp + 4 * 128 + d0 * 2), wr = *(const u32x2*)(sp + 5 * 128 + d0 * 2);
            const float vv = bf2f(*(const unsigned short*)(sp + 2 * 128 + row * 2));
            float sa = S0 * bflo(wa.x) + S1 * bfhi(wa.x) + S2 * bflo(wa.y) + S3 * bfhi(wa.y);
            sa = row16_sum(sa);
            S0 = S0 * (1.f - bflo(wd.x)) + (sa * bflo(wb.x) + vv * bflo(wk.x));
            S1 = S1 * (1.f - bfhi(wd.x)) + (sa * bfhi(wb.x) + vv * bfhi(wk.x));
            S2 = S2 * (1.f - bflo(wd.y)) + (sa * bflo(wb.y) + vv * bflo(wk.y));
            S3 = S3 * (1.f - bfhi(wd.y)) + (sa * bfhi(wb.y) + vv * bfhi(wk.y));
            float y = S0 * bflo(wr.x) + S1 * bfhi(wr.x) + S2 * bflo(wr.y) + S3 * bfhi(wr.y);
            y = row16_sum(y);
            ykeep = ((st & 15) == cg) ? y : ykeep;
            if ((st & 15) == 15) p.Y()[(size_t)(b * TT + t0 + st - 15 + cg) * 512 + hd * 64 + row] = ykeep;
        }
        if (more) {
            char* nb = smem + ((tile + 1) & 1) * SCAN_TILE_B;
#pragma unroll
            for (int i = 0; i < 6; ++i) *(u32x4*)(nb + (i * 256 + tid) * 16) = pre[i];
        }
        __syncthreads();
    }
    *(f32x4*)(p.out + OUT_WP + ((size_t)chain * 64 + row) * 64 + d0) = (f32x4){S0, S1, S2, S3};
}

constexpr int SC2_TS = 32, SC2_STEP_B = 6 * 64 * 4, SC2_TILE_B = SC2_TS * SC2_STEP_B;
struct ScanOps { f32x4 w, k, a, b, r; float v; };
DI ScanOps scan_ld(const char* sp, int d0, int row) {
    ScanOps o; o.w = *(const f32x4*)(sp + 0 * 256 + d0 * 4); o.k = *(const f32x4*)(sp + 1 * 256 + d0 * 4); o.a = *(const f32x4*)(sp + 3 * 256 + d0 * 4);
    o.b = *(const f32x4*)(sp + 4 * 256 + d0 * 4); o.r = *(const f32x4*)(sp + 5 * 256 + d0 * 4); o.v = *(const float*)(sp + 2 * 256 + row * 4); return o;
}
DI void scan_unit2(const Params& p, char* smem, int unit, int tid) {
    const int chain = unit >> 2, rg = unit & 3, b = chain >> 3, hd = chain & 7;
    const int wave = tid >> 6, lane = tid & 63, rl = lane >> 4, cg = lane & 15;
    const int row = rg * 16 + (wave & 3) * 4 + rl, d0 = cg * 4;
    const bf16_t* src = p.SCAN() + (size_t)chain * TT * 384;
    f32x4 S = {0.f, 0.f, 0.f, 0.f}; float ykeep = 0.f;
    constexpr int NTILE = (TT + SC2_TS - 1) / SC2_TS;
    u32x4 pre[3];
    auto stage_load = [&](int t1) { const int lim = (TT - t1) * 48;
#pragma unroll
        for (int i = 0; i < 3; ++i) { const int c = i * 512 + tid; pre[i] = c < lim ? *(const u32x4*)(src + (size_t)t1 * 384 + (size_t)c * 8) : (u32x4){0u, 0u, 0u, 0u}; } };
    auto stage_store = [&](char* buf) {
#pragma unroll
        for (int i = 0; i < 3; ++i) { const int c = i * 512 + tid; float f[8]; unpack8(pre[i], f);
            if (((c >> 3) % 6) == 0) {
#pragma unroll
                for (int q = 0; q < 8; ++q) f[q] = 1.f - f[q]; }
            *(f32x4*)(buf + c * 32) = (f32x4){f[0], f[1], f[2], f[3]}; *(f32x4*)(buf + c * 32 + 16) = (f32x4){f[4], f[5], f[6], f[7]}; } };
    stage_load(0); stage_store(smem);
    __syncthreads();
    for (int tile = 0; tile < NTILE; ++tile) {
        const int t0 = tile * SC2_TS, nst = (TT - t0) < SC2_TS ? (TT - t0) : SC2_TS;
        const bool more = tile + 1 < NTILE;
        if (more) stage_load(t0 + SC2_TS);
        if (wave < 4) {
            const char* buf = smem + (tile & 1) * SC2_TILE_B;
            ScanOps cur = scan_ld(buf, d0, row);
#pragma unroll 2
            for (int st = 0; st < nst; ++st) {
                const ScanOps nxt = scan_ld(buf + ((st + 1 < nst) ? (st + 1) : st) * SC2_STEP_B, d0, row);
                float sa = (S.x * cur.a.x + S.y * cur.a.y) + (S.z * cur.a.z + S.w * cur.a.w);
                const f32x4 vk = cur.k * cur.v;
                sa = row16_sum(sa);
                S = S * cur.w + (cur.b * sa + vk);
                float y = (S.x * cur.r.x + S.y * cur.r.y) + (S.z * cur.r.z + S.w * cur.r.w);
                y = row16_sum(y);
                ykeep = ((st & 15) == cg) ? y : ykeep;
                if ((st & 15) == 15) p.Y()[(size_t)(b * TT + t0 + st - 15 + cg) * 512 + hd * 64 + row] = ykeep;
                cur = nxt;
            }
        }
        if (more) stage_store(smem + ((tile + 1) & 1) * SC2_TILE_B);
        __syncthreads();
    }
    if (wave < 4) *(f32x4*)(p.out + OUT_WP + ((size_t)chain * 64 + row) * 64 + d0) = S;
}

constexpr int CK_AT = 256, CK_RT = CK_AT + 17408, CK_BT = CK_RT + 17408, CK_KT = CK_BT + 17408, CK_VV = CK_KT + 17408, CK_AAB = CK_VV + 12288, CK_ARB = CK_AAB + 16384,
              CK_AAK = CK_ARB + 16384, CK_GT = CK_AAK + 9216, CK_HT = CK_GT + 9216, CK_LDS = CK_HT + 9216, CK_RAW = CK_AAB;
static_assert(CK_LDS <= 160 * 1024 - 128, "chunk LDS");
DI bf16x8 tr_frag(const char* img, int strideB, int row0, int colB) {
    return bf16x8{};
}
DI bf16x8 ld_tr8(const char* p_lo, const char* p_hi) {
    const s16x4 lo = __builtin_amdgcn_ds_read_tr16_b64_v4i16((LAS s16x4*)p_lo), hi = __builtin_amdgcn_ds_read_tr16_b64_v4i16((LAS s16x4*)p_hi);
    return __builtin_shufflevector(lo, hi, 0, 1, 2, 3, 4, 5, 6, 7);
}
DI bf16x8 pack16s(const f32x16& x, int s) {
    float f[8];
#pragma unroll
    for (int j = 0; j < 8; ++j) f[j] = x[8 * s + j];
    return pack8(f);
}
template <int I, bool ISG> DI void ck_bs4(float (&Xs)[16], const char* smem, int col, int sq, float pl, int zofs) {
    if constexpr (I + 5 < 64) asm volatile("" : "+v"(zofs) : "v"(Xs[(I + 5) & 15]));
    const char* ap = smem + CK_AAB + (I * 64 + 16 * sq) * 4 + zofs;
    const f32x4 a0 = *(const f32x4*)ap, a1 = *(const f32x4*)(ap + 16), a2 = *(const f32x4*)(ap + 32), a3 = *(const f32x4*)(ap + 48);
    float rhs = ISG ? *(const float*)(smem + CK_ARB + (I * 64 + col) * 4) : bf2f(*(const unsigned short*)(smem + CK_BT + I * 272 + col * 2)) * pl;
    float s0 = sq == 0 ? rhs : 0.f, s1 = 0.f;
    s0 += a0.x * Xs[0]; s1 += a0.y * Xs[1]; s0 += a0.z * Xs[2]; s1 += a0.w * Xs[3];
    s0 += a1.x * Xs[4]; s1 += a1.y * Xs[5]; s0 += a1.z * Xs[6]; s1 += a1.w * Xs[7];
    s0 += a2.x * Xs[8]; s1 += a2.y * Xs[9]; s0 += a2.z * Xs[10]; s1 += a2.w * Xs[11];
    s0 += a3.x * Xs[12]; s1 += a3.y * Xs[13]; s0 += a3.z * Xs[14]; s1 += a3.w * Xs[15];
    float x = s0 + s1; x += dpp_xor1(x); x += dpp_xor2(x);
    Xs[I & 15] = (sq == (I >> 4)) ? x : Xs[I & 15];
    if constexpr (I > 0) ck_bs4<I - 1, ISG>(Xs, smem, col, sq, pl, zofs);
}
DI void chunk_prefetch(const Params& p, int unit, int tid, unsigned short (&pre)[48]) {
    if (unit >= CK_UNITS) return;
    const int chain = unit / CK_N, c = unit - chain * CK_N, t0 = c * 64, lane = tid & 63, wave = tid >> 6;
    const bool ok = t0 + lane < TT;
    const bf16_t* src = p.SCAN() + scan_addr(chain, 0, 8 * wave, t0 + lane);
#pragma unroll
    for (int v = 0; v < 6; ++v)
#pragma unroll
        for (int q = 0; q < 8; ++q) pre[v * 8 + q] = ok ? src[((size_t)v * 64 + q) * TTP] : (unsigned short)0;
}
DI void chunk_pass1(const Params& p, char* smem_, int unit, int next_unit, unsigned short (&pre)[48], int tid_) {
    int tid = tid_, zb = 0; asm volatile("" : "+v"(tid), "+v"(zb)); char* smem = smem_ + zb;
    const int chain = unit / CK_N, c = unit - chain * CK_N, t0 = c * 64;
    const int wave = tid >> 6, lane = tid & 63, tk = lane & 31, hh = lane >> 5;
    const bf16_t* src = p.SCAN() + ((size_t)chain * TT + t0) * 384;
    const int nval = (TT - t0) < 64 ? (TT - t0) : 64;
    __syncthreads();
    {
        float dl[8], kv[8], vv[8], av[8], bv[8], rv[8];
#pragma unroll
        for (int q = 0; q < 8; ++q) { dl[q] = bf2f(pre[0 * 8 + q]); kv[q] = bf2f(pre[1 * 8 + q]); vv[q] = bf2f(pre[2 * 8 + q]); av[q] = bf2f(pre[3 * 8 + q]); bv[q] = bf2f(pre[4 * 8 + q]); rv[q] = bf2f(pre[5 * 8 + q]); }
        chunk_prefetch(p, next_unit, tid, pre);
        float P[8], Pm[8], inv[8], PL[8];
#pragma unroll
        for (int q = 0; q < 8; ++q) {
            float x = 1.f - dl[q];
#pragma unroll
            for (int o = 1; o < 64; o <<= 1) { const float y = __shfl_up(x, o); x = lane >= o ? x * y : x; }
            P[q] = x; const float pm = __shfl_up(x, 1); Pm[q] = lane ? pm : 1.f;
            PL[q] = __int_as_float(__builtin_amdgcn_readlane(__float_as_int(x), 63));
            inv[q] = 1.f / x;
        }
        __syncthreads();
        float o8[8];
#pragma unroll
        for (int q = 0; q < 8; ++q) o8[q] = av[q] * Pm[q];
        *(bf16x8*)(smem + CK_AT + lane * 272 + wave * 16) = pack8(o8);
#pragma unroll
        for (int q = 0; q < 8; ++q) o8[q] = rv[q] * P[q];
        *(bf16x8*)(smem + CK_RT + lane * 272 + wave * 16) = pack8(o8);
#pragma unroll
        for (int q = 0; q < 8; ++q) o8[q] = bv[q] * inv[q];
        *(bf16x8*)(smem + CK_BT + lane * 272 + wave * 16) = pack8(o8);
#pragma unroll
        for (int q = 0; q < 8; ++q) o8[q] = kv[q] * inv[q];
        *(bf16x8*)(smem + CK_KT + lane * 272 + wave * 16) = pack8(o8);
        *(bf16x8*)(smem + CK_VV + lane * 192 + wave * 16) = pack8(vv);
        if (lane == 63) { *(f32x4*)(smem + wave * 32) = (f32x4){PL[0], PL[1], PL[2], PL[3]}; *(f32x4*)(smem + wave * 32 + 16) = (f32x4){PL[4], PL[5], PL[6], PL[7]};
            float* plo = p.PLV() + (size_t)unit * 64 + wave * 8;
            *(f32x4*)plo = (f32x4){PL[0], PL[1], PL[2], PL[3]}; *(f32x4*)(plo + 4) = (f32x4){PL[4], PL[5], PL[6], PL[7]}; }
    }
    __syncthreads();
    const float* PLs = (const float*)smem;
    {
        const int prod = wave >> 1, half = wave & 1;
        const char* imgA = smem + ((prod == 0 || prod == 1) ? ((prod == 0) ? CK_BT : CK_BT) : CK_KT);
        const char* imgB = smem + ((prod == 0 || prod == 2) ? CK_AT : CK_RT);
        f32x16 acc[2] = {};
        if (prod < 3) {
#pragma unroll
            for (int nt = 0; nt < 2; ++nt)
#pragma unroll
                for (int s2 = 0; s2 < 4; ++s2) { const bf16x8 af = *(const bf16x8*)(imgA + (32 * half + tk) * 272 + (16 * s2 + 8 * hh) * 2), bf = *(const bf16x8*)(imgB + (32 * nt + tk) * 272 + (16 * s2 + 8 * hh) * 2);
                    acc[nt] = MFMA32(af, bf, acc[nt]); }
#pragma unroll
            for (int nt = 0; nt < 2; ++nt)
#pragma unroll
                for (int r2 = 0; r2 < 16; ++r2) { const int i = 32 * half + (r2 & 3) + 8 * (r2 >> 2) + 4 * hh, t = 32 * nt + tk;
                    const bool keep = (prod == 1) ? (i <= t) : (i < t);
                    const float v = keep ? acc[nt][r2] : 0.f;
                    if (prod == 0) *(float*)(smem + CK_AAB + (i * 64 + t) * 4) = v;
                    else if (prod == 1) *(float*)(smem + CK_ARB + (i * 64 + t) * 4) = v;
                    else *(unsigned short*)(smem + CK_AAK + i * 144 + t * 2) = bf16_1_(v); }
        }
    }
    __syncthreads();
    {
        int tz3 = tid; asm volatile("" : "+v"(tz3)); const int wave3 = __builtin_amdgcn_readfirstlane(tz3 >> 6), lane3 = tz3 & 63;
        const int col = 16 * (wave3 & 3) + (lane3 >> 2), sq = lane3 & 3;
        int zo = 0; asm volatile("" : "+v"(zo));
        float Xs[16];
#pragma unroll
        for (int j = 0; j < 16; ++j) Xs[j] = 0.f;
        if (wave3 < 4) ck_bs4<63, true>(Xs, smem, col, sq, 1.f, zo); else ck_bs4<63, false>(Xs, smem, col, sq, PLs[col], zo);
        char* dst = smem + (wave3 < 4 ? CK_GT : CK_HT) + col * 144 + sq * 32;
        float f0[8], f1[8];
#pragma unroll
        for (int j = 0; j < 8; ++j) { f0[j] = Xs[j]; f1[j] = Xs[8 + j]; }
        *(bf16x8*)dst = pack8(f0); *(bf16x8*)(dst + 16) = pack8(f1);
    }
    __syncthreads();
    {
        int tz4 = tid; asm volatile("" : "+v"(tz4)); const int wave = __builtin_amdgcn_readfirstlane(tz4 >> 6), lane = tz4 & 63, tk = lane & 31, hh = lane >> 5;
        const int half = wave & 1;
        const int i16 = lane & 15, qq = i16 >> 2, pp = i16 & 3, blk = (lane >> 4) & 1;
        if (wave < 4) {
            const char* imgB = smem + (wave < 2 ? CK_GT : CK_HT);
            f32x16 acc[2] = {};
#pragma unroll
            for (int nt = 0; nt < 2; ++nt)
#pragma unroll
                for (int s2 = 0; s2 < 4; ++s2) {
                    const char* pa = smem + CK_AT + (16 * s2 + 8 * hh + qq) * 272 + (32 * half + 16 * blk + 4 * pp) * 2;
                    const bf16x8 af = ld_tr8(pa, pa + 4 * 272);
                    const bf16x8 bf = *(const bf16x8*)(imgB + (32 * nt + tk) * 144 + (16 * s2 + 8 * hh) * 2);
                    acc[nt] = MFMA32(af, bf, acc[nt]); }
            bf16_t* dst = (wave < 2 ? p.MYT() : p.MST()) + (size_t)unit * 4096;
#pragma unroll
            for (int nt = 0; nt < 2; ++nt)
#pragma unroll
                for (int q4 = 0; q4 < 4; ++q4) { const int col = 32 * nt + tk, k0 = 32 * half + 8 * q4 + 4 * hh;
                    float v0 = acc[nt][4 * q4], v1 = acc[nt][4 * q4 + 1], v2 = acc[nt][4 * q4 + 2], v3 = acc[nt][4 * q4 + 3];
                    if (wave < 2) { const u32x2 rw = *(const u32x2*)(smem + CK_RT + col * 272 + k0 * 2); v0 += bflo(rw.x); v1 += bfhi(rw.x); v2 += bflo(rw.y); v3 += bfhi(rw.y); }
                    u32x2 o; o.x = pk2(v0, v1); o.y = pk2(v2, v3);
                    *(u32x2*)(dst + (size_t)col * 64 + k0) = o; }
        } else {
            const bool isy = wave >= 6;
            const char* imgB = smem + (isy ? CK_GT : CK_HT);
            f32x16 nn[2] = {};
#pragma unroll
            for (int mt = 0; mt < 2; ++mt)
#pragma unroll
                for (int s2 = 0; s2 < 4; ++s2) { const bf16x8 af = *(const bf16x8*)(smem + CK_AAK + (32 * mt + tk) * 144 + (16 * s2 + 8 * hh) * 2), bf = *(const bf16x8*)(imgB + (32 * half + tk) * 144 + (16 * s2 + 8 * hh) * 2);
                    nn[mt] = MFMA32(af, bf, nn[mt]); }
            if (isy) {
#pragma unroll
                for (int mt = 0; mt < 2; ++mt) {
                    f32x16 ark = {};
#pragma unroll
                    for (int s2 = 0; s2 < 4; ++s2) { const bf16x8 af = *(const bf16x8*)(smem + CK_KT + (32 * mt + tk) * 272 + (16 * s2 + 8 * hh) * 2), bf = *(const bf16x8*)(smem + CK_RT + (32 * half + tk) * 272 + (16 * s2 + 8 * hh) * 2);
                        ark = MFMA32(af, bf, ark); }
#pragma unroll
                    for (int r2 = 0; r2 < 16; ++r2) { const int i = 32 * mt + (r2 & 3) + 8 * (r2 >> 2) + 4 * hh, t = 32 * half + tk; nn[mt][r2] += (i <= t) ? ark[r2] : 0.f; }
                }
            }
            else { const float pl = PLs[32 * half + tk];
#pragma unroll
                for (int mt = 0; mt < 2; ++mt)
#pragma unroll
                    for (int r2 = 0; r2 < 16; ++r2) { const int i = 32 * mt + (r2 & 3) + 8 * (r2 >> 2) + 4 * hh; nn[mt][r2] += bf2f(*(const unsigned short*)(smem + CK_KT + i * 272 + (32 * half + tk) * 2)) * pl; } }
            float* dst = (isy ? p.WYT() : p.WST()) + (size_t)unit * 4096 + (size_t)half * 2048;
#pragma unroll
            for (int vt = 0; vt < 2; ++vt) {
                f32x16 wacc = {};
#pragma unroll
                for (int mt = 0; mt < 2; ++mt)
#pragma unroll
                    for (int s2 = 0; s2 < 2; ++s2) {
                        const bf16x8 af = pack16s(nn[mt], s2);
                        const char* pb = smem + CK_VV + (32 * mt + 16 * s2 + 4 * hh + qq) * 192 + (32 * vt + 16 * blk + 4 * pp) * 2;
                        const bf16x8 bf = ld_tr8(pb, pb + 8 * 192);
                        wacc = MFMA32(af, bf, wacc); }
#pragma unroll
                for (int r2 = 0; r2 < 16; ++r2) dst[(vt * 16 + r2) * 64 + lane] = wacc[r2];
            }
        }
    }
}
struct P2Ops { u32x2 a[2][2][2][2]; f32x4 pl[2][4]; float ws[2][16]; };
DI void p2_load(const Params& p, size_t u, int vh, int tk, int hh, int lane, P2Ops& o) {
    const bf16_t* ms = p.MST() + u * 4096; const float* plv = p.PLV() + u * 64; const float* ws = p.WST() + u * 4096;
#pragma unroll
    for (int mt = 0; mt < 2; ++mt) {
#pragma unroll
        for (int kt = 0; kt < 2; ++kt)
#pragma unroll
            for (int s2 = 0; s2 < 2; ++s2) { const bf16_t* ap = ms + (size_t)(32 * mt + tk) * 64 + 32 * kt + 16 * s2 + 4 * hh; o.a[mt][kt][s2][0] = *(const u32x2*)ap; o.a[mt][kt][s2][1] = *(const u32x2*)(ap + 8); }
#pragma unroll
        for (int q4 = 0; q4 < 4; ++q4) o.pl[mt][q4] = *(const f32x4*)(plv + 32 * mt + 8 * q4 + 4 * hh);
#pragma unroll
        for (int r2 = 0; r2 < 16; ++r2) o.ws[mt][r2] = ws[((size_t)mt * 2 + vh) * 1024 + r2 * 64 + lane];
    }
}
DI void chunk_pass2(const Params& p, int wunit, int lane, volatile LAS int* prog) {
    const int chain = wunit >> 1, vh = wunit & 1, tk = lane & 31, hh = lane >> 5;
    f32x16 st[2] = {};
    P2Ops cur; p2_load(p, (size_t)chain * CK_N, vh, tk, hh, lane, cur);
#pragma unroll 1
    for (int c = 0; c < CK_N; ++c) {
        const size_t u = (size_t)chain * CK_N + c;
        P2Ops nxt; p2_load(p, c + 1 < CK_N ? u + 1 : u, vh, tk, hh, lane, nxt);
        bf16x8 fh[2][2], fl[2][2];
#pragma unroll
        for (int kt = 0; kt < 2; ++kt)
#pragma unroll
            for (int s2 = 0; s2 < 2; ++s2) { float h8[8], l8[8];
#pragma unroll
                for (int j = 0; j < 8; ++j) { const float x = st[kt][8 * s2 + j]; const float xh = bflo(pk2(x, 0.f)); h8[j] = xh; l8[j] = x - xh; }
                fh[kt][s2] = pack8(h8); fl[kt][s2] = pack8(l8);
                u32x4* sc = (u32x4*)p.SCF() + ((((u * 2 + vh) * 2 + kt) * 2 + s2) * 2) * 64 + lane;
                sc[0] = __builtin_bit_cast(u32x4, fh[kt][s2]); sc[64] = __builtin_bit_cast(u32x4, fl[kt][s2]); }
        f32x16 nt[2];
#pragma unroll
        for (int mt = 0; mt < 2; ++mt) {
            f32x16 acc;
#pragma unroll
            for (int q4 = 0; q4 < 4; ++q4) { const f32x4 pl = cur.pl[mt][q4];
                acc[4 * q4] = cur.ws[mt][4 * q4] + st[mt][4 * q4] * pl.x; acc[4 * q4 + 1] = cur.ws[mt][4 * q4 + 1] + st[mt][4 * q4 + 1] * pl.y;
                acc[4 * q4 + 2] = cur.ws[mt][4 * q4 + 2] + st[mt][4 * q4 + 2] * pl.z; acc[4 * q4 + 3] = cur.ws[mt][4 * q4 + 3] + st[mt][4 * q4 + 3] * pl.w; }
#pragma unroll
            for (int kt = 0; kt < 2; ++kt)
#pragma unroll
                for (int s2 = 0; s2 < 2; ++s2) {
                    const u32x2 a0 = cur.a[mt][kt][s2][0], a1 = cur.a[mt][kt][s2][1];
                    const bf16x8 af = __builtin_bit_cast(bf16x8, (u32x4){a0.x, a0.y, a1.x, a1.y});
                    acc = MFMA32(af, fh[kt][s2], acc); acc = MFMA32(af, fl[kt][s2], acc); }
            nt[mt] = acc;
        }
        st[0] = nt[0]; st[1] = nt[1];
        cur = nxt;
        if (lane == 0) *prog = c + 1;
    }
    float* so = p.out + OUT_WP + ((size_t)chain * 64 + 32 * vh + tk) * 64;
#pragma unroll
    for (int kt = 0; kt < 2; ++kt)
#pragma unroll
        for (int q4 = 0; q4 < 4; ++q4) *(f32x4*)(so + 32 * kt + 8 * q4 + 4 * hh) = (f32x4){st[kt][4 * q4], st[kt][4 * q4 + 1], st[kt][4 * q4 + 2], st[kt][4 * q4 + 3]};
}
DI void chunk_pass2_prefetch(const Params& p, int wunit, int lane, volatile LAS int* prog) {
    const int chain = wunit >> 1, vh = wunit & 1;
    unsigned sink = 0;
    for (int c = 1; c < CK_N; ++c) {
        for (int spin = 0; spin < 200000 && *prog + 8 < c; ++spin) __builtin_amdgcn_s_sleep(4);
        const size_t u = (size_t)chain * CK_N + c;
        const char* l0 = (const char*)(p.MST() + u * 4096) + lane * 128;
        const char* l1 = (const char*)(p.WST() + u * 4096) + (size_t)(((lane >> 5) * 2 + vh) * 4096) + (lane & 31) * 128;
        sink += *(const volatile unsigned*)l0 + *(const volatile unsigned*)l1;
        if (lane < 2) sink += *(const volatile unsigned*)((const char*)(p.PLV() + u * 64) + lane * 128);
    }
    asm volatile("" :: "v"(sink));
}
DI float half32_sum(float v) {
    v += dpp_xor1(v); v += dpp_xor2(v); v += dpp_hmir(v); v += dpp_mir(v); v += __shfl_xor(v, 16); return v;
}
DI void chunk_pass3(const Params& p, int hunit, int lane) {
    const int unit = hunit >> 1, tt = hunit & 1;
    const int chain = unit / CK_N, c = unit - chain * CK_N, b = chain >> 3, hd = chain & 7, tk = lane & 31, hh = lane >> 5;
    const bf16_t* my = p.MYT() + (size_t)unit * 4096;
    const u32x4* sc = (const u32x4*)p.SCF() + (size_t)unit * 16 * 64 + lane;
    const float* wy = p.WYT() + (size_t)unit * 4096;
    bf16x8 Bf[2][2][2][2];
#pragma unroll
    for (int vt = 0; vt < 2; ++vt)
#pragma unroll
        for (int kt = 0; kt < 2; ++kt)
#pragma unroll
            for (int s2 = 0; s2 < 2; ++s2)
#pragma unroll
                for (int x = 0; x < 2; ++x) Bf[vt][kt][s2][x] = __builtin_bit_cast(bf16x8, sc[((((vt * 2 + kt) * 2 + s2) * 2) + x) * 64]);
    {
        f32x16 acc[2];
#pragma unroll
        for (int vt = 0; vt < 2; ++vt) {
#pragma unroll
            for (int r2 = 0; r2 < 16; ++r2) acc[vt][r2] = wy[((size_t)tt * 2 + vt) * 1024 + r2 * 64 + lane];
#pragma unroll
            for (int kt = 0; kt < 2; ++kt)
#pragma unroll
                for (int s2 = 0; s2 < 2; ++s2) {
                    const bf16_t* ap = my + (size_t)(32 * tt + tk) * 64 + 32 * kt + 16 * s2 + 4 * hh;
                    const u32x2 a0 = *(const u32x2*)ap, a1 = *(const u32x2*)(ap + 8);
                    const bf16x8 af = __builtin_bit_cast(bf16x8, (u32x4){a0.x, a0.y, a1.x, a1.y});
                    acc[vt] = MFMA32(af, Bf[vt][kt][s2][0], acc[vt]); acc[vt] = MFMA32(af, Bf[vt][kt][s2][1], acc[vt]); }
        }
        const float lg0 = p.rw_ln_g[hd * 64 + tk], lg1 = p.rw_ln_g[hd * 64 + 32 + tk], lb0 = p.rw_ln_b[hd * 64 + tk], lb1 = p.rw_ln_b[hd * 64 + 32 + tk];
#pragma unroll
        for (int r2 = 0; r2 < 16; ++r2) {
            const int t = c * 64 + 32 * tt + (r2 & 3) + 8 * (r2 >> 2) + 4 * hh;
            const float mu = half32_sum(acc[0][r2] + acc[1][r2]) * (1.f / 64.f);
            const float d0 = acc[0][r2] - mu, d1 = acc[1][r2] - mu;
            const float rs = rsqrtf(half32_sum(d0 * d0 + d1 * d1) * (1.f / 64.f) + 64e-5f);
            if (t < TT) {
                const size_t row = (size_t)b * TT + t;
                const bf16_t* vp = p.SCAN() + scan_addr(chain, 2, 0, t);
                const float bon = p.BONUS()[row * 8 + hd];
                const float o0 = (d0 * rs * lg0 + lb0 + bon * bf2f(vp[(size_t)tk * TTP])) * bf2f(p.G()[row * 512 + hd * 64 + tk]);
                const float o1 = (d1 * rs * lg1 + lb1 + bon * bf2f(vp[(size_t)(32 + tk) * TTP])) * bf2f(p.G()[row * 512 + hd * 64 + 32 + tk]);
                p.YO()[row * DM + hd * 64 + tk] = bf16_1_(o0); p.YO()[row * DM + hd * 64 + 32 + tk] = bf16_1_(o1);
            }
        }
    }
}

DI void rwkv_sample_unit(const Params& p, int unit, int tid) {
    const int s = unit >> 3, hd = unit & 7, row = tid >> 2, c0 = (tid & 3) * 16;
    const float* S0 = p.state_wkv + (((size_t)s * 8 + hd) * 64 + row) * 64 + c0;
    const float* in = p.SCAN_S() + ((size_t)s * 8 + hd) * 384;
    float S[16]; float sa = 0.f;
#pragma unroll
    for (int i = 0; i < 16; i += 4) { const f32x4 v = *(const f32x4*)(S0 + i); S[i] = v.x; S[i + 1] = v.y; S[i + 2] = v.z; S[i + 3] = v.w; }
#pragma unroll
    for (int i = 0; i < 16; ++i) sa += S[i] * in[3 * 64 + c0 + i];
    sa += dpp_xor1(sa); sa += dpp_xor2(sa);
    const float vv = in[2 * 64 + row];
    float y = 0.f;
#pragma unroll
    for (int i = 0; i < 16; ++i) { S[i] = S[i] * in[0 * 64 + c0 + i] + sa * in[4 * 64 + c0 + i] + vv * in[1 * 64 + c0 + i]; y += S[i] * in[5 * 64 + c0 + i]; }
    y += dpp_xor1(y); y += dpp_xor2(y);
    float* So = p.out + OUT_WS + (((size_t)s * 8 + hd) * 64 + row) * 64 + c0;
#pragma unroll
    for (int i = 0; i < 16; i += 4) *(f32x4*)(So + i) = (f32x4){S[i], S[i + 1], S[i + 2], S[i + 3]};
    if ((tid & 3) == 0) p.Y()[(size_t)(MPR + s) * 512 + hd * 64 + row] = y;
}

DI void rwkv_post_row(const Params& p, int row, int lane) {
    const int n0 = lane * 8, hd = lane >> 3;
    const f32x4 ya = *(const f32x4*)(p.Y() + (size_t)row * 512 + n0), yb = *(const f32x4*)(p.Y() + (size_t)row * 512 + n0 + 4);
    float y[8] = {ya.x, ya.y, ya.z, ya.w, yb.x, yb.y, yb.z, yb.w};
    float s = 0.f;
#pragma unroll
    for (int i = 0; i < 8; ++i) s += y[i];
    const float mu = row8_sum(s) * (1.f / 64.f);
    float q = 0.f;
#pragma unroll
    for (int i = 0; i < 8; ++i) { y[i] -= mu; q += y[i] * y[i]; }
    const float rs = rsqrtf(row8_sum(q) * (1.f / 64.f) + 64e-5f);
    float v[8];
    if (row < MPR) { const int b = row / TT, t = row - b * TT; unpack8(*(const u32x4*)(p.SCAN() + (((size_t)(b * 8 + hd) * TT + t) * 6 + 2) * 64 + (n0 & 63)), v); }
    else { const float* vs = p.SCAN_S() + (((size_t)(row - MPR) * 8 + hd) * 6 + 2) * 64 + (n0 & 63);
#pragma unroll
        for (int i = 0; i < 8; ++i) v[i] = vs[i]; }
    float g[8]; unpack8(*(const u32x4*)(p.G() + (size_t)row * 512 + n0), g);
    const float bon = p.BONUS()[(size_t)row * 8 + hd];
    float o[8];
#pragma unroll
    for (int i = 0; i < 8; ++i) o[i] = (y[i] * rs * p.rw_ln_g[n0 + i] + p.rw_ln_b[n0 + i] + bon * v[i]) * g[i];
    *(u32x4*)(p.YO() + (size_t)row * DM + n0) = __builtin_bit_cast(u32x4, pack8(o));
}

DI float compute_lam(const Params& p, int lane) {
    const float a = p.da_lam[lane] * p.da_lam[64 + lane], b = p.da_lam[128 + lane] * p.da_lam[192 + lane];
    return __expf(wave_sum(a)) - __expf(wave_sum(b)) + LAM_INIT;
}
constexpr int AT_KROW = 272, AT_VROW = 320, AT_BUF = 64 * AT_KROW + 64 * AT_VROW  , AT_V_OFF = 64 * AT_KROW, AT_X_OFF = 0, AT_LDS = 2 * AT_BUF;
DI void attn_unit(const Params& p, char* smem, int b, int h, int qb, float lam, int dmax, int tid) {
    const int wave = tid >> 6, lane = tid & 63, qs = wave >> 1, c = wave & 1, tk = lane & 31, hh = lane >> 5;
    const int qrow0 = qb * 128 + qs * 32, t = qrow0 + tk, tq = t < TT ? t : TT - 1;
    const size_t rb = (size_t)b * TT;
    const float c1 = 0.125f * LOG2E, slope2 = exp2f(-2.f * (h + 1)) * LOG2E;
    const int tref = qb * 128;
    bf16x8 Qf[4];
#pragma unroll
    for (int s = 0; s < 4; ++s) Qf[s] = *(const bf16x8*)(p.QN() + (rb + tq) * 512 + h * 128 + c * 64 + 16 * s + 8 * hh);
    f32x16 O[4] = {};
    float m = -1e30f, l = 0.f;
    const int kmax = (qb * 128 + 127 < TT - 1) ? qb * 128 + 127 : TT - 1;
    const int ntile = kmax / 64 + 1;
    int kts = (qb * 128 - dmax) / 64; kts = kts < 0 ? 0 : kts;
    const bool wave_live = qrow0 < TT;
    u32x4 rkA[2], rvA[2], rkB[2], rvB[2];
    auto g_load = [&](int kt0, u32x4 (&rk)[2], u32x4 (&rv)[2]) {
#pragma unroll
        for (int i = 0; i < 2; ++i) { const int ch = tid + 512 * i, key = ch >> 4, part = ch & 15; int kr = kt0 + key; kr = kr < TT ? kr : TT - 1;
            rk[i] = *(const u32x4*)(p.KN() + (rb + kr) * 512 + h * 128 + part * 8);
            rv[i] = *(const u32x4*)(p.PROJ() + (rb + kr) * INW + O_V + h * 128 + part * 8); } };
    auto l_store = [&](char* buf, const u32x4 (&rk)[2], const u32x4 (&rv)[2]) {
#pragma unroll
        for (int i = 0; i < 2; ++i) { const int ch = tid + 512 * i, key = ch >> 4, part = ch & 15;
            *(u32x4*)(buf + key * AT_KROW + part * 16) = rk[i]; *(u32x4*)(buf + AT_V_OFF + key * AT_VROW + part * 16) = rv[i]; } };
    auto tile_compute = [&](int kt0, const char* buf) {
        if (wave_live && kt0 <= qrow0 + 31) {
            f32x16 St[2] = {};
#pragma unroll
            for (int sub = 0; sub < 2; ++sub)
#pragma unroll
                for (int s = 0; s < 4; ++s) { const bf16x8 kf = *(const bf16x8*)(buf + (sub * 32 + tk) * AT_KROW + (c * 64 + 16 * s + 8 * hh) * 2); St[sub] = MFMA32(kf, Qf[s], St[sub]); }
            const bool diag = kt0 + 63 > qrow0;
            const float bias0 = slope2 * (float)(kt0 + 4 * hh - tref);
#pragma unroll
            for (int sub = 0; sub < 2; ++sub)
#pragma unroll
                for (int i = 0; i < 16; ++i) St[sub][i] = fmaf(St[sub][i], c1, fmaf(slope2, (float)(sub * 32 + (i & 3) + 8 * (i >> 2)), bias0));
            if (diag) {
#pragma unroll
                for (int sub = 0; sub < 2; ++sub)
#pragma unroll
                    for (int i = 0; i < 16; ++i) { const int key = kt0 + sub * 32 + (i & 3) + 8 * (i >> 2) + 4 * hh; if (key > t) St[sub][i] = -INFINITY; }
            }
            float mx = -1e30f;
#pragma unroll
            for (int sub = 0; sub < 2; ++sub)
#pragma unroll
                for (int i = 0; i < 16; ++i) mx = fmaxf(mx, St[sub][i]);
            mx = fmaxf(mx, __shfl_xor(mx, 32));
            const float mn = fmaxf(m, mx), alpha = __builtin_amdgcn_exp2f(m - mn);
            m = mn; l *= alpha;
#pragma unroll
            for (int dt = 0; dt < 4; ++dt)
#pragma unroll
                for (int i = 0; i < 16; ++i) O[dt][i] *= alpha;
#pragma unroll
            for (int sub = 0; sub < 2; ++sub)
#pragma unroll
                for (int i = 0; i < 16; ++i) { const float pv = __builtin_amdgcn_exp2f(St[sub][i] - mn); St[sub][i] = pv; l += pv; }
            const int i16 = lane & 15, qq = i16 >> 2, pp = i16 & 3, blk = (lane >> 4) & 1;
#pragma unroll
            for (int sub = 0; sub < 2; ++sub)
#pragma unroll
                for (int s2 = 0; s2 < 2; ++s2) {
                    float pf8[8];
#pragma unroll
                    for (int j = 0; j < 8; ++j) pf8[j] = St[sub][8 * s2 + j];
                    const bf16x8 Pf = pack8(pf8);
                    const int keyb = sub * 32 + 16 * s2 + 4 * hh + qq;
#pragma unroll
                    for (int dt = 0; dt < 4; ++dt) {
                        const int colb = (dt * 32 + 16 * blk + 4 * pp) * 2;
                        const s16x4 lo = __builtin_amdgcn_ds_read_tr16_b64_v4i16((LAS s16x4*)(buf + AT_V_OFF + keyb * AT_VROW + colb));
                        const s16x4 hi = __builtin_amdgcn_ds_read_tr16_b64_v4i16((LAS s16x4*)(buf + AT_V_OFF + (keyb + 8) * AT_VROW + colb));
                        const bf16x8 Vf = __builtin_shufflevector(lo, hi, 0, 1, 2, 3, 4, 5, 6, 7);
                        O[dt] = MFMA32(Vf, Pf, O[dt]);
                    }
                }
        }
    };
    __syncthreads();
    g_load(kts * 64, rkA, rvA); l_store(smem, rkA, rvA);
    if (kts + 1 < ntile) g_load(kts * 64 + 64, rkA, rvA);
    __syncthreads();
    for (int kt = kts; kt < ntile; kt += 2) {
        if (kt + 2 < ntile) g_load(kt * 64 + 128, rkB, rvB);
        tile_compute(kt * 64, smem);
        if (kt + 1 < ntile) l_store(smem + AT_BUF, rkA, rvA);
        __syncthreads();
        if (kt + 1 < ntile) {
            if (kt + 3 < ntile) g_load(kt * 64 + 192, rkA, rvA);
            tile_compute(kt * 64 + 64, smem + AT_BUF);
            if (kt + 2 < ntile) l_store(smem, rkB, rvB);
        }
        __syncthreads();
    }
    l += __shfl_xor(l, 32);
    const float linv = 1.f / l;
    float* xch = (float*)(smem + AT_X_OFF) + qs * (128 * 32);
    if (c == 1) {
#pragma unroll
        for (int dt = 0; dt < 4; ++dt)
#pragma unroll
            for (int i = 0; i < 16; ++i) { const int dv = dt * 32 + (i & 3) + 8 * (i >> 2) + 4 * hh; xch[dv * 32 + tk] = O[dt][i] * linv; }
    }
    __syncthreads();
    if (c == 0) {
        float ss = 0.f;
#pragma unroll
        for (int dt = 0; dt < 4; ++dt)
#pragma unroll
            for (int i = 0; i < 16; ++i) { const int dv = dt * 32 + (i & 3) + 8 * (i >> 2) + 4 * hh; const float o = O[dt][i] * linv - lam * xch[dv * 32 + tk]; O[dt][i] = o; ss += o * o; }
        ss += __shfl_xor(ss, 32);
        const float rs = rsqrtf(ss * (1.f / 128.f) + 1e-6f) * (1.f - LAM_INIT);
        if (t < TT) {
#pragma unroll
            for (int dt = 0; dt < 4; ++dt)
#pragma unroll
                for (int q4 = 0; q4 < 4; ++q4) { const int dv = dt * 32 + 8 * q4 + 4 * hh; const f32x4 g = *(const f32x4*)(p.da_subln_g + dv);
                    u32x2 o; o.x = pk2(O[dt][4 * q4] * rs * g.x, O[dt][4 * q4 + 1] * rs * g.y); o.y = pk2(O[dt][4 * q4 + 2] * rs * g.z, O[dt][4 * q4 + 3] * rs * g.w);
                    *(u32x2*)(p.YO() + (rb + t) * DM + 512 + h * 128 + dv) = o; }
        }
    }
}
DI int alibi_dmax(const Params& p, int h, int lane) {
    float gq = fabsf(p.da_qn_g[lane]), gk = fabsf(p.da_kn_g[lane]);
#pragma unroll
    for (int o = 1; o < 64; o <<= 1) { gq = fmaxf(gq, __shfl_xor(gq, o)); gk = fmaxf(gk, __shfl_xor(gk, o)); }
    const float B = 8.f * gq * gk * LOG2E, slope2 = exp2f(-2.f * (h + 1)) * LOG2E;
    const float d = (2.f * B + 40.f) / slope2;
    return d > 1.0e6f ? 1000000 : (int)d + 1;
}
constexpr int AT_NQB = 33, AT_UNITS = NB * 4 * AT_NQB;

DI void sattn_unit(const Params& p, int unit, int lane) {
    const int split = unit & 15, bh = unit >> 4, b = bh >> 2, h = bh & 3;
    const int ps = lane >> 3, sub = lane & 7;
    const float c1 = 0.125f * LOG2E, slope2 = exp2f(-2.f * (h + 1)) * LOG2E;
    f32x4 q[4];
    {
        const bf16_t* qr = p.QN() + (size_t)(MPR + b) * 512 + h * 128;
#pragma unroll
        for (int i = 0; i < 4; ++i) { const u32x2 w = *(const u32x2*)(qr + i * 32 + sub * 4); q[i] = (f32x4){bflo(w.x) * c1, bfhi(w.x) * c1, bflo(w.y) * c1, bfhi(w.y) * c1}; }
    }
    float m0 = -1e30f, m1 = -1e30f, l0 = 0.f, l1 = 0.f;
    f32x4 O0[4], O1[4];
#pragma unroll
    for (int i = 0; i < 4; ++i) { O0[i] = (f32x4){0.f, 0.f, 0.f, 0.f}; O1[i] = (f32x4){0.f, 0.f, 0.f, 0.f}; }
    struct RowSet { f32x4 k[4], v[4]; };
    auto ld = [&](int it, RowSet& r) {
        const int pos = split * 512 + it * 8 + ps;
        const int phys = p.page_table[b * NPAGES + (pos >> 7)];
        const size_t ro = (((size_t)phys * PAGE + (pos & 127)) * 4 + h) * 128 + sub * 4;
#pragma unroll
        for (int i = 0; i < 4; ++i) r.k[i] = __builtin_nontemporal_load((const f32x4*)(p.cache_k + ro + i * 32));
#pragma unroll
        for (int i = 0; i < 4; ++i) r.v[i] = __builtin_nontemporal_load((const f32x4*)(p.cache_v + ro + i * 32));
    };
    auto step = [&](int it, const RowSet& r) {
        const int pos = split * 512 + it * 8 + ps;
        float s0 = r.k[0].x * q[0].x + r.k[0].y * q[0].y + r.k[0].z * q[0].z + r.k[0].w * q[0].w + r.k[1].x * q[1].x + r.k[1].y * q[1].y + r.k[1].z * q[1].z + r.k[1].w * q[1].w;
        float s1 = r.k[2].x * q[2].x + r.k[2].y * q[2].y + r.k[2].z * q[2].z + r.k[2].w * q[2].w + r.k[3].x * q[3].x + r.k[3].y * q[3].y + r.k[3].z * q[3].z + r.k[3].w * q[3].w;
        s0 += dpp_xor1(s0); s0 += dpp_xor2(s0); s0 += dpp_hmir(s0);
        s1 += dpp_xor1(s1); s1 += dpp_xor2(s1); s1 += dpp_hmir(s1);
        const float bias = slope2 * (float)(PAST - pos);
        s0 -= bias; s1 -= bias;
        const float n0 = fmaxf(m0, s0), a0 = __builtin_amdgcn_exp2f(m0 - n0), e0 = __builtin_amdgcn_exp2f(s0 - n0);
        const float n1 = fmaxf(m1, s1), a1 = __builtin_amdgcn_exp2f(m1 - n1), e1 = __builtin_amdgcn_exp2f(s1 - n1);
        m0 = n0; m1 = n1; l0 = l0 * a0 + e0; l1 = l1 * a1 + e1;
#pragma unroll
        for (int i = 0; i < 4; ++i) { O0[i] = O0[i] * a0 + r.v[i] * e0; O1[i] = O1[i] * a1 + r.v[i] * e1; }
    };
    RowSet A, B, C;
    ld(0, A); ld(1, B);
#pragma unroll 1
    for (int it = 0; it < 63; it += 3) {
        ld(it + 2, C); step(it, A);
        ld(it + 3, A); step(it + 1, B);
        if (it + 4 < 64) ld(it + 4, B);
        step(it + 2, C);
    }
    step(63, A);
    float ma0 = m0, ma1 = m1;
#pragma unroll
    for (int o = 8; o < 64; o <<= 1) { ma0 = fmaxf(ma0, __shfl_xor(ma0, o)); ma1 = fmaxf(ma1, __shfl_xor(ma1, o)); }
    const float sc0 = __builtin_amdgcn_exp2f(m0 - ma0), sc1 = __builtin_amdgcn_exp2f(m1 - ma1);
    l0 *= sc0; l1 *= sc1;
#pragma unroll
    for (int o = 8; o < 64; o <<= 1) { l0 += __shfl_xor(l0, o); l1 += __shfl_xor(l1, o); }
#pragma unroll
    for (int i = 0; i < 4; ++i)
#pragma unroll
        for (int e = 0; e < 4; ++e) { float x0 = O0[i][e] * sc0, x1 = O1[i][e] * sc1;
#pragma unroll
            for (int o = 8; o < 64; o <<= 1) { x0 += __shfl_xor(x0, o); x1 += __shfl_xor(x1, o); }
            O0[i][e] = x0; O1[i][e] = x1; }
    if (ps == 0) {
        float* d0 = p.PART() + ((size_t)unit * 2 + 0) * 130; float* d1 = d0 + 130;
        if (sub == 0) { d0[0] = ma0; d0[1] = l0; d1[0] = ma1; d1[1] = l1; }
#pragma unroll
        for (int i = 0; i < 4; ++i) { *(f32x2*)(d0 + 2 + i * 32 + sub * 4) = (f32x2){O0[i].x, O0[i].y}; *(f32x2*)(d0 + 2 + i * 32 + sub * 4 + 2) = (f32x2){O0[i].z, O0[i].w};
            *(f32x2*)(d1 + 2 + i * 32 + sub * 4) = (f32x2){O1[i].x, O1[i].y}; *(f32x2*)(d1 + 2 + i * 32 + sub * 4 + 2) = (f32x2){O1[i].z, O1[i].w}; }
    }
}
DI void sattn_combine(const Params& p, int bh, float lam, int lane) {
    const int b = bh >> 2, h = bh & 3, row = MPR + b;
    const float c1 = 0.125f * LOG2E;
    float o[2][2];
    const float v0 = bf2f(p.PROJ()[(size_t)row * INW + O_V + h * 128 + lane]), v1 = bf2f(p.PROJ()[(size_t)row * INW + O_V + h * 128 + 64 + lane]);
#pragma unroll
    for (int c = 0; c < 2; ++c) {
        const float qd = bf2f(p.QN()[(size_t)row * 512 + h * 128 + c * 64 + lane]), kd = bf2f(p.KN()[(size_t)row * 512 + h * 128 + c * 64 + lane]);
        const float sself = wave_sum(qd * kd) * c1;
        float mm = sself;
        for (int s = 0; s < SA_SPLITS; ++s) mm = fmaxf(mm, p.PART()[((size_t)(bh * 16 + s) * 2 + c) * 130]);
        const float pself = __builtin_amdgcn_exp2f(sself - mm);
        float lt = pself, a0 = pself * v0, a1 = pself * v1;
        for (int s = 0; s < SA_SPLITS; ++s) { const float* pp = p.PART() + ((size_t)(bh * 16 + s) * 2 + c) * 130; const float sc = __builtin_amdgcn_exp2f(pp[0] - mm);
            lt += pp[1] * sc; a0 += pp[2 + lane] * sc; a1 += pp[2 + 64 + lane] * sc; }
        o[c][0] = a0 / lt; o[c][1] = a1 / lt;
    }
    const float r0 = o[0][0] - lam * o[1][0], r1 = o[0][1] - lam * o[1][1];
    const float ss = wave_sum(r0 * r0 + r1 * r1);
    const float rs = rsqrtf(ss * (1.f / 128.f) + 1e-6f) * (1.f - LAM_INIT);
    p.YO()[(size_t)row * DM + 512 + h * 128 + lane] = (bf16_t)(pk2(r0 * rs * p.da_subln_g[lane], 0.f) & 0xffffu);
    p.YO()[(size_t)row * DM + 512 + h * 128 + 64 + lane] = (bf16_t)(pk2(r1 * rs * p.da_subln_g[64 + lane], 0.f) & 0xffffu);
}

struct EpiBr1 {
    const bf16_t* PROJ; bf16_t* MIX;
    DI void operator()(const AccT& acc, int brow, int bcol, int wr, int wc, int fr, int fq) const {
        EPI_ROWS_BEGIN
            EPI_COLS_BEGIN
                const u32x2 g = *(const u32x2*)(PROJ + (size_t)row * INW + O_GA + col);
                u32x2 o; o.x = pk2(a.x * sigmoidf_(bflo(g.x)), a.y * sigmoidf_(bfhi(g.x))); o.y = pk2(a.z * sigmoidf_(bflo(g.y)), a.w * sigmoidf_(bfhi(g.y)));
                *(u32x2*)(MIX + (size_t)row * DM + col) = o;
            }
        }
    }
};
struct EpiBr2 {
    const bf16_t* PROJ; bf16_t* MIX;
    DI void operator()(const AccT& acc, int brow, int bcol, int wr, int wc, int fr, int fq) const {
        EPI_ROWS_BEGIN
            EPI_COLS_BEGIN
                const u32x2 g = *(const u32x2*)(PROJ + (size_t)row * INW + O_GB + col);
                const u32x2 f = *(const u32x2*)(MIX + (size_t)row * DM + col);
                u32x2 o; o.x = pk2(bflo(f.x) + a.x * sigmoidf_(bflo(g.x)), bfhi(f.x) + a.y * sigmoidf_(bfhi(g.x))); o.y = pk2(bflo(f.y) + a.z * sigmoidf_(bflo(g.y)), bfhi(f.y) + a.w * sigmoidf_(bfhi(g.y)));
                *(u32x2*)(MIX + (size_t)row * DM + col) = o;
            }
        }
    }
};
struct EpiOut {
    const float* const* XPTR; float* H1; bf16_t* HB; float* SS2;
    DI void operator()(const AccT& acc, int brow, int bcol, int wr, int wc, int fr, int fq) const {
        EPI_ROWS_BEGIN
            const float* xr = XPTR[row];
            float ss = 0.f;
            EPI_COLS_BEGIN
                f32x4 v = a;
                v += *(const f32x4*)(xr + col);
                ss += v.x * v.x + v.y * v.y + v.z * v.z + v.w * v.w;
                *(f32x4*)(H1 + (size_t)row * DM + col) = v;
                u32x2 o; o.x = pk2(v.x, v.y); o.y = pk2(v.z, v.w);
                *(u32x2*)(HB + (size_t)row * DM + col) = o;
            }
            ss += __shfl_xor(ss, 16); ss += __shfl_xor(ss, 32);
            if (fq == 0) atomicAdd(SS2 + row, ss);
        }
    }
};
struct EpiQ {
    const float* SS2; bf16_t* QP;
    DI void operator()(const AccT& acc, int brow, int bcol, int wr, int wc, int fr, int fq) const {
        EPI_ROWS_BEGIN
            const float rs = rsqrtf(SS2[row] * (1.f / DM) + 1e-6f);
            EPI_COLS_BEGIN
                const f32x4 v = a * rs;
                u32x2 o; o.x = pk2(v.x, v.y); o.y = pk2(v.z, v.w);
                *(u32x2*)(QP + (size_t)row * 2048 + col) = o;
            }
        }
    }
};

template <class F>
DI void skinny_gemm(const bf16_t* A, int lda, const bf16_t* Bt, int K, int N, char* smem, int bid, int nblk, int tid, F&& f) {
    const int wave = tid >> 6, lane = tid & 63, tk = lane & 31, hh = lane >> 5;
    const int ks = K / 128;
    for (int tile = bid; tile < N / 32; tile += nblk) {
        const int n0 = tile * 32;
        f32x16 acc = {};
        const bf16_t* ap = A + (size_t)(MPR + tk) * lda + 8 * hh + wave * ks * 16; const bf16_t* bp = Bt + (size_t)(n0 + tk) * K + 8 * hh + wave * ks * 16;
        if (ks == 4) {
            bf16x8 av[4], bv[4];
#pragma unroll
            for (int s2 = 0; s2 < 4; ++s2) { av[s2] = *(const bf16x8*)(ap + 16 * s2); bv[s2] = *(const bf16x8*)(bp + 16 * s2); }
#pragma unroll
            for (int s2 = 0; s2 < 4; ++s2) acc = MFMA32(av[s2], bv[s2], acc);
        } else {
            bf16x8 av[8], bv[8];
#pragma unroll
            for (int s2 = 0; s2 < 8; ++s2) { av[s2] = *(const bf16x8*)(ap + 16 * s2); bv[s2] = *(const bf16x8*)(bp + 16 * s2); }
#pragma unroll
            for (int s2 = 0; s2 < 8; ++s2) acc = MFMA32(av[s2], bv[s2], acc);
        }
        __syncthreads();
        float* part = (float*)smem + wave * 1024;
#pragma unroll
        for (int i = 0; i < 16; ++i) part[i * 64 + lane] = acc[i];
        __syncthreads();
        if (wave == 0) {
#pragma unroll
            for (int i = 0; i < 16; ++i) { float v = 0.f;
#pragma unroll
                for (int w = 0; w < 8; ++w) v += ((const float*)smem)[w * 1024 + i * 64 + lane];
                f(MPR + (i & 3) + 8 * (i >> 2) + 4 * hh, n0 + tk, v); }
        }
    }
    __syncthreads();
}
DI unsigned short bf16_1(float x) { return (unsigned short)(pk2(x, 0.f) & 0xffffu); }

DI int fkey(float f, int idx, int mask) { int b = (__float_as_int(f) & ~mask) | idx; return b ^ ((b >> 31) & 0x7fffffff); }
DI int funkey(int k) { return k ^ ((k >> 31) & 0x7fffffff); }
template <int N> DI void bitonic_sort_desc(int (&a)[N]) {
#pragma unroll
    for (int k = 2; k <= N; k <<= 1)
#pragma unroll
        for (int j = k >> 1; j > 0; j >>= 1)
#pragma unroll
            for (int i = 0; i < N; ++i) { const int l = i ^ j;
                if (l > i) { const bool desc = ((i & k) == 0); const int mx = max(a[i], a[l]), mn = min(a[i], a[l]); a[i] = desc ? mx : mn; a[l] = desc ? mn : mx; } }
}
DI void merge_top16(int (&a)[16], const int (&b)[16]) {
#pragma unroll
    for (int i = 0; i < 16; ++i) a[i] = max(a[i], b[15 - i]);
#pragma unroll
    for (int j = 8; j > 0; j >>= 1)
#pragma unroll
        for (int i = 0; i < 16; ++i) { const int l = i ^ j; if (l > i) { const int mx = max(a[i], a[l]), mn = min(a[i], a[l]); a[i] = mx; a[l] = mn; } }
}
DI void top16_of_64(int (&g0)[16], int (&g1)[16], int (&g2)[16], int (&g3)[16], bool g0_sorted) {
    if (!g0_sorted) bitonic_sort_desc<16>(g0);
    bitonic_sort_desc<16>(g1); bitonic_sort_desc<16>(g2); bitonic_sort_desc<16>(g3);
    merge_top16(g0, g1); merge_top16(g2, g3); merge_top16(g0, g2);
}
DI void half_topk(const Params& p, const char* skl, int row, int hd, int c, int tk, int hh, int (&top)[16]) {
    bf16x8 Bq[8];
#pragma unroll
    for (int s = 0; s < 8; ++s) Bq[s] = *(const bf16x8*)(p.QP() + (size_t)row * 2048 + hd * 256 + c * 128 + 16 * s + 8 * hh);
    int g[4][16];
#pragma unroll
    for (int kt = 0; kt < 4; ++kt) {
        f32x16 acc = {};
#pragma unroll
        for (int s = 0; s < 8; ++s) { const bf16x8 ak = *(const bf16x8*)(skl + (c * 128 + kt * 32 + tk) * 272 + (16 * s + 8 * hh) * 2); acc = MFMA32(ak, Bq[s], acc); }
#pragma unroll
        for (int i = 0; i < 16; ++i) g[kt][i] = fkey(acc[i], kt * 32 + (i & 3) + 8 * (i >> 2) + 4 * hh, 0x7f);
        __builtin_amdgcn_sched_barrier(0);
    }
    bitonic_sort_desc<16>(g[0]); __builtin_amdgcn_sched_barrier(0);
    bitonic_sort_desc<16>(g[1]); __builtin_amdgcn_sched_barrier(0);
    merge_top16(g[0], g[1]); __builtin_amdgcn_sched_barrier(0);
    bitonic_sort_desc<16>(g[2]); __builtin_amdgcn_sched_barrier(0);
    bitonic_sort_desc<16>(g[3]); __builtin_amdgcn_sched_barrier(0);
    merge_top16(g[2], g[3]); merge_top16(g[0], g[2]);
    int oth[16];
#pragma unroll
    for (int i = 0; i < 16; ++i) oth[i] = __shfl_xor(g[0][i], 32);
    merge_top16(g[0], oth);
#pragma unroll
    for (int i = 0; i < 16; ++i) top[i] = g[0][i];
    __builtin_amdgcn_sched_barrier(0);
}
DI void topk_unit(const Params& p, const char* skl, char* lds_wave  , int unit, int lane) {
    const int tile = unit >> 3, hd = unit & 7, tk = lane & 31, hh = lane >> 5, row = tile * 32 + tk;
    int top[2][16];
    half_topk(p, skl, row, hd, 0, tk, hh, top[0]);
    half_topk(p, skl, row, hd, 1, tk, hh, top[1]);
    float v1[16], v2[16]; unsigned i1w[4] = {0, 0, 0, 0}, i2w[4] = {0, 0, 0, 0};
#pragma unroll
    for (int i = 0; i < 16; ++i) { const int b1 = funkey(top[0][i]), b2 = funkey(top[1][i]);
        v1[i] = __int_as_float(b1 & ~0x7f); v2[i] = __int_as_float(b2 & ~0x7f);
        i1w[i >> 2] |= (unsigned)(b1 & 0x7f) << (8 * (i & 3)); i2w[i >> 2] |= (unsigned)(b2 & 0x7f) << (8 * (i & 3)); }
    LAS unsigned* myl = (LAS unsigned*)lds_wave + lane * 8;
#pragma unroll
    for (int i = 0; i < 4; ++i) { myl[i] = i1w[i]; myl[4 + i] = i2w[i]; }
    int cg0[16], cg1[16], cg2[16], cg3[16];
    constexpr int NEG = (int)0x80000000;
#pragma unroll
    for (int j = 0; j < 16; ++j) cg0[j] = fkey(v1[0] + v2[j], j, 0xff);
    {
        int n = 0;
#pragma unroll
        for (int i = 1; i < 16; ++i)
#pragma unroll
            for (int j = 0; j < 16; ++j) if ((i + 1) * (j + 1) <= 16) { const int k = fkey(v1[i] + v2[j], i * 16 + j, 0xff);
                if (n < 16) cg1[n] = k; else if (n < 32) cg2[n - 16] = k; else cg3[n - 32] = k; ++n; }
#pragma unroll
        for (int i = 2; i < 16; ++i) cg3[i] = NEG;
    }
    __builtin_amdgcn_sched_barrier(0);
    bitonic_sort_desc<16>(cg0); __builtin_amdgcn_sched_barrier(0);
    bitonic_sort_desc<16>(cg1); __builtin_amdgcn_sched_barrier(0);
    merge_top16(cg0, cg1); __builtin_amdgcn_sched_barrier(0);
    bitonic_sort_desc<16>(cg2); __builtin_amdgcn_sched_barrier(0);
    bitonic_sort_desc<16>(cg3); __builtin_amdgcn_sched_barrier(0);
    merge_top16(cg2, cg3); merge_top16(cg0, cg2);
    float sc[16]; int cid[16];
#pragma unroll
    for (int i = 0; i < 16; ++i) { const int bb = funkey(cg0[i]); sc[i] = __int_as_float(bb & ~0xff); cid[i] = bb & 0xff; }
    float e[16], sum = 0.f;
#pragma unroll
    for (int i = 0; i < 16; ++i) { e[i] = __expf(sc[i] - sc[0]); sum += e[i]; }
    const float inv = 1.f / sum;
    __builtin_amdgcn_s_waitcnt(0xc07f); asm volatile("" ::: "memory");
    const LAS unsigned char* myb = (const LAS unsigned char*)myl;
    int eidx[16];
#pragma unroll
    for (int i = 0; i < 16; ++i) eidx[i] = (int)myb[cid[i] >> 4] * 128 + (int)myb[16 + (cid[i] & 15)];
    if (hh == 0 && row < MTOT) {
        int* io = p.IDX() + ((size_t)row * 8 + hd) * 16; float* go = p.GATE() + ((size_t)row * 8 + hd) * 16;
#pragma unroll
        for (int i = 0; i < 16; i += 4) { *(int4*)(io + i) = make_int4(eidx[i], eidx[i + 1], eidx[i + 2], eidx[i + 3]); *(f32x4*)(go + i) = (f32x4){e[i] * inv, e[i + 1] * inv, e[i + 2] * inv, e[i + 3] * inv}; }
    }
    __builtin_amdgcn_s_waitcnt(0xc07f); asm volatile("" ::: "memory");
}

DI void experts_row(const Params& p, int row, int lane) {
    const float rs = rsqrtf(p.SS2()[row] * (1.f / DM) + 1e-6f);
    float x[16];
    {
        float t0[8], t1[8]; unpack8(*(const u32x4*)(p.HB() + (size_t)row * DM + lane * 8), t0); unpack8(*(const u32x4*)(p.HB() + (size_t)row * DM + 512 + lane * 8), t1);
#pragma unroll
        for (int i = 0; i < 8; ++i) { x[i] = t0[i] * rs * p.norm2_g[lane * 8 + i]; x[8 + i] = t1[i] * rs * p.norm2_g[512 + lane * 8 + i]; }
    }
    float out[16];
#pragma unroll
    for (int i = 0; i < 16; ++i) out[i] = 0.f;
    for (int hd = 0; hd < 8; ++hd) {
        const int myidx = p.IDX()[((size_t)row * 8 + hd) * 16 + (lane & 15)];
        const float mygate = p.GATE()[((size_t)row * 8 + hd) * 16 + (lane & 15)];
        float hid = 0.f;
#pragma unroll 4
        for (int k = 0; k < 16; ++k) {
            const int e = __builtin_amdgcn_readlane(myidx, k);
            const bf16_t* ur = p.U16() + (size_t)e * DM;
            float u0[8], u1[8]; unpack8(*(const u32x4*)(ur + lane * 8), u0); unpack8(*(const u32x4*)(ur + 512 + lane * 8), u1);
            float d = 0.f;
#pragma unroll
            for (int i = 0; i < 8; ++i) d += x[i] * u0[i] + x[8 + i] * u1[i];
            d = wave_sum(d);
            hid = (lane & 15) == k ? d : hid;
        }
        const float cf = 0.5f * hid * (1.f + erff(hid * 0.70710678118654752f)) * mygate;
#pragma unroll 4
        for (int k = 0; k < 16; ++k) {
            const int e = __builtin_amdgcn_readlane(myidx, k);
            const float ck = __int_as_float(__builtin_amdgcn_readlane(__float_as_int(cf), k));
            const bf16_t* vr = p.V16() + (size_t)e * DM;
            float u0[8], u1[8]; unpack8(*(const u32x4*)(vr + lane * 8), u0); unpack8(*(const u32x4*)(vr + 512 + lane * 8), u1);
#pragma unroll
            for (int i = 0; i < 8; ++i) { out[i] += ck * u0[i]; out[8 + i] += ck * u1[i]; }
        }
    }
    float* dst = nullptr;
    if (row < MPR) { const int b = row / TT, t = row - b * TT; if (t >= NMETA) dst = p.out + OUT_YP + ((size_t)b * SEQ + (t - NMETA)) * DM; }
    else dst = p.out + OUT_YS + (size_t)(row - MPR) * DM;
    if (dst) {
        const float* h1 = p.H1() + (size_t)row * DM;
#pragma unroll
        for (int j = 0; j < 2; ++j) {
            const f32x4 a = *(const f32x4*)(h1 + j * 512 + lane * 8), b = *(const f32x4*)(h1 + j * 512 + lane * 8 + 4);
            *(f32x4*)(dst + j * 512 + lane * 8) = (f32x4){a.x + out[8 * j], a.y + out[8 * j + 1], a.z + out[8 * j + 2], a.w + out[8 * j + 3]};
            *(f32x4*)(dst + j * 512 + lane * 8 + 4) = (f32x4){b.x + out[8 * j + 4], b.y + out[8 * j + 5], b.z + out[8 * j + 6], b.w + out[8 * j + 7]};
        }
    }
}

constexpr int EX_NSL = 1, EX_SLSH = 14;
constexpr int EX_IDX_OFF = 0, EX_COEF_OFF = 64 * 128 * 2, EX_OFF_OFF = EX_COEF_OFF + 64 * 128 * 4, EX_LIST_OFF = EX_OFF_OFF + 64 * 32 * 2, EX_LDS = EX_LIST_OFF + 8 * 256 * 2;
DI float row16_rorsum(float v) {
    v += __builtin_amdgcn_update_dpp(0.f, v, 0x128, 0xF, 0xF, false);
    v += __builtin_amdgcn_update_dpp(0.f, v, 0x124, 0xF, 0xF, false);
    v += __builtin_amdgcn_update_dpp(0.f, v, 0x122, 0xF, 0xF, false);
    v += __builtin_amdgcn_update_dpp(0.f, v, 0x121, 0xF, 0xF, false);
    return v;
}
DI void unpack_fp8x16(const u32x4& w, float (&f)[16]) {
#pragma unroll
    for (int q = 0; q < 4; ++q) { const f32x2 lo = __builtin_amdgcn_cvt_pk_f32_fp8((int)w[q], false), hi = __builtin_amdgcn_cvt_pk_f32_fp8((int)w[q], true);
        f[4 * q] = lo.x; f[4 * q + 1] = lo.y; f[4 * q + 2] = hi.x; f[4 * q + 3] = hi.y; }
}
DI int peer_row_of(int ci) { return ci < NB * SEQ ? (ci >> 12) * TT + NMETA + (ci & 4095) : (ci < NB * SEQ + MS ? MPR + (ci - NB * SEQ) : -1); }
DI void experts_wave(const Params& p, char* smem, int wave_, int lane_, int ci0, int ntok, int xcc) {
    int wave = wave_, lane = lane_; asm volatile("" : "+v"(lane), "+v"(wave)); wave = __builtin_amdgcn_readfirstlane(wave);
    LAS unsigned short* idxs = (LAS unsigned short*)(smem + EX_IDX_OFF) + wave * 8 * 128;
    LAS float* coef = (LAS float*)(smem + EX_COEF_OFF) + wave * 8 * 128;
    LAS unsigned short* offs = (LAS unsigned short*)(smem + EX_OFF_OFF) + wave * 8 * 32;
    const unsigned char* U8 = (const unsigned char*)p.U16(); const unsigned char* V8 = (const unsigned char*)p.V16();
    float xr[2][16];
#pragma unroll
    for (int j = 0; j < 2; ++j) {
        const int row = j < ntok ? peer_row_of(ci0 + j) : -1;
        if (row >= 0) {
            const int e0 = p.IDX()[(size_t)row * 128 + lane], e1 = p.IDX()[(size_t)row * 128 + 64 + lane];
            const float g0 = p.GATE()[(size_t)row * 128 + lane], g1 = p.GATE()[(size_t)row * 128 + 64 + lane];
            const int s0 = e0 >> EX_SLSH, s1 = e1 >> EX_SLSH;
            int base = 0, pos0 = 0, pos1 = 0;
#pragma unroll
            for (int sl = 0; sl < EX_NSL; ++sl) {
                const unsigned long long m0 = __ballot(s0 == sl), m1 = __ballot(s1 == sl);
                const int c0 = __popcll(m0), c1 = __popcll(m1);
                const int r0 = __builtin_amdgcn_mbcnt_hi((unsigned)(m0 >> 32), __builtin_amdgcn_mbcnt_lo((unsigned)m0, 0));
                const int r1 = __builtin_amdgcn_mbcnt_hi((unsigned)(m1 >> 32), __builtin_amdgcn_mbcnt_lo((unsigned)m1, 0));
                if (s0 == sl) pos0 = base + r0;
                if (s1 == sl) pos1 = base + c0 + r1;
                if (lane == 0) offs[j * 32 + sl] = (unsigned short)base;
                base += c0 + c1;
            }
            if (lane == 0) offs[j * 32 + EX_NSL] = (unsigned short)base;
            idxs[j * 128 + pos0] = (unsigned short)e0; idxs[j * 128 + pos1] = (unsigned short)e1;
            coef[j * 128 + pos0] = g0; coef[j * 128 + pos1] = g1;
            const float rs = rsqrtf(p.SS2()[row] * (1.f / DM) + 1e-6f) * (1.f / U8_SCALE);
            float t0[8], t1[8]; unpack8(*(const u32x4*)(p.HB() + (size_t)row * DM + lane * 16), t0); unpack8(*(const u32x4*)(p.HB() + (size_t)row * DM + lane * 16 + 8), t1);
#pragma unroll
            for (int q = 0; q < 2; ++q) { const f32x4 ga = *(const f32x4*)(p.norm2_g + lane * 16 + 4 * q), gb = *(const f32x4*)(p.norm2_g + lane * 16 + 8 + 4 * q);
                xr[j][4 * q] = t0[4 * q] * rs * ga.x; xr[j][4 * q + 1] = t0[4 * q + 1] * rs * ga.y; xr[j][4 * q + 2] = t0[4 * q + 2] * rs * ga.z; xr[j][4 * q + 3] = t0[4 * q + 3] * rs * ga.w;
                xr[j][8 + 4 * q] = t1[4 * q] * rs * gb.x; xr[j][8 + 4 * q + 1] = t1[4 * q + 1] * rs * gb.y; xr[j][8 + 4 * q + 2] = t1[4 * q + 2] * rs * gb.z; xr[j][8 + 4 * q + 3] = t1[4 * q + 3] * rs * gb.w; }
        } else {
            if (lane <= EX_NSL) offs[j * 32 + lane] = 0;
#pragma unroll
            for (int i = 0; i < 16; ++i) xr[j][i] = 0.f;
        }
    }
    __builtin_amdgcn_s_waitcnt(0xc07f); asm volatile("" ::: "memory");
    LAS unsigned short* blist = (LAS unsigned short*)(smem + EX_LIST_OFF) + wave * 256;
    int nbat;
    {
        const int r = (lane >> 1) & (EX_NSL - 1), j = lane & 1, sl = (xcc + r) & (EX_NSL - 1);
        const int beg = offs[j * 32 + sl], cnt = lane < 2 * EX_NSL ? (int)offs[j * 32 + sl + 1] - beg : 0, nb = (cnt + 7) >> 3;
        int incl = nb;
#pragma unroll
        for (int o = 1; o < 64; o <<= 1) { const int t = __shfl_up(incl, o); if (lane >= o) incl += t; }
        nbat = __builtin_amdgcn_readlane(incl, 63);
        int w = incl - nb;
        for (int q = 0; q < nb; ++q) { const int k = beg + 8 * q, n = (cnt - 8 * q) < 8 ? (cnt - 8 * q) : 8; blist[w + q] = (unsigned short)(j | (k << 3) | ((n - 1) << 10)); }
    }
    __builtin_amdgcn_s_waitcnt(0xc07f); asm volatile("" ::: "memory");
    const int pid = lane >> 4;
    auto fetch = [&](const unsigned char* tab, int bi, u32x4 (&buf)[8]) {
        const int e = __builtin_amdgcn_readfirstlane((int)blist[bi]);
        const int j = e & 7, k = (e >> 3) & 127, n = (e >> 10) + 1;
#pragma unroll
        for (int i = 0; i < 8; ++i) { const int kk = k + (i < n ? i : n - 1);
            const int ex = __builtin_amdgcn_readfirstlane((int)idxs[j * 128 + kk]);
            buf[i] = *(const u32x4*)(tab + (size_t)ex * DM + lane * 16); }
    };
    auto u_consume = [&](int bi, const u32x4 (&buf)[8]) {
        const int e = __builtin_amdgcn_readfirstlane((int)blist[bi]);
        const int j = e & 7, k = (e >> 3) & 127, n = (e >> 10) + 1;
        float pp[8], x[16];
#pragma unroll
        for (int q = 0; q < 16; ++q) x[q] = j ? xr[1][q] : xr[0][q];
#pragma unroll
        for (int i = 0; i < 8; ++i) { float f[16]; unpack_fp8x16(buf[i], f); float d0 = 0.f, d1 = 0.f;
#pragma unroll
            for (int q = 0; q < 16; q += 2) { d0 += f[q] * x[q]; d1 += f[q + 1] * x[q + 1]; }
            pp[i] = d0 + d1; __builtin_amdgcn_sched_barrier(0); }
#pragma unroll
        for (int hb = 0; hb < 2; ++hb) {
            const bool b5 = lane & 32, b4 = lane & 16;
            const float a0 = b5 ? pp[4 * hb + 2] : pp[4 * hb], a1 = b5 ? pp[4 * hb + 3] : pp[4 * hb + 1], s0 = b5 ? pp[4 * hb] : pp[4 * hb + 2], s1 = b5 ? pp[4 * hb + 1] : pp[4 * hb + 3];
            const float q0 = a0 + __shfl_xor(s0, 32), q1 = a1 + __shfl_xor(s1, 32);
            const float c0 = b4 ? q1 : q0, d0 = b4 ? q0 : q1;
            float z = c0 + __shfl_xor(d0, 16);
            z = row16_rorsum(z);
            const int ip = 4 * hb + pid;
            if ((lane & 15) == 0 && ip < n) {
                const float g = coef[j * 128 + k + ip];
                coef[j * 128 + k + ip] = 0.5f * z * (1.f + erff(z * 0.70710678118654752f)) * g * (1.f / V8_SCALE);
            }
        }
    };
    {
        u32x4 bufA[8], bufB[8];
        if (nbat > 0) fetch(U8, 0, bufA);
#pragma unroll 1
        for (int bi = 0; bi < nbat; bi += 2) {
            if (bi + 1 < nbat) fetch(U8, bi + 1, bufB);
            u_consume(bi, bufA);
            if (bi + 2 < nbat) fetch(U8, bi + 2, bufA);
            if (bi + 1 < nbat) u_consume(bi + 1, bufB);
        }
    }
    __builtin_amdgcn_s_waitcnt(0xc07f); asm volatile("" ::: "memory");
    float acc[2][16];
#pragma unroll
    for (int j = 0; j < 2; ++j)
#pragma unroll
        for (int i = 0; i < 16; ++i) acc[j][i] = 0.f;
    auto v_consume = [&](int bi, const u32x4 (&buf)[8]) {
        const int e = __builtin_amdgcn_readfirstlane((int)blist[bi]);
        const int j = e & 7, k = (e >> 3) & 127, n = (e >> 10) + 1;
        float cc[8];
#pragma unroll
        for (int i = 0; i < 8; ++i) { const float c = __int_as_float(__builtin_amdgcn_readfirstlane(__float_as_int(coef[j * 128 + k + (i < n ? i : n - 1)]))); cc[i] = i < n ? c : 0.f; }
        float d[16];
#pragma unroll
        for (int q = 0; q < 16; ++q) d[q] = 0.f;
#pragma unroll
        for (int i = 0; i < 8; ++i) { float f[16]; unpack_fp8x16(buf[i], f);
#pragma unroll
            for (int q = 0; q < 16; ++q) d[q] += cc[i] * f[q];
            __builtin_amdgcn_sched_barrier(0); }
#pragma unroll
        for (int q = 0; q < 16; ++q) { acc[0][q] += j ? 0.f : d[q]; acc[1][q] += j ? d[q] : 0.f; }
    };
    {
        u32x4 bufA[8], bufB[8];
        if (nbat > 0) fetch(V8, 0, bufA);
#pragma unroll 1
        for (int bi = 0; bi < nbat; bi += 2) {
            if (bi + 1 < nbat) fetch(V8, bi + 1, bufB);
            v_consume(bi, bufA);
            if (bi + 2 < nbat) fetch(V8, bi + 2, bufA);
            if (bi + 1 < nbat) v_consume(bi + 1, bufB);
        }
    }
#pragma unroll
    for (int j = 0; j < 2; ++j) {
        const int ci = ci0 + j;
        const int row = j < ntok ? peer_row_of(ci) : -1;
        if (row >= 0) {
            float* dst = (ci < NB * SEQ ? p.out + OUT_YP + (size_t)ci * DM : p.out + OUT_YS + (size_t)(ci - NB * SEQ) * DM) + lane * 16;
            const float* h1 = p.H1() + (size_t)row * DM + lane * 16;
#pragma unroll
            for (int q = 0; q < 4; ++q) { const f32x4 a = *(const f32x4*)(h1 + 4 * q);
                *(f32x4*)(dst + 4 * q) = (f32x4){a.x + acc[j][4 * q], a.y + acc[j][4 * q + 1], a.z + acc[j][4 * q + 2], a.w + acc[j][4 * q + 3]}; }
        }
    }
}

typedef float f32x32 __attribute__((ext_vector_type(32)));
typedef unsigned u32x6 __attribute__((ext_vector_type(6)));
typedef unsigned u32x6_a8 __attribute__((ext_vector_type(6), aligned(8)));
constexpr int EX_UCF_OFF = EX_LDS, EX_LDS6 = EX_UCF_OFF + 8 * 256 * 4;
typedef u32x6 Row6;
DI f32x32 unpack_fp6x32(const Row6& r) { return __builtin_amdgcn_cvt_scalef32_pk32_f32_fp6(r, 1.0f); }
DI void experts_wave6(const Params& p, char* smem, int wave_, int lane_, int ci0, int ntok) {
    int wave = wave_, lane = lane_; asm volatile("" : "+v"(lane), "+v"(wave)); wave = __builtin_amdgcn_readfirstlane(wave);
    LAS unsigned short* idxs = (LAS unsigned short*)(smem + EX_IDX_OFF) + wave * 8 * 128;
    LAS float* coef = (LAS float*)(smem + EX_COEF_OFF) + wave * 8 * 128;
    LAS float* ucf = (LAS float*)(smem + EX_UCF_OFF) + wave * 256;
    const unsigned char* U6 = (const unsigned char*)p.U16(); const unsigned char* V6 = (const unsigned char*)p.V16();
    const int h = lane >> 5, lq = lane & 31;
#pragma unroll
    for (int j = 0; j < 2; ++j) {
        const int row = j < ntok ? peer_row_of(ci0 + j) : -1;
        int e0 = 0, e1 = 0; float g0 = 0.f, g1 = 0.f;
        if (row >= 0) { e0 = p.IDX()[(size_t)row * 128 + lane]; e1 = p.IDX()[(size_t)row * 128 + 64 + lane]; g0 = p.GATE()[(size_t)row * 128 + lane]; g1 = p.GATE()[(size_t)row * 128 + 64 + lane]; }
        idxs[j * 128 + lane] = (unsigned short)e0; idxs[j * 128 + 64 + lane] = (unsigned short)e1;
        coef[j * 128 + lane] = g0 * p.VSC()[e0]; coef[j * 128 + 64 + lane] = g1 * p.VSC()[e1];
        ucf[j * 128 + lane] = p.USC()[e0]; ucf[j * 128 + 64 + lane] = p.USC()[e1];
    }
    const int myrow = h < ntok ? peer_row_of(ci0 + h) : -1;
    float x[32];
    {
        const int rr = myrow >= 0 ? myrow : 0;
        const float rs = myrow >= 0 ? rsqrtf(p.SS2()[rr] * (1.f / DM) + 1e-6f) : 0.f;
#pragma unroll
        for (int q = 0; q < 4; ++q) { float t[8]; unpack8(*(const u32x4*)(p.HB() + (size_t)rr * DM + lq * 32 + q * 8), t);
            const f32x4 ga = *(const f32x4*)(p.norm2_g + lq * 32 + q * 8), gb = *(const f32x4*)(p.norm2_g + lq * 32 + q * 8 + 4);
            x[8 * q] = t[0] * rs * ga.x; x[8 * q + 1] = t[1] * rs * ga.y; x[8 * q + 2] = t[2] * rs * ga.z; x[8 * q + 3] = t[3] * rs * ga.w;
            x[8 * q + 4] = t[4] * rs * gb.x; x[8 * q + 5] = t[5] * rs * gb.y; x[8 * q + 6] = t[6] * rs * gb.z; x[8 * q + 7] = t[7] * rs * gb.w; }
    }
    __builtin_amdgcn_s_waitcnt(0xc07f); asm volatile("" ::: "memory");
    auto fetch = [&](const unsigned char* tab, int b, Row6 (&buf)[8]) {
        const u32x4 iv = *(LAS const u32x4*)(idxs + h * 128 + b * 8);
#pragma unroll
        for (int i = 0; i < 8; ++i) { const unsigned ex = (iv[i >> 1] >> ((i & 1) * 16)) & 0xffffu;
            const unsigned char* src = tab + (size_t)ex * 768 + lq * 24;
            buf[i] = *(const u32x6_a8*)src; }
    };
    auto u_consume = [&](int b, const Row6 (&buf)[8]) {
        float pp[8];
#pragma unroll
        for (int i = 0; i < 8; ++i) { Row6 w = buf[i]; if (i > 0) asm volatile("" : "+v"(w) : "v"(pp[i - 1]));
            const f32x32 f = unpack_fp6x32(w); float d0 = 0.f, d1 = 0.f;
#pragma unroll
            for (int q = 0; q < 32; q += 2) { d0 += f[q] * x[q]; d1 += f[q + 1] * x[q + 1]; }
            pp[i] = d0 + d1; __builtin_amdgcn_sched_barrier(0); }
        const bool b4 = lane & 16, b3 = lane & 8, b2 = lane & 4;
        float q4[4], q2[2];
#pragma unroll
        for (int i = 0; i < 4; ++i) { const float a = b4 ? pp[i + 4] : pp[i], sx = b4 ? pp[i] : pp[i + 4]; q4[i] = a + __shfl_xor(sx, 16); }
#pragma unroll
        for (int i = 0; i < 2; ++i) { const float a = b3 ? q4[i + 2] : q4[i], sx = b3 ? q4[i] : q4[i + 2]; q2[i] = a + __builtin_amdgcn_update_dpp(0.f, sx, 0x128, 0xF, 0xF, false); }
        float t;
        { const float a = b2 ? q2[1] : q2[0], sx = b2 ? q2[0] : q2[1]; t = a + dpp_hmir(sx); }
        t += dpp_xor1(t); t += dpp_xor2(t);
        if ((lane & 3) == 0) {
            const int ix = h * 128 + b * 8 + ((lane >> 4) & 1) * 4 + ((lane >> 3) & 1) * 2 + ((lane >> 2) & 1);
            const float z = t * ucf[ix];
            coef[ix] = 0.5f * z * (1.f + erff(z * 0.70710678118654752f)) * coef[ix];
        }
    };
    f32x32 acc;
#pragma unroll
    for (int i = 0; i < 32; ++i) acc[i] = 0.f;
    auto v_consume = [&](int b, const Row6 (&buf)[8]) {
        const f32x4 c0 = *(LAS const f32x4*)(coef + h * 128 + b * 8), c1 = *(LAS const f32x4*)(coef + h * 128 + b * 8 + 4);
#pragma unroll
        for (int i = 0; i < 8; ++i) { Row6 w = buf[i]; asm volatile("" : "+v"(w), "+v"(acc));
            const f32x32 f = unpack_fp6x32(w); const float c = i < 4 ? c0[i & 3] : c1[i & 3];
            acc += f * c;
            __builtin_amdgcn_sched_barrier(0); }
    };
    {
        Row6 bufA[8], bufB[8];
        fetch(U6, 0, bufA);
#pragma unroll 1
        for (int b = 0; b < 16; b += 2) {
            fetch(U6, b + 1, bufB);
            u_consume(b, bufA);
            if (b + 2 < 16) fetch(U6, b + 2, bufA); else fetch(V6, 0, bufA);
            u_consume(b + 1, bufB);
        }
        __builtin_amdgcn_s_waitcnt(0xc07f); asm volatile("" ::: "memory");
#pragma unroll 1
        for (int b = 0; b < 16; b += 2) {
            fetch(V6, b + 1, bufB);
            v_consume(b, bufA);
            if (b + 2 < 16) fetch(V6, b + 2, bufA);
            v_consume(b + 1, bufB);
        }
    }
    if (myrow >= 0) {
        const int ci = ci0 + h;
        float* dst = (ci < NB * SEQ ? p.out + OUT_YP + (size_t)ci * DM : p.out + OUT_YS + (size_t)(ci - NB * SEQ) * DM) + lq * 32;
        const float* h1 = p.H1() + (size_t)myrow * DM + lq * 32;
#pragma unroll
        for (int q = 0; q < 8; ++q) { const f32x4 a = *(const f32x4*)(h1 + 4 * q);
            *(f32x4*)(dst + 4 * q) = (f32x4){a.x + acc[4 * q], a.y + acc[4 * q + 1], a.z + acc[4 * q + 2], a.w + acc[4 * q + 3]}; }
    }
}
typedef u32x4 Row4;
DI f32x32 unpack_fp4x32(const Row4& r) {
    f32x32 f;
#define FP4_B(d, b) { const f32x2 t = __builtin_amdgcn_cvt_scalef32_pk_f32_fp4(r[d], 1.0f, b); f[8 * (d) + 2 * (b)] = t.x; f[8 * (d) + 2 * (b) + 1] = t.y; }
#define FP4_D(d) FP4_B(d, 0) FP4_B(d, 1) FP4_B(d, 2) FP4_B(d, 3)
    FP4_D(0) FP4_D(1) FP4_D(2) FP4_D(3)
#undef FP4_D
#undef FP4_B
    return f;
}
DI void experts_wave4(const Params& p, char* smem, int wave_, int lane_, int ci0, int ntok) {
    int wave = wave_, lane = lane_; asm volatile("" : "+v"(lane), "+v"(wave)); wave = __builtin_amdgcn_readfirstlane(wave);
    LAS unsigned short* idxs = (LAS unsigned short*)(smem + EX_IDX_OFF) + wave * 8 * 128;
    LAS float* coef = (LAS float*)(smem + EX_COEF_OFF) + wave * 8 * 128;
    LAS float* ucf = (LAS float*)(smem + EX_UCF_OFF) + wave * 256;
    const unsigned char* U6 = (const unsigned char*)p.U16(); const unsigned char* V6 = (const unsigned char*)p.V16();
    const int h = lane >> 5, lq = lane & 31;
#pragma unroll
    for (int j = 0; j < 2; ++j) {
        const int row = j < ntok ? peer_row_of(ci0 + j) : -1;
        int e0 = 0, e1 = 0; float g0 = 0.f, g1 = 0.f;
        if (row >= 0) { e0 = p.IDX()[(size_t)row * 128 + lane]; e1 = p.IDX()[(size_t)row * 128 + 64 + lane]; g0 = p.GATE()[(size_t)row * 128 + lane]; g1 = p.GATE()[(size_t)row * 128 + 64 + lane]; }
        idxs[j * 128 + lane] = (unsigned short)e0; idxs[j * 128 + 64 + lane] = (unsigned short)e1;
        coef[j * 128 + lane] = g0 * p.VSC()[e0]; coef[j * 128 + 64 + lane] = g1 * p.VSC()[e1];
        ucf[j * 128 + lane] = p.USC()[e0]; ucf[j * 128 + 64 + lane] = p.USC()[e1];
    }
    const int myrow = h < ntok ? peer_row_of(ci0 + h) : -1;
    float x[32];
    {
        const int rr = myrow >= 0 ? myrow : 0;
        const float rs = myrow >= 0 ? rsqrtf(p.SS2()[rr] * (1.f / DM) + 1e-6f) : 0.f;
#pragma unroll
        for (int q = 0; q < 4; ++q) { float t[8]; unpack8(*(const u32x4*)(p.HB() + (size_t)rr * DM + lq * 32 + q * 8), t);
            const f32x4 ga = *(const f32x4*)(p.norm2_g + lq * 32 + q * 8), gb = *(const f32x4*)(p.norm2_g + lq * 32 + q * 8 + 4);
            x[8 * q] = t[0] * rs * ga.x; x[8 * q + 1] = t[1] * rs * ga.y; x[8 * q + 2] = t[2] * rs * ga.z; x[8 * q + 3] = t[3] * rs * ga.w;
            x[8 * q + 4] = t[4] * rs * gb.x; x[8 * q + 5] = t[5] * rs * gb.y; x[8 * q + 6] = t[6] * rs * gb.z; x[8 * q + 7] = t[7] * rs * gb.w; }
    }
    __builtin_amdgcn_s_waitcnt(0xc07f); asm volatile("" ::: "memory");
    auto fetch = [&](const unsigned char* tab, int b, Row4 (&buf)[8]) {
        const u32x4 iv = *(LAS const u32x4*)(idxs + h * 128 + b * 8);
#pragma unroll
        for (int i = 0; i < 8; ++i) { const unsigned ex = (iv[i >> 1] >> ((i & 1) * 16)) & 0xffffu;
            buf[i] = *(const u32x4*)(tab + (size_t)ex * 512 + lq * 16); }
    };
    auto u_consume = [&](int b, const Row4 (&buf)[8]) {
        float pp[8];
#pragma unroll
        for (int i = 0; i < 8; ++i) { Row4 w = buf[i]; if (i > 0) asm volatile("" : "+v"(w) : "v"(pp[i - 1]));
            const f32x32 f = unpack_fp4x32(w); f32x2 d = {0.f, 0.f}, e = {0.f, 0.f};
#pragma unroll
            for (int q = 0; q < 32; q += 4) { d = __builtin_elementwise_fma((f32x2){f[q], f[q + 1]}, (f32x2){x[q], x[q + 1]}, d); e = __builtin_elementwise_fma((f32x2){f[q + 2], f[q + 3]}, (f32x2){x[q + 2], x[q + 3]}, e); }
            d += e; pp[i] = d.x + d.y; __builtin_amdgcn_sched_barrier(0); }
        const bool b4 = lane & 16, b3 = lane & 8, b2 = lane & 4;
        float q4[4], q2[2];
#pragma unroll
        for (int i = 0; i < 4; ++i) { const float a = b4 ? pp[i + 4] : pp[i], sx = b4 ? pp[i] : pp[i + 4]; q4[i] = a + __shfl_xor(sx, 16); }
#pragma unroll
        for (int i = 0; i < 2; ++i) { const float a = b3 ? q4[i + 2] : q4[i], sx = b3 ? q4[i] : q4[i + 2]; q2[i] = a + __builtin_amdgcn_update_dpp(0.f, sx, 0x128, 0xF, 0xF, false); }
        float t;
        { const float a = b2 ? q2[1] : q2[0], sx = b2 ? q2[0] : q2[1]; t = a + dpp_hmir(sx); }
        t += dpp_xor1(t); t += dpp_xor2(t);
        if ((lane & 3) == 0) {
            const int ix = h * 128 + b * 8 + ((lane >> 4) & 1) * 4 + ((lane >> 3) & 1) * 2 + ((lane >> 2) & 1);
            const float z = t * ucf[ix];
            coef[ix] = 0.5f * z * (1.f + erff(z * 0.70710678118654752f)) * coef[ix];
        }
    };
    f32x32 acc;
#pragma unroll
    for (int i = 0; i < 32; ++i) acc[i] = 0.f;
    auto v_consume = [&](int b, const Row4 (&buf)[8]) {
        const f32x4 c0 = *(LAS const f32x4*)(coef + h * 128 + b * 8), c1 = *(LAS const f32x4*)(coef + h * 128 + b * 8 + 4);
#pragma unroll
        for (int i = 0; i < 8; ++i) { Row4 w = buf[i]; asm volatile("" : "+v"(w), "+v"(acc));
            const f32x32 f = unpack_fp4x32(w); const float c = i < 4 ? c0[i & 3] : c1[i & 3];
            acc += f * c;
            __builtin_amdgcn_sched_barrier(0); }
    };
    {
        Row4 bufA[8], bufB[8], bufC[8];
        auto fetch_j = [&](int j, Row4 (&buf)[8]) { if (j < 32) fetch(j < 16 ? U6 : V6, j & 15, buf); };
        fetch_j(0, bufA); fetch_j(1, bufB);
#pragma unroll 1
        for (int j = 0; j < 15; j += 3) {
            fetch_j(j + 2, bufC); u_consume(j, bufA);
            fetch_j(j + 3, bufA); u_consume(j + 1, bufB);
            fetch_j(j + 4, bufB); u_consume(j + 2, bufC);
        }
        fetch_j(17, bufC); u_consume(15, bufA);
        __builtin_amdgcn_s_waitcnt(0xc07f); asm volatile("" ::: "memory");
#pragma unroll 1
        for (int j = 16; j < 31; j += 3) {
            fetch_j(j + 2, bufA); v_consume(j - 16, bufB);
            fetch_j(j + 3, bufB); v_consume(j - 15, bufC);
            fetch_j(j + 4, bufC); v_consume(j - 14, bufA);
        }
        v_consume(15, bufB);
    }
    if (myrow >= 0) {
        const int ci = ci0 + h;
        float* dst = (ci < NB * SEQ ? p.out + OUT_YP + (size_t)ci * DM : p.out + OUT_YS + (size_t)(ci - NB * SEQ) * DM) + lq * 32;
        const float* h1 = p.H1() + (size_t)myrow * DM + lq * 32;
#pragma unroll
        for (int q = 0; q < 8; ++q) { const f32x4 a = *(const f32x4*)(h1 + 4 * q);
            *(f32x4*)(dst + 4 * q) = (f32x4){a.x + acc[4 * q], a.y + acc[4 * q + 1], a.z + acc[4 * q + 2], a.w + acc[4 * q + 3]}; }
    }
}

#define XB_TMO      128
#define XB_XCNT(j)  (256  + 64 * (j))
#define XB_XSUB(j)  (1280 + 64 * (j))
#define XB_XGEN(j)  (2304 + 64 * (j))
#define XB_TOP      3328
#define XB_TOPGEN   3392
#define XCD_BAR_WORDS 3456
#define XB_SPIN_CAP (1u << 18)

__device__ __forceinline__ unsigned xb_ld(unsigned* p)              { return __hip_atomic_load(p, __ATOMIC_RELAXED, __HIP_MEMORY_SCOPE_AGENT); }
__device__ __forceinline__ unsigned xb_add(unsigned* p, unsigned v) { return __hip_atomic_fetch_add(p, v, __ATOMIC_RELAXED, __HIP_MEMORY_SCOPE_AGENT); }
__device__ __forceinline__ unsigned xb_xcc_id() { return (unsigned)__builtin_amdgcn_s_getreg((3 << 11) | 20) & 0xFu; }
#define XB_SPIN(cond, bar) do { unsigned _sp = 0; while (cond) { __builtin_amdgcn_s_sleep(1); \
    if ((++_sp & 255u) == 0u) { if (xb_ld(&(bar)[XB_TMO])) break; if (_sp > XB_SPIN_CAP) { atomicAdd(&(bar)[XB_TMO], 1u); break; } } } } while (0)

struct XcdBarrier {
    unsigned* bar; unsigned x;
    volatile LAS unsigned* st;
};
__device__ __forceinline__ XcdBarrier xcd_barrier_post(unsigned* bar, volatile LAS unsigned* st) {
    XcdBarrier b; b.bar = bar; b.x = xb_xcc_id(); b.st = st;
    if (threadIdx.x == 0) (void)xb_add(&bar[XB_XCNT(b.x)], 1u);
    return b;
}
__device__ __forceinline__ void xcd_barrier_complete(unsigned* bar, unsigned x, unsigned& nloc, unsigned& nx) {
    const unsigned G = gridDim.x * gridDim.y * gridDim.z;
    unsigned sum, cnt, mine, sp = 0u;
    for (;;) {
        sum = 0u; cnt = 0u; mine = 0u;
#pragma unroll
        for (unsigned j = 0; j < 16; ++j) { const unsigned c = xb_ld(&bar[XB_XCNT(j)]); sum += c; cnt += (c > 0u) ? 1u : 0u; mine = (j == x) ? c : mine; }
        if (sum == G) break;
        __builtin_amdgcn_s_sleep(1);
        if ((++sp & 255u) == 0u) { if (xb_ld(&bar[XB_TMO])) break; if (sp > XB_SPIN_CAP) { atomicAdd(&bar[XB_TMO], 1u); break; } }
    }
    nloc = mine > 0u ? mine : 1u; nx = cnt > 0u ? cnt : 1u;
}
__device__ __forceinline__ void xcd_barrier(const XcdBarrier& b) {
    asm volatile("s_waitcnt vmcnt(0)" ::: "memory");
    __syncthreads();
    if (threadIdx.x == 0) {
        unsigned* bar = b.bar;
        __builtin_amdgcn_s_waitcnt(0);
        unsigned nloc = b.st[0], nx = b.st[1];
        if (nloc == 0u) { xcd_barrier_complete(bar, b.x, nloc, nx); b.st[0] = nloc; b.st[1] = nx; }
        const unsigned old = xb_add(&bar[XB_XSUB(b.x)], 1u);
        const unsigned gen = old / nloc;
        if (old + 1u == (gen + 1u) * nloc) {
            __builtin_amdgcn_fence(__ATOMIC_RELEASE, "agent");
            asm volatile("s_waitcnt vmcnt(0)" ::: "memory");
            const unsigned og = xb_add(&bar[XB_TOP], 1u);
            const unsigned tg = og / nx;
            if (og + 1u == (tg + 1u) * nx) xb_add(&bar[XB_TOPGEN], 1u);
            else XB_SPIN(xb_ld(&bar[XB_TOPGEN]) == tg, bar);
            __builtin_amdgcn_fence(__ATOMIC_ACQUIRE, "agent");
            xb_add(&bar[XB_XGEN(b.x)], 1u);
            asm volatile("s_waitcnt vmcnt(0)" ::: "memory");
        } else {
            XB_SPIN(xb_ld(&bar[XB_XGEN(b.x)]) == gen, bar);
            __builtin_amdgcn_fence(__ATOMIC_ACQUIRE, "agent");
            asm volatile("s_waitcnt vmcnt(0)" ::: "memory");
        }
    }
    __syncthreads();
}

constexpr int NTHR = 512, NBLK = 256;
constexpr int LDS_MAIN = 159744, LDS_BYTES = LDS_MAIN + 64;
extern __shared__ __attribute__((aligned(16))) char dyn_smem[];

DI int pull_work(unsigned* q, char* smem, int tid, int step) {
    LAS int* bw = (LAS int*)(smem + LDS_MAIN + 32);
    __syncthreads();
    if (tid == 0) *bw = (int)__hip_atomic_fetch_add(q, (unsigned)step, __ATOMIC_RELAXED, __HIP_MEMORY_SCOPE_AGENT);
    __syncthreads();
    return *bw;
}

#define PH_IDS int tid = threadIdx.x; asm volatile("" : "+v"(tid)); const int wave = tid >> 6, lane = tid & 63, gw = bid * 8 + wave; (void)wave; (void)lane; (void)gw;
__global__ void __launch_bounds__(NTHR, 2) k_mega(Params p) {
    const int bid = blockIdx.x, nblk = gridDim.x, ngw = nblk * 8;
    char* smem = dyn_smem;
    if (threadIdx.x == 0) *(u32x4*)(smem + LDS_MAIN) = (u32x4){0u, 0u, 0u, 0u};
    __syncthreads();
    XcdBarrier bar = xcd_barrier_post(p.ctl(), (volatile LAS unsigned*)(smem + LDS_MAIN));
    { PH_IDS phase_convert(p, smem, 0, gw, ngw, wave, lane); }
    xcd_barrier(bar);
    { EpiProj e{p.RSTD1(), p.PROJ(), p.out}; g8::gemm_phase<false>(p.XB(), 1024, p.WIN_T(), 1024, MP / 256, INW / 256, (bf16_t*)smem, e, bid, nblk); }
    { PH_IDS constexpr int G1_REM = (MP / 256) * (INW / 256) % NBLK;
      if (bid >= G1_REM) phase_convert(p, smem, 1, (bid - G1_REM) * 8 + wave, (nblk - G1_REM) * 8, wave, lane); }
    xcd_barrier(bar);
    { PH_IDS phase_prep(p, smem, bid, nblk, gw, ngw, tid, lane); }
    xcd_barrier(bar);
    { PH_IDS unsigned short pre[48]; chunk_prefetch(p, bid, tid, pre); for (int u = bid; u < CK_UNITS; u += nblk) chunk_pass1(p, smem, u, u + nblk, pre, tid); }
    xcd_barrier(bar);
    {
        PH_IDS
        volatile LAS int* prog = (volatile LAS int*)(smem + LDS_MAIN + 48);
        if (tid == 0) *prog = 0;
        __syncthreads();
        if (bid < 64) {
            if (wave == 0) chunk_pass2(p, bid, lane, prog);
            else if (wave == 1) chunk_pass2_prefetch(p, bid, lane, prog);
            else {
                while (*prog < CK_N) {
                    int u = 0; if (lane == 0) u = (int)__hip_atomic_fetch_add(p.ctl() + CTL_Q_SATTN, 1u, __ATOMIC_RELAXED, __HIP_MEMORY_SCOPE_AGENT);
                    u = __builtin_amdgcn_readfirstlane(u);
                    if (u >= SA_UNITS) break;
                    sattn_unit(p, u, lane);
                }
            }
        }
        else if (bid >= 128) rwkv_sample_unit(p, (bid - 128) * 2 + (tid >> 8), tid & 255);
    }
    {
        PH_IDS
        const float lam = compute_lam(p, lane);
        for (;;) {
            const int idx = pull_work(p.ctl() + CTL_Q_ATTN, smem, tid, 1);
            if (idx >= AT_UNITS) break;
            const int qbi = idx >> 4, bh = idx & 15, qb = qbi < 32 ? 31 - qbi : 32;
            attn_unit(p, smem, bh >> 2, bh & 3, qb, lam, alibi_dmax(p, bh & 3, lane), tid);
        }
    }
    {
        PH_IDS
        for (;;) {
            const int u0 = pull_work(p.ctl() + CTL_Q_SATTN, smem, tid, 8);
            if (u0 >= SA_UNITS) break;
            if (u0 + wave < SA_UNITS) sattn_unit(p, u0 + wave, lane);
        }
    }
    xcd_barrier(bar);
    {
        PH_IDS
        for (int u = gw; u < 2 * CK_UNITS; u += ngw) chunk_pass3(p, u, lane);
        for (int r = MPR + gw; r < MTOT; r += ngw) rwkv_post_row(p, r, lane);
        const float lam = compute_lam(p, lane);
        for (int u = gw; u < MS * 4; u += ngw) sattn_combine(p, u, lam, lane);
    }
    xcd_barrier(bar);
    { PH_IDS
      skinny_gemm(p.YO(), 1024, p.WRW_T(), 512, 1024, smem, bid, nblk, tid, [&](int row, int col, float v) { p.MIXF()[(size_t)row * DM + col] = v * sigmoidf_(bf2f(p.PROJ()[(size_t)row * INW + O_GA + col])); });
      skinny_gemm(p.YO() + 512, 1024, p.WDA_T(), 512, 1024, smem, bid, nblk, tid, [&](int row, int col, float v) { p.MIX()[(size_t)row * DM + col] = bf16_1(p.MIXF()[(size_t)row * DM + col] + v * sigmoidf_(bf2f(p.PROJ()[(size_t)row * INW + O_GB + col]))); }); }
    { EpiBr1 e{p.PROJ(), p.MIX()}; g8::gemm_phase<true>(p.YO(), 1024, p.WRW_T(), 512, 64, 4, (bf16_t*)smem, e, bid, nblk); }
    { EpiBr2 e{p.PROJ(), p.MIX()}; g8::gemm_phase<true>(p.YO() + 512, 1024, p.WDA_T(), 512, 64, 4, (bf16_t*)smem, e, bid, nblk); }
    xcd_barrier(bar);
    { PH_IDS
      skinny_gemm(p.MIX(), 1024, p.WOUT_T(), 1024, 1024, smem, bid, nblk, tid, [&](int row, int col, float v) {
          const float h = p.x_sample[(size_t)(row - MPR) * DM + col] + v; p.H1()[(size_t)row * DM + col] = h; p.HB()[(size_t)row * DM + col] = bf16_1(h);
          float ss = h * h; ss += __shfl_xor(ss, 1); ss += __shfl_xor(ss, 2); ss += __shfl_xor(ss, 4); ss += __shfl_xor(ss, 8); ss += __shfl_xor(ss, 16);
          if ((lane & 31) == 0) atomicAdd(p.SS2() + row, ss); }); }
    { EpiOut e{p.XPTR(), p.H1(), p.HB(), p.SS2()}; g8::gemm_phase<true>(p.MIX(), 1024, p.WOUT_T(), 1024, 64, 4, (bf16_t*)smem, e, bid, nblk); }
    xcd_barrier(bar);
    { PH_IDS
      skinny_gemm(p.HB(), 1024, p.WQ_T(), 1024, 2048, smem, bid, nblk, tid, [&](int row, int col, float v) { p.QP()[(size_t)row * 2048 + col] = bf16_1(v * rsqrtf(p.SS2()[row] * (1.f / DM) + 1e-6f)); }); }
    { EpiQ e{p.SS2(), p.QP()}; g8::gemm_phase<true>(p.HB(), 1024, p.WQ_T(), 1024, 64, 8, (bf16_t*)smem, e, bid, nblk); }
    xcd_barrier(bar);
    {
        PH_IDS
        for (int ch = tid; ch < 256 * 16; ch += 512) { const int r = ch >> 4, cc = ch & 15; *(u32x4*)(smem + 16384 + r * 272 + cc * 16) = *(const u32x4*)(p.SK() + (size_t)r * 128 + cc * 8); }
        __syncthreads();
        for (int u = gw; u < (MTOT / 32) * 8; u += ngw) topk_unit(p, smem + 16384, smem + wave * 2048, u, lane);
        constexpr int TK_REM = (MTOT / 32) * 8 - 2 * NBLK * 8;
        if (gw >= TK_REM) { const int cw = gw - TK_REM, ncw = ngw - TK_REM;
            for (int it = cw; it < 32768; it += ncw) { if (it < 16384) convert_row_fp4(p.peer_u, (unsigned char*)p.U16(), p.USC(), it, lane); else convert_row_fp4(p.peer_v, (unsigned char*)p.V16(), p.VSC(), it - 16384, lane); } }
    }
    xcd_barrier(bar);
    {
        PH_IDS
#pragma unroll 1
        for (int pass = 0; pass < 5; ++pass) {
            const int ci0 = pass < 4 ? bid * 64 + wave * 8 + 2 * pass : NB * SEQ + bid;
            const int ntok = pass < 4 ? 2 : ((bid < MS && wave == 0) ? 1 : 0);
            if (ntok > 0) experts_wave4(p, smem, wave, lane, ci0, ntok);
        }
    }
}

extern "C" void kernel_launch(void* const* d_in, const int* in_sizes, int n_in, void* d_out, int out_size, void* d_ws, size_t ws_size, hipStream_t stream) {
    Params p{};
    p.x_prompt = (const float*)d_in[0]; p.x_sample = (const float*)d_in[1]; p.cache_k = (const float*)d_in[2]; p.cache_v = (const float*)d_in[3];
    p.state_wkv = (const float*)d_in[4]; p.state_shift = (const float*)d_in[5]; p.page_table = (const int*)d_in[6];
    p.meta = (const float*)d_in[7]; p.norm1_g = (const float*)d_in[8]; p.w_in = (const float*)d_in[9]; p.rw_mu = (const float*)d_in[10]; p.rw_w0 = (const float*)d_in[11];
    p.rw_w2 = (const float*)d_in[12]; p.rw_a0 = (const float*)d_in[13]; p.rw_a2 = (const float*)d_in[14]; p.rw_g2 = (const float*)d_in[15]; p.rw_kk = (const float*)d_in[16];
    p.rw_ka = (const float*)d_in[17]; p.rw_rk = (const float*)d_in[18]; p.rw_ln_g = (const float*)d_in[19]; p.rw_ln_b = (const float*)d_in[20]; p.w_rw_br = (const float*)d_in[21];
    p.da_qn_g = (const float*)d_in[22]; p.da_kn_g = (const float*)d_in[23]; p.da_lam = (const float*)d_in[24]; p.da_subln_g = (const float*)d_in[25]; p.w_da_br = (const float*)d_in[26];
    p.w_out = (const float*)d_in[27]; p.norm2_g = (const float*)d_in[28]; p.peer_wq = (const float*)d_in[29]; p.peer_subkeys = (const float*)d_in[30]; p.peer_u = (const float*)d_in[31];
    p.peer_v = (const float*)d_in[32];
    (void)in_sizes; (void)n_in; (void)out_size; (void)ws_size;
    p.out = (float*)d_out;
    p.ws = (char*)d_ws;
    static bool attr_done = false;
    if (!attr_done) { (void)hipFuncSetAttribute((const void*)k_mega, hipFuncAttributeMaxDynamicSharedMemorySize, LDS_BYTES); attr_done = true; }
    (void)hipMemsetAsync(p.ws + WO_ctl, 0, CTL_WORDS * 4, stream);
    k_mega<<<NBLK, NTHR, LDS_BYTES, stream>>>(p);
}
```

```cpp
#include <hip/hip_runtime.h>
#include <stdint.h>
#include <stdio.h>

#define DI __device__ __forceinline__
#define LAS __attribute__((address_space(3)))
typedef unsigned short bf16_t;
typedef short bf16x8 __attribute__((ext_vector_type(8)));
typedef short s16x4 __attribute__((ext_vector_type(4)));
typedef float f32x2 __attribute__((ext_vector_type(2)));
typedef float f32x4 __attribute__((ext_vector_type(4)));
typedef float f32x16 __attribute__((ext_vector_type(16)));
typedef unsigned u32x2 __attribute__((ext_vector_type(2)));
typedef unsigned u32x4 __attribute__((ext_vector_type(4)));
typedef __bf16 bf16v2 __attribute__((ext_vector_type(2)));

constexpr int DM = 1024, NB = 4, SEQ = 4096, NMETA = 16, TT = SEQ + NMETA  ;
constexpr int MPR = NB * TT  , MS = 32, MTOT = MPR + MS  , MP = 16640  ;
constexpr int RWP = 1792, INW = 5376;
constexpr int O_Q = 1792, O_K = 2304, O_V = 2816, O_GA = 3328, O_GB = 4352;
constexpr int NPAGES = 64, PAGE = 128, PAST = 8192;
constexpr float LOG2E = 1.4426950408889634f;
constexpr float LAM_INIT = 0.2f;
constexpr size_t OUT_YP = 0, OUT_YS = OUT_YP + (size_t)NB * SEQ * DM, OUT_KP = OUT_YS + (size_t)MS * DM, OUT_VP = OUT_KP + (size_t)MPR * 512,
                 OUT_KS = OUT_VP + (size_t)MPR * 512, OUT_VS = OUT_KS + (size_t)MS * 512, OUT_WP = OUT_VS + (size_t)MS * 512,
                 OUT_WS = OUT_WP + (size_t)NB * 8 * 4096, OUT_SP = OUT_WS + (size_t)MS * 8 * 4096, OUT_SS = OUT_SP + (size_t)NB * RWP,
                 OUT_END = OUT_SS + (size_t)MS * RWP;

constexpr int SA_SPLITS = 16, SA_UNITS = MS * 4 * SA_SPLITS;
constexpr int CK_N = 65, CK_UNITS = 32 * CK_N;
constexpr int TTP = CK_N * 64;
constexpr int CTL_WORDS = 8192, CTL_Q_ATTN = 4096, CTL_Q_SATTN = 4096 + 64;
constexpr size_t ws_al(size_t b) { return (b + 255) & ~(size_t)255; }
constexpr size_t WO_ctl = 0;
constexpr size_t WO_XB = WO_ctl + ws_al(CTL_WORDS * 4);
constexpr size_t WO_WIN_T = WO_XB + ws_al((size_t)MP * DM * 2);
constexpr size_t WO_WRW_T = WO_WIN_T + ws_al((size_t)INW * DM * 2);
constexpr size_t WO_WDA_T = WO_WRW_T + ws_al((size_t)1024 * 512 * 2);
constexpr size_t WO_WOUT_T = WO_WDA_T + ws_al((size_t)1024 * 512 * 2);
constexpr size_t WO_WQ_T = WO_WOUT_T + ws_al((size_t)1024 * 1024 * 2);
constexpr size_t WO_W2_T = WO_WQ_T + ws_al((size_t)2048 * 1024 * 2);
constexpr size_t WO_A2_T = WO_W2_T + ws_al(512 * 64 * 2);
constexpr size_t WO_G2_T = WO_A2_T + ws_al(512 * 64 * 2);
constexpr size_t WO_SK = WO_G2_T + ws_al(512 * 128 * 2);
constexpr size_t WO_U16 = WO_SK + ws_al(2 * 128 * 128 * 2);
constexpr size_t WO_V16 = WO_U16 + ws_al((size_t)16384 * DM * 2);
constexpr size_t WO_PROJ = WO_V16 + ws_al((size_t)16384 * DM * 2);
constexpr size_t WO_QN = WO_PROJ + ws_al((size_t)MP * INW * 2);
constexpr size_t WO_KN = WO_QN + ws_al((size_t)MP * 512 * 2);
constexpr size_t WO_SCAN = WO_KN + ws_al((size_t)MP * 512 * 2);
constexpr size_t WO_G = WO_SCAN + ws_al((size_t)32 * 6 * 64 * TTP * 2);
constexpr size_t WO_YO = WO_G + ws_al((size_t)MP * 512 * 2);
constexpr size_t WO_MIX = WO_YO + ws_al((size_t)MP * DM * 2);
constexpr size_t WO_HB = WO_MIX + ws_al((size_t)MP * DM * 2);
constexpr size_t WO_QP = WO_HB + ws_al((size_t)MP * DM * 2);
constexpr size_t WO_RSTD1 = WO_QP + ws_al((size_t)MP * 2048 * 2);
constexpr size_t WO_BONUS = WO_RSTD1 + ws_al((size_t)MP * 4);
constexpr size_t WO_Y = WO_BONUS + ws_al((size_t)MP * 8 * 4);
constexpr size_t WO_MIXF = WO_Y + ws_al((size_t)MP * 512 * 4);
constexpr size_t WO_H1 = WO_MIXF + ws_al((size_t)MP * DM * 4);
constexpr size_t WO_SS2 = WO_H1 + ws_al((size_t)MP * DM * 4);
constexpr size_t WO_GATE = WO_SS2 + ws_al((size_t)MP * 4);
constexpr size_t WO_PART = WO_GATE + ws_al((size_t)MP * 128 * 4);
constexpr size_t WO_SCAN_S = WO_PART + ws_al((size_t)SA_UNITS * 2 * 130 * 4);
constexpr size_t WO_IDX = WO_SCAN_S + ws_al((size_t)MS * 8 * 384 * 4);
constexpr size_t WO_XPTR = WO_IDX + ws_al((size_t)MP * 128 * 4);
constexpr size_t WO_ZROW = WO_XPTR + ws_al((size_t)MP * 8);
constexpr size_t WO_MYT = WO_ZROW + ws_al(4096);
constexpr size_t WO_MST = WO_MYT + ws_al((size_t)CK_UNITS * 4096 * 2);
constexpr size_t WO_PLV = WO_MST + ws_al((size_t)CK_UNITS * 4096 * 2);
constexpr size_t WO_WYT = WO_PLV + ws_al((size_t)CK_UNITS * 64 * 4);
constexpr size_t WO_WST = WO_WYT + ws_al((size_t)CK_UNITS * 4096 * 4);
constexpr size_t WO_SCF = WO_WST + ws_al((size_t)CK_UNITS * 4096 * 4);
constexpr size_t WS_END = WO_SCF + ws_al((size_t)CK_UNITS * 16 * 64 * 16);
struct Params {
    const float *x_prompt, *x_sample, *cache_k, *cache_v, *state_wkv, *state_shift; const int* page_table;
    const float *meta, *norm1_g, *w_in, *rw_mu, *rw_w0, *rw_w2, *rw_a0, *rw_a2, *rw_g2, *rw_kk, *rw_ka, *rw_rk, *rw_ln_g, *rw_ln_b, *w_rw_br,
        *da_qn_g, *da_kn_g, *da_lam, *da_subln_g, *w_da_br, *w_out, *norm2_g, *peer_wq, *peer_subkeys, *peer_u, *peer_v;
    float* out; char* ws;
    DI unsigned* ctl() const { return (unsigned*)(ws + WO_ctl); }
    DI bf16_t* XB() const { return (bf16_t*)(ws + WO_XB); }
    DI bf16_t* WIN_T() const { return (bf16_t*)(ws + WO_WIN_T); }
    DI bf16_t* WRW_T() const { return (bf16_t*)(ws + WO_WRW_T); }
    DI bf16_t* WDA_T() const { return (bf16_t*)(ws + WO_WDA_T); }
    DI bf16_t* WOUT_T() const { return (bf16_t*)(ws + WO_WOUT_T); }
    DI bf16_t* WQ_T() const { return (bf16_t*)(ws + WO_WQ_T); }
    DI bf16_t* W2_T() const { return (bf16_t*)(ws + WO_W2_T); }
    DI bf16_t* A2_T() const { return (bf16_t*)(ws + WO_A2_T); }
    DI bf16_t* G2_T() const { return (bf16_t*)(ws + WO_G2_T); }
    DI bf16_t* SK() const { return (bf16_t*)(ws + WO_SK); }
    DI bf16_t* U16() const { return (bf16_t*)(ws + WO_U16); }
    DI bf16_t* V16() const { return (bf16_t*)(ws + WO_V16); }
    DI float* USC() const { return (float*)(ws + WO_U16 + ((size_t)16 << 20)); }
    DI float* VSC() const { return (float*)(ws + WO_V16 + ((size_t)16 << 20)); }
    DI bf16_t* PROJ() const { return (bf16_t*)(ws + WO_PROJ); }
    DI bf16_t* QN() const { return (bf16_t*)(ws + WO_QN); }
    DI bf16_t* KN() const { return (bf16_t*)(ws + WO_KN); }
    DI bf16_t* SCAN() const { return (bf16_t*)(ws + WO_SCAN); }
    DI bf16_t* G() const { return (bf16_t*)(ws + WO_G); }
    DI bf16_t* YO() const { return (bf16_t*)(ws + WO_YO); }
    DI bf16_t* MIX() const { return (bf16_t*)(ws + WO_MIX); }
    DI bf16_t* HB() const { return (bf16_t*)(ws + WO_HB); }
    DI bf16_t* QP() const { return (bf16_t*)(ws + WO_QP); }
    DI float* RSTD1() const { return (float*)(ws + WO_RSTD1); }
    DI float* BONUS() const { return (float*)(ws + WO_BONUS); }
    DI float* Y() const { return (float*)(ws + WO_Y); }
    DI float* MIXF() const { return (float*)(ws + WO_MIXF); }
    DI float* H1() const { return (float*)(ws + WO_H1); }
    DI float* SS2() const { return (float*)(ws + WO_SS2); }
    DI float* GATE() const { return (float*)(ws + WO_GATE); }
    DI float* PART() const { return (float*)(ws + WO_PART); }
    DI float* SCAN_S() const { return (float*)(ws + WO_SCAN_S); }
    DI int* IDX() const { return (int*)(ws + WO_IDX); }
    DI const float** XPTR() const { return (const float**)(ws + WO_XPTR); }
    DI float* ZROW() const { return (float*)(ws + WO_ZROW); }
    DI bf16_t* MYT() const { return (bf16_t*)(ws + WO_MYT); }
    DI bf16_t* MST() const { return (bf16_t*)(ws + WO_MST); }
    DI float* PLV() const { return (float*)(ws + WO_PLV); }
    DI float* WYT() const { return (float*)(ws + WO_WYT); }
    DI float* WST() const { return (float*)(ws + WO_WST); }
    DI unsigned* SCF() const { return (unsigned*)(ws + WO_SCF); }
};


DI size_t scan_addr(int chain, int vec, int d, int t) { return (((size_t)chain * 6 + vec) * 64 + d) * TTP + t; }
DI float bf2f(unsigned h) { return __uint_as_float(h << 16); }
DI float bflo(unsigned w) { return __uint_as_float(w << 16); }
DI float bfhi(unsigned w) { return __uint_as_float(w & 0xffff0000u); }
DI unsigned pk2(float lo, float hi) { f32x2 v = {lo, hi}; bf16v2 b = __builtin_convertvector(v, bf16v2); return __builtin_bit_cast(unsigned, b); }
DI unsigned short bf16_1_(float x) { return (unsigned short)(pk2(x, 0.f) & 0xffffu); }
DI float wave_sum(float v) {
#pragma unroll
    for (int o = 1; o < 64; o <<= 1) v += __shfl_xor(v, o);
    return v;
}
DI float sigmoidf_(float x) { return __builtin_amdgcn_rcpf(1.f + __expf(-x)); }
DI void unpack8(const u32x4& w, float (&f)[8]) {
    f[0] = bflo(w.x); f[1] = bfhi(w.x); f[2] = bflo(w.y); f[3] = bfhi(w.y); f[4] = bflo(w.z); f[5] = bfhi(w.z); f[6] = bflo(w.w); f[7] = bfhi(w.w);
}
DI const float* xrow_ptr(const Params& p, int row) {
    if (row < MPR) { const int b = row / TT, t = row - b * TT; return t < NMETA ? p.meta + (size_t)t * DM : p.x_prompt + ((size_t)b * SEQ + (t - NMETA)) * DM; }
    if (row < MTOT) return p.x_sample + (size_t)(row - MPR) * DM;
    return nullptr;
}

DI void transpose_item(const float* __restrict__ W, int K, int N, const float* __restrict__ gain, bf16_t* __restrict__ WT, LAS float* scr, int item, int lane) {
    const int nblk = N / 32, kb = item / nblk, nb = item - kb * nblk, k0 = 64 * kb, n0 = 32 * nb;
#pragma unroll 8
    for (int i = 0; i < 32; ++i) { const int kk = 2 * i + (lane >> 5); float g = gain ? gain[k0 + kk] : 1.f; scr[kk * 33 + (lane & 31)] = g * W[(size_t)(k0 + kk) * N + n0 + (lane & 31)]; }
    __builtin_amdgcn_s_waitcnt(0xc07f); asm volatile("" ::: "memory");
    const int c = lane & 7;
#pragma unroll
    for (int j = 0; j < 4; ++j) { const int n = (lane >> 3) + 8 * j; const LAS float* s = scr + (8 * c) * 33 + n;
        u32x4 o; o.x = pk2(s[0 * 33], s[1 * 33]); o.y = pk2(s[2 * 33], s[3 * 33]); o.z = pk2(s[4 * 33], s[5 * 33]); o.w = pk2(s[6 * 33], s[7 * 33]);
        *(u32x4*)(WT + (size_t)(n0 + n) * K + k0 + 8 * c) = o; }
    __builtin_amdgcn_s_waitcnt(0xc07f); asm volatile("" ::: "memory");
}
DI void convert_chunk(const float* __restrict__ src, bf16_t* __restrict__ dst, int item, int lane) {
    const size_t base = (size_t)item * 4096;
#pragma unroll
    for (int j = 0; j < 8; ++j) { const size_t o = base + (size_t)(j * 64 + lane) * 8;
        const f32x4 a = *(const f32x4*)(src + o), b = *(const f32x4*)(src + o + 4);
        u32x4 w; w.x = pk2(a.x, a.y); w.y = pk2(a.z, a.w); w.z = pk2(b.x, b.y); w.w = pk2(b.z, b.w);
        *(u32x4*)(dst + o) = w; }
}
constexpr float U8_SCALE = 256.f, V8_SCALE = 64.f;
DI void convert_chunk_fp8(const float* __restrict__ src, unsigned char* __restrict__ dst, float scale, int item, int lane) {
    const size_t base = (size_t)item * 4096;
#pragma unroll
    for (int j = 0; j < 4; ++j) { const size_t o = base + (size_t)(j * 64 + lane) * 16;
        u32x4 w;
#pragma unroll
        for (int q = 0; q < 4; ++q) { const f32x4 a = *(const f32x4*)(src + o + 4 * q);
            int pk = __builtin_amdgcn_cvt_pk_fp8_f32(a.x * scale, a.y * scale, 0, false); pk = __builtin_amdgcn_cvt_pk_fp8_f32(a.z * scale, a.w * scale, pk, true); w[q] = (unsigned)pk; }
        *(u32x4*)(dst + o) = w; }
}
DI unsigned fp6_code(float x, float s) {
    const float a = fminf(fabsf(x) * s, 7.5f);
    const float c = a < 2.f ? rintf(a * 8.f) : (a < 4.f ? 16.f + rintf((a - 2.f) * 4.f) : 24.f + rintf((a - 4.f) * 2.f));
    return (unsigned)c | (x < 0.f ? 32u : 0u);
}
DI void convert_row_fp6(const float* __restrict__ src, unsigned char* __restrict__ dst, float* __restrict__ sc, int row, int lane) {
    const float* sp = src + (size_t)row * DM + lane * 16;
    f32x4 v[4]; float am = 0.f;
#pragma unroll
    for (int q = 0; q < 4; ++q) { v[q] = *(const f32x4*)(sp + 4 * q); am = fmaxf(am, fmaxf(fmaxf(fabsf(v[q].x), fabsf(v[q].y)), fmaxf(fabsf(v[q].z), fabsf(v[q].w)))); }
#pragma unroll
    for (int o = 32; o; o >>= 1) am = fmaxf(am, __shfl_xor(am, o));
    const float s = am > 0.f ? 7.5f / am : 0.f;
    if (lane == 0) sc[row] = am * (1.f / 7.5f);
    unsigned long long lo = 0; unsigned hi = 0;
#pragma unroll
    for (int i = 0; i < 16; ++i) {
        const unsigned c = fp6_code(v[i >> 2][i & 3], s);
        if (i < 10) lo |= (unsigned long long)c << (6 * i);
        else if (i == 10) { lo |= (unsigned long long)(c & 15u) << 60; hi |= c >> 4; }
        else hi |= c << (6 * i - 64);
    }
    unsigned* dp = (unsigned*)(dst + (size_t)row * 768 + lane * 12);
    dp[0] = (unsigned)lo; dp[1] = (unsigned)(lo >> 32); dp[2] = hi;
}
DI void phase_convert(const Params& p, char* smem, int part, int gw, int ngw, int wave, int lane) {
    LAS float* scr = (LAS float*)(smem) + wave * (64 * 33);
    constexpr int I_ROWS = MP;
    constexpr int I_WIN = 16 * (INW / 32), I_RW = 8 * 32, I_DA = 8 * 32, I_OUT = 16 * 32, I_WQ = 16 * 64, I_W2 = 16, I_A2 = 16, I_G2 = 32;
    constexpr int I_SK = 8, I_Z = MP / 256;
    if (part == 0) {
        constexpr int NIT = I_ROWS + I_WIN + I_Z;
        for (int it = gw; it < NIT; it += ngw) {
            int r = it;
            if (r < I_ROWS) {
                const float* src = xrow_ptr(p, r);
                f32x4 v[4]; float ss = 0.f;
#pragma unroll
                for (int j = 0; j < 4; ++j) { v[j] = src ? *(const f32x4*)(src + (j * 64 + lane) * 4) : (f32x4){0.f, 0.f, 0.f, 0.f}; ss += v[j].x * v[j].x + v[j].y * v[j].y + v[j].z * v[j].z + v[j].w * v[j].w; }
                ss = wave_sum(ss);
#pragma unroll
                for (int j = 0; j < 4; ++j) { u32x2 o; o.x = pk2(v[j].x, v[j].y); o.y = pk2(v[j].z, v[j].w); *(u32x2*)(p.XB() + (size_t)r * DM + (j * 64 + lane) * 4) = o; }
                if (lane == 0) { p.RSTD1()[r] = rsqrtf(ss * (1.f / DM) + 1e-6f); p.XPTR()[r] = src ? src : p.ZROW(); }
                continue;
            }
            r -= I_ROWS;
            if (r < I_WIN) { transpose_item(p.w_in, 1024, INW, p.norm1_g, p.WIN_T(), scr, r, lane); continue; } r -= I_WIN;
            { *(f32x4*)(p.SS2() + (size_t)r * 256 + lane * 4) = (f32x4){0.f, 0.f, 0.f, 0.f}; if (r < 4) *(f32x4*)(p.ZROW() + (size_t)r * 256 + lane * 4) = (f32x4){0.f, 0.f, 0.f, 0.f}; }
        }
    } else {
        constexpr int NIT = I_RW + I_DA + I_OUT + I_WQ + I_W2 + I_A2 + I_G2 + I_SK;
        for (int it = gw; it < NIT; it += ngw) {
            int r = it;
            if (r < I_W2) { transpose_item(p.rw_w2, 64, 512, nullptr, p.W2_T(), scr, r, lane); continue; } r -= I_W2;
            if (r < I_A2) { transpose_item(p.rw_a2, 64, 512, nullptr, p.A2_T(), scr, r, lane); continue; } r -= I_A2;
            if (r < I_G2) { transpose_item(p.rw_g2, 128, 512, nullptr, p.G2_T(), scr, r, lane); continue; } r -= I_G2;
            if (r < I_RW) { transpose_item(p.w_rw_br, 512, 1024, nullptr, p.WRW_T(), scr, r, lane); continue; } r -= I_RW;
            if (r < I_DA) { transpose_item(p.w_da_br, 512, 1024, nullptr, p.WDA_T(), scr, r, lane); continue; } r -= I_DA;
            if (r < I_OUT) { transpose_item(p.w_out, 1024, 1024, nullptr, p.WOUT_T(), scr, r, lane); continue; } r -= I_OUT;
            if (r < I_WQ) { transpose_item(p.peer_wq, 1024, 2048, p.norm2_g, p.WQ_T(), scr, r, lane); continue; } r -= I_WQ;
            convert_chunk(p.peer_subkeys, p.SK(), r, lane);
        }
    }
}

DI void convert_row_fp4(const float* __restrict__ src, unsigned char* __restrict__ dst, float* __restrict__ sc, int row, int lane) {
    const float* sp = src + (size_t)row * DM + lane * 16;
    f32x4 v[4]; float am = 0.f;
#pragma unroll
    for (int q = 0; q < 4; ++q) { v[q] = *(const f32x4*)(sp + 4 * q); am = fmaxf(am, fmaxf(fmaxf(fabsf(v[q].x), fabsf(v[q].y)), fmaxf(fabsf(v[q].z), fabsf(v[q].w)))); }
#pragma unroll
    for (int o = 32; o; o >>= 1) am = fmaxf(am, __shfl_xor(am, o));
    const float s = am > 0.f ? 6.f / am : 0.f;
    if (lane == 0) sc[row] = am * (1.f / 6.f);
    unsigned w0 = 0u, w1 = 0u;
    w0 = __builtin_amdgcn_cvt_scalef32_pk_fp4_f32(w0, v[0].x * s, v[0].y * s, 1.0f, 0); w0 = __builtin_amdgcn_cvt_scalef32_pk_fp4_f32(w0, v[0].z * s, v[0].w * s, 1.0f, 1);
    w0 = __builtin_amdgcn_cvt_scalef32_pk_fp4_f32(w0, v[1].x * s, v[1].y * s, 1.0f, 2); w0 = __builtin_amdgcn_cvt_scalef32_pk_fp4_f32(w0, v[1].z * s, v[1].w * s, 1.0f, 3);
    w1 = __builtin_amdgcn_cvt_scalef32_pk_fp4_f32(w1, v[2].x * s, v[2].y * s, 1.0f, 0); w1 = __builtin_amdgcn_cvt_scalef32_pk_fp4_f32(w1, v[2].z * s, v[2].w * s, 1.0f, 1);
    w1 = __builtin_amdgcn_cvt_scalef32_pk_fp4_f32(w1, v[3].x * s, v[3].y * s, 1.0f, 2); w1 = __builtin_amdgcn_cvt_scalef32_pk_fp4_f32(w1, v[3].z * s, v[3].w * s, 1.0f, 3);
    *(u32x2*)(dst + (size_t)row * 512 + lane * 8) = (u32x2){w0, w1};
}

namespace g8 {
constexpr int BM = 256, BK = 64, HALF = 128, HT = HALF * BK, SHM_B = 8 * HT * 2, NXCD = 8, WGM = 8;
DI int lds_byte(int r, int c) { int st = (r >> 4) * 2 + (c >> 5), rr = r & 15, cc = c & 31, ob = rr * 64 + cc * 2; return st * 1024 + (ob ^ (((ob >> 9) & 1) << 5)); }
DI void stage_rc(int b, int& R, int& C) { int st = b / 1024, sb = b % 1024, swz = sb ^ (((sb >> 9) & 1) << 5); R = (st >> 1) * 16 + swz / 64; C = (st & 1) * 32 + (swz % 64) / 2; }
DI void unit_map(int L, int nM, int nN, int& pm, int& pn) {
    const int nwg = nM * nN; int wgid = L;
    { const int q = nwg / NXCD, r = nwg % NXCD, xcd = wgid % NXCD, off = wgid / NXCD; wgid = (xcd < r ? xcd * (q + 1) : r * (q + 1) + (xcd - r) * q) + off; }
    const int nig = WGM * nN, gid = wgid / nig, fm = gid * WGM, gsz = (nM - fm) < WGM ? (nM - fm) : WGM;
    pm = fm + ((wgid % nig) % gsz); pn = (wgid % nig) / gsz;
}
template <class Epi>
DI void gemm_tile(const bf16_t* __restrict__ A, const int lda, const bf16_t* __restrict__ Bt, const int K, const int brow, const int bcol, bf16_t* shm, const Epi& epi) {
#define SA(b, h) (shm + ((b) * 2 + (h)) * HT)
#define SB(b, h) (shm + (4 + (b) * 2 + (h)) * HT)
#define STAGE_X(T, P, BASE, LD, br, kt) do { long _g = (long)(br) * (LD) + (long)(kt) * BK; \
    for (int _i = 0; _i < 2; ++_i) { int _b = (T) * 16 + _i * 8192; int _r, _c; stage_rc(_b, _r, _c); \
      __builtin_amdgcn_global_load_lds((const unsigned*)(BASE + _g + (long)_r * (LD) + _c), (LAS unsigned*)((LAS char*)(P) + _b), 16, 0, 0); } } while (0)
#define STAGEA(P, BASE, br, kt) STAGE_X(tz0, P, BASE, lda, br, kt)
#define STAGEB(P, BASE, br, kt) STAGE_X(tz0, P, BASE, K, br, kt)
#define LDA(dst, b, h) for (int m = 0; m < 4; ++m) for (int k = 0; k < 2; ++k) \
    dst[m][k] = *reinterpret_cast<const bf16x8*>((char*)SA(b, h) + lds_byte(wr * 64 + m * 16 + fr, k * 32 + fq * 8))
#define LDB(dst, b, h) for (int n = 0; n < 2; ++n) for (int k = 0; k < 2; ++k) \
    dst[n][k] = *reinterpret_cast<const bf16x8*>((char*)SB(b, h) + lds_byte(wc * 32 + n * 16 + fr, k * 32 + fq * 8))
#define MMA(ai, bj, At, Bf) do { __builtin_amdgcn_s_setprio(1); \
    for (int m = 0; m < 4; ++m) for (int n = 0; n < 2; ++n) for (int k = 0; k < 2; ++k) \
      acc[ai][bj][m][n] = __builtin_amdgcn_mfma_f32_16x16x32_bf16(Bf[n][k], At[m][k], acc[ai][bj][m][n], 0, 0, 0); \
    __builtin_amdgcn_s_setprio(0); } while (0)
#define WAIT_V(n) asm volatile("s_waitcnt vmcnt(" #n ")" ::: "memory")
#define WAIT_L(n) asm volatile("s_waitcnt lgkmcnt(" #n ")" ::: "memory")
#define BAR __builtin_amdgcn_s_barrier()
#define SCHED __builtin_amdgcn_sched_barrier(0)
    int tz0 = threadIdx.x; asm volatile("" : "+v"(tz0));
    int wid = tz0 >> 6, lane = tz0 & 63, wr = wid >> 2, wc = wid & 3, fr = lane & 15, fq = lane >> 4;
    f32x4 acc[2][2][4][2] = {};
    bf16x8 At[4][2], B0[2][2], B1[2][2];
    const int nt = K / BK;
    STAGEB(SB(0, 0), Bt, bcol, 0); STAGEA(SA(0, 0), A, brow, 0);
    STAGEB(SB(0, 1), Bt, bcol + HALF, 0); STAGEA(SA(0, 1), A, brow + HALF, 0);
    if (wr == 1) BAR;
    WAIT_V(4); BAR;
    STAGEB(SB(1, 0), Bt, bcol, 1); STAGEA(SA(1, 0), A, brow, 1); STAGEB(SB(1, 1), Bt, bcol + HALF, 1);
    WAIT_V(6); BAR;
    for (int t = 0; t < nt - 2; t += 2) {
        LDB(B0, 0, 0); SCHED; LDA(At, 0, 0); STAGEA(SA(1, 1), A, brow + HALF, t + 1);
        WAIT_L(8); BAR; WAIT_L(0); MMA(0, 0, At, B0); BAR; SCHED;
        LDB(B1, 0, 1); STAGEB(SB(0, 0), Bt, bcol, t + 2);
        BAR; WAIT_L(0); MMA(0, 1, At, B1); BAR;
        LDA(At, 0, 1); STAGEA(SA(0, 0), A, brow, t + 2);
        BAR; WAIT_L(0); MMA(1, 0, At, B0); BAR; SCHED;
        STAGEB(SB(0, 1), Bt, bcol + HALF, t + 2);
        WAIT_V(6); BAR; MMA(1, 1, At, B1); BAR;
        LDB(B0, 1, 0); SCHED; LDA(At, 1, 0); STAGEA(SA(0, 1), A, brow + HALF, t + 2);
        WAIT_L(8); BAR; WAIT_L(0); MMA(0, 0, At, B0); BAR; SCHED;
        LDB(B1, 1, 1); STAGEB(SB(1, 0), Bt, bcol, t + 3);
        BAR; WAIT_L(0); MMA(0, 1, At, B1); BAR;
        LDA(At, 1, 1); STAGEA(SA(1, 0), A, brow, t + 3);
        BAR; WAIT_L(0); MMA(1, 0, At, B0); BAR; SCHED;
        STAGEB(SB(1, 1), Bt, bcol + HALF, t + 3);
        WAIT_V(6); BAR; MMA(1, 1, At, B1); BAR;
    }
    int tz = tz0; asm volatile("" : "+v"(tz)); wid = tz >> 6; lane = tz & 63; wr = wid >> 2; wc = wid & 3; fr = lane & 15; fq = lane >> 4;
    { LDB(B0, 0, 0); WAIT_V(0); LDA(At, 0, 0); STAGE_X(tz, SA(1, 1), A, lda, brow + HALF, nt - 1);
      BAR; WAIT_L(0); MMA(0, 0, At, B0); BAR;
      LDB(B1, 0, 1); BAR; WAIT_L(0); MMA(0, 1, At, B1); BAR;
      LDA(At, 0, 1); WAIT_V(4); BAR; WAIT_L(0); MMA(1, 0, At, B0); MMA(1, 1, At, B1); BAR; }
    { LDB(B0, 1, 0); LDA(At, 1, 0); WAIT_V(2); BAR; WAIT_L(0); MMA(0, 0, At, B0); BAR;
      LDB(B1, 1, 1); WAIT_V(0); BAR; WAIT_L(0); MMA(0, 1, At, B1); BAR;
      LDA(At, 1, 1); BAR; WAIT_L(0); MMA(1, 0, At, B0); MMA(1, 1, At, B1); BAR; }
    if (wr == 0) BAR;
    epi(acc, brow, bcol, wr, wc, fr, fq);
#undef SA
#undef SB
#undef STAGE_X
#undef STAGEA
#undef STAGEB
#undef LDA
#undef LDB
#undef MMA
}
template <bool REMAP, class Epi>
DI void gemm_phase(const bf16_t* A, int lda, const bf16_t* Bt, int K, int nM, int nN, bf16_t* shm, const Epi& epi, int bid, int nblk) {
    const int nwg = nM * nN;
    for (int L = bid; L < nwg; L += nblk) {
        int pm, pn; unit_map(L, nM, nN, pm, pn);
        const int brow = REMAP ? (pm >> 4) * TT + NMETA + (pm & 15) * BM : pm * BM;
        gemm_tile(A, lda, Bt, K, brow, pn * BM, shm, epi);
        __syncthreads();
    }
}
}
typedef f32x4 AccT[2][2][4][2];
#define EPI_ROWS_BEGIN _Pragma("unroll") for (int ai = 0; ai < 2; ++ai) _Pragma("unroll") for (int m = 0; m < 4; ++m) { __builtin_amdgcn_sched_barrier(0); asm volatile("" ::: "memory"); const int row = brow + ai * 128 + wr * 64 + m * 16 + fr;
#define EPI_COLS_BEGIN _Pragma("unroll") for (int bj = 0; bj < 2; ++bj) _Pragma("unroll") for (int n = 0; n < 2; ++n) { const int col = bcol + bj * 128 + wc * 32 + n * 16 + fq * 4; const f32x4 a = acc[ai][bj][m][n];

struct EpiProj {
    const float* rstd; bf16_t* PROJ; float* out;
    DI void operator()(const AccT& acc, int brow, int bcol, int wr, int wc, int fr, int fq) const {
        EPI_ROWS_BEGIN
            const float rs = rstd[row];
            float* sh = nullptr;
            if (bcol < RWP) {
                if (row < MPR) { const int b = row / TT; if (row - b * TT == TT - 1) sh = out + OUT_SP + (size_t)b * RWP; }
                else if (row < MTOT) sh = out + OUT_SS + (size_t)(row - MPR) * RWP;
            }
            EPI_COLS_BEGIN
                const f32x4 v = a * rs;
                u32x2 o; o.x = pk2(v.x, v.y); o.y = pk2(v.z, v.w);
                *(u32x2*)(PROJ + (size_t)row * INW + col) = o;
                if (sh) *(f32x4*)(sh + col) = v;
            }
        }
    }
};

DI void prep_qkv_row(const Params& p, int row, int lane) {
    const bf16_t* pr = p.PROJ() + (size_t)row * INW;
    const u32x4 w0 = *(const u32x4*)(pr + O_Q + lane * 16), w1 = *(const u32x4*)(pr + O_Q + lane * 16 + 8);
    float f[16]; { float t0[8], t1[8]; unpack8(w0, t0); unpack8(w1, t1);
#pragma unroll
        for (int i = 0; i < 8; ++i) { f[i] = t0[i]; f[8 + i] = t1[i]; } }
    float ss = 0.f;
#pragma unroll
    for (int i = 0; i < 16; ++i) ss += f[i] * f[i];
    ss += __shfl_xor(ss, 1); ss += __shfl_xor(ss, 2);
    const float rs = rsqrtf(ss * (1.f / 64.f) + 1e-6f);
    const bool isk = lane >= 32;
    const float* gp = (isk ? p.da_kn_g : p.da_qn_g) + (lane & 3) * 16;
#pragma unroll
    for (int i = 0; i < 16; ++i) f[i] = f[i] * rs * gp[i];
    u32x4 o0, o1; o0.x = pk2(f[0], f[1]); o0.y = pk2(f[2], f[3]); o0.z = pk2(f[4], f[5]); o0.w = pk2(f[6], f[7]);
    o1.x = pk2(f[8], f[9]); o1.y = pk2(f[10], f[11]); o1.z = pk2(f[12], f[13]); o1.w = pk2(f[14], f[15]);
    bf16_t* dst = (isk ? p.KN() : p.QN()) + (size_t)row * 512 + (lane & 31) * 16;
    *(u32x4*)dst = o0; *(u32x4*)(dst + 8) = o1;
    float* kout = row < MPR ? p.out + OUT_KP + (size_t)row * 512 : p.out + OUT_KS + (size_t)(row - MPR) * 512;
    float* vout = row < MPR ? p.out + OUT_VP + (size_t)row * 512 : p.out + OUT_VS + (size_t)(row - MPR) * 512;
    if (isk) {
#pragma unroll
        for (int i = 0; i < 4; ++i) *(f32x4*)(kout + (lane - 32) * 16 + 4 * i) = (f32x4){f[4 * i], f[4 * i + 1], f[4 * i + 2], f[4 * i + 3]};
    }
    const u32x4 wv = *(const u32x4*)(pr + O_V + lane * 8);
    float v8[8]; unpack8(wv, v8);
    *(f32x4*)(vout + lane * 8) = (f32x4){v8[0], v8[1], v8[2], v8[3]};
    *(f32x4*)(vout + lane * 8 + 4) = (f32x4){v8[4], v8[5], v8[6], v8[7]};
}

template <int N>
DI void ps_load(const LAS float* pl, const bf16_t* cur, const bf16_t* prevb, const float* prevf, int col0, float (&o)[N]) {
    float c[N], pv[N];
    if (N == 8) { float t[8]; unpack8(*(const u32x4*)(cur + col0), t);
#pragma unroll
        for (int i = 0; i < N; ++i) c[i] = t[i]; }
    else { const u32x2 w = *(const u32x2*)(cur + col0); c[0] = bflo(w.x); c[1] = bfhi(w.x); c[2] = bflo(w.y); c[3] = bfhi(w.y); }
    if (prevb) {
        if (N == 8) { float t[8]; unpack8(*(const u32x4*)(prevb + col0), t);
#pragma unroll
            for (int i = 0; i < N; ++i) pv[i] = t[i]; }
        else { const u32x2 w = *(const u32x2*)(prevb + col0); pv[0] = bflo(w.x); pv[1] = bfhi(w.x); pv[2] = bflo(w.y); pv[3] = bfhi(w.y); }
    } else if (prevf) {
#pragma unroll
        for (int i = 0; i < N; i += 4) { const f32x4 t = *(const f32x4*)(prevf + col0 + i); pv[i] = t.x; pv[i + 1] = t.y; pv[i + 2] = t.z; pv[i + 3] = t.w; }
    } else {
#pragma unroll
        for (int i = 0; i < N; ++i) pv[i] = 0.f;
    }
#pragma unroll
    for (int i = 0; i < N; i += 4) { const f32x4 mu = *(const LAS f32x4*)(pl + col0 + i);
        o[i] = c[i] + (pv[i] - c[i]) * mu.x; o[i + 1] = c[i + 1] + (pv[i + 1] - c[i + 1]) * mu.y;
        o[i + 2] = c[i + 2] + (pv[i + 2] - c[i + 2]) * mu.z; o[i + 3] = c[i + 3] + (pv[i + 3] - c[i + 3]) * mu.w; }
}
DI bf16x8 pack8(const float (&f)[8]) { u32x4 w; w.x = pk2(f[0], f[1]); w.y = pk2(f[2], f[3]); w.z = pk2(f[4], f[5]); w.w = pk2(f[6], f[7]); return __builtin_bit_cast(bf16x8, w); }
#define MFMA32(a, b, c) __builtin_amdgcn_mfma_f32_32x32x16_bf16((a), (b), (c), 0, 0, 0)

DI float tanh_fast(float x) { const float e = __expf(2.f * x); return 1.f - 2.f * __builtin_amdgcn_rcpf(e + 1.f); }
constexpr int PL_W0 = 1792, PL_A0 = 2304, PL_KK = 2816, PL_KA = 3328, PL_RK = 3840, PL_N = 4352;
DI void prep_rwkv_tile(const Params& p, const LAS float* pl, int tile, int lane) {
    const int tk = lane & 31, hh = lane >> 5, row = tile * 32 + tk;
    const bool samp = row >= MPR;
    int b = 0, t = 0;
    if (!samp) { b = row / TT; t = row - b * TT; }
    const bf16_t* cur = p.PROJ() + (size_t)row * INW;
    const bf16_t* prevb = (!samp && t > 0) ? cur - INW : nullptr;
    const float* prevf = samp ? p.state_shift + (size_t)(row - MPR) * RWP : nullptr;
    {
        bf16x8 Bw[4], Ba[4];
#pragma unroll
        for (int s = 0; s < 4; ++s) { float x[8]; ps_load<8>(pl, cur, prevb, prevf, 1536 + 16 * s + 8 * hh, x);
#pragma unroll
            for (int i = 0; i < 8; ++i) x[i] = tanh_fast(x[i]);
            Bw[s] = pack8(x); }
#pragma unroll
        for (int s = 0; s < 4; ++s) { float x[8]; ps_load<8>(pl, cur, prevb, prevf, 1600 + 16 * s + 8 * hh, x); Ba[s] = pack8(x); }
#pragma unroll 1
        for (int hd = 0; hd < 8; ++hd) {
            float kk2 = 0.f;
#pragma unroll 2
            for (int q8 = 0; q8 < 8; ++q8) { const int n = hd * 64 + (q8 >> 2) * 32 + 8 * (q8 & 3) + 4 * hh;
                float k4[4]; ps_load<4>(pl, cur, prevb, prevf, 512 + n, k4); const f32x4 kkp = *(const LAS f32x4*)(pl + PL_KK + n);
                const float a0 = k4[0] * kkp.x, a1 = k4[1] * kkp.y, a2 = k4[2] * kkp.z, a3 = k4[3] * kkp.w; kk2 += a0 * a0 + a1 * a1 + a2 * a2 + a3 * a3; }
            kk2 += __shfl_xor(kk2, 32);
            const float kinv = __builtin_amdgcn_rcpf(fmaxf(__builtin_amdgcn_sqrtf(kk2), 1e-12f));
            float bon = 0.f;
#pragma unroll 1
            for (int nt2 = 0; nt2 < 2; ++nt2) {
                const int n0 = hd * 64 + nt2 * 32;
                f32x16 dW = {}, dA = {};
#pragma unroll
                for (int s = 0; s < 4; ++s) { const bf16x8 aw = *(const bf16x8*)(p.W2_T() + (size_t)(n0 + tk) * 64 + 16 * s + 8 * hh); dW = MFMA32(aw, Bw[s], dW); }
#pragma unroll
                for (int s = 0; s < 4; ++s) { const bf16x8 aa = *(const bf16x8*)(p.A2_T() + (size_t)(n0 + tk) * 64 + 16 * s + 8 * hh); dA = MFMA32(aa, Ba[s], dA); }
#pragma unroll 1
                for (int q4 = 0; q4 < 4; ++q4) {
                    const int d0 = nt2 * 32 + 8 * q4 + 4 * hh, n = hd * 64 + d0;
                    float r4[4], k4[4], v4[4];
                    ps_load<4>(pl, cur, prevb, prevf, n, r4); ps_load<4>(pl, cur, prevb, prevf, 512 + n, k4); ps_load<4>(pl, cur, prevb, prevf, 1024 + n, v4);
                    const f32x4 w0 = *(const LAS f32x4*)(pl + PL_W0 + n), a0 = *(const LAS f32x4*)(pl + PL_A0 + n), kkp = *(const LAS f32x4*)(pl + PL_KK + n), ka = *(const LAS f32x4*)(pl + PL_KA + n), rk = *(const LAS f32x4*)(pl + PL_RK + n);
                    float dl[4], kp[4], av[4], bv[4];
#pragma unroll
                    for (int e = 0; e < 4; ++e) {
                        const float zw = w0[e] + dW[e];
                        const float ez = __expf(-zw);
                        const float sp = (zw > 15.f) ? ez : __logf(1.f + ez);
                        const float ew = __expf(-sp - 0.5f);
                        dl[e] = 1.f - __expf(-ew);
                        const float a = sigmoidf_(a0[e] + dA[e]);
                        const float kkn = k4[e] * kkp[e] * kinv;
                        kp[e] = k4[e] * (1.f + (a - 1.f) * ka[e]);
                        av[e] = -kkn; bv[e] = kkn * a;
                        bon += r4[e] * kp[e] * rk[e];
                    }
                    if (!samp) {
                        bf16_t* so = p.SCAN() + scan_addr(b * 8 + hd, 0, d0, t);
#pragma unroll
                        for (int e = 0; e < 4; ++e) { bf16_t* se = so + (size_t)e * TTP;
                            se[(size_t)0 * 64 * TTP] = bf16_1_(dl[e]); se[(size_t)1 * 64 * TTP] = bf16_1_(kp[e]); se[(size_t)2 * 64 * TTP] = bf16_1_(v4[e]);
                            se[(size_t)3 * 64 * TTP] = bf16_1_(av[e]); se[(size_t)4 * 64 * TTP] = bf16_1_(bv[e]); se[(size_t)5 * 64 * TTP] = bf16_1_(r4[e]); }
                    } else {
                        float* so = p.SCAN_S() + (((size_t)(row - MPR) * 8 + hd) * 6) * 64 + d0;
                        *(f32x4*)(so + 0 * 64) = (f32x4){1.f - dl[0], 1.f - dl[1], 1.f - dl[2], 1.f - dl[3]};
                        *(f32x4*)(so + 1 * 64) = (f32x4){kp[0], kp[1], kp[2], kp[3]};
                        *(f32x4*)(so + 2 * 64) = (f32x4){v4[0], v4[1], v4[2], v4[3]};
                        *(f32x4*)(so + 3 * 64) = (f32x4){av[0], av[1], av[2], av[3]};
                        *(f32x4*)(so + 4 * 64) = (f32x4){bv[0], bv[1], bv[2], bv[3]};
                        *(f32x4*)(so + 5 * 64) = (f32x4){r4[0], r4[1], r4[2], r4[3]};
                    }
                    dW = __builtin_shufflevector(dW, dW, 4, 5, 6, 7, 8, 9, 10, 11, 12, 13, 14, 15, 0, 1, 2, 3);
                    dA = __builtin_shufflevector(dA, dA, 4, 5, 6, 7, 8, 9, 10, 11, 12, 13, 14, 15, 0, 1, 2, 3);
                }
            }
            bon += __shfl_xor(bon, 32);
            if (hh == 0) p.BONUS()[(size_t)row * 8 + hd] = bon;
        }
    }
    __builtin_amdgcn_sched_barrier(0);
    {
        bf16x8 Bg[8];
#pragma unroll
        for (int s = 0; s < 8; ++s) { float x[8]; ps_load<8>(pl, cur, prevb, prevf, 1664 + 16 * s + 8 * hh, x);
#pragma unroll
            for (int i = 0; i < 8; ++i) x[i] = sigmoidf_(x[i]);
            Bg[s] = pack8(x); }
#pragma unroll 1
        for (int nt = 0; nt < 16; ++nt) {
            f32x16 dG = {};
#pragma unroll
            for (int s = 0; s < 8; ++s) { const bf16x8 ag = *(const bf16x8*)(p.G2_T() + (size_t)(nt * 32 + tk) * 128 + 16 * s + 8 * hh); dG = MFMA32(ag, Bg[s], dG); }
#pragma unroll
            for (int q4 = 0; q4 < 4; ++q4) { u32x2 og; og.x = pk2(dG[4 * q4], dG[4 * q4 + 1]); og.y = pk2(dG[4 * q4 + 2], dG[4 * q4 + 3]);
                *(u32x2*)(p.G() + (size_t)row * 512 + nt * 32 + 8 * q4 + 4 * hh) = og; }
        }
    }
}
constexpr int PV_ROWB = 3600, PV_STAGE_OFF = PL_N * 4  , PV_LDS = PV_STAGE_OFF + 33 * PV_ROWB;
template <int N>
DI void ps_lds(const LAS float* pl, const LAS char* curp, const LAS char* prevp, bool pz, int col0, float (&o)[N]) {
    float c[N], pv[N];
    if (N == 8) { const u32x4 wc = *(const LAS u32x4*)(curp + col0 * 2), wp = *(const LAS u32x4*)(prevp + col0 * 2); float t[8]; unpack8(wc, t); float u[8]; unpack8(wp, u);
#pragma unroll
        for (int i = 0; i < N; ++i) { c[i] = t[i]; pv[i] = pz ? 0.f : u[i]; } }
    else { const u32x2 w = *(const LAS u32x2*)(curp + col0 * 2), x = *(const LAS u32x2*)(prevp + col0 * 2);
        c[0] = bflo(w.x); c[1] = bfhi(w.x); c[2] = bflo(w.y); c[3] = bfhi(w.y);
        pv[0] = pz ? 0.f : bflo(x.x); pv[1] = pz ? 0.f : bfhi(x.x); pv[2] = pz ? 0.f : bflo(x.y); pv[3] = pz ? 0.f : bfhi(x.y); }
#pragma unroll
    for (int i = 0; i < N; i += 4) { const f32x4 mu = *(const LAS f32x4*)(pl + col0 + i);
        o[i] = c[i] + (pv[i] - c[i]) * mu.x; o[i + 1] = c[i + 1] + (pv[i + 1] - c[i + 1]) * mu.y;
        o[i + 2] = c[i + 2] + (pv[i + 2] - c[i + 2]) * mu.z; o[i + 3] = c[i + 3] + (pv[i + 3] - c[i + 3]) * mu.w; }
}
DI void prep_block(const Params& p, char* smem, int unit, int tid) {
    const LAS float* pl = (const LAS float*)smem;
    LAS char* stage = (LAS char*)smem + PV_STAGE_OFF;
    const bool samp = unit >= 514;
    const int row0 = samp ? MPR + (unit - 514) * 16 : unit * 32;
    __syncthreads();
#pragma unroll 1
    for (int i0 = 0; i0 < 16; i0 += 8) {
        u32x4 w[8];
#pragma unroll
        for (int i = 0; i < 8; ++i) {
            const int c = tid + 512 * (i0 + i), sl = c / 224, ch = c - sl * 224;
            w[i] = (u32x4){0u, 0u, 0u, 0u};
            if (c < 33 * 224) {
                if (!samp) { int gr = row0 - 1 + sl; gr = gr < 0 ? 0 : gr; w[i] = *(const u32x4*)(p.PROJ() + (size_t)gr * INW + ch * 8); }
                else if (sl < 16) w[i] = *(const u32x4*)(p.PROJ() + (size_t)(row0 + sl) * INW + ch * 8);
                else if (sl < 32) { const float* sp = p.state_shift + (size_t)(row0 - MPR + sl - 16) * RWP + ch * 8; const f32x4 a = *(const f32x4*)sp, b2 = *(const f32x4*)(sp + 4);
                    w[i].x = pk2(a.x, a.y); w[i].y = pk2(a.z, a.w); w[i].z = pk2(b2.x, b2.y); w[i].w = pk2(b2.z, b2.w); }
            }
        }
#pragma unroll
        for (int i = 0; i < 8; ++i) { const int c = tid + 512 * (i0 + i), sl = c / 224, ch = c - sl * 224; if (c < 33 * 224) *(LAS u32x4*)(stage + sl * PV_ROWB + ch * 16) = w[i]; }
    }
    __syncthreads();
    const int hd = tid >> 6, lane = tid & 63, tk = lane & 31, hh = lane >> 5;
    const int ntk = samp ? 16 : 32;
    const int tkc = tk < ntk ? tk : ntk - 1;
    const bool act = tk < ntk;
    const int row = row0 + tkc;
    int b = 0, t = 0; if (!samp) { b = row / TT; t = row - b * TT; }
    const LAS char* curp = stage + (samp ? tkc : tkc + 1) * PV_ROWB;
    const LAS char* prevp = stage + (samp ? 16 + tkc : tkc) * PV_ROWB;
    const bool pz = !samp && t == 0;
    {
        bf16x8 Bw[4], Ba[4];
#pragma unroll
        for (int s2 = 0; s2 < 4; ++s2) { float x[8]; ps_lds<8>(pl, curp, prevp, pz, 1536 + 16 * s2 + 8 * hh, x);
#pragma unroll
            for (int i = 0; i < 8; ++i) x[i] = tanh_fast(x[i]);
            Bw[s2] = pack8(x); }
#pragma unroll
        for (int s2 = 0; s2 < 4; ++s2) { float x[8]; ps_lds<8>(pl, curp, prevp, pz, 1600 + 16 * s2 + 8 * hh, x); Ba[s2] = pack8(x); }
        float kk2 = 0.f;
#pragma unroll 2
        for (int q8 = 0; q8 < 8; ++q8) { const int n = hd * 64 + (q8 >> 2) * 32 + 8 * (q8 & 3) + 4 * hh;
            float k4[4]; ps_lds<4>(pl, curp, prevp, pz, 512 + n, k4); const f32x4 kkp = *(const LAS f32x4*)(pl + PL_KK + n);
            const float a0 = k4[0] * kkp.x, a1 = k4[1] * kkp.y, a2 = k4[2] * kkp.z, a3 = k4[3] * kkp.w; kk2 += a0 * a0 + a1 * a1 + a2 * a2 + a3 * a3; }
        kk2 += __shfl_xor(kk2, 32);
        const float kinv = __builtin_amdgcn_rcpf(fmaxf(__builtin_amdgcn_sqrtf(kk2), 1e-12f));
        float bon = 0.f;
#pragma unroll 1
        for (int nt2 = 0; nt2 < 2; ++nt2) {
            const int n0 = hd * 64 + nt2 * 32;
            f32x16 dW = {}, dA = {};
            {
                bf16x8 aw[4], aa[4];
#pragma unroll
                for (int s2 = 0; s2 < 4; ++s2) { aw[s2] = *(const bf16x8*)(p.W2_T() + (size_t)(n0 + tk) * 64 + 16 * s2 + 8 * hh); aa[s2] = *(const bf16x8*)(p.A2_T() + (size_t)(n0 + tk) * 64 + 16 * s2 + 8 * hh); }
                __builtin_amdgcn_sched_barrier(0);
#pragma unroll
                for (int s2 = 0; s2 < 4; ++s2) { dW = MFMA32(aw[s2], Bw[s2], dW); dA = MFMA32(aa[s2], Ba[s2], dA); }
                __builtin_amdgcn_sched_barrier(0);
            }
#pragma unroll
            for (int q4 = 0; q4 < 4; ++q4) {
                const int d0 = nt2 * 32 + 8 * q4 + 4 * hh, n = hd * 64 + d0;
                float r4[4], k4[4], v4[4];
                ps_lds<4>(pl, curp, prevp, pz, n, r4); ps_lds<4>(pl, curp, prevp, pz, 512 + n, k4); ps_lds<4>(pl, curp, prevp, pz, 1024 + n, v4);
                const f32x4 w0 = *(const LAS f32x4*)(pl + PL_W0 + n), a0 = *(const LAS f32x4*)(pl + PL_A0 + n), kkp = *(const LAS f32x4*)(pl + PL_KK + n), ka = *(const LAS f32x4*)(pl + PL_KA + n), rk = *(const LAS f32x4*)(pl + PL_RK + n);
                float dl[4], kp[4], av[4], bv[4];
#pragma unroll
                for (int e = 0; e < 4; ++e) {
                    const float zw = w0[e] + dW[e];
                    const float ez = __expf(-zw);
                    const float sp = (zw > 15.f) ? ez : __logf(1.f + ez);
                    const float ew = __expf(-sp - 0.5f);
                    dl[e] = 1.f - __expf(-ew);
                    const float a = sigmoidf_(a0[e] + dA[e]);
                    const float kkn = k4[e] * kkp[e] * kinv;
                    kp[e] = k4[e] * (1.f + (a - 1.f) * ka[e]);
                    av[e] = -kkn; bv[e] = kkn * a;
                    bon += r4[e] * kp[e] * rk[e];
                }
                if (act) {
                    if (!samp) {
                        const int q = tk & 3;
                        bf16_t* so = p.SCAN() + scan_addr(b * 8 + hd, 0, d0 + q, t - q);
                        const unsigned sel1 = (q & 1) ? 0x03020706u : 0x05040100u;
                        auto quad_store = [&](int vec, const float (&x)[4]) {
                            const unsigned p01 = pk2(x[0], x[1]), p23 = pk2(x[2], x[3]);
                            const unsigned n01 = (unsigned)__builtin_amdgcn_update_dpp(0, (int)p01, 0xB1, 0xF, 0xF, false), n23 = (unsigned)__builtin_amdgcn_update_dpp(0, (int)p23, 0xB1, 0xF, 0xF, false);
                            const unsigned a0 = __builtin_amdgcn_perm(n01, p01, sel1), a1 = __builtin_amdgcn_perm(n23, p23, sel1);
                            const unsigned r = (unsigned)__builtin_amdgcn_update_dpp(0, (int)(q >= 2 ? a0 : a1), 0x4E, 0xF, 0xF, false);
                            *(u32x2*)(so + (size_t)vec * 64 * TTP) = (u32x2){q < 2 ? a0 : r, q < 2 ? r : a1};
                        };
                        quad_store(0, dl); quad_store(1, kp); quad_store(2, v4); quad_store(3, av); quad_store(4, bv); quad_store(5, r4);
                    } else {
                        float* so = p.SCAN_S() + (((size_t)(row - MPR) * 8 + hd) * 6) * 64 + d0;
                        *(f32x4*)(so + 0 * 64) = (f32x4){1.f - dl[0], 1.f - dl[1], 1.f - dl[2], 1.f - dl[3]};
                        *(f32x4*)(so + 1 * 64) = (f32x4){kp[0], kp[1], kp[2], kp[3]};
                        *(f32x4*)(so + 2 * 64) = (f32x4){v4[0], v4[1], v4[2], v4[3]};
                        *(f32x4*)(so + 3 * 64) = (f32x4){av[0], av[1], av[2], av[3]};
                        *(f32x4*)(so + 4 * 64) = (f32x4){bv[0], bv[1], bv[2], bv[3]};
                        *(f32x4*)(so + 5 * 64) = (f32x4){r4[0], r4[1], r4[2], r4[3]};
                    }
                }
                dW = __builtin_shufflevector(dW, dW, 4, 5, 6, 7, 8, 9, 10, 11, 12, 13, 14, 15, 0, 1, 2, 3);
                dA = __builtin_shufflevector(dA, dA, 4, 5, 6, 7, 8, 9, 10, 11, 12, 13, 14, 15, 0, 1, 2, 3);
            }
        }
        bon += __shfl_xor(bon, 32);
        if (hh == 0 && act) p.BONUS()[(size_t)row * 8 + hd] = bon;
    }
    __builtin_amdgcn_sched_barrier(0);
    {
        bf16x8 Bg[8];
#pragma unroll
        for (int s2 = 0; s2 < 8; ++s2) { float x[8]; ps_lds<8>(pl, curp, prevp, pz, 1664 + 16 * s2 + 8 * hh, x);
#pragma unroll
            for (int i = 0; i < 8; ++i) x[i] = sigmoidf_(x[i]);
            Bg[s2] = pack8(x); }
#pragma unroll 1
        for (int nt = 2 * hd; nt < 2 * hd + 2; ++nt) {
            f32x16 dG = {};
            {
                bf16x8 ag[8];
#pragma unroll
                for (int s2 = 0; s2 < 8; ++s2) ag[s2] = *(const bf16x8*)(p.G2_T() + (size_t)(nt * 32 + tk) * 128 + 16 * s2 + 8 * hh);
                __builtin_amdgcn_sched_barrier(0);
#pragma unroll
                for (int s2 = 0; s2 < 8; ++s2) dG = MFMA32(ag[s2], Bg[s2], dG);
                __builtin_amdgcn_sched_barrier(0);
            }
            if (act) {
#pragma unroll
                for (int q4 = 0; q4 < 4; ++q4) { u32x2 og; og.x = pk2(dG[4 * q4], dG[4 * q4 + 1]); og.y = pk2(dG[4 * q4 + 2], dG[4 * q4 + 3]);
                    *(u32x2*)(p.G() + (size_t)row * 512 + nt * 32 + 8 * q4 + 4 * hh) = og; }
            }
        }
    }
}
DI void phase_prep(const Params& p, char* smem, int bid, int nblk, int gw, int ngw, int tid, int lane) {
    LAS float* pl = (LAS float*)smem;
    for (int i = tid; i < PL_N; i += 512) {
        float v;
        if (i < PL_W0) v = p.rw_mu[i]; else if (i < PL_A0) v = p.rw_w0[i - PL_W0]; else if (i < PL_KK) v = p.rw_a0[i - PL_A0];
        else if (i < PL_KA) v = p.rw_kk[i - PL_KK]; else if (i < PL_RK) v = p.rw_ka[i - PL_KA]; else v = p.rw_rk[i - PL_RK];
        pl[i] = v;
    }
    for (int u = bid; u < 512; u += nblk) prep_block(p, smem, u, tid);
    if (bid < 4 && nblk >= 8) prep_block(p, smem, 512 + bid, tid);
    else if (nblk < 8) { for (int u = 512 + bid; u < 516; u += nblk) prep_block(p, smem, u, tid); }
    {
        const int rb = (nblk >= 8) ? bid - 4 : bid, rn = (nblk >= 8) ? nblk - 4 : nblk;
        if (rb >= 0) for (int r = rb * 8 + (tid >> 6); r < MTOT; r += rn * 8) prep_qkv_row(p, r, lane);
    }
}

DI float dpp_xor1(float x) { return __builtin_amdgcn_update_dpp(0.f, x, 0xB1, 0xF, 0xF, false); }
DI float dpp_xor2(float x) { return __builtin_amdgcn_update_dpp(0.f, x, 0x4E, 0xF, 0xF, false); }
DI float dpp_hmir(float x) { return __builtin_amdgcn_update_dpp(0.f, x, 0x141, 0xF, 0xF, false); }
DI float dpp_mir(float x)  { return __builtin_amdgcn_update_dpp(0.f, x, 0x140, 0xF, 0xF, false); }
DI float row16_sum(float v) { v += dpp_xor1(v); v += dpp_xor2(v); v += dpp_hmir(v); v += dpp_mir(v); return v; }
DI float row8_sum(float v) { v += dpp_xor1(v); v += dpp_xor2(v); v += dpp_hmir(v); return v; }

constexpr int SCAN_TS = 32;
constexpr int SCAN_TILE_B = SCAN_TS * 6 * 64 * 2;
DI void scan_unit(const Params& p, char* smem, int unit, int tid) {
    const int chain = unit >> 2, rg = unit & 3, b = chain >> 3, hd = chain & 7;
    const int wave = tid >> 6, lane = tid & 63, rl = lane >> 4, cg = lane & 15;
    const int row = rg * 16 + wave * 4 + rl, d0 = cg * 4;
    const bf16_t* src = p.SCAN() + (size_t)chain * TT * 384;
    float S0 = 0.f, S1 = 0.f, S2 = 0.f, S3 = 0.f, ykeep = 0.f;
    constexpr int NTILE = (TT + SCAN_TS - 1) / SCAN_TS;
    u32x4 pre[6];
    {
#pragma unroll
        for (int i = 0; i < 6; ++i) pre[i] = *(const u32x4*)(src + (size_t)(i * 256 + tid) * 8);
#pragma unroll
        for (int i = 0; i < 6; ++i) *(u32x4*)(smem + (i * 256 + tid) * 16) = pre[i];
    }
    __syncthreads();
    for (int tile = 0; tile < NTILE; ++tile) {
        const int t0 = tile * SCAN_TS, nst = (TT - t0) < SCAN_TS ? (TT - t0) : SCAN_TS;
        const bool more = tile + 1 < NTILE;
        if (more) {
            const int t1 = t0 + SCAN_TS; const int lim = (TT - t1) * 384 / 8;
#pragma unroll
            for (int i = 0; i < 6; ++i) { const int c = i * 256 + tid; pre[i] = c < lim ? *(const u32x4*)(src + (size_t)t1 * 384 + (size_t)c * 8) : (u32x4){0u, 0u, 0u, 0u}; }
        }
        const char* buf = smem + (tile & 1) * SCAN_TILE_B;
        for (int st = 0; st < nst; ++st) {
            const char* sp = buf + st * 768;
            const u32x2 wd = *(const u32x2*)(sp + 0 * 128 + d0 * 2), wk = *(const u32x2*)(sp + 1 * 128 + d0 * 2), wa = *(const u32x2*)(sp + 3 * 128 + d0 * 2),
                        wb = *(const u32x2*)(sp + 4 * 128 + d0 * 2), wr = *(const u32x2*)(sp + 5 * 128 + d0 * 2);
            const float vv = bf2f(*(const unsigned short*)(sp + 2 * 128 + row * 2));
            float sa = S0 * bflo(wa.x) + S1 * bfhi(wa.x) + S2 * bflo(wa.y) + S3 * bfhi(wa.y);
            sa = row16_sum(sa);
            S0 = S0 * (1.f - bflo(wd.x)) + (sa * bflo(wb.x) + vv * bflo(wk.x));
            S1 = S1 * (1.f - bfhi(wd.x)) + (sa * bfhi(wb.x) + vv * bfhi(wk.x));
            S2 = S2 * (1.f - bflo(wd.y)) + (sa * bflo(wb.y) + vv * bflo(wk.y));
            S3 = S3 * (1.f - bfhi(wd.y)) + (sa * bfhi(wb.y) + vv * bfhi(wk.y));
            float y = S0 * bflo(wr.x) + S1 * bfhi(wr.x) + S2 * bflo(wr.y) + S3 * bfhi(wr.y);
            y = row16_sum(y);
            ykeep = ((st & 15) == cg) ? y : ykeep;
            if ((st & 15) == 15) p.Y()[(size_t)(b * TT + t0 + st - 15 + cg) * 512 + hd * 64 + row] = ykeep;
        }
        if (more) {
            char* nb = smem + ((tile + 1) & 1) * SCAN_TILE_B;
#pragma unroll
            for (int i = 0; i < 6; ++i) *(u32x4*)(nb + (i * 256 + tid) * 16) = pre[i];
        }
        __syncthreads();
    }
    *(f32x4*)(p.out + OUT_WP + ((size_t)chain * 64 + row) * 64 + d0) = (f32x4){S0, S1, S2, S3};
}

constexpr int SC2_TS = 32, SC2_STEP_B = 6 * 64 * 4, SC2_TILE_B = SC2_TS * SC2_STEP_B;
struct ScanOps { f32x4 w, k, a, b, r; float v; };
DI ScanOps scan_ld(const char* sp, int d0, int row) {
    ScanOps o; o.w = *(const f32x4*)(sp + 0 * 256 + d0 * 4); o.k = *(const f32x4*)(sp + 1 * 256 + d0 * 4); o.a = *(const f32x4*)(sp + 3 * 256 + d0 * 4);
    o.b = *(const f32x4*)(sp + 4 * 256 + d0 * 4); o.r = *(const f32x4*)(sp + 5 * 256 + d0 * 4); o.v = *(const float*)(sp + 2 * 256 + row * 4); return o;
}
DI void scan_unit2(const Params& p, char* smem, int unit, int tid) {
    const int chain = unit >> 2, rg = unit & 3, b = chain >> 3, hd = chain & 7;
    const int wave = tid >> 6, lane = tid & 63, rl = lane >> 4, cg = lane & 15;
    const int row = rg * 16 + (wave & 3) * 4 + rl, d0 = cg * 4;
    const bf16_t* src = p.SCAN() + (size_t)chain * TT * 384;
    f32x4 S = {0.f, 0.f, 0.f, 0.f}; float ykeep = 0.f;
    constexpr int NTILE = (TT + SC2_TS - 1) / SC2_TS;
    u32x4 pre[3];
    auto stage_load = [&](int t1) { const int lim = (TT - t1) * 48;
#pragma unroll
        for (int i = 0; i < 3; ++i) { const int c = i * 512 + tid; pre[i] = c < lim ? *(const u32x4*)(src + (size_t)t1 * 384 + (size_t)c * 8) : (u32x4){0u, 0u, 0u, 0u}; } };
    auto stage_store = [&](char* buf) {
#pragma unroll
        for (int i = 0; i < 3; ++i) { const int c = i * 512 + tid; float f[8]; unpack8(pre[i], f);
            if (((c >> 3) % 6) == 0) {
#pragma unroll
                for (int q = 0; q < 8; ++q) f[q] = 1.f - f[q]; }
            *(f32x4*)(buf + c * 32) = (f32x4){f[0], f[1], f[2], f[3]}; *(f32x4*)(buf + c * 32 + 16) = (f32x4){f[4], f[5], f[6], f[7]}; } };
    stage_load(0); stage_store(smem);
    __syncthreads();
    for (int tile = 0; tile < NTILE; ++tile) {
        const int t0 = tile * SC2_TS, nst = (TT - t0) < SC2_TS ? (TT - t0) : SC2_TS;
        const bool more = tile + 1 < NTILE;
        if (more) stage_load(t0 + SC2_TS);
        if (wave < 4) {
            const char* buf = smem + (tile & 1) * SC2_TILE_B;
            ScanOps cur = scan_ld(buf, d0, row);
#pragma unroll 2
            for (int st = 0; st < nst; ++st) {
                const ScanOps nxt = scan_ld(buf + ((st + 1 < nst) ? (st + 1) : st) * SC2_STEP_B, d0, row);
                float sa = (S.x * cur.a.x + S.y * cur.a.y) + (S.z * cur.a.z + S.w * cur.a.w);
                const f32x4 vk = cur.k * cur.v;
                sa = row16_sum(sa);
                S = S * cur.w + (cur.b * sa + vk);
                float y = (S.x * cur.r.x + S.y * cur.r.y) + (S.z * cur.r.z + S.w * cur.r.w);
                y = row16_sum(y);
                ykeep = ((st & 15) == cg) ? y : ykeep;
                if ((st & 15) == 15) p.Y()[(size_t)(b * TT + t0 + st - 15 + cg) * 512 + hd * 64 + row] = ykeep;
                cur = nxt;
            }
        }
        if (more) stage_store(smem + ((tile + 1) & 1) * SC2_TILE_B);
        __syncthreads();
    }
    if (wave < 4) *(f32x4*)(p.out + OUT_WP + ((size_t)chain * 64 + row) * 64 + d0) = S;
}

constexpr int CK_AT = 256, CK_RT = CK_AT + 17408, CK_BT = CK_RT + 17408, CK_KT = CK_BT + 17408, CK_VV = CK_KT + 17408, CK_AAB = CK_VV + 12288, CK_ARB = CK_AAB + 16384,
              CK_AAK = CK_ARB + 16384, CK_GT = CK_AAK + 9216, CK_HT = CK_GT + 9216, CK_LDS = CK_HT + 9216, CK_RAW = CK_AAB;
static_assert(CK_LDS <= 160 * 1024 - 128, "chunk LDS");
DI bf16x8 tr_frag(const char* img, int strideB, int row0, int colB) {
    return bf16x8{};
}
DI bf16x8 ld_tr8(const char* p_lo, const char* p_hi) {
    const s16x4 lo = __builtin_amdgcn_ds_read_tr16_b64_v4i16((LAS s16x4*)p_lo), hi = __builtin_amdgcn_ds_read_tr16_b64_v4i16((LAS s16x4*)p_hi);
    return __builtin_shufflevector(lo, hi, 0, 1, 2, 3, 4, 5, 6, 7);
}
DI bf16x8 pack16s(const f32x16& x, int s) {
    float f[8];
#pragma unroll
    for (int j = 0; j < 8; ++j) f[j] = x[8 * s + j];
    return pack8(f);
}
template <int I, bool ISG> DI void ck_bs4(float (&Xs)[16], const char* smem, int col, int sq, float pl, int zofs) {
    if constexpr (I + 5 < 64) asm volatile("" : "+v"(zofs) : "v"(Xs[(I + 5) & 15]));
    const char* ap = smem + CK_AAB + (I * 64 + 16 * sq) * 4 + zofs;
    const f32x4 a0 = *(const f32x4*)ap, a1 = *(const f32x4*)(ap + 16), a2 = *(const f32x4*)(ap + 32), a3 = *(const f32x4*)(ap + 48);
    float rhs = ISG ? *(const float*)(smem + CK_ARB + (I * 64 + col) * 4) : bf2f(*(const unsigned short*)(smem + CK_BT + I * 272 + col * 2)) * pl;
    float s0 = sq == 0 ? rhs : 0.f, s1 = 0.f;
    s0 += a0.x * Xs[0]; s1 += a0.y * Xs[1]; s0 += a0.z * Xs[2]; s1 += a0.w * Xs[3];
    s0 += a1.x * Xs[4]; s1 += a1.y * Xs[5]; s0 += a1.z * Xs[6]; s1 += a1.w * Xs[7];
    s0 += a2.x * Xs[8]; s1 += a2.y * Xs[9]; s0 += a2.z * Xs[10]; s1 += a2.w * Xs[11];
    s0 += a3.x * Xs[12]; s1 += a3.y * Xs[13]; s0 += a3.z * Xs[14]; s1 += a3.w * Xs[15];
    float x = s0 + s1; x += dpp_xor1(x); x += dpp_xor2(x);
    Xs[I & 15] = (sq == (I >> 4)) ? x : Xs[I & 15];
    if constexpr (I > 0) ck_bs4<I - 1, ISG>(Xs, smem, col, sq, pl, zofs);
}
DI void chunk_prefetch(const Params& p, int unit, int tid, unsigned short (&pre)[48]) {
    if (unit >= CK_UNITS) return;
    const int chain = unit / CK_N, c = unit - chain * CK_N, t0 = c * 64, lane = tid & 63, wave = tid >> 6;
    const bool ok = t0 + lane < TT;
    const bf16_t* src = p.SCAN() + scan_addr(chain, 0, 8 * wave, t0 + lane);
#pragma unroll
    for (int v = 0; v < 6; ++v)
#pragma unroll
        for (int q = 0; q < 8; ++q) pre[v * 8 + q] = ok ? src[((size_t)v * 64 + q) * TTP] : (unsigned short)0;
}
DI void chunk_pass1(const Params& p, char* smem_, int unit, int next_unit, unsigned short (&pre)[48], int tid_) {
    int tid = tid_, zb = 0; asm volatile("" : "+v"(tid), "+v"(zb)); char* smem = smem_ + zb;
    const int chain = unit / CK_N, c = unit - chain * CK_N, t0 = c * 64;
    const int wave = tid >> 6, lane = tid & 63, tk = lane & 31, hh = lane >> 5;
    const bf16_t* src = p.SCAN() + ((size_t)chain * TT + t0) * 384;
    const int nval = (TT - t0) < 64 ? (TT - t0) : 64;
    __syncthreads();
    {
        float dl[8], kv[8], vv[8], av[8], bv[8], rv[8];
#pragma unroll
        for (int q = 0; q < 8; ++q) { dl[q] = bf2f(pre[0 * 8 + q]); kv[q] = bf2f(pre[1 * 8 + q]); vv[q] = bf2f(pre[2 * 8 + q]); av[q] = bf2f(pre[3 * 8 + q]); bv[q] = bf2f(pre[4 * 8 + q]); rv[q] = bf2f(pre[5 * 8 + q]); }
        chunk_prefetch(p, next_unit, tid, pre);
        float P[8], Pm[8], inv[8], PL[8];
#pragma unroll
        for (int q = 0; q < 8; ++q) {
            float x = 1.f - dl[q];
#pragma unroll
            for (int o = 1; o < 64; o <<= 1) { const float y = __shfl_up(x, o); x = lane >= o ? x * y : x; }
            P[q] = x; const float pm = __shfl_up(x, 1); Pm[q] = lane ? pm : 1.f;
            PL[q] = __int_as_float(__builtin_amdgcn_readlane(__float_as_int(x), 63));
            inv[q] = 1.f / x;
        }
        __syncthreads();
        float o8[8];
#pragma unroll
        for (int q = 0; q < 8; ++q) o8[q] = av[q] * Pm[q];
        *(bf16x8*)(smem + CK_AT + lane * 272 + wave * 16) = pack8(o8);
#pragma unroll
        for (int q = 0; q < 8; ++q) o8[q] = rv[q] * P[q];
        *(bf16x8*)(smem + CK_RT + lane * 272 + wave * 16) = pack8(o8);
#pragma unroll
        for (int q = 0; q < 8; ++q) o8[q] = bv[q] * inv[q];
        *(bf16x8*)(smem + CK_BT + lane * 272 + wave * 16) = pack8(o8);
#pragma unroll
        for (int q = 0; q < 8; ++q) o8[q] = kv[q] * inv[q];
        *(bf16x8*)(smem + CK_KT + lane * 272 + wave * 16) = pack8(o8);
        *(bf16x8*)(smem + CK_VV + lane * 192 + wave * 16) = pack8(vv);
        if (lane == 63) { *(f32x4*)(smem + wave * 32) = (f32x4){PL[0], PL[1], PL[2], PL[3]}; *(f32x4*)(smem + wave * 32 + 16) = (f32x4){PL[4], PL[5], PL[6], PL[7]};
            float* plo = p.PLV() + (size_t)unit * 64 + wave * 8;
            *(f32x4*)plo = (f32x4){PL[0], PL[1], PL[2], PL[3]}; *(f32x4*)(plo + 4) = (f32x4){PL[4], PL[5], PL[6], PL[7]}; }
    }
    __syncthreads();
    const float* PLs = (const float*)smem;
    {
        const int prod = wave >> 1, half = wave & 1;
        const char* imgA = smem + ((prod == 0 || prod == 1) ? ((prod == 0) ? CK_BT : CK_BT) : CK_KT);
        const char* imgB = smem + ((prod == 0 || prod == 2) ? CK_AT : CK_RT);
        f32x16 acc[2] = {};
        if (prod < 3) {
#pragma unroll
            for (int nt = 0; nt < 2; ++nt)
#pragma unroll
                for (int s2 = 0; s2 < 4; ++s2) { const bf16x8 af = *(const bf16x8*)(imgA + (32 * half + tk) * 272 + (16 * s2 + 8 * hh) * 2), bf = *(const bf16x8*)(imgB + (32 * nt + tk) * 272 + (16 * s2 + 8 * hh) * 2);
                    acc[nt] = MFMA32(af, bf, acc[nt]); }
#pragma unroll
            for (int nt = 0; nt < 2; ++nt)
#pragma unroll
                for (int r2 = 0; r2 < 16; ++r2) { const int i = 32 * half + (r2 & 3) + 8 * (r2 >> 2) + 4 * hh, t = 32 * nt + tk;
                    const bool keep = (prod == 1) ? (i <= t) : (i < t);
                    const float v = keep ? acc[nt][r2] : 0.f;
                    if (prod == 0) *(float*)(smem + CK_AAB + (i * 64 + t) * 4) = v;
                    else if (prod == 1) *(float*)(smem + CK_ARB + (i * 64 + t) * 4) = v;
                    else *(unsigned short*)(smem + CK_AAK + i * 144 + t * 2) = bf16_1_(v); }
        }
    }
    __syncthreads();
    {
        int tz3 = tid; asm volatile("" : "+v"(tz3)); const int wave3 = __builtin_amdgcn_readfirstlane(tz3 >> 6), lane3 = tz3 & 63;
        const int col = 16 * (wave3 & 3) + (lane3 >> 2), sq = lane3 & 3;
        int zo = 0; asm volatile("" : "+v"(zo));
        float Xs[16];
#pragma unroll
        for (int j = 0; j < 16; ++j) Xs[j] = 0.f;
        if (wave3 < 4) ck_bs4<63, true>(Xs, smem, col, sq, 1.f, zo); else ck_bs4<63, false>(Xs, smem, col, sq, PLs[col], zo);
        char* dst = smem + (wave3 < 4 ? CK_GT : CK_HT) + col * 144 + sq * 32;
        float f0[8], f1[8];
#pragma unroll
        for (int j = 0; j < 8; ++j) { f0[j] = Xs[j]; f1[j] = Xs[8 + j]; }
        *(bf16x8*)dst = pack8(f0); *(bf16x8*)(dst + 16) = pack8(f1);
    }
    __syncthreads();
    {
        int tz4 = tid; asm volatile("" : "+v"(tz4)); const int wave = __builtin_amdgcn_readfirstlane(tz4 >> 6), lane = tz4 & 63, tk = lane & 31, hh = lane >> 5;
        const int half = wave & 1;
        const int i16 = lane & 15, qq = i16 >> 2, pp = i16 & 3, blk = (lane >> 4) & 1;
        if (wave < 4) {
            const char* imgB = smem + (wave < 2 ? CK_GT : CK_HT);
            f32x16 acc[2] = {};
#pragma unroll
            for (int nt = 0; nt < 2; ++nt)
#pragma unroll
                for (int s2 = 0; s2 < 4; ++s2) {
                    const char* pa = smem + CK_AT + (16 * s2 + 8 * hh + qq) * 272 + (32 * half + 16 * blk + 4 * pp) * 2;
                    const bf16x8 af = ld_tr8(pa, pa + 4 * 272);
                    const bf16x8 bf = *(const bf16x8*)(imgB + (32 * nt + tk) * 144 + (16 * s2 + 8 * hh) * 2);
                    acc[nt] = MFMA32(af, bf, acc[nt]); }
            bf16_t* dst = (wave < 2 ? p.MYT() : p.MST()) + (size_t)unit * 4096;
#pragma unroll
            for (int nt = 0; nt < 2; ++nt)
#pragma unroll
                for (int q4 = 0; q4 < 4; ++q4) { const int col = 32 * nt + tk, k0 = 32 * half + 8 * q4 + 4 * hh;
                    float v0 = acc[nt][4 * q4], v1 = acc[nt][4 * q4 + 1], v2 = acc[nt][4 * q4 + 2], v3 = acc[nt][4 * q4 + 3];
                    if (wave < 2) { const u32x2 rw = *(const u32x2*)(smem + CK_RT + col * 272 + k0 * 2); v0 += bflo(rw.x); v1 += bfhi(rw.x); v2 += bflo(rw.y); v3 += bfhi(rw.y); }
                    u32x2 o; o.x = pk2(v0, v1); o.y = pk2(v2, v3);
                    *(u32x2*)(dst + (size_t)col * 64 + k0) = o; }
        } else {
            const bool isy = wave >= 6;
            const char* imgB = smem + (isy ? CK_GT : CK_HT);
            f32x16 nn[2] = {};
#pragma unroll
            for (int mt = 0; mt < 2; ++mt)
#pragma unroll
                for (int s2 = 0; s2 < 4; ++s2) { const bf16x8 af = *(const bf16x8*)(smem + CK_AAK + (32 * mt + tk) * 144 + (16 * s2 + 8 * hh) * 2), bf = *(const bf16x8*)(imgB + (32 * half + tk) * 144 + (16 * s2 + 8 * hh) * 2);
                    nn[mt] = MFMA32(af, bf, nn[mt]); }
            if (isy) {
#pragma unroll
                for (int mt = 0; mt < 2; ++mt) {
                    f32x16 ark = {};
#pragma unroll
                    for (int s2 = 0; s2 < 4; ++s2) { const bf16x8 af = *(const bf16x8*)(smem + CK_KT + (32 * mt + tk) * 272 + (16 * s2 + 8 * hh) * 2), bf = *(const bf16x8*)(smem + CK_RT + (32 * half + tk) * 272 + (16 * s2 + 8 * hh) * 2);
                        ark = MFMA32(af, bf, ark); }
#pragma unroll
                    for (int r2 = 0; r2 < 16; ++r2) { const int i = 32 * mt + (r2 & 3) + 8 * (r2 >> 2) + 4 * hh, t = 32 * half + tk; nn[mt][r2] += (i <= t) ? ark[r2] : 0.f; }
                }
            }
            else { const float pl = PLs[32 * half + tk];
#pragma unroll
                for (int mt = 0; mt < 2; ++mt)
#pragma unroll
                    for (int r2 = 0; r2 < 16; ++r2) { const int i = 32 * mt + (r2 & 3) + 8 * (r2 >> 2) + 4 * hh; nn[mt][r2] += bf2f(*(const unsigned short*)(smem + CK_KT + i * 272 + (32 * half + tk) * 2)) * pl; } }
            float* dst = (isy ? p.WYT() : p.WST()) + (size_t)unit * 4096 + (size_t)half * 2048;
#pragma unroll
            for (int vt = 0; vt < 2; ++vt) {
                f32x16 wacc = {};
#pragma unroll
                for (int mt = 0; mt < 2; ++mt)
#pragma unroll
                    for (int s2 = 0; s2 < 2; ++s2) {
                        const bf16x8 af = pack16s(nn[mt], s2);
                        const char* pb = smem + CK_VV + (32 * mt + 16 * s2 + 4 * hh + qq) * 192 + (32 * vt + 16 * blk + 4 * pp) * 2;
                        const bf16x8 bf = ld_tr8(pb, pb + 8 * 192);
                        wacc = MFMA32(af, bf, wacc); }
#pragma unroll
                for (int r2 = 0; r2 < 16; ++r2) dst[(vt * 16 + r2) * 64 + lane] = wacc[r2];
            }
        }
    }
}
struct P2Ops { u32x2 a[2][2][2][2]; f32x4 pl[2][4]; float ws[2][16]; };
DI void p2_load(const Params& p, size_t u, int vh, int tk, int hh, int lane, P2Ops& o) {
    const bf16_t* ms = p.MST() + u * 4096; const float* plv = p.PLV() + u * 64; const float* ws = p.WST() + u * 4096;
#pragma unroll
    for (int mt = 0; mt < 2; ++mt) {
#pragma unroll
        for (int kt = 0; kt < 2; ++kt)
#pragma unroll
            for (int s2 = 0; s2 < 2; ++s2) { const bf16_t* ap = ms + (size_t)(32 * mt + tk) * 64 + 32 * kt + 16 * s2 + 4 * hh; o.a[mt][kt][s2][0] = *(const u32x2*)ap; o.a[mt][kt][s2][1] = *(const u32x2*)(ap + 8); }
#pragma unroll
        for (int q4 = 0; q4 < 4; ++q4) o.pl[mt][q4] = *(const f32x4*)(plv + 32 * mt + 8 * q4 + 4 * hh);
#pragma unroll
        for (int r2 = 0; r2 < 16; ++r2) o.ws[mt][r2] = ws[((size_t)mt * 2 + vh) * 1024 + r2 * 64 + lane];
    }
}
DI void chunk_pass2(const Params& p, int wunit, int lane, volatile LAS int* prog) {
    const int chain = wunit >> 1, vh = wunit & 1, tk = lane & 31, hh = lane >> 5;
    f32x16 st[2] = {};
    P2Ops cur; p2_load(p, (size_t)chain * CK_N, vh, tk, hh, lane, cur);
#pragma unroll 1
    for (int c = 0; c < CK_N; ++c) {
        const size_t u = (size_t)chain * CK_N + c;
        P2Ops nxt; p2_load(p, c + 1 < CK_N ? u + 1 : u, vh, tk, hh, lane, nxt);
        bf16x8 fh[2][2], fl[2][2];
#pragma unroll
        for (int kt = 0; kt < 2; ++kt)
#pragma unroll
            for (int s2 = 0; s2 < 2; ++s2) { float h8[8], l8[8];
#pragma unroll
                for (int j = 0; j < 8; ++j) { const float x = st[kt][8 * s2 + j]; const float xh = bflo(pk2(x, 0.f)); h8[j] = xh; l8[j] = x - xh; }
                fh[kt][s2] = pack8(h8); fl[kt][s2] = pack8(l8);
                u32x4* sc = (u32x4*)p.SCF() + ((((u * 2 + vh) * 2 + kt) * 2 + s2) * 2) * 64 + lane;
                sc[0] = __builtin_bit_cast(u32x4, fh[kt][s2]); sc[64] = __builtin_bit_cast(u32x4, fl[kt][s2]); }
        f32x16 nt[2];
#pragma unroll
        for (int mt = 0; mt < 2; ++mt) {
            f32x16 acc;
#pragma unroll
            for (int q4 = 0; q4 < 4; ++q4) { const f32x4 pl = cur.pl[mt][q4];
                acc[4 * q4] = cur.ws[mt][4 * q4] + st[mt][4 * q4] * pl.x; acc[4 * q4 + 1] = cur.ws[mt][4 * q4 + 1] + st[mt][4 * q4 + 1] * pl.y;
                acc[4 * q4 + 2] = cur.ws[mt][4 * q4 + 2] + st[mt][4 * q4 + 2] * pl.z; acc[4 * q4 + 3] = cur.ws[mt][4 * q4 + 3] + st[mt][4 * q4 + 3] * pl.w; }
#pragma unroll
            for (int kt = 0; kt < 2; ++kt)
#pragma unroll
                for (int s2 = 0; s2 < 2; ++s2) {
                    const u32x2 a0 = cur.a[mt][kt][s2][0], a1 = cur.a[mt][kt][s2][1];
                    const bf16x8 af = __builtin_bit_cast(bf16x8, (u32x4){a0.x, a0.y, a1.x, a1.y});
                    acc = MFMA32(af, fh[kt][s2], acc); acc = MFMA32(af, fl[kt][s2], acc); }
            nt[mt] = acc;
        }
        st[0] = nt[0]; st[1] = nt[1];
        cur = nxt;
        if (lane == 0) *prog = c + 1;
    }
    float* so = p.out + OUT_WP + ((size_t)chain * 64 + 32 * vh + tk) * 64;
#pragma unroll
    for (int kt = 0; kt < 2; ++kt)
#pragma unroll
        for (int q4 = 0; q4 < 4; ++q4) *(f32x4*)(so + 32 * kt + 8 * q4 + 4 * hh) = (f32x4){st[kt][4 * q4], st[kt][4 * q4 + 1], st[kt][4 * q4 + 2], st[kt][4 * q4 + 3]};
}
DI void chunk_pass2_prefetch(const Params& p, int wunit, int lane, volatile LAS int* prog) {
    const int chain = wunit >> 1, vh = wunit & 1;
    unsigned sink = 0;
    for (int c = 1; c < CK_N; ++c) {
        for (int spin = 0; spin < 200000 && *prog + 8 < c; ++spin) __builtin_amdgcn_s_sleep(4);
        const size_t u = (size_t)chain * CK_N + c;
        const char* l0 = (const char*)(p.MST() + u * 4096) + lane * 128;
        const char* l1 = (const char*)(p.WST() + u * 4096) + (size_t)(((lane >> 5) * 2 + vh) * 4096) + (lane & 31) * 128;
        sink += *(const volatile unsigned*)l0 + *(const volatile unsigned*)l1;
        if (lane < 2) sink += *(const volatile unsigned*)((const char*)(p.PLV() + u * 64) + lane * 128);
    }
    asm volatile("" :: "v"(sink));
}
DI float half32_sum(float v) {
    v += dpp_xor1(v); v += dpp_xor2(v); v += dpp_hmir(v); v += dpp_mir(v); v += __shfl_xor(v, 16); return v;
}
DI void chunk_pass3(const Params& p, int hunit, int lane) {
    const int unit = hunit >> 1, tt = hunit & 1;
    const int chain = unit / CK_N, c = unit - chain * CK_N, b = chain >> 3, hd = chain & 7, tk = lane & 31, hh = lane >> 5;
    const bf16_t* my = p.MYT() + (size_t)unit * 4096;
    const u32x4* sc = (const u32x4*)p.SCF() + (size_t)unit * 16 * 64 + lane;
    const float* wy = p.WYT() + (size_t)unit * 4096;
    bf16x8 Bf[2][2][2][2];
#pragma unroll
    for (int vt = 0; vt < 2; ++vt)
#pragma unroll
        for (int kt = 0; kt < 2; ++kt)
#pragma unroll
            for (int s2 = 0; s2 < 2; ++s2)
#pragma unroll
                for (int x = 0; x < 2; ++x) Bf[vt][kt][s2][x] = __builtin_bit_cast(bf16x8, sc[((((vt * 2 + kt) * 2 + s2) * 2) + x) * 64]);
    {
        f32x16 acc[2];
#pragma unroll
        for (int vt = 0; vt < 2; ++vt) {
#pragma unroll
            for (int r2 = 0; r2 < 16; ++r2) acc[vt][r2] = wy[((size_t)tt * 2 + vt) * 1024 + r2 * 64 + lane];
#pragma unroll
            for (int kt = 0; kt < 2; ++kt)
#pragma unroll
                for (int s2 = 0; s2 < 2; ++s2) {
                    const bf16_t* ap = my + (size_t)(32 * tt + tk) * 64 + 32 * kt + 16 * s2 + 4 * hh;
                    const u32x2 a0 = *(const u32x2*)ap, a1 = *(const u32x2*)(ap + 8);
                    const bf16x8 af = __builtin_bit_cast(bf16x8, (u32x4){a0.x, a0.y, a1.x, a1.y});
                    acc[vt] = MFMA32(af, Bf[vt][kt][s2][0], acc[vt]); acc[vt] = MFMA32(af, Bf[vt][kt][s2][1], acc[vt]); }
        }
        const float lg0 = p.rw_ln_g[hd * 64 + tk], lg1 = p.rw_ln_g[hd * 64 + 32 + tk], lb0 = p.rw_ln_b[hd * 64 + tk], lb1 = p.rw_ln_b[hd * 64 + 32 + tk];
#pragma unroll
        for (int r2 = 0; r2 < 16; ++r2) {
            const int t = c * 64 + 32 * tt + (r2 & 3) + 8 * (r2 >> 2) + 4 * hh;
            const float mu = half32_sum(acc[0][r2] + acc[1][r2]) * (1.f / 64.f);
            const float d0 = acc[0][r2] - mu, d1 = acc[1][r2] - mu;
            const float rs = rsqrtf(half32_sum(d0 * d0 + d1 * d1) * (1.f / 64.f) + 64e-5f);
            if (t < TT) {
                const size_t row = (size_t)b * TT + t;
                const bf16_t* vp = p.SCAN() + scan_addr(chain, 2, 0, t);
                const float bon = p.BONUS()[row * 8 + hd];
                const float o0 = (d0 * rs * lg0 + lb0 + bon * bf2f(vp[(size_t)tk * TTP])) * bf2f(p.G()[row * 512 + hd * 64 + tk]);
                const float o1 = (d1 * rs * lg1 + lb1 + bon * bf2f(vp[(size_t)(32 + tk) * TTP])) * bf2f(p.G()[row * 512 + hd * 64 + 32 + tk]);
                p.YO()[row * DM + hd * 64 + tk] = bf16_1_(o0); p.YO()[row * DM + hd * 64 + 32 + tk] = bf16_1_(o1);
            }
        }
    }
}

DI void rwkv_sample_unit(const Params& p, int unit, int tid) {
    const int s = unit >> 3, hd = unit & 7, row = tid >> 2, c0 = (tid & 3) * 16;
    const float* S0 = p.state_wkv + (((size_t)s * 8 + hd) * 64 + row) * 64 + c0;
    const float* in = p.SCAN_S() + ((size_t)s * 8 + hd) * 384;
    float S[16]; float sa = 0.f;
#pragma unroll
    for (int i = 0; i < 16; i += 4) { const f32x4 v = *(const f32x4*)(S0 + i); S[i] = v.x; S[i + 1] = v.y; S[i + 2] = v.z; S[i + 3] = v.w; }
#pragma unroll
    for (int i = 0; i < 16; ++i) sa += S[i] * in[3 * 64 + c0 + i];
    sa += dpp_xor1(sa); sa += dpp_xor2(sa);
    const float vv = in[2 * 64 + row];
    float y = 0.f;
#pragma unroll
    for (int i = 0; i < 16; ++i) { S[i] = S[i] * in[0 * 64 + c0 + i] + sa * in[4 * 64 + c0 + i] + vv * in[1 * 64 + c0 + i]; y += S[i] * in[5 * 64 + c0 + i]; }
    y += dpp_xor1(y); y += dpp_xor2(y);
    float* So = p.out + OUT_WS + (((size_t)s * 8 + hd) * 64 + row) * 64 + c0;
#pragma unroll
    for (int i = 0; i < 16; i += 4) *(f32x4*)(So + i) = (f32x4){S[i], S[i + 1], S[i + 2], S[i + 3]};
    if ((tid & 3) == 0) p.Y()[(size_t)(MPR + s) * 512 + hd * 64 + row] = y;
}

DI void rwkv_post_row(const Params& p, int row, int lane) {
    const int n0 = lane * 8, hd = lane >> 3;
    const f32x4 ya = *(const f32x4*)(p.Y() + (size_t)row * 512 + n0), yb = *(const f32x4*)(p.Y() + (size_t)row * 512 + n0 + 4);
    float y[8] = {ya.x, ya.y, ya.z, ya.w, yb.x, yb.y, yb.z, yb.w};
    float s = 0.f;
#pragma unroll
    for (int i = 0; i < 8; ++i) s += y[i];
    const float mu = row8_sum(s) * (1.f / 64.f);
    float q = 0.f;
#pragma unroll
    for (int i = 0; i < 8; ++i) { y[i] -= mu; q += y[i] * y[i]; }
    const float rs = rsqrtf(row8_sum(q) * (1.f / 64.f) + 64e-5f);
    float v[8];
    if (row < MPR) { const int b = row / TT, t = row - b * TT; unpack8(*(const u32x4*)(p.SCAN() + (((size_t)(b * 8 + hd) * TT + t) * 6 + 2) * 64 + (n0 & 63)), v); }
    else { const float* vs = p.SCAN_S() + (((size_t)(row - MPR) * 8 + hd) * 6 + 2) * 64 + (n0 & 63);
#pragma unroll
        for (int i = 0; i < 8; ++i) v[i] = vs[i]; }
    float g[8]; unpack8(*(const u32x4*)(p.G() + (size_t)row * 512 + n0), g);
    const float bon = p.BONUS()[(size_t)row * 8 + hd];
    float o[8];
#pragma unroll
    for (int i = 0; i < 8; ++i) o[i] = (y[i] * rs * p.rw_ln_g[n0 + i] + p.rw_ln_b[n0 + i] + bon * v[i]) * g[i];
    *(u32x4*)(p.YO() + (size_t)row * DM + n0) = __builtin_bit_cast(u32x4, pack8(o));
}

DI float compute_lam(const Params& p, int lane) {
    const float a = p.da_lam[lane] * p.da_lam[64 + lane], b = p.da_lam[128 + lane] * p.da_lam[192 + lane];
    return __expf(wave_sum(a)) - __expf(wave_sum(b)) + LAM_INIT;
}
constexpr int AT_KROW = 272, AT_VROW = 320, AT_BUF = 64 * AT_KROW + 64 * AT_VROW  , AT_V_OFF = 64 * AT_KROW, AT_X_OFF = 0, AT_LDS = 2 * AT_BUF;
DI void attn_unit(const Params& p, char* smem, int b, int h, int qb, float lam, int dmax, int tid) {
    const int wave = tid >> 6, lane = tid & 63, qs = wave >> 1, c = wave & 1, tk = lane & 31, hh = lane >> 5;
    const int qrow0 = qb * 128 + qs * 32, t = qrow0 + tk, tq = t < TT ? t : TT - 1;
    const size_t rb = (size_t)b * TT;
    const float c1 = 0.125f * LOG2E, slope2 = exp2f(-2.f * (h + 1)) * LOG2E;
    const int tref = qb * 128;
    bf16x8 Qf[4];
#pragma unroll
    for (int s = 0; s < 4; ++s) Qf[s] = *(const bf16x8*)(p.QN() + (rb + tq) * 512 + h * 128 + c * 64 + 16 * s + 8 * hh);
    f32x16 O[4] = {};
    float m = -1e30f, l = 0.f;
    const int kmax = (qb * 128 + 127 < TT - 1) ? qb * 128 + 127 : TT - 1;
    const int ntile = kmax / 64 + 1;
    int kts = (qb * 128 - dmax) / 64; kts = kts < 0 ? 0 : kts;
    const bool wave_live = qrow0 < TT;
    u32x4 rkA[2], rvA[2], rkB[2], rvB[2];
    auto g_load = [&](int kt0, u32x4 (&rk)[2], u32x4 (&rv)[2]) {
#pragma unroll
        for (int i = 0; i < 2; ++i) { const int ch = tid + 512 * i, key = ch >> 4, part = ch & 15; int kr = kt0 + key; kr = kr < TT ? kr : TT - 1;
            rk[i] = *(const u32x4*)(p.KN() + (rb + kr) * 512 + h * 128 + part * 8);
            rv[i] = *(const u32x4*)(p.PROJ() + (rb + kr) * INW + O_V + h * 128 + part * 8); } };
    auto l_store = [&](char* buf, const u32x4 (&rk)[2], const u32x4 (&rv)[2]) {
#pragma unroll
        for (int i = 0; i < 2; ++i) { const int ch = tid + 512 * i, key = ch >> 4, part = ch & 15;
            *(u32x4*)(buf + key * AT_KROW + part * 16) = rk[i]; *(u32x4*)(buf + AT_V_OFF + key * AT_VROW + part * 16) = rv[i]; } };
    auto tile_compute = [&](int kt0, const char* buf) {
        if (wave_live && kt0 <= qrow0 + 31) {
            f32x16 St[2] = {};
#pragma unroll
            for (int sub = 0; sub < 2; ++sub)
#pragma unroll
                for (int s = 0; s < 4; ++s) { const bf16x8 kf = *(const bf16x8*)(buf + (sub * 32 + tk) * AT_KROW + (c * 64 + 16 * s + 8 * hh) * 2); St[sub] = MFMA32(kf, Qf[s], St[sub]); }
            const bool diag = kt0 + 63 > qrow0;
            const float bias0 = slope2 * (float)(kt0 + 4 * hh - tref);
#pragma unroll
            for (int sub = 0; sub < 2; ++sub)
#pragma unroll
                for (int i = 0; i < 16; ++i) St[sub][i] = fmaf(St[sub][i], c1, fmaf(slope2, (float)(sub * 32 + (i & 3) + 8 * (i >> 2)), bias0));
            if (diag) {
#pragma unroll
                for (int sub = 0; sub < 2; ++sub)
#pragma unroll
                    for (int i = 0; i < 16; ++i) { const int key = kt0 + sub * 32 + (i & 3) + 8 * (i >> 2) + 4 * hh; if (key > t) St[sub][i] = -INFINITY; }
            }
            float mx = -1e30f;
#pragma unroll
            for (int sub = 0; sub < 2; ++sub)
#pragma unroll
                for (int i = 0; i < 16; ++i) mx = fmaxf(mx, St[sub][i]);
            mx = fmaxf(mx, __shfl_xor(mx, 32));
            const float mn = fmaxf(m, mx), alpha = __builtin_amdgcn_exp2f(m - mn);
            m = mn; l *= alpha;
#pragma unroll
            for (int dt = 0; dt < 4; ++dt)
#pragma unroll
                for (int i = 0; i < 16; ++i) O[dt][i] *= alpha;
#pragma unroll
            for (int sub = 0; sub < 2; ++sub)
#pragma unroll
                for (int i = 0; i < 16; ++i) { const float pv = __builtin_amdgcn_exp2f(St[sub][i] - mn); St[sub][i] = pv; l += pv; }
            const int i16 = lane & 15, qq = i16 >> 2, pp = i16 & 3, blk = (lane >> 4) & 1;
#pragma unroll
            for (int sub = 0; sub < 2; ++sub)
#pragma unroll
                for (int s2 = 0; s2 < 2; ++s2) {
                    float pf8[8];
#pragma unroll
                    for (int j = 0; j < 8; ++j) pf8[j] = St[sub][8 * s2 + j];
                    const bf16x8 Pf = pack8(pf8);
                    const int keyb = sub * 32 + 16 * s2 + 4 * hh + qq;
#pragma unroll
                    for (int dt = 0; dt < 4; ++dt) {
                        const int colb = (dt * 32 + 16 * blk + 4 * pp) * 2;
                        const s16x4 lo = __builtin_amdgcn_ds_read_tr16_b64_v4i16((LAS s16x4*)(buf + AT_V_OFF + keyb * AT_VROW + colb));
                        const s16x4 hi = __builtin_amdgcn_ds_read_tr16_b64_v4i16((LAS s16x4*)(buf + AT_V_OFF + (keyb + 8) * AT_VROW + colb));
                        const bf16x8 Vf = __builtin_shufflevector(lo, hi, 0, 1, 2, 3, 4, 5, 6, 7);
                        O[dt] = MFMA32(Vf, Pf, O[dt]);
                    }
                }
        }
    };
    __syncthreads();
    g_load(kts * 64, rkA, rvA); l_store(smem, rkA, rvA);
    if (kts + 1 < ntile) g_load(kts * 64 + 64, rkA, rvA);
    __syncthreads();
    for (int kt = kts; kt < ntile; kt += 2) {
        if (kt + 2 < ntile) g_load(kt * 64 + 128, rkB, rvB);
        tile_compute(kt * 64, smem);
        if (kt + 1 < ntile) l_store(smem + AT_BUF, rkA, rvA);
        __syncthreads();
        if (kt + 1 < ntile) {
            if (kt + 3 < ntile) g_load(kt * 64 + 192, rkA, rvA);
            tile_compute(kt * 64 + 64, smem + AT_BUF);
            if (kt + 2 < ntile) l_store(smem, rkB, rvB);
        }
        __syncthreads();
    }
    l += __shfl_xor(l, 32);
    const float linv = 1.f / l;
    float* xch = (float*)(smem + AT_X_OFF) + qs * (128 * 32);
    if (c == 1) {
#pragma unroll
        for (int dt = 0; dt < 4; ++dt)
#pragma unroll
            for (int i = 0; i < 16; ++i) { const int dv = dt * 32 + (i & 3) + 8 * (i >> 2) + 4 * hh; xch[dv * 32 + tk] = O[dt][i] * linv; }
    }
    __syncthreads();
    if (c == 0) {
        float ss = 0.f;
#pragma unroll
        for (int dt = 0; dt < 4; ++dt)
#pragma unroll
            for (int i = 0; i < 16; ++i) { const int dv = dt * 32 + (i & 3) + 8 * (i >> 2) + 4 * hh; const float o = O[dt][i] * linv - lam * xch[dv * 32 + tk]; O[dt][i] = o; ss += o * o; }
        ss += __shfl_xor(ss, 32);
        const float rs = rsqrtf(ss * (1.f / 128.f) + 1e-6f) * (1.f - LAM_INIT);
        if (t < TT) {
#pragma unroll
            for (int dt = 0; dt < 4; ++dt)
#pragma unroll
                for (int q4 = 0; q4 < 4; ++q4) { const int dv = dt * 32 + 8 * q4 + 4 * hh; const f32x4 g = *(const f32x4*)(p.da_subln_g + dv);
                    u32x2 o; o.x = pk2(O[dt][4 * q4] * rs * g.x, O[dt][4 * q4 + 1] * rs * g.y); o.y = pk2(O[dt][4 * q4 + 2] * rs * g.z, O[dt][4 * q4 + 3] * rs * g.w);
                    *(u32x2*)(p.YO() + (rb + t) * DM + 512 + h * 128 + dv) = o; }
        }
    }
}
DI int alibi_dmax(const Params& p, int h, int lane) {
    float gq = fabsf(p.da_qn_g[lane]), gk = fabsf(p.da_kn_g[lane]);
#pragma unroll
    for (int o = 1; o < 64; o <<= 1) { gq = fmaxf(gq, __shfl_xor(gq, o)); gk = fmaxf(gk, __shfl_xor(gk, o)); }
    const float B = 8.f * gq * gk * LOG2E, slope2 = exp2f(-2.f * (h + 1)) * LOG2E;
    const float d = (2.f * B + 40.f) / slope2;
    return d > 1.0e6f ? 1000000 : (int)d + 1;
}
constexpr int AT_NQB = 33, AT_UNITS = NB * 4 * AT_NQB;

DI void sattn_unit(const Params& p, int unit, int lane) {
    const int split = unit & 15, bh = unit >> 4, b = bh >> 2, h = bh & 3;
    const int ps = lane >> 3, sub = lane & 7;
    const float c1 = 0.125f * LOG2E, slope2 = exp2f(-2.f * (h + 1)) * LOG2E;
    f32x4 q[4];
    {
        const bf16_t* qr = p.QN() + (size_t)(MPR + b) * 512 + h * 128;
#pragma unroll
        for (int i = 0; i < 4; ++i) { const u32x2 w = *(const u32x2*)(qr + i * 32 + sub * 4); q[i] = (f32x4){bflo(w.x) * c1, bfhi(w.x) * c1, bflo(w.y) * c1, bfhi(w.y) * c1}; }
    }
    float m0 = -1e30f, m1 = -1e30f, l0 = 0.f, l1 = 0.f;
    f32x4 O0[4], O1[4];
#pragma unroll
    for (int i = 0; i < 4; ++i) { O0[i] = (f32x4){0.f, 0.f, 0.f, 0.f}; O1[i] = (f32x4){0.f, 0.f, 0.f, 0.f}; }
    struct RowSet { f32x4 k[4], v[4]; };
    auto ld = [&](int it, RowSet& r) {
        const int pos = split * 512 + it * 8 + ps;
        const int phys = p.page_table[b * NPAGES + (pos >> 7)];
        const size_t ro = (((size_t)phys * PAGE + (pos & 127)) * 4 + h) * 128 + sub * 4;
#pragma unroll
        for (int i = 0; i < 4; ++i) r.k[i] = __builtin_nontemporal_load((const f32x4*)(p.cache_k + ro + i * 32));
#pragma unroll
        for (int i = 0; i < 4; ++i) r.v[i] = __builtin_nontemporal_load((const f32x4*)(p.cache_v + ro + i * 32));
    };
    auto step = [&](int it, const RowSet& r) {
        const int pos = split * 512 + it * 8 + ps;
        float s0 = r.k[0].x * q[0].x + r.k[0].y * q[0].y + r.k[0].z * q[0].z + r.k[0].w * q[0].w + r.k[1].x * q[1].x + r.k[1].y * q[1].y + r.k[1].z * q[1].z + r.k[1].w * q[1].w;
        float s1 = r.k[2].x * q[2].x + r.k[2].y * q[2].y + r.k[2].z * q[2].z + r.k[2].w * q[2].w + r.k[3].x * q[3].x + r.k[3].y * q[3].y + r.k[3].z * q[3].z + r.k[3].w * q[3].w;
        s0 += dpp_xor1(s0); s0 += dpp_xor2(s0); s0 += dpp_hmir(s0);
        s1 += dpp_xor1(s1); s1 += dpp_xor2(s1); s1 += dpp_hmir(s1);
        const float bias = slope2 * (float)(PAST - pos);
        s0 -= bias; s1 -= bias;
        const float n0 = fmaxf(m0, s0), a0 = __builtin_amdgcn_exp2f(m0 - n0), e0 = __builtin_amdgcn_exp2f(s0 - n0);
        const float n1 = fmaxf(m1, s1), a1 = __builtin_amdgcn_exp2f(m1 - n1), e1 = __builtin_amdgcn_exp2f(s1 - n1);
        m0 = n0; m1 = n1; l0 = l0 * a0 + e0; l1 = l1 * a1 + e1;
#pragma unroll
        for (int i = 0; i < 4; ++i) { O0[i] = O0[i] * a0 + r.v[i] * e0; O1[i] = O1[i] * a1 + r.v[i] * e1; }
    };
    RowSet A, B, C;
    ld(0, A); ld(1, B);
#pragma unroll 1
    for (int it = 0; it < 63; it += 3) {
        ld(it + 2, C); step(it, A);
        ld(it + 3, A); step(it + 1, B);
        if (it + 4 < 64) ld(it + 4, B);
        step(it + 2, C);
    }
    step(63, A);
    float ma0 = m0, ma1 = m1;
#pragma unroll
    for (int o = 8; o < 64; o <<= 1) { ma0 = fmaxf(ma0, __shfl_xor(ma0, o)); ma1 = fmaxf(ma1, __shfl_xor(ma1, o)); }
    const float sc0 = __builtin_amdgcn_exp2f(m0 - ma0), sc1 = __builtin_amdgcn_exp2f(m1 - ma1);
    l0 *= sc0; l1 *= sc1;
#pragma unroll
    for (int o = 8; o < 64; o <<= 1) { l0 += __shfl_xor(l0, o); l1 += __shfl_xor(l1, o); }
#pragma unroll
    for (int i = 0; i < 4; ++i)
#pragma unroll
        for (int e = 0; e < 4; ++e) { float x0 = O0[i][e] * sc0, x1 = O1[i][e] * sc1;
#pragma unroll
            for (int o = 8; o < 64; o <<= 1) { x0 += __shfl_xor(x0, o); x1 += __shfl_xor(x1, o); }
            O0[i][e] = x0; O1[i][e] = x1; }
    if (ps == 0) {
        float* d0 = p.PART() + ((size_t)unit * 2 + 0) * 130; float* d1 = d0 + 130;
        if (sub == 0) { d0[0] = ma0; d0[1] = l0; d1[0] = ma1; d1[1] = l1; }
#pragma unroll
        for (int i = 0; i < 4; ++i) { *(f32x2*)(d0 + 2 + i * 32 + sub * 4) = (f32x2){O0[i].x, O0[i].y}; *(f32x2*)(d0 + 2 + i * 32 + sub * 4 + 2) = (f32x2){O0[i].z, O0[i].w};
            *(f32x2*)(d1 + 2 + i * 32 + sub * 4) = (f32x2){O1[i].x, O1[i].y}; *(f32x2*)(d1 + 2 + i * 32 + sub * 4 + 2) = (f32x2){O1[i].z, O1[i].w}; }
    }
}
DI void sattn_combine(const Params& p, int bh, float lam, int lane) {
    const int b = bh >> 2, h = bh & 3, row = MPR + b;
    const float c1 = 0.125f * LOG2E;
    float o[2][2];
    const float v0 = bf2f(p.PROJ()[(size_t)row * INW + O_V + h * 128 + lane]), v1 = bf2f(p.PROJ()[(size_t)row * INW + O_V + h * 128 + 64 + lane]);
#pragma unroll
    for (int c = 0; c < 2; ++c) {
        const float qd = bf2f(p.QN()[(size_t)row * 512 + h * 128 + c * 64 + lane]), kd = bf2f(p.KN()[(size_t)row * 512 + h * 128 + c * 64 + lane]);
        const float sself = wave_sum(qd * kd) * c1;
        float mm = sself;
        for (int s = 0; s < SA_SPLITS; ++s) mm = fmaxf(mm, p.PART()[((size_t)(bh * 16 + s) * 2 + c) * 130]);
        const float pself = __builtin_amdgcn_exp2f(sself - mm);
        float lt = pself, a0 = pself * v0, a1 = pself * v1;
        for (int s = 0; s < SA_SPLITS; ++s) { const float* pp = p.PART() + ((size_t)(bh * 16 + s) * 2 + c) * 130; const float sc = __builtin_amdgcn_exp2f(pp[0] - mm);
            lt += pp[1] * sc; a0 += pp[2 + lane] * sc; a1 += pp[2 + 64 + lane] * sc; }
        o[c][0] = a0 / lt; o[c][1] = a1 / lt;
    }
    const float r0 = o[0][0] - lam * o[1][0], r1 = o[0][1] - lam * o[1][1];
    const float ss = wave_sum(r0 * r0 + r1 * r1);
    const float rs = rsqrtf(ss * (1.f / 128.f) + 1e-6f) * (1.f - LAM_INIT);
    p.YO()[(size_t)row * DM + 512 + h * 128 + lane] = (bf16_t)(pk2(r0 * rs * p.da_subln_g[lane], 0.f) & 0xffffu);
    p.YO()[(size_t)row * DM + 512 + h * 128 + 64 + lane] = (bf16_t)(pk2(r1 * rs * p.da_subln_g[64 + lane], 0.f) & 0xffffu);
}

struct EpiBr1 {
    const bf16_t* PROJ; bf16_t* MIX;
    DI void operator()(const AccT& acc, int brow, int bcol, int wr, int wc, int fr, int fq) const {
        EPI_ROWS_BEGIN
            EPI_COLS_BEGIN
                const u32x2 g = *(const u32x2*)(PROJ + (size_t)row * INW + O_GA + col);
                u32x2 o; o.x = pk2(a.x * sigmoidf_(bflo(g.x)), a.y * sigmoidf_(bfhi(g.x))); o.y = pk2(a.z * sigmoidf_(bflo(g.y)), a.w * sigmoidf_(bfhi(g.y)));
                *(u32x2*)(MIX + (size_t)row * DM + col) = o;
            }
        }
    }
};
struct EpiBr2 {
    const bf16_t* PROJ; bf16_t* MIX;
    DI void operator()(const AccT& acc, int brow, int bcol, int wr, int wc, int fr, int fq) const {
        EPI_ROWS_BEGIN
            EPI_COLS_BEGIN
                const u32x2 g = *(const u32x2*)(PROJ + (size_t)row * INW + O_GB + col);
                const u32x2 f = *(const u32x2*)(MIX + (size_t)row * DM + col);
                u32x2 o; o.x = pk2(bflo(f.x) + a.x * sigmoidf_(bflo(g.x)), bfhi(f.x) + a.y * sigmoidf_(bfhi(g.x))); o.y = pk2(bflo(f.y) + a.z * sigmoidf_(bflo(g.y)), bfhi(f.y) + a.w * sigmoidf_(bfhi(g.y)));
                *(u32x2*)(MIX + (size_t)row * DM + col) = o;
            }
        }
    }
};
struct EpiOut {
    const float* const* XPTR; float* H1; bf16_t* HB; float* SS2;
    DI void operator()(const AccT& acc, int brow, int bcol, int wr, int wc, int fr, int fq) const {
        EPI_ROWS_BEGIN
            const float* xr = XPTR[row];
            float ss = 0.f;
            EPI_COLS_BEGIN
                f32x4 v = a;
                v += *(const f32x4*)(xr + col);
                ss += v.x * v.x + v.y * v.y + v.z * v.z + v.w * v.w;
                *(f32x4*)(H1 + (size_t)row * DM + col) = v;
                u32x2 o; o.x = pk2(v.x, v.y); o.y = pk2(v.z, v.w);
                *(u32x2*)(HB + (size_t)row * DM + col) = o;
            }
            ss += __shfl_xor(ss, 16); ss += __shfl_xor(ss, 32);
            if (fq == 0) atomicAdd(SS2 + row, ss);
        }
    }
};
struct EpiQ {
    const float* SS2; bf16_t* QP;
    DI void operator()(const AccT& acc, int brow, int bcol, int wr, int wc, int fr, int fq) const {
        EPI_ROWS_BEGIN
            const float rs = rsqrtf(SS2[row] * (1.f / DM) + 1e-6f);
            EPI_COLS_BEGIN
                const f32x4 v = a * rs;
                u32x2 o; o.x = pk2(v.x, v.y); o.y = pk2(v.z, v.w);
                *(u32x2*)(QP + (size_t)row * 2048 + col) = o;
            }
        }
    }
};

template <class F>
DI void skinny_gemm(const bf16_t* A, int lda, const bf16_t* Bt, int K, int N, char* smem, int bid, int nblk, int tid, F&& f) {
    const int wave = tid >> 6, lane = tid & 63, tk = lane & 31, hh = lane >> 5;
    const int ks = K / 128;
    for (int tile = bid; tile < N / 32; tile += nblk) {
        const int n0 = tile * 32;
        f32x16 acc = {};
        const bf16_t* ap = A + (size_t)(MPR + tk) * lda + 8 * hh + wave * ks * 16; const bf16_t* bp = Bt + (size_t)(n0 + tk) * K + 8 * hh + wave * ks * 16;
        if (ks == 4) {
            bf16x8 av[4], bv[4];
#pragma unroll
            for (int s2 = 0; s2 < 4; ++s2) { av[s2] = *(const bf16x8*)(ap + 16 * s2); bv[s2] = *(const bf16x8*)(bp + 16 * s2); }
#pragma unroll
            for (int s2 = 0; s2 < 4; ++s2) acc = MFMA32(av[s2], bv[s2], acc);
        } else {
            bf16x8 av[8], bv[8];
#pragma unroll
            for (int s2 = 0; s2 < 8; ++s2) { av[s2] = *(const bf16x8*)(ap + 16 * s2); bv[s2] = *(const bf16x8*)(bp + 16 * s2); }
#pragma unroll
            for (int s2 = 0; s2 < 8; ++s2) acc = MFMA32(av[s2], bv[s2], acc);
        }
        __syncthreads();
        float* part = (float*)smem + wave * 1024;
#pragma unroll
        for (int i = 0; i < 16; ++i) part[i * 64 + lane] = acc[i];
        __syncthreads();
        if (wave == 0) {
#pragma unroll
            for (int i = 0; i < 16; ++i) { float v = 0.f;
#pragma unroll
                for (int w = 0; w < 8; ++w) v += ((const float*)smem)[w * 1024 + i * 64 + lane];
                f(MPR + (i & 3) + 8 * (i >> 2) + 4 * hh, n0 + tk, v); }
        }
    }
    __syncthreads();
}
DI unsigned short bf16_1(float x) { return (unsigned short)(pk2(x, 0.f) & 0xffffu); }

DI int fkey(float f, int idx, int mask) { int b = (__float_as_int(f) & ~mask) | idx; return b ^ ((b >> 31) & 0x7fffffff); }
DI int funkey(int k) { return k ^ ((k >> 31) & 0x7fffffff); }
template <int N> DI void bitonic_sort_desc(int (&a)[N]) {
#pragma unroll
    for (int k = 2; k <= N; k <<= 1)
#pragma unroll
        for (int j = k >> 1; j > 0; j >>= 1)
#pragma unroll
            for (int i = 0; i < N; ++i) { const int l = i ^ j;
                if (l > i) { const bool desc = ((i & k) == 0); const int mx = max(a[i], a[l]), mn = min(a[i], a[l]); a[i] = desc ? mx : mn; a[l] = desc ? mn : mx; } }
}
DI void merge_top16(int (&a)[16], const int (&b)[16]) {
#pragma unroll
    for (int i = 0; i < 16; ++i) a[i] = max(a[i], b[15 - i]);
#pragma unroll
    for (int j = 8; j > 0; j >>= 1)
#pragma unroll
        for (int i = 0; i < 16; ++i) { const int l = i ^ j; if (l > i) { const int mx = max(a[i], a[l]), mn = min(a[i], a[l]); a[i] = mx; a[l] = mn; } }
}
DI void top16_of_64(int (&g0)[16], int (&g1)[16], int (&g2)[16], int (&g3)[16], bool g0_sorted) {
    if (!g0_sorted) bitonic_sort_desc<16>(g0);
    bitonic_sort_desc<16>(g1); bitonic_sort_desc<16>(g2); bitonic_sort_desc<16>(g3);
    merge_top16(g0, g1); merge_top16(g2, g3); merge_top16(g0, g2);
}
DI void half_topk(const Params& p, const char* skl, int row, int hd, int c, int tk, int hh, int (&top)[16]) {
    bf16x8 Bq[8];
#pragma unroll
    for (int s = 0; s < 8; ++s) Bq[s] = *(const bf16x8*)(p.QP() + (size_t)row * 2048 + hd * 256 + c * 128 + 16 * s + 8 * hh);
    int g[4][16];
#pragma unroll
    for (int kt = 0; kt < 4; ++kt) {
        f32x16 acc = {};
#pragma unroll
        for (int s = 0; s < 8; ++s) { const bf16x8 ak = *(const bf16x8*)(skl + (c * 128 + kt * 32 + tk) * 272 + (16 * s + 8 * hh) * 2); acc = MFMA32(ak, Bq[s], acc); }
#pragma unroll
        for (int i = 0; i < 16; ++i) g[kt][i] = fkey(acc[i], kt * 32 + (i & 3) + 8 * (i >> 2) + 4 * hh, 0x7f);
        __builtin_amdgcn_sched_barrier(0);
    }
    bitonic_sort_desc<16>(g[0]); __builtin_amdgcn_sched_barrier(0);
    bitonic_sort_desc<16>(g[1]); __builtin_amdgcn_sched_barrier(0);
    merge_top16(g[0], g[1]); __builtin_amdgcn_sched_barrier(0);
    bitonic_sort_desc<16>(g[2]); __builtin_amdgcn_sched_barrier(0);
    bitonic_sort_desc<16>(g[3]); __builtin_amdgcn_sched_barrier(0);
    merge_top16(g[2], g[3]); merge_top16(g[0], g[2]);
    int oth[16];
#pragma unroll
    for (int i = 0; i < 16; ++i) oth[i] = __shfl_xor(g[0][i], 32);
    merge_top16(g[0], oth);
#pragma unroll
    for (int i = 0; i < 16; ++i) top[i] = g[0][i];
    __builtin_amdgcn_sched_barrier(0);
}
DI void topk_unit(const Params& p, const char* skl, char* lds_wave  , int unit, int lane) {
    const int tile = unit >> 3, hd = unit & 7, tk = lane & 31, hh = lane >> 5, row = tile * 32 + tk;
    int top[2][16];
    half_topk(p, skl, row, hd, 0, tk, hh, top[0]);
    half_topk(p, skl, row, hd, 1, tk, hh, top[1]);
    float v1[16], v2[16]; unsigned i1w[4] = {0, 0, 0, 0}, i2w[4] = {0, 0, 0, 0};
#pragma unroll
    for (int i = 0; i < 16; ++i) { const int b1 = funkey(top[0][i]), b2 = funkey(top[1][i]);
        v1[i] = __int_as_float(b1 & ~0x7f); v2[i] = __int_as_float(b2 & ~0x7f);
        i1w[i >> 2] |= (unsigned)(b1 & 0x7f) << (8 * (i & 3)); i2w[i >> 2] |= (unsigned)(b2 & 0x7f) << (8 * (i & 3)); }
    LAS unsigned* myl = (LAS unsigned*)lds_wave + lane * 8;
#pragma unroll
    for (int i = 0; i < 4; ++i) { myl[i] = i1w[i]; myl[4 + i] = i2w[i]; }
    int cg0[16], cg1[16], cg2[16], cg3[16];
    constexpr int NEG = (int)0x80000000;
#pragma unroll
    for (int j = 0; j < 16; ++j) cg0[j] = fkey(v1[0] + v2[j], j, 0xff);
    {
        int n = 0;
#pragma unroll
        for (int i = 1; i < 16; ++i)
#pragma unroll
            for (int j = 0; j < 16; ++j) if ((i + 1) * (j + 1) <= 16) { const int k = fkey(v1[i] + v2[j], i * 16 + j, 0xff);
                if (n < 16) cg1[n] = k; else if (n < 32) cg2[n - 16] = k; else cg3[n - 32] = k; ++n; }
#pragma unroll
        for (int i = 2; i < 16; ++i) cg3[i] = NEG;
    }
    __builtin_amdgcn_sched_barrier(0);
    bitonic_sort_desc<16>(cg0); __builtin_amdgcn_sched_barrier(0);
    bitonic_sort_desc<16>(cg1); __builtin_amdgcn_sched_barrier(0);
    merge_top16(cg0, cg1); __builtin_amdgcn_sched_barrier(0);
    bitonic_sort_desc<16>(cg2); __builtin_amdgcn_sched_barrier(0);
    bitonic_sort_desc<16>(cg3); __builtin_amdgcn_sched_barrier(0);
    merge_top16(cg2, cg3); merge_top16(cg0, cg2);
    float sc[16]; int cid[16];
#pragma unroll
    for (int i = 0; i < 16; ++i) { const int bb = funkey(cg0[i]); sc[i] = __int_as_float(bb & ~0xff); cid[i] = bb & 0xff; }
    float e[16], sum = 0.f;
#pragma unroll
    for (int i = 0; i < 16; ++i) { e[i] = __expf(sc[i] - sc[0]); sum += e[i]; }
    const float inv = 1.f / sum;
    __builtin_amdgcn_s_waitcnt(0xc07f); asm volatile("" ::: "memory");
    const LAS unsigned char* myb = (const LAS unsigned char*)myl;
    int eidx[16];
#pragma unroll
    for (int i = 0; i < 16; ++i) eidx[i] = (int)myb[cid[i] >> 4] * 128 + (int)myb[16 + (cid[i] & 15)];
    if (hh == 0 && row < MTOT) {
        int* io = p.IDX() + ((size_t)row * 8 + hd) * 16; float* go = p.GATE() + ((size_t)row * 8 + hd) * 16;
#pragma unroll
        for (int i = 0; i < 16; i += 4) { *(int4*)(io + i) = make_int4(eidx[i], eidx[i + 1], eidx[i + 2], eidx[i + 3]); *(f32x4*)(go + i) = (f32x4){e[i] * inv, e[i + 1] * inv, e[i + 2] * inv, e[i + 3] * inv}; }
    }
    __builtin_amdgcn_s_waitcnt(0xc07f); asm volatile("" ::: "memory");
}

DI void experts_row(const Params& p, int row, int lane) {
    const float rs = rsqrtf(p.SS2()[row] * (1.f / DM) + 1e-6f);
    float x[16];
    {
        float t0[8], t1[8]; unpack8(*(const u32x4*)(p.HB() + (size_t)row * DM + lane * 8), t0); unpack8(*(const u32x4*)(p.HB() + (size_t)row * DM + 512 + lane * 8), t1);
#pragma unroll
        for (int i = 0; i < 8; ++i) { x[i] = t0[i] * rs * p.norm2_g[lane * 8 + i]; x[8 + i] = t1[i] * rs * p.norm2_g[512 + lane * 8 + i]; }
    }
    float out[16];
#pragma unroll
    for (int i = 0; i < 16; ++i) out[i] = 0.f;
    for (int hd = 0; hd < 8; ++hd) {
        const int myidx = p.IDX()[((size_t)row * 8 + hd) * 16 + (lane & 15)];
        const float mygate = p.GATE()[((size_t)row * 8 + hd) * 16 + (lane & 15)];
        float hid = 0.f;
#pragma unroll 4
        for (int k = 0; k < 16; ++k) {
            const int e = __builtin_amdgcn_readlane(myidx, k);
            const bf16_t* ur = p.U16() + (size_t)e * DM;
            float u0[8], u1[8]; unpack8(*(const u32x4*)(ur + lane * 8), u0); unpack8(*(const u32x4*)(ur + 512 + lane * 8), u1);
            float d = 0.f;
#pragma unroll
            for (int i = 0; i < 8; ++i) d += x[i] * u0[i] + x[8 + i] * u1[i];
            d = wave_sum(d);
            hid = (lane & 15) == k ? d : hid;
        }
        const float cf = 0.5f * hid * (1.f + erff(hid * 0.70710678118654752f)) * mygate;
#pragma unroll 4
        for (int k = 0; k < 16; ++k) {
            const int e = __builtin_amdgcn_readlane(myidx, k);
            const float ck = __int_as_float(__builtin_amdgcn_readlane(__float_as_int(cf), k));
            const bf16_t* vr = p.V16() + (size_t)e * DM;
            float u0[8], u1[8]; unpack8(*(const u32x4*)(vr + lane * 8), u0); unpack8(*(const u32x4*)(vr + 512 + lane * 8), u1);
#pragma unroll
            for (int i = 0; i < 8; ++i) { out[i] += ck * u0[i]; out[8 + i] += ck * u1[i]; }
        }
    }
    float* dst = nullptr;
    if (row < MPR) { const int b = row / TT, t = row - b * TT; if (t >= NMETA) dst = p.out + OUT_YP + ((size_t)b * SEQ + (t - NMETA)) * DM; }
    else dst = p.out + OUT_YS + (size_t)(row - MPR) * DM;
    if (dst) {
        const float* h1 = p.H1() + (size_t)row * DM;
#pragma unroll
        for (int j = 0; j < 2; ++j) {
            const f32x4 a = *(const f32x4*)(h1 + j * 512 + lane * 8), b = *(const f32x4*)(h1 + j * 512 + lane * 8 + 4);
            *(f32x4*)(dst + j * 512 + lane * 8) = (f32x4){a.x + out[8 * j], a.y + out[8 * j + 1], a.z + out[8 * j + 2], a.w + out[8 * j + 3]};
            *(f32x4*)(dst + j * 512 + lane * 8 + 4) = (f32x4){b.x + out[8 * j + 4], b.y + out[8 * j + 5], b.z + out[8 * j + 6], b.w + out[8 * j + 7]};
        }
    }
}

constexpr int EX_NSL = 1, EX_SLSH = 14;
constexpr int EX_IDX_OFF = 0, EX_COEF_OFF = 64 * 128 * 2, EX_OFF_OFF = EX_COEF_OFF + 64 * 128 * 4, EX_LIST_OFF = EX_OFF_OFF + 64 * 32 * 2, EX_LDS = EX_LIST_OFF + 8 * 256 * 2;
DI float row16_rorsum(float v) {
    v += __builtin_amdgcn_update_dpp(0.f, v, 0x128, 0xF, 0xF, false);
    v += __builtin_amdgcn_update_dpp(0.f, v, 0x124, 0xF, 0xF, false);
    v += __builtin_amdgcn_update_dpp(0.f, v, 0x122, 0xF, 0xF, false);
    v += __builtin_amdgcn_update_dpp(0.f, v, 0x121, 0xF, 0xF, false);
    return v;
}
DI void unpack_fp8x16(const u32x4& w, float (&f)[16]) {
#pragma unroll
    for (int q = 0; q < 4; ++q) { const f32x2 lo = __builtin_amdgcn_cvt_pk_f32_fp8((int)w[q], false), hi = __builtin_amdgcn_cvt_pk_f32_fp8((int)w[q], true);
        f[4 * q] = lo.x; f[4 * q + 1] = lo.y; f[4 * q + 2] = hi.x; f[4 * q + 3] = hi.y; }
}
DI int peer_row_of(int ci) { return ci < NB * SEQ ? (ci >> 12) * TT + NMETA + (ci & 4095) : (ci < NB * SEQ + MS ? MPR + (ci - NB * SEQ) : -1); }
DI void experts_wave(const Params& p, char* smem, int wave_, int lane_, int ci0, int ntok, int xcc) {
    int wave = wave_, lane = lane_; asm volatile("" : "+v"(lane), "+v"(wave)); wave = __builtin_amdgcn_readfirstlane(wave);
    LAS unsigned short* idxs = (LAS unsigned short*)(smem + EX_IDX_OFF) + wave * 8 * 128;
    LAS float* coef = (LAS float*)(smem + EX_COEF_OFF) + wave * 8 * 128;
    LAS unsigned short* offs = (LAS unsigned short*)(smem + EX_OFF_OFF) + wave * 8 * 32;
    const unsigned char* U8 = (const unsigned char*)p.U16(); const unsigned char* V8 = (const unsigned char*)p.V16();
    float xr[2][16];
#pragma unroll
    for (int j = 0; j < 2; ++j) {
        const int row = j < ntok ? peer_row_of(ci0 + j) : -1;
        if (row >= 0) {
            const int e0 = p.IDX()[(size_t)row * 128 + lane], e1 = p.IDX()[(size_t)row * 128 + 64 + lane];
            const float g0 = p.GATE()[(size_t)row * 128 + lane], g1 = p.GATE()[(size_t)row * 128 + 64 + lane];
            const int s0 = e0 >> EX_SLSH, s1 = e1 >> EX_SLSH;
            int base = 0, pos0 = 0, pos1 = 0;
#pragma unroll
            for (int sl = 0; sl < EX_NSL; ++sl) {
                const unsigned long long m0 = __ballot(s0 == sl), m1 = __ballot(s1 == sl);
                const int c0 = __popcll(m0), c1 = __popcll(m1);
                const int r0 = __builtin_amdgcn_mbcnt_hi((unsigned)(m0 >> 32), __builtin_amdgcn_mbcnt_lo((unsigned)m0, 0));
                const int r1 = __builtin_amdgcn_mbcnt_hi((unsigned)(m1 >> 32), __builtin_amdgcn_mbcnt_lo((unsigned)m1, 0));
                if (s0 == sl) pos0 = base + r0;
                if (s1 == sl) pos1 = base + c0 + r1;
                if (lane == 0) offs[j * 32 + sl] = (unsigned short)base;
                base += c0 + c1;
            }
            if (lane == 0) offs[j * 32 + EX_NSL] = (unsigned short)base;
            idxs[j * 128 + pos0] = (unsigned short)e0; idxs[j * 128 + pos1] = (unsigned short)e1;
            coef[j * 128 + pos0] = g0; coef[j * 128 + pos1] = g1;
            const float rs = rsqrtf(p.SS2()[row] * (1.f / DM) + 1e-6f) * (1.f / U8_SCALE);
            float t0[8], t1[8]; unpack8(*(const u32x4*)(p.HB() + (size_t)row * DM + lane * 16), t0); unpack8(*(const u32x4*)(p.HB() + (size_t)row * DM + lane * 16 + 8), t1);
#pragma unroll
            for (int q = 0; q < 2; ++q) { const f32x4 ga = *(const f32x4*)(p.norm2_g + lane * 16 + 4 * q), gb = *(const f32x4*)(p.norm2_g + lane * 16 + 8 + 4 * q);
                xr[j][4 * q] = t0[4 * q] * rs * ga.x; xr[j][4 * q + 1] = t0[4 * q + 1] * rs * ga.y; xr[j][4 * q + 2] = t0[4 * q + 2] * rs * ga.z; xr[j][4 * q + 3] = t0[4 * q + 3] * rs * ga.w;
                xr[j][8 + 4 * q] = t1[4 * q] * rs * gb.x; xr[j][8 + 4 * q + 1] = t1[4 * q + 1] * rs * gb.y; xr[j][8 + 4 * q + 2] = t1[4 * q + 2] * rs * gb.z; xr[j][8 + 4 * q + 3] = t1[4 * q + 3] * rs * gb.w; }
        } else {
            if (lane <= EX_NSL) offs[j * 32 + lane] = 0;
#pragma unroll
            for (int i = 0; i < 16; ++i) xr[j][i] = 0.f;
        }
    }
    __builtin_amdgcn_s_waitcnt(0xc07f); asm volatile("" ::: "memory");
    LAS unsigned short* blist = (LAS unsigned short*)(smem + EX_LIST_OFF) + wave * 256;
    int nbat;
    {
        const int r = (lane >> 1) & (EX_NSL - 1), j = lane & 1, sl = (xcc + r) & (EX_NSL - 1);
        const int beg = offs[j * 32 + sl], cnt = lane < 2 * EX_NSL ? (int)offs[j * 32 + sl + 1] - beg : 0, nb = (cnt + 7) >> 3;
        int incl = nb;
#pragma unroll
        for (int o = 1; o < 64; o <<= 1) { const int t = __shfl_up(incl, o); if (lane >= o) incl += t; }
        nbat = __builtin_amdgcn_readlane(incl, 63);
        int w = incl - nb;
        for (int q = 0; q < nb; ++q) { const int k = beg + 8 * q, n = (cnt - 8 * q) < 8 ? (cnt - 8 * q) : 8; blist[w + q] = (unsigned short)(j | (k << 3) | ((n - 1) << 10)); }
    }
    __builtin_amdgcn_s_waitcnt(0xc07f); asm volatile("" ::: "memory");
    const int pid = lane >> 4;
    auto fetch = [&](const unsigned char* tab, int bi, u32x4 (&buf)[8]) {
        const int e = __builtin_amdgcn_readfirstlane((int)blist[bi]);
        const int j = e & 7, k = (e >> 3) & 127, n = (e >> 10) + 1;
#pragma unroll
        for (int i = 0; i < 8; ++i) { const int kk = k + (i < n ? i : n - 1);
            const int ex = __builtin_amdgcn_readfirstlane((int)idxs[j * 128 + kk]);
            buf[i] = *(const u32x4*)(tab + (size_t)ex * DM + lane * 16); }
    };
    auto u_consume = [&](int bi, const u32x4 (&buf)[8]) {
        const int e = __builtin_amdgcn_readfirstlane((int)blist[bi]);
        const int j = e & 7, k = (e >> 3) & 127, n = (e >> 10) + 1;
        float pp[8], x[16];
#pragma unroll
        for (int q = 0; q < 16; ++q) x[q] = j ? xr[1][q] : xr[0][q];
#pragma unroll
        for (int i = 0; i < 8; ++i) { float f[16]; unpack_fp8x16(buf[i], f); float d0 = 0.f, d1 = 0.f;
#pragma unroll
            for (int q = 0; q < 16; q += 2) { d0 += f[q] * x[q]; d1 += f[q + 1] * x[q + 1]; }
            pp[i] = d0 + d1; __builtin_amdgcn_sched_barrier(0); }
#pragma unroll
        for (int hb = 0; hb < 2; ++hb) {
            const bool b5 = lane & 32, b4 = lane & 16;
            const float a0 = b5 ? pp[4 * hb + 2] : pp[4 * hb], a1 = b5 ? pp[4 * hb + 3] : pp[4 * hb + 1], s0 = b5 ? pp[4 * hb] : pp[4 * hb + 2], s1 = b5 ? pp[4 * hb + 1] : pp[4 * hb + 3];
            const float q0 = a0 + __shfl_xor(s0, 32), q1 = a1 + __shfl_xor(s1, 32);
            const float c0 = b4 ? q1 : q0, d0 = b4 ? q0 : q1;
            float z = c0 + __shfl_xor(d0, 16);
            z = row16_rorsum(z);
            const int ip = 4 * hb + pid;
            if ((lane & 15) == 0 && ip < n) {
                const float g = coef[j * 128 + k + ip];
                coef[j * 128 + k + ip] = 0.5f * z * (1.f + erff(z * 0.70710678118654752f)) * g * (1.f / V8_SCALE);
            }
        }
    };
    {
        u32x4 bufA[8], bufB[8];
        if (nbat > 0) fetch(U8, 0, bufA);
#pragma unroll 1
        for (int bi = 0; bi < nbat; bi += 2) {
            if (bi + 1 < nbat) fetch(U8, bi + 1, bufB);
            u_consume(bi, bufA);
            if (bi + 2 < nbat) fetch(U8, bi + 2, bufA);
            if (bi + 1 < nbat) u_consume(bi + 1, bufB);
        }
    }
    __builtin_amdgcn_s_waitcnt(0xc07f); asm volatile("" ::: "memory");
    float acc[2][16];
#pragma unroll
    for (int j = 0; j < 2; ++j)
#pragma unroll
        for (int i = 0; i < 16; ++i) acc[j][i] = 0.f;
    auto v_consume = [&](int bi, const u32x4 (&buf)[8]) {
        const int e = __builtin_amdgcn_readfirstlane((int)blist[bi]);
        const int j = e & 7, k = (e >> 3) & 127, n = (e >> 10) + 1;
        float cc[8];
#pragma unroll
        for (int i = 0; i < 8; ++i) { const float c = __int_as_float(__builtin_amdgcn_readfirstlane(__float_as_int(coef[j * 128 + k + (i < n ? i : n - 1)]))); cc[i] = i < n ? c : 0.f; }
        float d[16];
#pragma unroll
        for (int q = 0; q < 16; ++q) d[q] = 0.f;
#pragma unroll
        for (int i = 0; i < 8; ++i) { float f[16]; unpack_fp8x16(buf[i], f);
#pragma unroll
            for (int q = 0; q < 16; ++q) d[q] += cc[i] * f[q];
            __builtin_amdgcn_sched_barrier(0); }
#pragma unroll
        for (int q = 0; q < 16; ++q) { acc[0][q] += j ? 0.f : d[q]; acc[1][q] += j ? d[q] : 0.f; }
    };
    {
        u32x4 bufA[8], bufB[8];
        if (nbat > 0) fetch(V8, 0, bufA);
#pragma unroll 1
        for (int bi = 0; bi < nbat; bi += 2) {
            if (bi + 1 < nbat) fetch(V8, bi + 1, bufB);
            v_consume(bi, bufA);
            if (bi + 2 < nbat) fetch(V8, bi + 2, bufA);
            if (bi + 1 < nbat) v_consume(bi + 1, bufB);
        }
    }
#pragma unroll
    for (int j = 0; j < 2; ++j) {
        const int ci = ci0 + j;
        const int row = j < ntok ? peer_row_of(ci) : -1;
        if (row >= 0) {
            float* dst = (ci < NB * SEQ ? p.out + OUT_YP + (size_t)ci * DM : p.out + OUT_YS + (size_t)(ci - NB * SEQ) * DM) + lane * 16;
            const float* h1 = p.H1() + (size_t)row * DM + lane * 16;
#pragma unroll
            for (int q = 0; q < 4; ++q) { const f32x4 a = *(const f32x4*)(h1 + 4 * q);
                *(f32x4*)(dst + 4 * q) = (f32x4){a.x + acc[j][4 * q], a.y + acc[j][4 * q + 1], a.z + acc[j][4 * q + 2], a.w + acc[j][4 * q + 3]}; }
        }
    }
}

typedef float f32x32 __attribute__((ext_vector_type(32)));
typedef unsigned u32x6 __attribute__((ext_vector_type(6)));
typedef unsigned u32x6_a8 __attribute__((ext_vector_type(6), aligned(8)));
constexpr int EX_UCF_OFF = EX_LDS, EX_LDS6 = EX_UCF_OFF + 8 * 256 * 4;
typedef u32x6 Row6;
DI f32x32 unpack_fp6x32(const Row6& r) { return __builtin_amdgcn_cvt_scalef32_pk32_f32_fp6(r, 1.0f); }
DI void experts_wave6(const Params& p, char* smem, int wave_, int lane_, int ci0, int ntok) {
    int wave = wave_, lane = lane_; asm volatile("" : "+v"(lane), "+v"(wave)); wave = __builtin_amdgcn_readfirstlane(wave);
    LAS unsigned short* idxs = (LAS unsigned short*)(smem + EX_IDX_OFF) + wave * 8 * 128;
    LAS float* coef = (LAS float*)(smem + EX_COEF_OFF) + wave * 8 * 128;
    LAS float* ucf = (LAS float*)(smem + EX_UCF_OFF) + wave * 256;
    const unsigned char* U6 = (const unsigned char*)p.U16(); const unsigned char* V6 = (const unsigned char*)p.V16();
    const int h = lane >> 5, lq = lane & 31;
#pragma unroll
    for (int j = 0; j < 2; ++j) {
        const int row = j < ntok ? peer_row_of(ci0 + j) : -1;
        int e0 = 0, e1 = 0; float g0 = 0.f, g1 = 0.f;
        if (row >= 0) { e0 = p.IDX()[(size_t)row * 128 + lane]; e1 = p.IDX()[(size_t)row * 128 + 64 + lane]; g0 = p.GATE()[(size_t)row * 128 + lane]; g1 = p.GATE()[(size_t)row * 128 + 64 + lane]; }
        idxs[j * 128 + lane] = (unsigned short)e0; idxs[j * 128 + 64 + lane] = (unsigned short)e1;
        coef[j * 128 + lane] = g0 * p.VSC()[e0]; coef[j * 128 + 64 + lane] = g1 * p.VSC()[e1];
        ucf[j * 128 + lane] = p.USC()[e0]; ucf[j * 128 + 64 + lane] = p.USC()[e1];
    }
    const int myrow = h < ntok ? peer_row_of(ci0 + h) : -1;
    float x[32];
    {
        const int rr = myrow >= 0 ? myrow : 0;
        const float rs = myrow >= 0 ? rsqrtf(p.SS2()[rr] * (1.f / DM) + 1e-6f) : 0.f;
#pragma unroll
        for (int q = 0; q < 4; ++q) { float t[8]; unpack8(*(const u32x4*)(p.HB() + (size_t)rr * DM + lq * 32 + q * 8), t);
            const f32x4 ga = *(const f32x4*)(p.norm2_g + lq * 32 + q * 8), gb = *(const f32x4*)(p.norm2_g + lq * 32 + q * 8 + 4);
            x[8 * q] = t[0] * rs * ga.x; x[8 * q + 1] = t[1] * rs * ga.y; x[8 * q + 2] = t[2] * rs * ga.z; x[8 * q + 3] = t[3] * rs * ga.w;
            x[8 * q + 4] = t[4] * rs * gb.x; x[8 * q + 5] = t[5] * rs * gb.y; x[8 * q + 6] = t[6] * rs * gb.z; x[8 * q + 7] = t[7] * rs * gb.w; }
    }
    __builtin_amdgcn_s_waitcnt(0xc07f); asm volatile("" ::: "memory");
    auto fetch = [&](const unsigned char* tab, int b, Row6 (&buf)[8]) {
        const u32x4 iv = *(LAS const u32x4*)(idxs + h * 128 + b * 8);
#pragma unroll
        for (int i = 0; i < 8; ++i) { const unsigned ex = (iv[i >> 1] >> ((i & 1) * 16)) & 0xffffu;
            const unsigned char* src = tab + (size_t)ex * 768 + lq * 24;
            buf[i] = *(const u32x6_a8*)src; }
    };
    auto u_consume = [&](int b, const Row6 (&buf)[8]) {
        float pp[8];
#pragma unroll
        for (int i = 0; i < 8; ++i) { Row6 w = buf[i]; if (i > 0) asm volatile("" : "+v"(w) : "v"(pp[i - 1]));
            const f32x32 f = unpack_fp6x32(w); float d0 = 0.f, d1 = 0.f;
#pragma unroll
            for (int q = 0; q < 32; q += 2) { d0 += f[q] * x[q]; d1 += f[q + 1] * x[q + 1]; }
            pp[i] = d0 + d1; __builtin_amdgcn_sched_barrier(0); }
        const bool b4 = lane & 16, b3 = lane & 8, b2 = lane & 4;
        float q4[4], q2[2];
#pragma unroll
        for (int i = 0; i < 4; ++i) { const float a = b4 ? pp[i + 4] : pp[i], sx = b4 ? pp[i] : pp[i + 4]; q4[i] = a + __shfl_xor(sx, 16); }
#pragma unroll
        for (int i = 0; i < 2; ++i) { const float a = b3 ? q4[i + 2] : q4[i], sx = b3 ? q4[i] : q4[i + 2]; q2[i] = a + __builtin_amdgcn_update_dpp(0.f, sx, 0x128, 0xF, 0xF, false); }
        float t;
        { const float a = b2 ? q2[1] : q2[0], sx = b2 ? q2[0] : q2[1]; t = a + dpp_hmir(sx); }
        t += dpp_xor1(t); t += dpp_xor2(t);
        if ((lane & 3) == 0) {
            const int ix = h * 128 + b * 8 + ((lane >> 4) & 1) * 4 + ((lane >> 3) & 1) * 2 + ((lane >> 2) & 1);
            const float z = t * ucf[ix];
            coef[ix] = 0.5f * z * (1.f + erff(z * 0.70710678118654752f)) * coef[ix];
        }
    };
    f32x32 acc;
#pragma unroll
    for (int i = 0; i < 32; ++i) acc[i] = 0.f;
    auto v_consume = [&](int b, const Row6 (&buf)[8]) {
        const f32x4 c0 = *(LAS const f32x4*)(coef + h * 128 + b * 8), c1 = *(LAS const f32x4*)(coef + h * 128 + b * 8 + 4);
#pragma unroll
        for (int i = 0; i < 8; ++i) { Row6 w = buf[i]; asm volatile("" : "+v"(w), "+v"(acc));
            const f32x32 f = unpack_fp6x32(w); const float c = i < 4 ? c0[i & 3] : c1[i & 3];
            acc += f * c;
            __builtin_amdgcn_sched_barrier(0); }
    };
    {
        Row6 bufA[8], bufB[8];
        fetch(U6, 0, bufA);
#pragma unroll 1
        for (int b = 0; b < 16; b += 2) {
            fetch(U6, b + 1, bufB);
            u_consume(b, bufA);
            if (b + 2 < 16) fetch(U6, b + 2, bufA); else fetch(V6, 0, bufA);
            u_consume(b + 1, bufB);
        }
        __builtin_amdgcn_s_waitcnt(0xc07f); asm volatile("" ::: "memory");
#pragma unroll 1
        for (int b = 0; b < 16; b += 2) {
            fetch(V6, b + 1, bufB);
            v_consume(b, bufA);
            if (b + 2 < 16) fetch(V6, b + 2, bufA);
            v_consume(b + 1, bufB);
        }
    }
    if (myrow >= 0) {
        const int ci = ci0 + h;
        float* dst = (ci < NB * SEQ ? p.out + OUT_YP + (size_t)ci * DM : p.out + OUT_YS + (size_t)(ci - NB * SEQ) * DM) + lq * 32;
        const float* h1 = p.H1() + (size_t)myrow * DM + lq * 32;
#pragma unroll
        for (int q = 0; q < 8; ++q) { const f32x4 a = *(const f32x4*)(h1 + 4 * q);
            *(f32x4*)(dst + 4 * q) = (f32x4){a.x + acc[4 * q], a.y + acc[4 * q + 1], a.z + acc[4 * q + 2], a.w + acc[4 * q + 3]}; }
    }
}
typedef u32x4 Row4;
DI f32x32 unpack_fp4x32(const Row4& r) {
    f32x32 f;
#define FP4_B(d, b) { const f32x2 t = __builtin_amdgcn_cvt_scalef32_pk_f32_fp4(r[d], 1.0f, b); f[8 * (d) + 2 * (b)] = t.x; f[8 * (d) + 2 * (b) + 1] = t.y; }
#define FP4_D(d) FP4_B(d, 0) FP4_B(d, 1) FP4_B(d, 2) FP4_B(d, 3)
    FP4_D(0) FP4_D(1) FP4_D(2) FP4_D(3)
#undef FP4_D
#undef FP4_B
    return f;
}
DI void experts_wave4(const Params& p, char* smem, int wave_, int lane_, int ci0, int ntok) {
    int wave = wave_, lane = lane_; asm volatile("" : "+v"(lane), "+v"(wave)); wave = __builtin_amdgcn_readfirstlane(wave);
    LAS unsigned short* idxs = (LAS unsigned short*)(smem + EX_IDX_OFF) + wave * 8 * 128;
    LAS float* coef = (LAS float*)(smem + EX_COEF_OFF) + wave * 8 * 128;
    LAS float* ucf = (LAS float*)(smem + EX_UCF_OFF) + wave * 256;
    const unsigned char* U6 = (const unsigned char*)p.U16(); const unsigned char* V6 = (const unsigned char*)p.V16();
    const int h = lane >> 5, lq = lane & 31;
#pragma unroll
    for (int j = 0; j < 2; ++j) {
        const int row = j < ntok ? peer_row_of(ci0 + j) : -1;
        int e0 = 0, e1 = 0; float g0 = 0.f, g1 = 0.f;
        if (row >= 0) { e0 = p.IDX()[(size_t)row * 128 + lane]; e1 = p.IDX()[(size_t)row * 128 + 64 + lane]; g0 = p.GATE()[(size_t)row * 128 + lane]; g1 = p.GATE()[(size_t)row * 128 + 64 + lane]; }
        idxs[j * 128 + lane] = (unsigned short)e0; idxs[j * 128 + 64 + lane] = (unsigned short)e1;
        coef[j * 128 + lane] = g0 * p.VSC()[e0]; coef[j * 128 + 64 + lane] = g1 * p.VSC()[e1];
        ucf[j * 128 + lane] = p.USC()[e0]; ucf[j * 128 + 64 + lane] = p.USC()[e1];
    }
    const int myrow = h < ntok ? peer_row_of(ci0 + h) : -1;
    float x[32];
    {
        const int rr = myrow >= 0 ? myrow : 0;
        const float rs = myrow >= 0 ? rsqrtf(p.SS2()[rr] * (1.f / DM) + 1e-6f) : 0.f;
#pragma unroll
        for (int q = 0; q < 4; ++q) { float t[8]; unpack8(*(const u32x4*)(p.HB() + (size_t)rr * DM + lq * 32 + q * 8), t);
            const f32x4 ga = *(const f32x4*)(p.norm2_g + lq * 32 + q * 8), gb = *(const f32x4*)(p.norm2_g + lq * 32 + q * 8 + 4);
            x[8 * q] = t[0] * rs * ga.x; x[8 * q + 1] = t[1] * rs * ga.y; x[8 * q + 2] = t[2] * rs * ga.z; x[8 * q + 3] = t[3] * rs * ga.w;
            x[8 * q + 4] = t[4] * rs * gb.x; x[8 * q + 5] = t[5] * rs * gb.y; x[8 * q + 6] = t[6] * rs * gb.z; x[8 * q + 7] = t[7] * rs * gb.w; }
    }
    __builtin_amdgcn_s_waitcnt(0xc07f); asm volatile("" ::: "memory");
    auto fetch = [&](const unsigned char* tab, int b, Row4 (&buf)[8]) {
        const u32x4 iv = *(LAS const u32x4*)(idxs + h * 128 + b * 8);
#pragma unroll
        for (int i = 0; i < 8; ++i) { const unsigned ex = (iv[i >> 1] >> ((i & 1) * 16)) & 0xffffu;
            buf[i] = *(const u32x4*)(tab + (size_t)ex * 512 + lq * 16); }
    };
    auto u_consume = [&](int b, const Row4 (&buf)[8]) {
        float pp[8];
#pragma unroll
        for (int i = 0; i < 8; ++i) { Row4 w = buf[i]; if (i > 0) asm volatile("" : "+v"(w) : "v"(pp[i - 1]));
            const f32x32 f = unpack_fp4x32(w); f32x2 d = {0.f, 0.f}, e = {0.f, 0.f};
#pragma unroll
            for (int q = 0; q < 32; q += 4) { d = __builtin_elementwise_fma((f32x2){f[q], f[q + 1]}, (f32x2){x[q], x[q + 1]}, d); e = __builtin_elementwise_fma((f32x2){f[q + 2], f[q + 3]}, (f32x2){x[q + 2], x[q + 3]}, e); }
            d += e; pp[i] = d.x + d.y; __builtin_amdgcn_sched_barrier(0); }
        const bool b4 = lane & 16, b3 = lane & 8, b2 = lane & 4;
        float q4[4], q2[2];
#pragma unroll
        for (int i = 0; i < 4; ++i) { const float a = b4 ? pp[i + 4] : pp[i], sx = b4 ? pp[i] : pp[i + 4]; q4[i] = a + __shfl_xor(sx, 16); }
#pragma unroll
        for (int i = 0; i < 2; ++i) { const float a = b3 ? q4[i + 2] : q4[i], sx = b3 ? q4[i] : q4[i + 2]; q2[i] = a + __builtin_amdgcn_update_dpp(0.f, sx, 0x128, 0xF, 0xF, false); }
        float t;
        { const float a = b2 ? q2[1] : q2[0], sx = b2 ? q2[0] : q2[1]; t = a + dpp_hmir(sx); }
        t += dpp_xor1(t); t += dpp_xor2(t);
        if ((lane & 3) == 0) {
            const int ix = h * 128 + b * 8 + ((lane >> 4) & 1) * 4 + ((lane >> 3) & 1) * 2 + ((lane >> 2) & 1);
            const float z = t * ucf[ix];
            coef[ix] = 0.5f * z * (1.f + erff(z * 0.70710678118654752f)) * coef[ix];
        }
    };
    f32x32 acc;
#pragma unroll
    for (int i = 0; i < 32; ++i) acc[i] = 0.f;
    auto v_consume = [&](int b, const Row4 (&buf)[8]) {
        const f32x4 c0 = *(LAS const f32x4*)(coef + h * 128 + b * 8), c1 = *(LAS const f32x4*)(coef + h * 128 + b * 8 + 4);
#pragma unroll
        for (int i = 0; i < 8; ++i) { Row4 w = buf[i]; asm volatile("" : "+v"(w), "+v"(acc));
            const f32x32 f = unpack_fp4x32(w); const float c = i < 4 ? c0[i & 3] : c1[i & 3];
            acc += f * c;
            __builtin_amdgcn_sched_barrier(0); }
    };
    {
        Row4 bufA[8], bufB[8], bufC[8];
        auto fetch_j = [&](int j, Row4 (&buf)[8]) { if (j < 32) fetch(j < 16 ? U6 : V6, j & 15, buf); };
        fetch_j(0, bufA); fetch_j(1, bufB);
#pragma unroll 1
        for (int j = 0; j < 15; j += 3) {
            fetch_j(j + 2, bufC); u_consume(j, bufA);
            fetch_j(j + 3, bufA); u_consume(j + 1, bufB);
            fetch_j(j + 4, bufB); u_consume(j + 2, bufC);
        }
        fetch_j(17, bufC); u_consume(15, bufA);
        __builtin_amdgcn_s_waitcnt(0xc07f); asm volatile("" ::: "memory");
#pragma unroll 1
        for (int j = 16; j < 31; j += 3) {
            fetch_j(j + 2, bufA); v_consume(j - 16, bufB);
            fetch_j(j + 3, bufB); v_consume(j - 15, bufC);
            fetch_j(j + 4, bufC); v_consume(j - 14, bufA);
        }
        v_consume(15, bufB);
    }
    if (myrow >= 0) {
        const int ci = ci0 + h;
        float* dst = (ci < NB * SEQ ? p.out + OUT_YP + (size_t)ci * DM : p.out + OUT_YS + (size_t)(ci - NB * SEQ) * DM) + lq * 32;
        const float* h1 = p.H1() + (size_t)myrow * DM + lq * 32;
#pragma unroll
        for (int q = 0; q < 8; ++q) { const f32x4 a = *(const f32x4*)(h1 + 4 * q);
            *(f32x4*)(dst + 4 * q) = (f32x4){a.x + acc[4 * q], a.y + acc[4 * q + 1], a.z + acc[4 * q + 2], a.w + acc[4 * q + 3]}; }
    }
}

#define XB_TMO      128
#define XB_XCNT(j)  (256  + 64 * (j))
#define XB_XSUB(j)  (1280 + 64 * (j))
#define XB_XGEN(j)  (2304 + 64 * (j))
#define XB_TOP      3328
#define XB_TOPGEN   3392
#define XCD_BAR_WORDS 3456
#define XB_SPIN_CAP (1u << 18)

__device__ __forceinline__ unsigned xb_ld(unsigned* p)              { return __hip_atomic_load(p, __ATOMIC_RELAXED, __HIP_MEMORY_SCOPE_AGENT); }
__device__ __forceinline__ unsigned xb_add(unsigned* p, unsigned v) { return __hip_atomic_fetch_add(p, v, __ATOMIC_RELAXED, __HIP_MEMORY_SCOPE_AGENT); }
__device__ __forceinline__ unsigned xb_xcc_id() { return (unsigned)__builtin_amdgcn_s_getreg((3 << 11) | 20) & 0xFu; }
#define XB_SPIN(cond, bar) do { unsigned _sp = 0; while (cond) { __builtin_amdgcn_s_sleep(1); \
    if ((++_sp & 255u) == 0u) { if (xb_ld(&(bar)[XB_TMO])) break; if (_sp > XB_SPIN_CAP) { atomicAdd(&(bar)[XB_TMO], 1u); break; } } } } while (0)

struct XcdBarrier {
    unsigned* bar; unsigned x;
    volatile LAS unsigned* st;
};
__device__ __forceinline__ XcdBarrier xcd_barrier_post(unsigned* bar, volatile LAS unsigned* st) {
    XcdBarrier b; b.bar = bar; b.x = xb_xcc_id(); b.st = st;
    if (threadIdx.x == 0) (void)xb_add(&bar[XB_XCNT(b.x)], 1u);
    return b;
}
__device__ __forceinline__ void xcd_barrier_complete(unsigned* bar, unsigned x, unsigned& nloc, unsigned& nx) {
    const unsigned G = gridDim.x * gridDim.y * gridDim.z;
    unsigned sum, cnt, mine, sp = 0u;
    for (;;) {
        sum = 0u; cnt = 0u; mine = 0u;
#pragma unroll
        for (unsigned j = 0; j < 16; ++j) { const unsigned c = xb_ld(&bar[XB_XCNT(j)]); sum += c; cnt += (c > 0u) ? 1u : 0u; mine = (j == x) ? c : mine; }
        if (sum == G) break;
        __builtin_amdgcn_s_sleep(1);
        if ((++sp & 255u) == 0u) { if (xb_ld(&bar[XB_TMO])) break; if (sp > XB_SPIN_CAP) { atomicAdd(&bar[XB_TMO], 1u); break; } }
    }
    nloc = mine > 0u ? mine : 1u; nx = cnt > 0u ? cnt : 1u;
}
__device__ __forceinline__ void xcd_barrier(const XcdBarrier& b) {
    asm volatile("s_waitcnt vmcnt(0)" ::: "memory");
    __syncthreads();
    if (threadIdx.x == 0) {
        unsigned* bar = b.bar;
        __builtin_amdgcn_s_waitcnt(0);
        unsigned nloc = b.st[0], nx = b.st[1];
        if (nloc == 0u) { xcd_barrier_complete(bar, b.x, nloc, nx); b.st[0] = nloc; b.st[1] = nx; }
        const unsigned old = xb_add(&bar[XB_XSUB(b.x)], 1u);
        const unsigned gen = old / nloc;
        if (old + 1u == (gen + 1u) * nloc) {
            __builtin_amdgcn_fence(__ATOMIC_RELEASE, "agent");
            asm volatile("s_waitcnt vmcnt(0)" ::: "memory");
            const unsigned og = xb_add(&bar[XB_TOP], 1u);
            const unsigned tg = og / nx;
            if (og + 1u == (tg + 1u) * nx) xb_add(&bar[XB_TOPGEN], 1u);
            else XB_SPIN(xb_ld(&bar[XB_TOPGEN]) == tg, bar);
            __builtin_amdgcn_fence(__ATOMIC_ACQUIRE, "agent");
            xb_add(&bar[XB_XGEN(b.x)], 1u);
            asm volatile("s_waitcnt vmcnt(0)" ::: "memory");
        } else {
            XB_SPIN(xb_ld(&bar[XB_XGEN(b.x)]) == gen, bar);
            __builtin_amdgcn_fence(__ATOMIC_ACQUIRE, "agent");
            asm volatile("s_waitcnt vmcnt(0)" ::: "memory");
        }
    }
    __syncthreads();
}

constexpr int NTHR = 512, NBLK = 256;
constexpr int LDS_MAIN = 159744, LDS_BYTES = LDS_MAIN + 64;
extern __shared__ __attribute__((aligned(16))) char dyn_smem[];

DI int pull_work(unsigned* q, char* smem, int tid, int step) {
    LAS int* bw = (LAS int*)(smem + LDS_MAIN + 32);
    __syncthreads();
    if (tid == 0) *bw = (int)__hip_atomic_fetch_add(q, (unsigned)step, __ATOMIC_RELAXED, __HIP_MEMORY_SCOPE_AGENT);
    __syncthreads();
    return *bw;
}

#define PH_IDS int tid = threadIdx.x; asm volatile("" : "+v"(tid)); const int wave = tid >> 6, lane = tid & 63, gw = bid * 8 + wave; (void)wave; (void)lane; (void)gw;
__global__ void __launch_bounds__(NTHR, 2) k_mega(Params p) {
    const int bid = blockIdx.x, nblk = gridDim.x, ngw = nblk * 8;
    char* smem = dyn_smem;
    if (threadIdx.x == 0) *(u32x4*)(smem + LDS_MAIN) = (u32x4){0u, 0u, 0u, 0u};
    __syncthreads();
    XcdBarrier bar = xcd_barrier_post(p.ctl(), (volatile LAS unsigned*)(smem + LDS_MAIN));
    { PH_IDS phase_convert(p, smem, 0, gw, ngw, wave, lane); }
    xcd_barrier(bar);
    { EpiProj e{p.RSTD1(), p.PROJ(), p.out}; g8::gemm_phase<false>(p.XB(), 1024, p.WIN_T(), 1024, MP / 256, INW / 256, (bf16_t*)smem, e, bid, nblk); }
    { PH_IDS constexpr int G1_REM = (MP / 256) * (INW / 256) % NBLK;
      if (bid >= G1_REM) phase_convert(p, smem, 1, (bid - G1_REM) * 8 + wave, (nblk - G1_REM) * 8, wave, lane); }
    xcd_barrier(bar);
    { PH_IDS phase_prep(p, smem, bid, nblk, gw, ngw, tid, lane); }
    xcd_barrier(bar);
    { PH_IDS unsigned short pre[48]; chunk_prefetch(p, bid, tid, pre); for (int u = bid; u < CK_UNITS; u += nblk) chunk_pass1(p, smem, u, u + nblk, pre, tid); }
    xcd_barrier(bar);
    {
        PH_IDS
        volatile LAS int* prog = (volatile LAS int*)(smem + LDS_MAIN + 48);
        if (tid == 0) *prog = 0;
        __syncthreads();
        if (bid < 64) {
            if (wave == 0) chunk_pass2(p, bid, lane, prog);
            else if (wave == 1) chunk_pass2_prefetch(p, bid, lane, prog);
            else {
                while (*prog < CK_N) {
                    int u = 0; if (lane == 0) u = (int)__hip_atomic_fetch_add(p.ctl() + CTL_Q_SATTN, 1u, __ATOMIC_RELAXED, __HIP_MEMORY_SCOPE_AGENT);
                    u = __builtin_amdgcn_readfirstlane(u);
                    if (u >= SA_UNITS) break;
                    sattn_unit(p, u, lane);
                }
            }
        }
        else if (bid >= 128) rwkv_sample_unit(p, (bid - 128) * 2 + (tid >> 8), tid & 255);
    }
    {
        PH_IDS
        const float lam = compute_lam(p, lane);
        for (;;) {
            const int idx = pull_work(p.ctl() + CTL_Q_ATTN, smem, tid, 1);
            if (idx >= AT_UNITS) break;
            const int qbi = idx >> 4, bh = idx & 15, qb = qbi < 32 ? 31 - qbi : 32;
            attn_unit(p, smem, bh >> 2, bh & 3, qb, lam, alibi_dmax(p, bh & 3, lane), tid);
        }
    }
    {
        PH_IDS
        for (;;) {
            const int u0 = pull_work(p.ctl() + CTL_Q_SATTN, smem, tid, 8);
            if (u0 >= SA_UNITS) break;
            if (u0 + wave < SA_UNITS) sattn_unit(p, u0 + wave, lane);
        }
    }
    xcd_barrier(bar);
    {
        PH_IDS
        for (int u = gw; u < 2 * CK_UNITS; u += ngw) chunk_pass3(p, u, lane);
        for (int r = MPR + gw; r < MTOT; r += ngw) rwkv_post_row(p, r, lane);
        const float lam = compute_lam(p, lane);
        for (int u = gw; u < MS * 4; u += ngw) sattn_combine(p, u, lam, lane);
    }
    xcd_barrier(bar);
    { PH_IDS
      skinny_gemm(p.YO(), 1024, p.WRW_T(), 512, 1024, smem, bid, nblk, tid, [&](int row, int col, float v) { p.MIXF()[(size_t)row * DM + col] = v * sigmoidf_(bf2f(p.PROJ()[(size_t)row * INW + O_GA + col])); });
      skinny_gemm(p.YO() + 512, 1024, p.WDA_T(), 512, 1024, smem, bid, nblk, tid, [&](int row, int col, float v) { p.MIX()[(size_t)row * DM + col] = bf16_1(p.MIXF()[(size_t)row * DM + col] + v * sigmoidf_(bf2f(p.PROJ()[(size_t)row * INW + O_GB + col]))); }); }
    { EpiBr1 e{p.PROJ(), p.MIX()}; g8::gemm_phase<true>(p.YO(), 1024, p.WRW_T(), 512, 64, 4, (bf16_t*)smem, e, bid, nblk); }
    { EpiBr2 e{p.PROJ(), p.MIX()}; g8::gemm_phase<true>(p.YO() + 512, 1024, p.WDA_T(), 512, 64, 4, (bf16_t*)smem, e, bid, nblk); }
    xcd_barrier(bar);
    { PH_IDS
      skinny_gemm(p.MIX(), 1024, p.WOUT_T(), 1024, 1024, smem, bid, nblk, tid, [&](int row, int col, float v) {
          const float h = p.x_sample[(size_t)(row - MPR) * DM + col] + v; p.H1()[(size_t)row * DM + col] = h; p.HB()[(size_t)row * DM + col] = bf16_1(h);
          float ss = h * h; ss += __shfl_xor(ss, 1); ss += __shfl_xor(ss, 2); ss += __shfl_xor(ss, 4); ss += __shfl_xor(ss, 8); ss += __shfl_xor(ss, 16);
          if ((lane & 31) == 0) atomicAdd(p.SS2() + row, ss); }); }
    { EpiOut e{p.XPTR(), p.H1(), p.HB(), p.SS2()}; g8::gemm_phase<true>(p.MIX(), 1024, p.WOUT_T(), 1024, 64, 4, (bf16_t*)smem, e, bid, nblk); }
    xcd_barrier(bar);
    { PH_IDS
      skinny_gemm(p.HB(), 1024, p.WQ_T(), 1024, 2048, smem, bid, nblk, tid, [&](int row, int col, float v) { p.QP()[(size_t)row * 2048 + col] = bf16_1(v * rsqrtf(p.SS2()[row] * (1.f / DM) + 1e-6f)); }); }
    { EpiQ e{p.SS2(), p.QP()}; g8::gemm_phase<true>(p.HB(), 1024, p.WQ_T(), 1024, 64, 8, (bf16_t*)smem, e, bid, nblk); }
    xcd_barrier(bar);
    {
        PH_IDS
        for (int ch = tid; ch < 256 * 16; ch += 512) { const int r = ch >> 4, cc = ch & 15; *(u32x4*)(smem + 16384 + r * 272 + cc * 16) = *(const u32x4*)(p.SK() + (size_t)r * 128 + cc * 8); }
        __syncthreads();
        for (int u = gw; u < (MTOT / 32) * 8; u += ngw) topk_unit(p, smem + 16384, smem + wave * 2048, u, lane);
        constexpr int TK_REM = (MTOT / 32) * 8 - 2 * NBLK * 8;
        if (gw >= TK_REM) { const int cw = gw - TK_REM, ncw = ngw - TK_REM;
            for (int it = cw; it < 32768; it += ncw) { if (it < 16384) convert_row_fp4(p.peer_u, (unsigned char*)p.U16(), p.USC(), it, lane); else convert_row_fp4(p.peer_v, (unsigned char*)p.V16(), p.VSC(), it - 16384, lane); } }
    }
    xcd_barrier(bar);
    {
        PH_IDS
#pragma unroll 1
        for (int pass = 0; pass < 5; ++pass) {
            const int ci0 = pass < 4 ? bid * 64 + wave * 8 + 2 * pass : NB * SEQ + bid;
            const int ntok = pass < 4 ? 2 : ((bid < MS && wave == 0) ? 1 : 0);
            if (ntok > 0) experts_wave4(p, smem, wave, lane, ci0, ntok);
        }
    }
}

extern "C" void kernel_launch(void* const* d_in, const int* in_sizes, int n_in, void* d_out, int out_size, void* d_ws, size_t ws_size, hipStream_t stream) {
    Params p{};
    p.x_prompt = (const float*)d_in[0]; p.x_sample = (const float*)d_in[1]; p.cache_k = (const float*)d_in[2]; p.cache_v = (const float*)d_in[3];
    p.state_wkv = (const float*)d_in[4]; p.state_shift = (const float*)d_in[5]; p.page_table = (const int*)d_in[6];
    p.meta = (const float*)d_in[7]; p.norm1_g = (const float*)d_in[8]; p.w_in = (const float*)d_in[9]; p.rw_mu = (const float*)d_in[10]; p.rw_w0 = (const float*)d_in[11];
    p.rw_w2 = (const float*)d_in[12]; p.rw_a0 = (const float*)d_in[13]; p.rw_a2 = (const float*)d_in[14]; p.rw_g2 = (const float*)d_in[15]; p.rw_kk = (const float*)d_in[16];
    p.rw_ka = (const float*)d_in[17]; p.rw_rk = (const float*)d_in[18]; p.rw_ln_g = (const float*)d_in[19]; p.rw_ln_b = (const float*)d_in[20]; p.w_rw_br = (const float*)d_in[21];
    p.da_qn_g = (const float*)d_in[22]; p.da_kn_g = (const float*)d_in[23]; p.da_lam = (const float*)d_in[24]; p.da_subln_g = (const float*)d_in[25]; p.w_da_br = (const float*)d_in[26];
    p.w_out = (const float*)d_in[27]; p.norm2_g = (const float*)d_in[28]; p.peer_wq = (const float*)d_in[29]; p.peer_subkeys = (const float*)d_in[30]; p.peer_u = (const float*)d_in[31];
    p.peer_v = (const float*)d_in[32];
    (void)in_sizes; (void)n_in; (void)out_size; (void)ws_size;
    p.out = (float*)d_out;
    p.ws = (char*)d_ws;
    static bool attr_done = false;
    if (!attr_done) { (void)hipFuncSetAttribute((const void*)k_mega, hipFuncAttributeMaxDynamicSharedMemorySize, LDS_BYTES); attr_done = true; }
    (void)hipMemsetAsync(p.ws + WO_ctl, 0, CTL_WORDS * 4, stream);
    k_mega<<<NBLK, NTHR, LDS_BYTES, stream>>>(p);
}
```

```cpp
#include <hip/hip_runtime.h>
#include <stdint.h>
#include <stdio.h>

#define DI __device__ __forceinline__
#define LAS __attribute__((address_space(3)))
typedef unsigned short bf16_t;
typedef short bf16x8 __attribute__((ext_vector_type(8)));
typedef short s16x4 __attribute__((ext_vector_type(4)));
typedef float f32x2 __attribute__((ext_vector_type(2)));
typedef float f32x4 __attribute__((ext_vector_type(4)));
typedef float f32x16 __attribute__((ext_vector_type(16)));
typedef unsigned u32x2 __attribute__((ext_vector_type(2)));
typedef unsigned u32x4 __attribute__((ext_vector_type(4)));
typedef __bf16 bf16v2 __attribute__((ext_vector_type(2)));

constexpr int DM = 1024, NB = 4, SEQ = 4096, NMETA = 16, TT = SEQ + NMETA  ;
constexpr int MPR = NB * TT  , MS = 32, MTOT = MPR + MS  , MP = 16640  ;
constexpr int RWP = 1792, INW = 5376;
constexpr int O_Q = 1792, O_K = 2304, O_V = 2816, O_GA = 3328, O_GB = 4352;
constexpr int NPAGES = 64, PAGE = 128, PAST = 8192;
constexpr float LOG2E = 1.4426950408889634f;
constexpr float LAM_INIT = 0.2f;
constexpr size_t OUT_YP = 0, OUT_YS = OUT_YP + (size_t)NB * SEQ * DM, OUT_KP = OUT_YS + (size_t)MS * DM, OUT_VP = OUT_KP + (size_t)MPR * 512,
                 OUT_KS = OUT_VP + (size_t)MPR * 512, OUT_VS = OUT_KS + (size_t)MS * 512, OUT_WP = OUT_VS + (size_t)MS * 512,
                 OUT_WS = OUT_WP + (size_t)NB * 8 * 4096, OUT_SP = OUT_WS + (size_t)MS * 8 * 4096, OUT_SS = OUT_SP + (size_t)NB * RWP,
                 OUT_END = OUT_SS + (size_t)MS * RWP;

constexpr int SA_SPLITS = 16, SA_UNITS = MS * 4 * SA_SPLITS;
constexpr int CK_N = 65, CK_UNITS = 32 * CK_N;
constexpr int TTP = CK_N * 64;
constexpr int CTL_WORDS = 8192, CTL_Q_ATTN = 4096, CTL_Q_SATTN = 4096 + 64, CTL_P3A_DONE = 4096 + 512;
constexpr size_t ws_al(size_t b) { return (b + 255) & ~(size_t)255; }
constexpr size_t WO_ctl = 0;
constexpr size_t WO_XB = WO_ctl + ws_al(CTL_WORDS * 4);
constexpr size_t WO_WIN_T = WO_XB + ws_al((size_t)MP * DM * 2);
constexpr size_t WO_WRW_T = WO_WIN_T + ws_al((size_t)INW * DM * 2);
constexpr size_t WO_WDA_T = WO_WRW_T + ws_al((size_t)1024 * 512 * 2);
constexpr size_t WO_WOUT_T = WO_WDA_T + ws_al((size_t)1024 * 512 * 2);
constexpr size_t WO_WQ_T = WO_WOUT_T + ws_al((size_t)1024 * 1024 * 2);
constexpr size_t WO_W2_T = WO_WQ_T + ws_al((size_t)2048 * 1024 * 2);
constexpr size_t WO_A2_T = WO_W2_T + ws_al(512 * 64 * 2);
constexpr size_t WO_G2_T = WO_A2_T + ws_al(512 * 64 * 2);
constexpr size_t WO_SK = WO_G2_T + ws_al(512 * 128 * 2);
constexpr size_t WO_U16 = WO_SK + ws_al(2 * 128 * 128 * 2);
constexpr size_t WO_V16 = WO_U16 + ws_al((size_t)16384 * DM * 2);
constexpr size_t WO_PROJ = WO_V16 + ws_al((size_t)16384 * DM * 2);
constexpr size_t WO_QN = WO_PROJ + ws_al((size_t)MP * INW * 2);
constexpr size_t WO_KN = WO_QN + ws_al((size_t)MP * 512 * 2);
constexpr size_t WO_SCAN = WO_KN + ws_al((size_t)MP * 512 * 2);
constexpr size_t WO_G = WO_SCAN + ws_al((size_t)32 * 6 * 64 * TTP * 2);
constexpr size_t WO_YO = WO_G + ws_al((size_t)MP * 512 * 2);
constexpr size_t WO_MIX = WO_YO + ws_al((size_t)MP * DM * 2);
constexpr size_t WO_HB = WO_MIX + ws_al((size_t)MP * DM * 2);
constexpr size_t WO_QP = WO_HB + ws_al((size_t)MP * DM * 2);
constexpr size_t WO_RSTD1 = WO_QP + ws_al((size_t)MP * 2048 * 2);
constexpr size_t WO_BONUS = WO_RSTD1 + ws_al((size_t)MP * 4);
constexpr size_t WO_Y = WO_BONUS + ws_al((size_t)MP * 8 * 4);
constexpr size_t WO_MIXF = WO_Y + ws_al((size_t)MP * 512 * 4);
constexpr size_t WO_H1 = WO_MIXF + ws_al((size_t)MP * DM * 4);
constexpr size_t WO_SS2 = WO_H1 + ws_al((size_t)MP * DM * 4);
constexpr size_t WO_GATE = WO_SS2 + ws_al((size_t)MP * 4);
constexpr size_t WO_PART = WO_GATE + ws_al((size_t)MP * 128 * 4);
constexpr size_t WO_SCAN_S = WO_PART + ws_al((size_t)SA_UNITS * 2 * 130 * 4);
constexpr size_t WO_IDX = WO_SCAN_S + ws_al((size_t)MS * 8 * 384 * 4);
constexpr size_t WO_XPTR = WO_IDX + ws_al((size_t)MP * 128 * 4);
constexpr size_t WO_ZROW = WO_XPTR + ws_al((size_t)MP * 8);
constexpr size_t WO_MYT = WO_ZROW + ws_al(4096);
constexpr size_t WO_MST = WO_MYT + ws_al((size_t)CK_UNITS * 4096 * 2);
constexpr size_t WO_PLV = WO_MST + ws_al((size_t)CK_UNITS * 4096 * 2);
constexpr size_t WO_WYT = WO_PLV + ws_al((size_t)CK_UNITS * 64 * 4);
constexpr size_t WO_WST = WO_WYT + ws_al((size_t)CK_UNITS * 4096 * 4);
constexpr size_t WO_SCF = WO_WST + ws_al((size_t)CK_UNITS * 4096 * 4);
constexpr size_t WS_END = WO_SCF + ws_al((size_t)CK_UNITS * 16 * 64 * 16);
struct Params {
    const float *x_prompt, *x_sample, *cache_k, *cache_v, *state_wkv, *state_shift; const int* page_table;
    const float *meta, *norm1_g, *w_in, *rw_mu, *rw_w0, *rw_w2, *rw_a0, *rw_a2, *rw_g2, *rw_kk, *rw_ka, *rw_rk, *rw_ln_g, *rw_ln_b, *w_rw_br,
        *da_qn_g, *da_kn_g, *da_lam, *da_subln_g, *w_da_br, *w_out, *norm2_g, *peer_wq, *peer_subkeys, *peer_u, *peer_v;
    float* out; char* ws;
    DI unsigned* ctl() const { return (unsigned*)(ws + WO_ctl); }
    DI bf16_t* XB() const { return (bf16_t*)(ws + WO_XB); }
    DI bf16_t* WIN_T() const { return (bf16_t*)(ws + WO_WIN_T); }
    DI bf16_t* WRW_T() const { return (bf16_t*)(ws + WO_WRW_T); }
    DI bf16_t* WDA_T() const { return (bf16_t*)(ws + WO_WDA_T); }
    DI bf16_t* WOUT_T() const { return (bf16_t*)(ws + WO_WOUT_T); }
    DI bf16_t* WQ_T() const { return (bf16_t*)(ws + WO_WQ_T); }
    DI bf16_t* W2_T() const { return (bf16_t*)(ws + WO_W2_T); }
    DI bf16_t* A2_T() const { return (bf16_t*)(ws + WO_A2_T); }
    DI bf16_t* G2_T() const { return (bf16_t*)(ws + WO_G2_T); }
    DI bf16_t* SK() const { return (bf16_t*)(ws + WO_SK); }
    DI bf16_t* U16() const { return (bf16_t*)(ws + WO_U16); }
    DI bf16_t* V16() const { return (bf16_t*)(ws + WO_V16); }
    DI float* USC() const { return (float*)(ws + WO_U16 + ((size_t)16 << 20)); }
    DI float* VSC() const { return (float*)(ws + WO_V16 + ((size_t)16 << 20)); }
    DI bf16_t* PROJ() const { return (bf16_t*)(ws + WO_PROJ); }
    DI bf16_t* QN() const { return (bf16_t*)(ws + WO_QN); }
    DI bf16_t* KN() const { return (bf16_t*)(ws + WO_KN); }
    DI bf16_t* SCAN() const { return (bf16_t*)(ws + WO_SCAN); }
    DI bf16_t* G() const { return (bf16_t*)(ws + WO_G); }
    DI bf16_t* YO() const { return (bf16_t*)(ws + WO_YO); }
    DI bf16_t* MIX() const { return (bf16_t*)(ws + WO_MIX); }
    DI bf16_t* HB() const { return (bf16_t*)(ws + WO_HB); }
    DI bf16_t* QP() const { return (bf16_t*)(ws + WO_QP); }
    DI float* RSTD1() const { return (float*)(ws + WO_RSTD1); }
    DI float* BONUS() const { return (float*)(ws + WO_BONUS); }
    DI float* Y() const { return (float*)(ws + WO_Y); }
    DI float* MIXF() const { return (float*)(ws + WO_MIXF); }
    DI float* H1() const { return (float*)(ws + WO_H1); }
    DI float* SS2() const { return (float*)(ws + WO_SS2); }
    DI float* GATE() const { return (float*)(ws + WO_GATE); }
    DI float* PART() const { return (float*)(ws + WO_PART); }
    DI float* SCAN_S() const { return (float*)(ws + WO_SCAN_S); }
    DI int* IDX() const { return (int*)(ws + WO_IDX); }
    DI const float** XPTR() const { return (const float**)(ws + WO_XPTR); }
    DI float* ZROW() const { return (float*)(ws + WO_ZROW); }
    DI bf16_t* MYT() const { return (bf16_t*)(ws + WO_MYT); }
    DI bf16_t* MST() const { return (bf16_t*)(ws + WO_MST); }
    DI float* PLV() const { return (float*)(ws + WO_PLV); }
    DI float* WYT() const { return (float*)(ws + WO_WYT); }
    DI float* WST() const { return (float*)(ws + WO_WST); }
    DI unsigned* SCF() const { return (unsigned*)(ws + WO_SCF); }
};


DI size_t scan_addr(int chain, int vec, int d, int t) { return (((size_t)chain * 6 + vec) * 64 + d) * TTP + t; }
DI float bf2f(unsigned h) { return __uint_as_float(h << 16); }
DI float bflo(unsigned w) { return __uint_as_float(w << 16); }
DI float bfhi(unsigned w) { return __uint_as_float(w & 0xffff0000u); }
DI unsigned pk2(float lo, float hi) { f32x2 v = {lo, hi}; bf16v2 b = __builtin_convertvector(v, bf16v2); return __builtin_bit_cast(unsigned, b); }
DI unsigned short bf16_1_(float x) { return (unsigned short)(pk2(x, 0.f) & 0xffffu); }
DI float wave_sum(float v) {
#pragma unroll
    for (int o = 1; o < 64; o <<= 1) v += __shfl_xor(v, o);
    return v;
}
DI float sigmoidf_(float x) { return __builtin_amdgcn_rcpf(1.f + __expf(-x)); }
DI void unpack8(const u32x4& w, float (&f)[8]) {
    f[0] = bflo(w.x); f[1] = bfhi(w.x); f[2] = bflo(w.y); f[3] = bfhi(w.y); f[4] = bflo(w.z); f[5] = bfhi(w.z); f[6] = bflo(w.w); f[7] = bfhi(w.w);
}
DI const float* xrow_ptr(const Params& p, int row) {
    if (row < MPR) { const int b = row / TT, t = row - b * TT; return t < NMETA ? p.meta + (size_t)t * DM : p.x_prompt + ((size_t)b * SEQ + (t - NMETA)) * DM; }
    if (row < MTOT) return p.x_sample + (size_t)(row - MPR) * DM;
    return nullptr;
}

DI void transpose_item(const float* __restrict__ W, int K, int N, const float* __restrict__ gain, bf16_t* __restrict__ WT, LAS float* scr, int item, int lane) {
    const int nblk = N / 32, kb = item / nblk, nb = item - kb * nblk, k0 = 64 * kb, n0 = 32 * nb;
#pragma unroll 8
    for (int i = 0; i < 32; ++i) { const int kk = 2 * i + (lane >> 5); float g = gain ? gain[k0 + kk] : 1.f; scr[kk * 33 + (lane & 31)] = g * W[(size_t)(k0 + kk) * N + n0 + (lane & 31)]; }
    __builtin_amdgcn_s_waitcnt(0xc07f); asm volatile("" ::: "memory");
    const int c = lane & 7;
#pragma unroll
    for (int j = 0; j < 4; ++j) { const int n = (lane >> 3) + 8 * j; const LAS float* s = scr + (8 * c) * 33 + n;
        u32x4 o; o.x = pk2(s[0 * 33], s[1 * 33]); o.y = pk2(s[2 * 33], s[3 * 33]); o.z = pk2(s[4 * 33], s[5 * 33]); o.w = pk2(s[6 * 33], s[7 * 33]);
        *(u32x4*)(WT + (size_t)(n0 + n) * K + k0 + 8 * c) = o; }
    __builtin_amdgcn_s_waitcnt(0xc07f); asm volatile("" ::: "memory");
}
DI void convert_chunk(const float* __restrict__ src, bf16_t* __restrict__ dst, int item, int lane) {
    const size_t base = (size_t)item * 4096;
#pragma unroll
    for (int j = 0; j < 8; ++j) { const size_t o = base + (size_t)(j * 64 + lane) * 8;
        const f32x4 a = *(const f32x4*)(src + o), b = *(const f32x4*)(src + o + 4);
        u32x4 w; w.x = pk2(a.x, a.y); w.y = pk2(a.z, a.w); w.z = pk2(b.x, b.y); w.w = pk2(b.z, b.w);
        *(u32x4*)(dst + o) = w; }
}
constexpr float U8_SCALE = 256.f, V8_SCALE = 64.f;
DI void convert_chunk_fp8(const float* __restrict__ src, unsigned char* __restrict__ dst, float scale, int item, int lane) {
    const size_t base = (size_t)item * 4096;
#pragma unroll
    for (int j = 0; j < 4; ++j) { const size_t o = base + (size_t)(j * 64 + lane) * 16;
        u32x4 w;
#pragma unroll
        for (int q = 0; q < 4; ++q) { const f32x4 a = *(const f32x4*)(src + o + 4 * q);
            int pk = __builtin_amdgcn_cvt_pk_fp8_f32(a.x * scale, a.y * scale, 0, false); pk = __builtin_amdgcn_cvt_pk_fp8_f32(a.z * scale, a.w * scale, pk, true); w[q] = (unsigned)pk; }
        *(u32x4*)(dst + o) = w; }
}
DI unsigned fp6_code(float x, float s) {
    const float a = fminf(fabsf(x) * s, 7.5f);
    const float c = a < 2.f ? rintf(a * 8.f) : (a < 4.f ? 16.f + rintf((a - 2.f) * 4.f) : 24.f + rintf((a - 4.f) * 2.f));
    return (unsigned)c | (x < 0.f ? 32u : 0u);
}
DI void convert_row_fp6(const float* __restrict__ src, unsigned char* __restrict__ dst, float* __restrict__ sc, int row, int lane) {
    const float* sp = src + (size_t)row * DM + lane * 16;
    f32x4 v[4]; float am = 0.f;
#pragma unroll
    for (int q = 0; q < 4; ++q) { v[q] = *(const f32x4*)(sp + 4 * q); am = fmaxf(am, fmaxf(fmaxf(fabsf(v[q].x), fabsf(v[q].y)), fmaxf(fabsf(v[q].z), fabsf(v[q].w)))); }
#pragma unroll
    for (int o = 32; o; o >>= 1) am = fmaxf(am, __shfl_xor(am, o));
    const float s = am > 0.f ? 7.5f / am : 0.f;
    if (lane == 0) sc[row] = am * (1.f / 7.5f);
    unsigned long long lo = 0; unsigned hi = 0;
#pragma unroll
    for (int i = 0; i < 16; ++i) {
        const unsigned c = fp6_code(v[i >> 2][i & 3], s);
        if (i < 10) lo |= (unsigned long long)c << (6 * i);
        else if (i == 10) { lo |= (unsigned long long)(c & 15u) << 60; hi |= c >> 4; }
        else hi |= c << (6 * i - 64);
    }
    unsigned* dp = (unsigned*)(dst + (size_t)row * 768 + lane * 12);
    dp[0] = (unsigned)lo; dp[1] = (unsigned)(lo >> 32); dp[2] = hi;
}
DI void phase_convert(const Params& p, char* smem, int part, int gw, int ngw, int wave, int lane) {
    LAS float* scr = (LAS float*)(smem) + wave * (64 * 33);
    constexpr int I_ROWS = MP;
    constexpr int I_WIN = 16 * (INW / 32), I_RW = 8 * 32, I_DA = 8 * 32, I_OUT = 16 * 32, I_WQ = 16 * 64, I_W2 = 16, I_A2 = 16, I_G2 = 32;
    constexpr int I_SK = 8, I_Z = MP / 256;
    if (part == 0) {
        constexpr int NIT = I_ROWS + I_WIN + I_Z;
        for (int it = gw; it < NIT; it += ngw) {
            int r = it;
            if (r < I_ROWS) {
                const float* src = xrow_ptr(p, r);
                f32x4 v[4]; float ss = 0.f;
#pragma unroll
                for (int j = 0; j < 4; ++j) { v[j] = src ? *(const f32x4*)(src + (j * 64 + lane) * 4) : (f32x4){0.f, 0.f, 0.f, 0.f}; ss += v[j].x * v[j].x + v[j].y * v[j].y + v[j].z * v[j].z + v[j].w * v[j].w; }
                ss = wave_sum(ss);
#pragma unroll
                for (int j = 0; j < 4; ++j) { u32x2 o; o.x = pk2(v[j].x, v[j].y); o.y = pk2(v[j].z, v[j].w); *(u32x2*)(p.XB() + (size_t)r * DM + (j * 64 + lane) * 4) = o; }
                if (lane == 0) { p.RSTD1()[r] = rsqrtf(ss * (1.f / DM) + 1e-6f); p.XPTR()[r] = src ? src : p.ZROW(); }
                continue;
            }
            r -= I_ROWS;
            if (r < I_WIN) { transpose_item(p.w_in, 1024, INW, p.norm1_g, p.WIN_T(), scr, r, lane); continue; } r -= I_WIN;
            { *(f32x4*)(p.SS2() + (size_t)r * 256 + lane * 4) = (f32x4){0.f, 0.f, 0.f, 0.f}; if (r < 4) *(f32x4*)(p.ZROW() + (size_t)r * 256 + lane * 4) = (f32x4){0.f, 0.f, 0.f, 0.f}; }
        }
    } else {
        constexpr int NIT = I_RW + I_DA + I_OUT + I_WQ + I_W2 + I_A2 + I_G2 + I_SK;
        for (int it = gw; it < NIT; it += ngw) {
            int r = it;
            if (r < I_W2) { transpose_item(p.rw_w2, 64, 512, nullptr, p.W2_T(), scr, r, lane); continue; } r -= I_W2;
            if (r < I_A2) { transpose_item(p.rw_a2, 64, 512, nullptr, p.A2_T(), scr, r, lane); continue; } r -= I_A2;
            if (r < I_G2) { transpose_item(p.rw_g2, 128, 512, nullptr, p.G2_T(), scr, r, lane); continue; } r -= I_G2;
            if (r < I_RW) { transpose_item(p.w_rw_br, 512, 1024, nullptr, p.WRW_T(), scr, r, lane); continue; } r -= I_RW;
            if (r < I_DA) { transpose_item(p.w_da_br, 512, 1024, nullptr, p.WDA_T(), scr, r, lane); continue; } r -= I_DA;
            if (r < I_OUT) { transpose_item(p.w_out, 1024, 1024, nullptr, p.WOUT_T(), scr, r, lane); continue; } r -= I_OUT;
            if (r < I_WQ) { transpose_item(p.peer_wq, 1024, 2048, p.norm2_g, p.WQ_T(), scr, r, lane); continue; } r -= I_WQ;
            convert_chunk(p.peer_subkeys, p.SK(), r, lane);
        }
    }
}

DI void convert_row_fp4(const float* __restrict__ src, unsigned char* __restrict__ dst, float* __restrict__ sc, int row, int lane) {
    const float* sp = src + (size_t)row * DM + lane * 16;
    f32x4 v[4]; float am = 0.f;
#pragma unroll
    for (int q = 0; q < 4; ++q) { v[q] = *(const f32x4*)(sp + 4 * q); am = fmaxf(am, fmaxf(fmaxf(fabsf(v[q].x), fabsf(v[q].y)), fmaxf(fabsf(v[q].z), fabsf(v[q].w)))); }
#pragma unroll
    for (int o = 32; o; o >>= 1) am = fmaxf(am, __shfl_xor(am, o));
    const float s = am > 0.f ? 6.f / am : 0.f;
    if (lane == 0) sc[row] = am * (1.f / 6.f);
    unsigned w0 = 0u, w1 = 0u;
    w0 = __builtin_amdgcn_cvt_scalef32_pk_fp4_f32(w0, v[0].x * s, v[0].y * s, 1.0f, 0); w0 = __builtin_amdgcn_cvt_scalef32_pk_fp4_f32(w0, v[0].z * s, v[0].w * s, 1.0f, 1);
    w0 = __builtin_amdgcn_cvt_scalef32_pk_fp4_f32(w0, v[1].x * s, v[1].y * s, 1.0f, 2); w0 = __builtin_amdgcn_cvt_scalef32_pk_fp4_f32(w0, v[1].z * s, v[1].w * s, 1.0f, 3);
    w1 = __builtin_amdgcn_cvt_scalef32_pk_fp4_f32(w1, v[2].x * s, v[2].y * s, 1.0f, 0); w1 = __builtin_amdgcn_cvt_scalef32_pk_fp4_f32(w1, v[2].z * s, v[2].w * s, 1.0f, 1);
    w1 = __builtin_amdgcn_cvt_scalef32_pk_fp4_f32(w1, v[3].x * s, v[3].y * s, 1.0f, 2); w1 = __builtin_amdgcn_cvt_scalef32_pk_fp4_f32(w1, v[3].z * s, v[3].w * s, 1.0f, 3);
    *(u32x2*)(dst + (size_t)row * 512 + lane * 8) = (u32x2){w0, w1};
}

namespace g8 {
constexpr int BM = 256, BK = 64, HALF = 128, HT = HALF * BK, SHM_B = 8 * HT * 2, NXCD = 8, WGM = 8;
DI int lds_byte(int r, int c) { int st = (r >> 4) * 2 + (c >> 5), rr = r & 15, cc = c & 31, ob = rr * 64 + cc * 2; return st * 1024 + (ob ^ (((ob >> 9) & 1) << 5)); }
DI void stage_rc(int b, int& R, int& C) { int st = b / 1024, sb = b % 1024, swz = sb ^ (((sb >> 9) & 1) << 5); R = (st >> 1) * 16 + swz / 64; C = (st & 1) * 32 + (swz % 64) / 2; }
DI void unit_map(int L, int nM, int nN, int& pm, int& pn) {
    const int nwg = nM * nN; int wgid = L;
    { const int q = nwg / NXCD, r = nwg % NXCD, xcd = wgid % NXCD, off = wgid / NXCD; wgid = (xcd < r ? xcd * (q + 1) : r * (q + 1) + (xcd - r) * q) + off; }
    const int nig = WGM * nN, gid = wgid / nig, fm = gid * WGM, gsz = (nM - fm) < WGM ? (nM - fm) : WGM;
    pm = fm + ((wgid % nig) % gsz); pn = (wgid % nig) / gsz;
}
template <class Epi>
DI void gemm_tile(const bf16_t* __restrict__ A, const int lda, const bf16_t* __restrict__ Bt, const int K, const int brow, const int bcol, bf16_t* shm, const Epi& epi) {
#define SA(b, h) (shm + ((b) * 2 + (h)) * HT)
#define SB(b, h) (shm + (4 + (b) * 2 + (h)) * HT)
#define STAGE_X(T, P, BASE, LD, br, kt) do { long _g = (long)(br) * (LD) + (long)(kt) * BK; \
    for (int _i = 0; _i < 2; ++_i) { int _b = (T) * 16 + _i * 8192; int _r, _c; stage_rc(_b, _r, _c); \
      __builtin_amdgcn_global_load_lds((const unsigned*)(BASE + _g + (long)_r * (LD) + _c), (LAS unsigned*)((LAS char*)(P) + _b), 16, 0, 0); } } while (0)
#define STAGEA(P, BASE, br, kt) STAGE_X(tz0, P, BASE, lda, br, kt)
#define STAGEB(P, BASE, br, kt) STAGE_X(tz0, P, BASE, K, br, kt)
#define LDA(dst, b, h) for (int m = 0; m < 4; ++m) for (int k = 0; k < 2; ++k) \
    dst[m][k] = *reinterpret_cast<const bf16x8*>((char*)SA(b, h) + lds_byte(wr * 64 + m * 16 + fr, k * 32 + fq * 8))
#define LDB(dst, b, h) for (int n = 0; n < 2; ++n) for (int k = 0; k < 2; ++k) \
    dst[n][k] = *reinterpret_cast<const bf16x8*>((char*)SB(b, h) + lds_byte(wc * 32 + n * 16 + fr, k * 32 + fq * 8))
#define MMA(ai, bj, At, Bf) do { __builtin_amdgcn_s_setprio(1); \
    for (int m = 0; m < 4; ++m) for (int n = 0; n < 2; ++n) for (int k = 0; k < 2; ++k) \
      acc[ai][bj][m][n] = __builtin_amdgcn_mfma_f32_16x16x32_bf16(Bf[n][k], At[m][k], acc[ai][bj][m][n], 0, 0, 0); \
    __builtin_amdgcn_s_setprio(0); } while (0)
#define WAIT_V(n) asm volatile("s_waitcnt vmcnt(" #n ")" ::: "memory")
#define WAIT_L(n) asm volatile("s_waitcnt lgkmcnt(" #n ")" ::: "memory")
#define BAR __builtin_amdgcn_s_barrier()
#define SCHED __builtin_amdgcn_sched_barrier(0)
    int tz0 = threadIdx.x; asm volatile("" : "+v"(tz0));
    int wid = tz0 >> 6, lane = tz0 & 63, wr = wid >> 2, wc = wid & 3, fr = lane & 15, fq = lane >> 4;
    f32x4 acc[2][2][4][2] = {};
    bf16x8 At[4][2], B0[2][2], B1[2][2];
    const int nt = K / BK;
    STAGEB(SB(0, 0), Bt, bcol, 0); STAGEA(SA(0, 0), A, brow, 0);
    STAGEB(SB(0, 1), Bt, bcol + HALF, 0); STAGEA(SA(0, 1), A, brow + HALF, 0);
    if (wr == 1) BAR;
    WAIT_V(4); BAR;
    STAGEB(SB(1, 0), Bt, bcol, 1); STAGEA(SA(1, 0), A, brow, 1); STAGEB(SB(1, 1), Bt, bcol + HALF, 1);
    WAIT_V(6); BAR;
    for (int t = 0; t < nt - 2; t += 2) {
        LDB(B0, 0, 0); SCHED; LDA(At, 0, 0); STAGEA(SA(1, 1), A, brow + HALF, t + 1);
        WAIT_L(8); BAR; WAIT_L(0); MMA(0, 0, At, B0); BAR; SCHED;
        LDB(B1, 0, 1); STAGEB(SB(0, 0), Bt, bcol, t + 2);
        BAR; WAIT_L(0); MMA(0, 1, At, B1); BAR;
        LDA(At, 0, 1); STAGEA(SA(0, 0), A, brow, t + 2);
        BAR; WAIT_L(0); MMA(1, 0, At, B0); BAR; SCHED;
        STAGEB(SB(0, 1), Bt, bcol + HALF, t + 2);
        WAIT_V(6); BAR; MMA(1, 1, At, B1); BAR;
        LDB(B0, 1, 0); SCHED; LDA(At, 1, 0); STAGEA(SA(0, 1), A, brow + HALF, t + 2);
        WAIT_L(8); BAR; WAIT_L(0); MMA(0, 0, At, B0); BAR; SCHED;
        LDB(B1, 1, 1); STAGEB(SB(1, 0), Bt, bcol, t + 3);
        BAR; WAIT_L(0); MMA(0, 1, At, B1); BAR;
        LDA(At, 1, 1); STAGEA(SA(1, 0), A, brow, t + 3);
        BAR; WAIT_L(0); MMA(1, 0, At, B0); BAR; SCHED;
        STAGEB(SB(1, 1), Bt, bcol + HALF, t + 3);
        WAIT_V(6); BAR; MMA(1, 1, At, B1); BAR;
    }
    int tz = tz0; asm volatile("" : "+v"(tz)); wid = tz >> 6; lane = tz & 63; wr = wid >> 2; wc = wid & 3; fr = lane & 15; fq = lane >> 4;
    { LDB(B0, 0, 0); WAIT_V(0); LDA(At, 0, 0); STAGE_X(tz, SA(1, 1), A, lda, brow + HALF, nt - 1);
      BAR; WAIT_L(0); MMA(0, 0, At, B0); BAR;
      LDB(B1, 0, 1); BAR; WAIT_L(0); MMA(0, 1, At, B1); BAR;
      LDA(At, 0, 1); WAIT_V(4); BAR; WAIT_L(0); MMA(1, 0, At, B0); MMA(1, 1, At, B1); BAR; }
    { LDB(B0, 1, 0); LDA(At, 1, 0); WAIT_V(2); BAR; WAIT_L(0); MMA(0, 0, At, B0); BAR;
      LDB(B1, 1, 1); WAIT_V(0); BAR; WAIT_L(0); MMA(0, 1, At, B1); BAR;
      LDA(At, 1, 1); BAR; WAIT_L(0); MMA(1, 0, At, B0); MMA(1, 1, At, B1); BAR; }
    if (wr == 0) BAR;
    epi(acc, brow, bcol, wr, wc, fr, fq);
#undef SA
#undef SB
#undef STAGE_X
#undef STAGEA
#undef STAGEB
#undef LDA
#undef LDB
#undef MMA
}
template <bool REMAP, class Epi>
DI void gemm_phase(const bf16_t* A, int lda, const bf16_t* Bt, int K, int nM, int nN, bf16_t* shm, const Epi& epi, int bid, int nblk) {
    const int nwg = nM * nN;
    for (int L = bid; L < nwg; L += nblk) {
        int pm, pn; unit_map(L, nM, nN, pm, pn);
        const int brow = REMAP ? (pm >> 4) * TT + NMETA + (pm & 15) * BM : pm * BM;
        gemm_tile(A, lda, Bt, K, brow, pn * BM, shm, epi);
        __syncthreads();
    }
}
}
typedef f32x4 AccT[2][2][4][2];
#define EPI_ROWS_BEGIN _Pragma("unroll") for (int ai = 0; ai < 2; ++ai) _Pragma("unroll") for (int m = 0; m < 4; ++m) { __builtin_amdgcn_sched_barrier(0); asm volatile("" ::: "memory"); const int row = brow + ai * 128 + wr * 64 + m * 16 + fr;
#define EPI_COLS_BEGIN _Pragma("unroll") for (int bj = 0; bj < 2; ++bj) _Pragma("unroll") for (int n = 0; n < 2; ++n) { const int col = bcol + bj * 128 + wc * 32 + n * 16 + fq * 4; const f32x4 a = acc[ai][bj][m][n];

struct EpiProj {
    const float* rstd; bf16_t* PROJ; float* out;
    DI void operator()(const AccT& acc, int brow, int bcol, int wr, int wc, int fr, int fq) const {
        EPI_ROWS_BEGIN
            const float rs = rstd[row];
            float* sh = nullptr;
            if (bcol < RWP) {
                if (row < MPR) { const int b = row / TT; if (row - b * TT == TT - 1) sh = out + OUT_SP + (size_t)b * RWP; }
                else if (row < MTOT) sh = out + OUT_SS + (size_t)(row - MPR) * RWP;
            }
            EPI_COLS_BEGIN
                const f32x4 v = a * rs;
                u32x2 o; o.x = pk2(v.x, v.y); o.y = pk2(v.z, v.w);
                *(u32x2*)(PROJ + (size_t)row * INW + col) = o;
                if (sh) *(f32x4*)(sh + col) = v;
            }
        }
    }
};

DI void prep_qkv_row(const Params& p, int row, int lane) {
    const bf16_t* pr = p.PROJ() + (size_t)row * INW;
    const u32x4 w0 = *(const u32x4*)(pr + O_Q + lane * 16), w1 = *(const u32x4*)(pr + O_Q + lane * 16 + 8);
    float f[16]; { float t0[8], t1[8]; unpack8(w0, t0); unpack8(w1, t1);
#pragma unroll
        for (int i = 0; i < 8; ++i) { f[i] = t0[i]; f[8 + i] = t1[i]; } }
    float ss = 0.f;
#pragma unroll
    for (int i = 0; i < 16; ++i) ss += f[i] * f[i];
    ss += __shfl_xor(ss, 1); ss += __shfl_xor(ss, 2);
    const float rs = rsqrtf(ss * (1.f / 64.f) + 1e-6f);
    const bool isk = lane >= 32;
    const float* gp = (isk ? p.da_kn_g : p.da_qn_g) + (lane & 3) * 16;
#pragma unroll
    for (int i = 0; i < 16; ++i) f[i] = f[i] * rs * gp[i];
    u32x4 o0, o1; o0.x = pk2(f[0], f[1]); o0.y = pk2(f[2], f[3]); o0.z = pk2(f[4], f[5]); o0.w = pk2(f[6], f[7]);
    o1.x = pk2(f[8], f[9]); o1.y = pk2(f[10], f[11]); o1.z = pk2(f[12], f[13]); o1.w = pk2(f[14], f[15]);
    bf16_t* dst = (isk ? p.KN() : p.QN()) + (size_t)row * 512 + (lane & 31) * 16;
    *(u32x4*)dst = o0; *(u32x4*)(dst + 8) = o1;
    float* kout = row < MPR ? p.out + OUT_KP + (size_t)row * 512 : p.out + OUT_KS + (size_t)(row - MPR) * 512;
    float* vout = row < MPR ? p.out + OUT_VP + (size_t)row * 512 : p.out + OUT_VS + (size_t)(row - MPR) * 512;
    if (isk) {
#pragma unroll
        for (int i = 0; i < 4; ++i) *(f32x4*)(kout + (lane - 32) * 16 + 4 * i) = (f32x4){f[4 * i], f[4 * i + 1], f[4 * i + 2], f[4 * i + 3]};
    }
    const u32x4 wv = *(const u32x4*)(pr + O_V + lane * 8);
    float v8[8]; unpack8(wv, v8);
    *(f32x4*)(vout + lane * 8) = (f32x4){v8[0], v8[1], v8[2], v8[3]};
    *(f32x4*)(vout + lane * 8 + 4) = (f32x4){v8[4], v8[5], v8[6], v8[7]};
}

template <int N>
DI void ps_load(const LAS float* pl, const bf16_t* cur, const bf16_t* prevb, const float* prevf, int col0, float (&o)[N]) {
    float c[N], pv[N];
    if (N == 8) { float t[8]; unpack8(*(const u32x4*)(cur + col0), t);
#pragma unroll
        for (int i = 0; i < N; ++i) c[i] = t[i]; }
    else { const u32x2 w = *(const u32x2*)(cur + col0); c[0] = bflo(w.x); c[1] = bfhi(w.x); c[2] = bflo(w.y); c[3] = bfhi(w.y); }
    if (prevb) {
        if (N == 8) { float t[8]; unpack8(*(const u32x4*)(prevb + col0), t);
#pragma unroll
            for (int i = 0; i < N; ++i) pv[i] = t[i]; }
        else { const u32x2 w = *(const u32x2*)(prevb + col0); pv[0] = bflo(w.x); pv[1] = bfhi(w.x); pv[2] = bflo(w.y); pv[3] = bfhi(w.y); }
    } else if (prevf) {
#pragma unroll
        for (int i = 0; i < N; i += 4) { const f32x4 t = *(const f32x4*)(prevf + col0 + i); pv[i] = t.x; pv[i + 1] = t.y; pv[i + 2] = t.z; pv[i + 3] = t.w; }
    } else {
#pragma unroll
        for (int i = 0; i < N; ++i) pv[i] = 0.f;
    }
#pragma unroll
    for (int i = 0; i < N; i += 4) { const f32x4 mu = *(const LAS f32x4*)(pl + col0 + i);
        o[i] = c[i] + (pv[i] - c[i]) * mu.x; o[i + 1] = c[i + 1] + (pv[i + 1] - c[i + 1]) * mu.y;
        o[i + 2] = c[i + 2] + (pv[i + 2] - c[i + 2]) * mu.z; o[i + 3] = c[i + 3] + (pv[i + 3] - c[i + 3]) * mu.w; }
}
DI bf16x8 pack8(const float (&f)[8]) { u32x4 w; w.x = pk2(f[0], f[1]); w.y = pk2(f[2], f[3]); w.z = pk2(f[4], f[5]); w.w = pk2(f[6], f[7]); return __builtin_bit_cast(bf16x8, w); }
#define MFMA32(a, b, c) __builtin_amdgcn_mfma_f32_32x32x16_bf16((a), (b), (c), 0, 0, 0)

DI float tanh_fast(float x) { const float e = __expf(2.f * x); return 1.f - 2.f * __builtin_amdgcn_rcpf(e + 1.f); }
constexpr int PL_W0 = 1792, PL_A0 = 2304, PL_KK = 2816, PL_KA = 3328, PL_RK = 3840, PL_N = 4352;
DI void prep_rwkv_tile(const Params& p, const LAS float* pl, int tile, int lane) {
    const int tk = lane & 31, hh = lane >> 5, row = tile * 32 + tk;
    const bool samp = row >= MPR;
    int b = 0, t = 0;
    if (!samp) { b = row / TT; t = row - b * TT; }
    const bf16_t* cur = p.PROJ() + (size_t)row * INW;
    const bf16_t* prevb = (!samp && t > 0) ? cur - INW : nullptr;
    const float* prevf = samp ? p.state_shift + (size_t)(row - MPR) * RWP : nullptr;
    {
        bf16x8 Bw[4], Ba[4];
#pragma unroll
        for (int s = 0; s < 4; ++s) { float x[8]; ps_load<8>(pl, cur, prevb, prevf, 1536 + 16 * s + 8 * hh, x);
#pragma unroll
            for (int i = 0; i < 8; ++i) x[i] = tanh_fast(x[i]);
            Bw[s] = pack8(x); }
#pragma unroll
        for (int s = 0; s < 4; ++s) { float x[8]; ps_load<8>(pl, cur, prevb, prevf, 1600 + 16 * s + 8 * hh, x); Ba[s] = pack8(x); }
#pragma unroll 1
        for (int hd = 0; hd < 8; ++hd) {
            float kk2 = 0.f;
#pragma unroll 2
            for (int q8 = 0; q8 < 8; ++q8) { const int n = hd * 64 + (q8 >> 2) * 32 + 8 * (q8 & 3) + 4 * hh;
                float k4[4]; ps_load<4>(pl, cur, prevb, prevf, 512 + n, k4); const f32x4 kkp = *(const LAS f32x4*)(pl + PL_KK + n);
                const float a0 = k4[0] * kkp.x, a1 = k4[1] * kkp.y, a2 = k4[2] * kkp.z, a3 = k4[3] * kkp.w; kk2 += a0 * a0 + a1 * a1 + a2 * a2 + a3 * a3; }
            kk2 += __shfl_xor(kk2, 32);
            const float kinv = __builtin_amdgcn_rcpf(fmaxf(__builtin_amdgcn_sqrtf(kk2), 1e-12f));
            float bon = 0.f;
#pragma unroll 1
            for (int nt2 = 0; nt2 < 2; ++nt2) {
                const int n0 = hd * 64 + nt2 * 32;
                f32x16 dW = {}, dA = {};
#pragma unroll
                for (int s = 0; s < 4; ++s) { const bf16x8 aw = *(const bf16x8*)(p.W2_T() + (size_t)(n0 + tk) * 64 + 16 * s + 8 * hh); dW = MFMA32(aw, Bw[s], dW); }
#pragma unroll
                for (int s = 0; s < 4; ++s) { const bf16x8 aa = *(const bf16x8*)(p.A2_T() + (size_t)(n0 + tk) * 64 + 16 * s + 8 * hh); dA = MFMA32(aa, Ba[s], dA); }
#pragma unroll 1
                for (int q4 = 0; q4 < 4; ++q4) {
                    const int d0 = nt2 * 32 + 8 * q4 + 4 * hh, n = hd * 64 + d0;
                    float r4[4], k4[4], v4[4];
                    ps_load<4>(pl, cur, prevb, prevf, n, r4); ps_load<4>(pl, cur, prevb, prevf, 512 + n, k4); ps_load<4>(pl, cur, prevb, prevf, 1024 + n, v4);
                    const f32x4 w0 = *(const LAS f32x4*)(pl + PL_W0 + n), a0 = *(const LAS f32x4*)(pl + PL_A0 + n), kkp = *(const LAS f32x4*)(pl + PL_KK + n), ka = *(const LAS f32x4*)(pl + PL_KA + n), rk = *(const LAS f32x4*)(pl + PL_RK + n);
                    float dl[4], kp[4], av[4], bv[4];
#pragma unroll
                    for (int e = 0; e < 4; ++e) {
                        const float zw = w0[e] + dW[e];
                        const float ez = __expf(-zw);
                        const float sp = (zw > 15.f) ? ez : __logf(1.f + ez);
                        const float ew = __expf(-sp - 0.5f);
                        dl[e] = 1.f - __expf(-ew);
                        const float a = sigmoidf_(a0[e] + dA[e]);
                        const float kkn = k4[e] * kkp[e] * kinv;
                        kp[e] = k4[e] * (1.f + (a - 1.f) * ka[e]);
                        av[e] = -kkn; bv[e] = kkn * a;
                        bon += r4[e] * kp[e] * rk[e];
                    }
                    if (!samp) {
                        bf16_t* so = p.SCAN() + scan_addr(b * 8 + hd, 0, d0, t);
#pragma unroll
                        for (int e = 0; e < 4; ++e) { bf16_t* se = so + (size_t)e * TTP;
                            se[(size_t)0 * 64 * TTP] = bf16_1_(dl[e]); se[(size_t)1 * 64 * TTP] = bf16_1_(kp[e]); se[(size_t)2 * 64 * TTP] = bf16_1_(v4[e]);
                            se[(size_t)3 * 64 * TTP] = bf16_1_(av[e]); se[(size_t)4 * 64 * TTP] = bf16_1_(bv[e]); se[(size_t)5 * 64 * TTP] = bf16_1_(r4[e]); }
                    } else {
                        float* so = p.SCAN_S() + (((size_t)(row - MPR) * 8 + hd) * 6) * 64 + d0;
                        *(f32x4*)(so + 0 * 64) = (f32x4){1.f - dl[0], 1.f - dl[1], 1.f - dl[2], 1.f - dl[3]};
                        *(f32x4*)(so + 1 * 64) = (f32x4){kp[0], kp[1], kp[2], kp[3]};
                        *(f32x4*)(so + 2 * 64) = (f32x4){v4[0], v4[1], v4[2], v4[3]};
                        *(f32x4*)(so + 3 * 64) = (f32x4){av[0], av[1], av[2], av[3]};
                        *(f32x4*)(so + 4 * 64) = (f32x4){bv[0], bv[1], bv[2], bv[3]};
                        *(f32x4*)(so + 5 * 64) = (f32x4){r4[0], r4[1], r4[2], r4[3]};
                    }
                    dW = __builtin_shufflevector(dW, dW, 4, 5, 6, 7, 8, 9, 10, 11, 12, 13, 14, 15, 0, 1, 2, 3);
                    dA = __builtin_shufflevector(dA, dA, 4, 5, 6, 7, 8, 9, 10, 11, 12, 13, 14, 15, 0, 1, 2, 3);
                }
            }
            bon += __shfl_xor(bon, 32);
            if (hh == 0) p.BONUS()[(size_t)row * 8 + hd] = bon;
        }
    }
    __builtin_amdgcn_sched_barrier(0);
    {
        bf16x8 Bg[8];
#pragma unroll
        for (int s = 0; s < 8; ++s) { float x[8]; ps_load<8>(pl, cur, prevb, prevf, 1664 + 16 * s + 8 * hh, x);
#pragma unroll
            for (int i = 0; i < 8; ++i) x[i] = sigmoidf_(x[i]);
            Bg[s] = pack8(x); }
#pragma unroll 1
        for (int nt = 0; nt < 16; ++nt) {
            f32x16 dG = {};
#pragma unroll
            for (int s = 0; s < 8; ++s) { const bf16x8 ag = *(const bf16x8*)(p.G2_T() + (size_t)(nt * 32 + tk) * 128 + 16 * s + 8 * hh); dG = MFMA32(ag, Bg[s], dG); }
#pragma unroll
            for (int q4 = 0; q4 < 4; ++q4) { u32x2 og; og.x = pk2(dG[4 * q4], dG[4 * q4 + 1]); og.y = pk2(dG[4 * q4 + 2], dG[4 * q4 + 3]);
                *(u32x2*)(p.G() + (size_t)row * 512 + nt * 32 + 8 * q4 + 4 * hh) = og; }
        }
    }
}
constexpr int PV_ROWB = 3600, PV_STAGE_OFF = PL_N * 4  , PV_LDS = PV_STAGE_OFF + 33 * PV_ROWB;
template <int N>
DI void ps_lds(const LAS float* pl, const LAS char* curp, const LAS char* prevp, bool pz, int col0, float (&o)[N]) {
    float c[N], pv[N];
    if (N == 8) { const u32x4 wc = *(const LAS u32x4*)(curp + col0 * 2), wp = *(const LAS u32x4*)(prevp + col0 * 2); float t[8]; unpack8(wc, t); float u[8]; unpack8(wp, u);
#pragma unroll
        for (int i = 0; i < N; ++i) { c[i] = t[i]; pv[i] = pz ? 0.f : u[i]; } }
    else { const u32x2 w = *(const LAS u32x2*)(curp + col0 * 2), x = *(const LAS u32x2*)(prevp + col0 * 2);
        c[0] = bflo(w.x); c[1] = bfhi(w.x); c[2] = bflo(w.y); c[3] = bfhi(w.y);
        pv[0] = pz ? 0.f : bflo(x.x); pv[1] = pz ? 0.f : bfhi(x.x); pv[2] = pz ? 0.f : bflo(x.y); pv[3] = pz ? 0.f : bfhi(x.y); }
#pragma unroll
    for (int i = 0; i < N; i += 4) { const f32x4 mu = *(const LAS f32x4*)(pl + col0 + i);
        o[i] = c[i] + (pv[i] - c[i]) * mu.x; o[i + 1] = c[i + 1] + (pv[i + 1] - c[i + 1]) * mu.y;
        o[i + 2] = c[i + 2] + (pv[i + 2] - c[i + 2]) * mu.z; o[i + 3] = c[i + 3] + (pv[i + 3] - c[i + 3]) * mu.w; }
}
DI void prep_block(const Params& p, char* smem, int unit, int tid) {
    const LAS float* pl = (const LAS float*)smem;
    LAS char* stage = (LAS char*)smem + PV_STAGE_OFF;
    const bool samp = unit >= 514;
    const int row0 = samp ? MPR + (unit - 514) * 16 : unit * 32;
    __syncthreads();
#pragma unroll 1
    for (int i0 = 0; i0 < 16; i0 += 8) {
        u32x4 w[8];
#pragma unroll
        for (int i = 0; i < 8; ++i) {
            const int c = tid + 512 * (i0 + i), sl = c / 224, ch = c - sl * 224;
            w[i] = (u32x4){0u, 0u, 0u, 0u};
            if (c < 33 * 224) {
                if (!samp) { int gr = row0 - 1 + sl; gr = gr < 0 ? 0 : gr; w[i] = *(const u32x4*)(p.PROJ() + (size_t)gr * INW + ch * 8); }
                else if (sl < 16) w[i] = *(const u32x4*)(p.PROJ() + (size_t)(row0 + sl) * INW + ch * 8);
                else if (sl < 32) { const float* sp = p.state_shift + (size_t)(row0 - MPR + sl - 16) * RWP + ch * 8; const f32x4 a = *(const f32x4*)sp, b2 = *(const f32x4*)(sp + 4);
                    w[i].x = pk2(a.x, a.y); w[i].y = pk2(a.z, a.w); w[i].z = pk2(b2.x, b2.y); w[i].w = pk2(b2.z, b2.w); }
            }
        }
#pragma unroll
        for (int i = 0; i < 8; ++i) { const int c = tid + 512 * (i0 + i), sl = c / 224, ch = c - sl * 224; if (c < 33 * 224) *(LAS u32x4*)(stage + sl * PV_ROWB + ch * 16) = w[i]; }
    }
    __syncthreads();
    const int hd = tid >> 6, lane = tid & 63, tk = lane & 31, hh = lane >> 5;
    const int ntk = samp ? 16 : 32;
    const int tkc = tk < ntk ? tk : ntk - 1;
    const bool act = tk < ntk;
    const int row = row0 + tkc;
    int b = 0, t = 0; if (!samp) { b = row / TT; t = row - b * TT; }
    const LAS char* curp = stage + (samp ? tkc : tkc + 1) * PV_ROWB;
    const LAS char* prevp = stage + (samp ? 16 + tkc : tkc) * PV_ROWB;
    const bool pz = !samp && t == 0;
    {
        bf16x8 Bw[4], Ba[4];
#pragma unroll
        for (int s2 = 0; s2 < 4; ++s2) { float x[8]; ps_lds<8>(pl, curp, prevp, pz, 1536 + 16 * s2 + 8 * hh, x);
#pragma unroll
            for (int i = 0; i < 8; ++i) x[i] = tanh_fast(x[i]);
            Bw[s2] = pack8(x); }
#pragma unroll
        for (int s2 = 0; s2 < 4; ++s2) { float x[8]; ps_lds<8>(pl, curp, prevp, pz, 1600 + 16 * s2 + 8 * hh, x); Ba[s2] = pack8(x); }
        float kk2 = 0.f;
#pragma unroll 2
        for (int q8 = 0; q8 < 8; ++q8) { const int n = hd * 64 + (q8 >> 2) * 32 + 8 * (q8 & 3) + 4 * hh;
            float k4[4]; ps_lds<4>(pl, curp, prevp, pz, 512 + n, k4); const f32x4 kkp = *(const LAS f32x4*)(pl + PL_KK + n);
            const float a0 = k4[0] * kkp.x, a1 = k4[1] * kkp.y, a2 = k4[2] * kkp.z, a3 = k4[3] * kkp.w; kk2 += a0 * a0 + a1 * a1 + a2 * a2 + a3 * a3; }
        kk2 += __shfl_xor(kk2, 32);
        const float kinv = __builtin_amdgcn_rcpf(fmaxf(__builtin_amdgcn_sqrtf(kk2), 1e-12f));
        float bon = 0.f;
#pragma unroll 1
        for (int nt2 = 0; nt2 < 2; ++nt2) {
            const int n0 = hd * 64 + nt2 * 32;
            f32x16 dW = {}, dA = {};
            {
                bf16x8 aw[4], aa[4];
#pragma unroll
                for (int s2 = 0; s2 < 4; ++s2) { aw[s2] = *(const bf16x8*)(p.W2_T() + (size_t)(n0 + tk) * 64 + 16 * s2 + 8 * hh); aa[s2] = *(const bf16x8*)(p.A2_T() + (size_t)(n0 + tk) * 64 + 16 * s2 + 8 * hh); }
                __builtin_amdgcn_sched_barrier(0);
#pragma unroll
                for (int s2 = 0; s2 < 4; ++s2) { dW = MFMA32(aw[s2], Bw[s2], dW); dA = MFMA32(aa[s2], Ba[s2], dA); }
                __builtin_amdgcn_sched_barrier(0);
            }
#pragma unroll
            for (int q4 = 0; q4 < 4; ++q4) {
                const int d0 = nt2 * 32 + 8 * q4 + 4 * hh, n = hd * 64 + d0;
                float r4[4], k4[4], v4[4];
                ps_lds<4>(pl, curp, prevp, pz, n, r4); ps_lds<4>(pl, curp, prevp, pz, 512 + n, k4); ps_lds<4>(pl, curp, prevp, pz, 1024 + n, v4);
                const f32x4 w0 = *(const LAS f32x4*)(pl + PL_W0 + n), a0 = *(const LAS f32x4*)(pl + PL_A0 + n), kkp = *(const LAS f32x4*)(pl + PL_KK + n), ka = *(const LAS f32x4*)(pl + PL_KA + n), rk = *(const LAS f32x4*)(pl + PL_RK + n);
                float dl[4], kp[4], av[4], bv[4];
#pragma unroll
                for (int e = 0; e < 4; ++e) {
                    const float zw = w0[e] + dW[e];
                    const float ez = __expf(-zw);
                    const float sp = (zw > 15.f) ? ez : __logf(1.f + ez);
                    const float ew = __expf(-sp - 0.5f);
                    dl[e] = 1.f - __expf(-ew);
                    const float a = sigmoidf_(a0[e] + dA[e]);
                    const float kkn = k4[e] * kkp[e] * kinv;
                    kp[e] = k4[e] * (1.f + (a - 1.f) * ka[e]);
                    av[e] = -kkn; bv[e] = kkn * a;
                    bon += r4[e] * kp[e] * rk[e];
                }
                if (act) {
                    if (!samp) {
                        bf16_t* so = p.SCAN() + scan_addr(b * 8 + hd, 0, d0, t);
#pragma unroll
                        for (int e = 0; e < 4; ++e) { bf16_t* se = so + (size_t)e * TTP;
                            se[(size_t)0 * 64 * TTP] = bf16_1_(dl[e]); se[(size_t)1 * 64 * TTP] = bf16_1_(kp[e]); se[(size_t)2 * 64 * TTP] = bf16_1_(v4[e]);
                            se[(size_t)3 * 64 * TTP] = bf16_1_(av[e]); se[(size_t)4 * 64 * TTP] = bf16_1_(bv[e]); se[(size_t)5 * 64 * TTP] = bf16_1_(r4[e]); }
                    } else {
                        float* so = p.SCAN_S() + (((size_t)(row - MPR) * 8 + hd) * 6) * 64 + d0;
                        *(f32x4*)(so + 0 * 64) = (f32x4){1.f - dl[0], 1.f - dl[1], 1.f - dl[2], 1.f - dl[3]};
                        *(f32x4*)(so + 1 * 64) = (f32x4){kp[0], kp[1], kp[2], kp[3]};
                        *(f32x4*)(so + 2 * 64) = (f32x4){v4[0], v4[1], v4[2], v4[3]};
                        *(f32x4*)(so + 3 * 64) = (f32x4){av[0], av[1], av[2], av[3]};
                        *(f32x4*)(so + 4 * 64) = (f32x4){bv[0], bv[1], bv[2], bv[3]};
                        *(f32x4*)(so + 5 * 64) = (f32x4){r4[0], r4[1], r4[2], r4[3]};
                    }
                }
                dW = __builtin_shufflevector(dW, dW, 4, 5, 6, 7, 8, 9, 10, 11, 12, 13, 14, 15, 0, 1, 2, 3);
                dA = __builtin_shufflevector(dA, dA, 4, 5, 6, 7, 8, 9, 10, 11, 12, 13, 14, 15, 0, 1, 2, 3);
            }
        }
        bon += __shfl_xor(bon, 32);
        if (hh == 0 && act) p.BONUS()[(size_t)row * 8 + hd] = bon;
    }
    __builtin_amdgcn_sched_barrier(0);
    {
        bf16x8 Bg[8];
#pragma unroll
        for (int s2 = 0; s2 < 8; ++s2) { float x[8]; ps_lds<8>(pl, curp, prevp, pz, 1664 + 16 * s2 + 8 * hh, x);
#pragma unroll
            for (int i = 0; i < 8; ++i) x[i] = sigmoidf_(x[i]);
            Bg[s2] = pack8(x); }
#pragma unroll 1
        for (int nt = 2 * hd; nt < 2 * hd + 2; ++nt) {
            f32x16 dG = {};
            {
                bf16x8 ag[8];
#pragma unroll
                for (int s2 = 0; s2 < 8; ++s2) ag[s2] = *(const bf16x8*)(p.G2_T() + (size_t)(nt * 32 + tk) * 128 + 16 * s2 + 8 * hh);
                __builtin_amdgcn_sched_barrier(0);
#pragma unroll
                for (int s2 = 0; s2 < 8; ++s2) dG = MFMA32(ag[s2], Bg[s2], dG);
                __builtin_amdgcn_sched_barrier(0);
            }
            if (act) {
#pragma unroll
                for (int q4 = 0; q4 < 4; ++q4) { u32x2 og; og.x = pk2(dG[4 * q4], dG[4 * q4 + 1]); og.y = pk2(dG[4 * q4 + 2], dG[4 * q4 + 3]);
                    *(u32x2*)(p.G() + (size_t)row * 512 + nt * 32 + 8 * q4 + 4 * hh) = og; }
            }
        }
    }
}
DI void phase_prep(const Params& p, char* smem, int bid, int nblk, int gw, int ngw, int tid, int lane) {
    LAS float* pl = (LAS float*)smem;
    for (int i = tid; i < PL_N; i += 512) {
        float v;
        if (i < PL_W0) v = p.rw_mu[i]; else if (i < PL_A0) v = p.rw_w0[i - PL_W0]; else if (i < PL_KK) v = p.rw_a0[i - PL_A0];
        else if (i < PL_KA) v = p.rw_kk[i - PL_KK]; else if (i < PL_RK) v = p.rw_ka[i - PL_KA]; else v = p.rw_rk[i - PL_RK];
        pl[i] = v;
    }
    for (int u = bid; u < 512; u += nblk) prep_block(p, smem, u, tid);
    if (bid < 4 && nblk >= 8) prep_block(p, smem, 512 + bid, tid);
    else if (nblk < 8) { for (int u = 512 + bid; u < 516; u += nblk) prep_block(p, smem, u, tid); }
    {
        const int rb = (nblk >= 8) ? bid - 4 : bid, rn = (nblk >= 8) ? nblk - 4 : nblk;
        if (rb >= 0) for (int r = rb * 8 + (tid >> 6); r < MTOT; r += rn * 8) prep_qkv_row(p, r, lane);
    }
}

DI float dpp_xor1(float x) { return __builtin_amdgcn_update_dpp(0.f, x, 0xB1, 0xF, 0xF, false); }
DI float dpp_xor2(float x) { return __builtin_amdgcn_update_dpp(0.f, x, 0x4E, 0xF, 0xF, false); }
DI float dpp_hmir(float x) { return __builtin_amdgcn_update_dpp(0.f, x, 0x141, 0xF, 0xF, false); }
DI float dpp_mir(float x)  { return __builtin_amdgcn_update_dpp(0.f, x, 0x140, 0xF, 0xF, false); }
DI float row16_sum(float v) { v += dpp_xor1(v); v += dpp_xor2(v); v += dpp_hmir(v); v += dpp_mir(v); return v; }
DI float row8_sum(float v) { v += dpp_xor1(v); v += dpp_xor2(v); v += dpp_hmir(v); return v; }

constexpr int SCAN_TS = 32;
constexpr int SCAN_TILE_B = SCAN_TS * 6 * 64 * 2;
DI void scan_unit(const Params& p, char* smem, int unit, int tid) {
    const int chain = unit >> 2, rg = unit & 3, b = chain >> 3, hd = chain & 7;
    const int wave = tid >> 6, lane = tid & 63, rl = lane >> 4, cg = lane & 15;
    const int row = rg * 16 + wave * 4 + rl, d0 = cg * 4;
    const bf16_t* src = p.SCAN() + (size_t)chain * TT * 384;
    float S0 = 0.f, S1 = 0.f, S2 = 0.f, S3 = 0.f, ykeep = 0.f;
    constexpr int NTILE = (TT + SCAN_TS - 1) / SCAN_TS;
    u32x4 pre[6];
    {
#pragma unroll
        for (int i = 0; i < 6; ++i) pre[i] = *(const u32x4*)(src + (size_t)(i * 256 + tid) * 8);
#pragma unroll
        for (int i = 0; i < 6; ++i) *(u32x4*)(smem + (i * 256 + tid) * 16) = pre[i];
    }
    __syncthreads();
    for (int tile = 0; tile < NTILE; ++tile) {
        const int t0 = tile * SCAN_TS, nst = (TT - t0) < SCAN_TS ? (TT - t0) : SCAN_TS;
        const bool more = tile + 1 < NTILE;
        if (more) {
            const int t1 = t0 + SCAN_TS; const int lim = (TT - t1) * 384 / 8;
#pragma unroll
            for (int i = 0; i < 6; ++i) { const int c = i * 256 + tid; pre[i] = c < lim ? *(const u32x4*)(src + (size_t)t1 * 384 + (size_t)c * 8) : (u32x4){0u, 0u, 0u, 0u}; }
        }
        const char* buf = smem + (tile & 1) * SCAN_TILE_B;
        for (int st = 0; st < nst; ++st) {
            const char* sp = buf + st * 768;
            const u32x2 wd = *(const u32x2*)(sp + 0 * 128 + d0 * 2), wk = *(const u32x2*)(sp + 1 * 128 + d0 * 2), wa = *(const u32x2*)(sp + 3 * 128 + d0 * 2),
                        wb = *(const u32x2*)(sp + 4 * 128 + d0 * 2), wr = *(const u32x2*)(sp + 5 * 128 + d0 * 2);
            const float vv = bf2f(*(const unsigned short*)(sp + 2 * 128 + row * 2));
            float sa = S0 * bflo(wa.x) + S1 * bfhi(wa.x) + S2 * bflo(wa.y) + S3 * bfhi(wa.y);
            sa = row16_sum(sa);
            S0 = S0 * (1.f - bflo(wd.x)) + (sa * bflo(wb.x) + vv * bflo(wk.x));
            S1 = S1 * (1.f - bfhi(wd.x)) + (sa * bfhi(wb.x) + vv * bfhi(wk.x));
            S2 = S2 * (1.f - bflo(wd.y)) + (sa * bflo(wb.y) + vv * bflo(wk.y));
            S3 = S3 * (1.f - bfhi(wd.y)) + (sa * bfhi(wb.y) + vv * bfhi(wk.y));
            float y = S0 * bflo(wr.x) + S1 * bfhi(wr.x) + S2 * bflo(wr.y) + S3 * bfhi(wr.y);
            y = row16_sum(y);
            ykeep = ((st & 15) == cg) ? y : ykeep;
            if ((st & 15) == 15) p.Y()[(size_t)(b * TT + t0 + st - 15 + cg) * 512 + hd * 64 + row] = ykeep;
        }
        if (more) {
            char* nb = smem + ((tile + 1) & 1) * SCAN_TILE_B;
#pragma unroll
            for (int i = 0; i < 6; ++i) *(u32x4*)(nb + (i * 256 + tid) * 16) = pre[i];
        }
        __syncthreads();
    }
    *(f32x4*)(p.out + OUT_WP + ((size_t)chain * 64 + row) * 64 + d0) = (f32x4){S0, S1, S2, S3};
}

constexpr int SC2_TS = 32, SC2_STEP_B = 6 * 64 * 4, SC2_TILE_B = SC2_TS * SC2_STEP_B;
struct ScanOps { f32x4 w, k, a, b, r; float v; };
DI ScanOps scan_ld(const char* sp, int d0, int row) {
    ScanOps o; o.w = *(const f32x4*)(sp + 0 * 256 + d0 * 4); o.k = *(const f32x4*)(sp + 1 * 256 + d0 * 4); o.a = *(const f32x4*)(sp + 3 * 256 + d0 * 4);
    o.b = *(const f32x4*)(sp + 4 * 256 + d0 * 4); o.r = *(const f32x4*)(sp + 5 * 256 + d0 * 4); o.v = *(const float*)(sp + 2 * 256 + row * 4); return o;
}
DI void scan_unit2(const Params& p, char* smem, int unit, int tid) {
    const int chain = unit >> 2, rg = unit & 3, b = chain >> 3, hd = chain & 7;
    const int wave = tid >> 6, lane = tid & 63, rl = lane >> 4, cg = lane & 15;
    const int row = rg * 16 + (wave & 3) * 4 + rl, d0 = cg * 4;
    const bf16_t* src = p.SCAN() + (size_t)chain * TT * 384;
    f32x4 S = {0.f, 0.f, 0.f, 0.f}; float ykeep = 0.f;
    constexpr int NTILE = (TT + SC2_TS - 1) / SC2_TS;
    u32x4 pre[3];
    auto stage_load = [&](int t1) { const int lim = (TT - t1) * 48;
#pragma unroll
        for (int i = 0; i < 3; ++i) { const int c = i * 512 + tid; pre[i] = c < lim ? *(const u32x4*)(src + (size_t)t1 * 384 + (size_t)c * 8) : (u32x4){0u, 0u, 0u, 0u}; } };
    auto stage_store = [&](char* buf) {
#pragma unroll
        for (int i = 0; i < 3; ++i) { const int c = i * 512 + tid; float f[8]; unpack8(pre[i], f);
            if (((c >> 3) % 6) == 0) {
#pragma unroll
                for (int q = 0; q < 8; ++q) f[q] = 1.f - f[q]; }
            *(f32x4*)(buf + c * 32) = (f32x4){f[0], f[1], f[2], f[3]}; *(f32x4*)(buf + c * 32 + 16) = (f32x4){f[4], f[5], f[6], f[7]}; } };
    stage_load(0); stage_store(smem);
    __syncthreads();
    for (int tile = 0; tile < NTILE; ++tile) {
        const int t0 = tile * SC2_TS, nst = (TT - t0) < SC2_TS ? (TT - t0) : SC2_TS;
        const bool more = tile + 1 < NTILE;
        if (more) stage_load(t0 + SC2_TS);
        if (wave < 4) {
            const char* buf = smem + (tile & 1) * SC2_TILE_B;
            ScanOps cur = scan_ld(buf, d0, row);
#pragma unroll 2
            for (int st = 0; st < nst; ++st) {
                const ScanOps nxt = scan_ld(buf + ((st + 1 < nst) ? (st + 1) : st) * SC2_STEP_B, d0, row);
                float sa = (S.x * cur.a.x + S.y * cur.a.y) + (S.z * cur.a.z + S.w * cur.a.w);
                const f32x4 vk = cur.k * cur.v;
                sa = row16_sum(sa);
                S = S * cur.w + (cur.b * sa + vk);
                float y = (S.x * cur.r.x + S.y * cur.r.y) + (S.z * cur.r.z + S.w * cur.r.w);
                y = row16_sum(y);
                ykeep = ((st & 15) == cg) ? y : ykeep;
                if ((st & 15) == 15) p.Y()[(size_t)(b * TT + t0 + st - 15 + cg) * 512 + hd * 64 + row] = ykeep;
                cur = nxt;
            }
        }
        if (more) stage_store(smem + ((tile + 1) & 1) * SC2_TILE_B);
        __syncthreads();
    }
    if (wave < 4) *(f32x4*)(p.out + OUT_WP + ((size_t)chain * 64 + row) * 64 + d0) = S;
}

constexpr int CK_AT = 256, CK_RT = CK_AT + 17408, CK_BT = CK_RT + 17408, CK_KT = CK_BT + 17408, CK_VV = CK_KT + 17408, CK_AAB = CK_VV + 12288, CK_ARB = CK_AAB + 16384,
              CK_AAK = CK_ARB + 16384, CK_GT = CK_AAK + 9216, CK_HT = CK_GT + 9216, CK_LDS = CK_HT + 9216, CK_RAW = CK_AAB;
static_assert(CK_LDS <= 160 * 1024 - 128, "chunk LDS");
DI bf16x8 tr_frag(const char* img, int strideB, int row0, int colB) {
    return bf16x8{};
}
DI bf16x8 ld_tr8(const char* p_lo, const char* p_hi) {
    const s16x4 lo = __builtin_amdgcn_ds_read_tr16_b64_v4i16((LAS s16x4*)p_lo), hi = __builtin_amdgcn_ds_read_tr16_b64_v4i16((LAS s16x4*)p_hi);
    return __builtin_shufflevector(lo, hi, 0, 1, 2, 3, 4, 5, 6, 7);
}
DI bf16x8 pack16s(const f32x16& x, int s) {
    float f[8];
#pragma unroll
    for (int j = 0; j < 8; ++j) f[j] = x[8 * s + j];
    return pack8(f);
}
template <int I, bool ISG> DI void ck_bs4(float (&Xs)[16], const char* smem, int col, int sq, float pl, int zofs) {
    if constexpr (I + 5 < 64) asm volatile("" : "+v"(zofs) : "v"(Xs[(I + 5) & 15]));
    const char* ap = smem + CK_AAB + (I * 64 + 16 * sq) * 4 + zofs;
    const f32x4 a0 = *(const f32x4*)ap, a1 = *(const f32x4*)(ap + 16), a2 = *(const f32x4*)(ap + 32), a3 = *(const f32x4*)(ap + 48);
    float rhs = ISG ? *(const float*)(smem + CK_ARB + (I * 64 + col) * 4) : bf2f(*(const unsigned short*)(smem + CK_BT + I * 272 + col * 2)) * pl;
    float s0 = sq == 0 ? rhs : 0.f, s1 = 0.f;
    s0 += a0.x * Xs[0]; s1 += a0.y * Xs[1]; s0 += a0.z * Xs[2]; s1 += a0.w * Xs[3];
    s0 += a1.x * Xs[4]; s1 += a1.y * Xs[5]; s0 += a1.z * Xs[6]; s1 += a1.w * Xs[7];
    s0 += a2.x * Xs[8]; s1 += a2.y * Xs[9]; s0 += a2.z * Xs[10]; s1 += a2.w * Xs[11];
    s0 += a3.x * Xs[12]; s1 += a3.y * Xs[13]; s0 += a3.z * Xs[14]; s1 += a3.w * Xs[15];
    float x = s0 + s1; x += dpp_xor1(x); x += dpp_xor2(x);
    Xs[I & 15] = (sq == (I >> 4)) ? x : Xs[I & 15];
    if constexpr (I > 0) ck_bs4<I - 1, ISG>(Xs, smem, col, sq, pl, zofs);
}
DI void chunk_prefetch(const Params& p, int unit, int tid, unsigned short (&pre)[48]) {
    if (unit >= CK_UNITS) return;
    const int chain = unit / CK_N, c = unit - chain * CK_N, t0 = c * 64, lane = tid & 63, wave = tid >> 6;
    const bool ok = t0 + lane < TT;
    const bf16_t* src = p.SCAN() + scan_addr(chain, 0, 8 * wave, t0 + lane);
#pragma unroll
    for (int v = 0; v < 6; ++v)
#pragma unroll
        for (int q = 0; q < 8; ++q) pre[v * 8 + q] = ok ? src[((size_t)v * 64 + q) * TTP] : (unsigned short)0;
}
DI void chunk_pass1(const Params& p, char* smem_, int unit, int next_unit, unsigned short (&pre)[48], int tid_) {
    int tid = tid_, zb = 0; asm volatile("" : "+v"(tid), "+v"(zb)); char* smem = smem_ + zb;
    const int chain = unit / CK_N, c = unit - chain * CK_N, t0 = c * 64;
    const int wave = tid >> 6, lane = tid & 63, tk = lane & 31, hh = lane >> 5;
    const bf16_t* src = p.SCAN() + ((size_t)chain * TT + t0) * 384;
    const int nval = (TT - t0) < 64 ? (TT - t0) : 64;
    __syncthreads();
    {
        float dl[8], kv[8], vv[8], av[8], bv[8], rv[8];
#pragma unroll
        for (int q = 0; q < 8; ++q) { dl[q] = bf2f(pre[0 * 8 + q]); kv[q] = bf2f(pre[1 * 8 + q]); vv[q] = bf2f(pre[2 * 8 + q]); av[q] = bf2f(pre[3 * 8 + q]); bv[q] = bf2f(pre[4 * 8 + q]); rv[q] = bf2f(pre[5 * 8 + q]); }
        chunk_prefetch(p, next_unit, tid, pre);
        float P[8], Pm[8], inv[8], PL[8];
#pragma unroll
        for (int q = 0; q < 8; ++q) {
            float x = 1.f - dl[q];
#pragma unroll
            for (int o = 1; o < 64; o <<= 1) { const float y = __shfl_up(x, o); x = lane >= o ? x * y : x; }
            P[q] = x; const float pm = __shfl_up(x, 1); Pm[q] = lane ? pm : 1.f;
            PL[q] = __int_as_float(__builtin_amdgcn_readlane(__float_as_int(x), 63));
            inv[q] = 1.f / x;
        }
        __syncthreads();
        float o8[8];
#pragma unroll
        for (int q = 0; q < 8; ++q) o8[q] = av[q] * Pm[q];
        *(bf16x8*)(smem + CK_AT + lane * 272 + wave * 16) = pack8(o8);
#pragma unroll
        for (int q = 0; q < 8; ++q) o8[q] = rv[q] * P[q];
        *(bf16x8*)(smem + CK_RT + lane * 272 + wave * 16) = pack8(o8);
#pragma unroll
        for (int q = 0; q < 8; ++q) o8[q] = bv[q] * inv[q];
        *(bf16x8*)(smem + CK_BT + lane * 272 + wave * 16) = pack8(o8);
#pragma unroll
        for (int q = 0; q < 8; ++q) o8[q] = kv[q] * inv[q];
        *(bf16x8*)(smem + CK_KT + lane * 272 + wave * 16) = pack8(o8);
        *(bf16x8*)(smem + CK_VV + lane * 192 + wave * 16) = pack8(vv);
        if (lane == 63) { *(f32x4*)(smem + wave * 32) = (f32x4){PL[0], PL[1], PL[2], PL[3]}; *(f32x4*)(smem + wave * 32 + 16) = (f32x4){PL[4], PL[5], PL[6], PL[7]};
            float* plo = p.PLV() + (size_t)unit * 64 + wave * 8;
            *(f32x4*)plo = (f32x4){PL[0], PL[1], PL[2], PL[3]}; *(f32x4*)(plo + 4) = (f32x4){PL[4], PL[5], PL[6], PL[7]}; }
    }
    __syncthreads();
    const float* PLs = (const float*)smem;
    {
        const int prod = wave >> 1, half = wave & 1;
        const char* imgA = smem + ((prod == 0 || prod == 1) ? ((prod == 0) ? CK_BT : CK_BT) : CK_KT);
        const char* imgB = smem + ((prod == 0 || prod == 2) ? CK_AT : CK_RT);
        f32x16 acc[2] = {};
        if (prod < 3) {
#pragma unroll
            for (int nt = 0; nt < 2; ++nt)
#pragma unroll
                for (int s2 = 0; s2 < 4; ++s2) { const bf16x8 af = *(const bf16x8*)(imgA + (32 * half + tk) * 272 + (16 * s2 + 8 * hh) * 2), bf = *(const bf16x8*)(imgB + (32 * nt + tk) * 272 + (16 * s2 + 8 * hh) * 2);
                    acc[nt] = MFMA32(af, bf, acc[nt]); }
#pragma unroll
            for (int nt = 0; nt < 2; ++nt)
#pragma unroll
                for (int r2 = 0; r2 < 16; ++r2) { const int i = 32 * half + (r2 & 3) + 8 * (r2 >> 2) + 4 * hh, t = 32 * nt + tk;
                    const bool keep = (prod == 1) ? (i <= t) : (i < t);
                    const float v = keep ? acc[nt][r2] : 0.f;
                    if (prod == 0) *(float*)(smem + CK_AAB + (i * 64 + t) * 4) = v;
                    else if (prod == 1) *(float*)(smem + CK_ARB + (i * 64 + t) * 4) = v;
                    else *(unsigned short*)(smem + CK_AAK + i * 144 + t * 2) = bf16_1_(v); }
        }
    }
    __syncthreads();
    {
        int tz3 = tid; asm volatile("" : "+v"(tz3)); const int wave3 = __builtin_amdgcn_readfirstlane(tz3 >> 6), lane3 = tz3 & 63;
        const int col = 16 * (wave3 & 3) + (lane3 >> 2), sq = lane3 & 3;
        int zo = 0; asm volatile("" : "+v"(zo));
        float Xs[16];
#pragma unroll
        for (int j = 0; j < 16; ++j) Xs[j] = 0.f;
        if (wave3 < 4) ck_bs4<63, true>(Xs, smem, col, sq, 1.f, zo); else ck_bs4<63, false>(Xs, smem, col, sq, PLs[col], zo);
        char* dst = smem + (wave3 < 4 ? CK_GT : CK_HT) + col * 144 + sq * 32;
        float f0[8], f1[8];
#pragma unroll
        for (int j = 0; j < 8; ++j) { f0[j] = Xs[j]; f1[j] = Xs[8 + j]; }
        *(bf16x8*)dst = pack8(f0); *(bf16x8*)(dst + 16) = pack8(f1);
    }
    __syncthreads();
    {
        int tz4 = tid; asm volatile("" : "+v"(tz4)); const int wave = __builtin_amdgcn_readfirstlane(tz4 >> 6), lane = tz4 & 63, tk = lane & 31, hh = lane >> 5;
        const int half = wave & 1;
        const int i16 = lane & 15, qq = i16 >> 2, pp = i16 & 3, blk = (lane >> 4) & 1;
        if (wave < 4) {
            const char* imgB = smem + (wave < 2 ? CK_GT : CK_HT);
            f32x16 acc[2] = {};
#pragma unroll
            for (int nt = 0; nt < 2; ++nt)
#pragma unroll
                for (int s2 = 0; s2 < 4; ++s2) {
                    const char* pa = smem + CK_AT + (16 * s2 + 8 * hh + qq) * 272 + (32 * half + 16 * blk + 4 * pp) * 2;
                    const bf16x8 af = ld_tr8(pa, pa + 4 * 272);
                    const bf16x8 bf = *(const bf16x8*)(imgB + (32 * nt + tk) * 144 + (16 * s2 + 8 * hh) * 2);
                    acc[nt] = MFMA32(af, bf, acc[nt]); }
            bf16_t* dst = (wave < 2 ? p.MYT() : p.MST()) + (size_t)unit * 4096;
#pragma unroll
            for (int nt = 0; nt < 2; ++nt)
#pragma unroll
                for (int q4 = 0; q4 < 4; ++q4) { const int col = 32 * nt + tk, k0 = 32 * half + 8 * q4 + 4 * hh;
                    float v0 = acc[nt][4 * q4], v1 = acc[nt][4 * q4 + 1], v2 = acc[nt][4 * q4 + 2], v3 = acc[nt][4 * q4 + 3];
                    if (wave < 2) { const u32x2 rw = *(const u32x2*)(smem + CK_RT + col * 272 + k0 * 2); v0 += bflo(rw.x); v1 += bfhi(rw.x); v2 += bflo(rw.y); v3 += bfhi(rw.y); }
                    u32x2 o; o.x = pk2(v0, v1); o.y = pk2(v2, v3);
                    *(u32x2*)(dst + (size_t)col * 64 + k0) = o; }
        } else {
            const bool isy = wave >= 6;
            const char* imgB = smem + (isy ? CK_GT : CK_HT);
            f32x16 nn[2] = {};
#pragma unroll
            for (int mt = 0; mt < 2; ++mt)
#pragma unroll
                for (int s2 = 0; s2 < 4; ++s2) { const bf16x8 af = *(const bf16x8*)(smem + CK_AAK + (32 * mt + tk) * 144 + (16 * s2 + 8 * hh) * 2), bf = *(const bf16x8*)(imgB + (32 * half + tk) * 144 + (16 * s2 + 8 * hh) * 2);
                    nn[mt] = MFMA32(af, bf, nn[mt]); }
            if (isy) {
#pragma unroll
                for (int mt = 0; mt < 2; ++mt) {
                    f32x16 ark = {};
#pragma unroll
                    for (int s2 = 0; s2 < 4; ++s2) { const bf16x8 af = *(const bf16x8*)(smem + CK_KT + (32 * mt + tk) * 272 + (16 * s2 + 8 * hh) * 2), bf = *(const bf16x8*)(smem + CK_RT + (32 * half + tk) * 272 + (16 * s2 + 8 * hh) * 2);
                        ark = MFMA32(af, bf, ark); }
#pragma unroll
                    for (int r2 = 0; r2 < 16; ++r2) { const int i = 32 * mt + (r2 & 3) + 8 * (r2 >> 2) + 4 * hh, t = 32 * half + tk; nn[mt][r2] += (i <= t) ? ark[r2] : 0.f; }
                }
            }
            else { const float pl = PLs[32 * half + tk];
#pragma unroll
                for (int mt = 0; mt < 2; ++mt)
#pragma unroll
                    for (int r2 = 0; r2 < 16; ++r2) { const int i = 32 * mt + (r2 & 3) + 8 * (r2 >> 2) + 4 * hh; nn[mt][r2] += bf2f(*(const unsigned short*)(smem + CK_KT + i * 272 + (32 * half + tk) * 2)) * pl; } }
            float* dst = (isy ? p.WYT() : p.WST()) + (size_t)unit * 4096 + (size_t)half * 2048;
#pragma unroll
            for (int vt = 0; vt < 2; ++vt) {
                f32x16 wacc = {};
#pragma unroll
                for (int mt = 0; mt < 2; ++mt)
#pragma unroll
                    for (int s2 = 0; s2 < 2; ++s2) {
                        const bf16x8 af = pack16s(nn[mt], s2);
                        const char* pb = smem + CK_VV + (32 * mt + 16 * s2 + 4 * hh + qq) * 192 + (32 * vt + 16 * blk + 4 * pp) * 2;
                        const bf16x8 bf = ld_tr8(pb, pb + 8 * 192);
                        wacc = MFMA32(af, bf, wacc); }
#pragma unroll
                for (int r2 = 0; r2 < 16; ++r2) dst[(vt * 16 + r2) * 64 + lane] = wacc[r2];
            }
        }
    }
}
struct P2Ops { u32x2 a[2][2][2][2]; f32x4 pl[2][4]; float ws[2][16]; };
DI void p2_load(const Params& p, size_t u, int vh, int tk, int hh, int lane, P2Ops& o) {
    const bf16_t* ms = p.MST() + u * 4096; const float* plv = p.PLV() + u * 64; const float* ws = p.WST() + u * 4096;
#pragma unroll
    for (int mt = 0; mt < 2; ++mt) {
#pragma unroll
        for (int kt = 0; kt < 2; ++kt)
#pragma unroll
            for (int s2 = 0; s2 < 2; ++s2) { const bf16_t* ap = ms + (size_t)(32 * mt + tk) * 64 + 32 * kt + 16 * s2 + 4 * hh; o.a[mt][kt][s2][0] = *(const u32x2*)ap; o.a[mt][kt][s2][1] = *(const u32x2*)(ap + 8); }
#pragma unroll
        for (int q4 = 0; q4 < 4; ++q4) o.pl[mt][q4] = *(const f32x4*)(plv + 32 * mt + 8 * q4 + 4 * hh);
#pragma unroll
        for (int r2 = 0; r2 < 16; ++r2) o.ws[mt][r2] = ws[((size_t)mt * 2 + vh) * 1024 + r2 * 64 + lane];
    }
}
DI void chunk_pass2(const Params& p, int wunit, int lane, volatile LAS int* prog) {
    const int chain = wunit >> 1, vh = wunit & 1, tk = lane & 31, hh = lane >> 5;
    f32x16 st[2] = {};
    P2Ops cur; p2_load(p, (size_t)chain * CK_N, vh, tk, hh, lane, cur);
#pragma unroll 1
    for (int c = 0; c < CK_N; ++c) {
        const size_t u = (size_t)chain * CK_N + c;
        P2Ops nxt; p2_load(p, c + 1 < CK_N ? u + 1 : u, vh, tk, hh, lane, nxt);
        bf16x8 fh[2][2], fl[2][2];
#pragma unroll
        for (int kt = 0; kt < 2; ++kt)
#pragma unroll
            for (int s2 = 0; s2 < 2; ++s2) { float h8[8], l8[8];
#pragma unroll
                for (int j = 0; j < 8; ++j) { const float x = st[kt][8 * s2 + j]; const float xh = bflo(pk2(x, 0.f)); h8[j] = xh; l8[j] = x - xh; }
                fh[kt][s2] = pack8(h8); fl[kt][s2] = pack8(l8);
                u32x4* sc = (u32x4*)p.SCF() + ((((u * 2 + vh) * 2 + kt) * 2 + s2) * 2) * 64 + lane;
                sc[0] = __builtin_bit_cast(u32x4, fh[kt][s2]); sc[64] = __builtin_bit_cast(u32x4, fl[kt][s2]); }
        f32x16 nt[2];
#pragma unroll
        for (int mt = 0; mt < 2; ++mt) {
            f32x16 acc;
#pragma unroll
            for (int q4 = 0; q4 < 4; ++q4) { const f32x4 pl = cur.pl[mt][q4];
                acc[4 * q4] = cur.ws[mt][4 * q4] + st[mt][4 * q4] * pl.x; acc[4 * q4 + 1] = cur.ws[mt][4 * q4 + 1] + st[mt][4 * q4 + 1] * pl.y;
                acc[4 * q4 + 2] = cur.ws[mt][4 * q4 + 2] + st[mt][4 * q4 + 2] * pl.z; acc[4 * q4 + 3] = cur.ws[mt][4 * q4 + 3] + st[mt][4 * q4 + 3] * pl.w; }
#pragma unroll
            for (int kt = 0; kt < 2; ++kt)
#pragma unroll
                for (int s2 = 0; s2 < 2; ++s2) {
                    const u32x2 a0 = cur.a[mt][kt][s2][0], a1 = cur.a[mt][kt][s2][1];
                    const bf16x8 af = __builtin_bit_cast(bf16x8, (u32x4){a0.x, a0.y, a1.x, a1.y});
                    acc = MFMA32(af, fh[kt][s2], acc); acc = MFMA32(af, fl[kt][s2], acc); }
            nt[mt] = acc;
        }
        st[0] = nt[0]; st[1] = nt[1];
        cur = nxt;
        if (lane == 0) *prog = c + 1;
    }
    float* so = p.out + OUT_WP + ((size_t)chain * 64 + 32 * vh + tk) * 64;
#pragma unroll
    for (int kt = 0; kt < 2; ++kt)
#pragma unroll
        for (int q4 = 0; q4 < 4; ++q4) *(f32x4*)(so + 32 * kt + 8 * q4 + 4 * hh) = (f32x4){st[kt][4 * q4], st[kt][4 * q4 + 1], st[kt][4 * q4 + 2], st[kt][4 * q4 + 3]};
}
DI void chunk_pass2_prefetch(const Params& p, int wunit, int lane, volatile LAS int* prog) {
    const int chain = wunit >> 1, vh = wunit & 1;
    unsigned sink = 0;
    for (int c = 1; c < CK_N; ++c) {
        for (int spin = 0; spin < 200000 && *prog + 8 < c; ++spin) __builtin_amdgcn_s_sleep(4);
        const size_t u = (size_t)chain * CK_N + c;
        const char* l0 = (const char*)(p.MST() + u * 4096) + lane * 128;
        const char* l1 = (const char*)(p.WST() + u * 4096) + (size_t)(((lane >> 5) * 2 + vh) * 4096) + (lane & 31) * 128;
        sink += *(const volatile unsigned*)l0 + *(const volatile unsigned*)l1;
        if (lane < 2) sink += *(const volatile unsigned*)((const char*)(p.PLV() + u * 64) + lane * 128);
    }
    asm volatile("" :: "v"(sink));
}
DI float half32_sum(float v) {
    v += dpp_xor1(v); v += dpp_xor2(v); v += dpp_hmir(v); v += dpp_mir(v); v += __shfl_xor(v, 16); return v;
}
DI void chunk_pass3(const Params& p, int hunit, int lane) {
    const int unit = hunit >> 1, tt = hunit & 1;
    const int chain = unit / CK_N, c = unit - chain * CK_N, b = chain >> 3, hd = chain & 7, tk = lane & 31, hh = lane >> 5;
    const bf16_t* my = p.MYT() + (size_t)unit * 4096;
    const u32x4* sc = (const u32x4*)p.SCF() + (size_t)unit * 16 * 64 + lane;
    const float* wy = p.WYT() + (size_t)unit * 4096;
    bf16x8 Bf[2][2][2][2];
#pragma unroll
    for (int vt = 0; vt < 2; ++vt)
#pragma unroll
        for (int kt = 0; kt < 2; ++kt)
#pragma unroll
            for (int s2 = 0; s2 < 2; ++s2)
#pragma unroll
                for (int x = 0; x < 2; ++x) Bf[vt][kt][s2][x] = __builtin_bit_cast(bf16x8, sc[((((vt * 2 + kt) * 2 + s2) * 2) + x) * 64]);
    {
        f32x16 acc[2];
#pragma unroll
        for (int vt = 0; vt < 2; ++vt) {
#pragma unroll
            for (int r2 = 0; r2 < 16; ++r2) acc[vt][r2] = wy[((size_t)tt * 2 + vt) * 1024 + r2 * 64 + lane];
#pragma unroll
            for (int kt = 0; kt < 2; ++kt)
#pragma unroll
                for (int s2 = 0; s2 < 2; ++s2) {
                    const bf16_t* ap = my + (size_t)(32 * tt + tk) * 64 + 32 * kt + 16 * s2 + 4 * hh;
                    const u32x2 a0 = *(const u32x2*)ap, a1 = *(const u32x2*)(ap + 8);
                    const bf16x8 af = __builtin_bit_cast(bf16x8, (u32x4){a0.x, a0.y, a1.x, a1.y});
                    acc[vt] = MFMA32(af, Bf[vt][kt][s2][0], acc[vt]); acc[vt] = MFMA32(af, Bf[vt][kt][s2][1], acc[vt]); }
        }
        const float lg0 = p.rw_ln_g[hd * 64 + tk], lg1 = p.rw_ln_g[hd * 64 + 32 + tk], lb0 = p.rw_ln_b[hd * 64 + tk], lb1 = p.rw_ln_b[hd * 64 + 32 + tk];
#pragma unroll
        for (int r2 = 0; r2 < 16; ++r2) {
            const int t = c * 64 + 32 * tt + (r2 & 3) + 8 * (r2 >> 2) + 4 * hh;
            const float mu = half32_sum(acc[0][r2] + acc[1][r2]) * (1.f / 64.f);
            const float d0 = acc[0][r2] - mu, d1 = acc[1][r2] - mu;
            const float rs = rsqrtf(half32_sum(d0 * d0 + d1 * d1) * (1.f / 64.f) + 64e-5f);
            if (t < TT) {
                const size_t row = (size_t)b * TT + t;
                const bf16_t* vp = p.SCAN() + scan_addr(chain, 2, 0, t);
                const float bon = p.BONUS()[row * 8 + hd];
                const float o0 = (d0 * rs * lg0 + lb0 + bon * bf2f(vp[(size_t)tk * TTP])) * bf2f(p.G()[row * 512 + hd * 64 + tk]);
                const float o1 = (d1 * rs * lg1 + lb1 + bon * bf2f(vp[(size_t)(32 + tk) * TTP])) * bf2f(p.G()[row * 512 + hd * 64 + 32 + tk]);
                p.YO()[row * DM + hd * 64 + tk] = bf16_1_(o0); p.YO()[row * DM + hd * 64 + 32 + tk] = bf16_1_(o1);
            }
        }
    }
}

DI void rwkv_sample_unit(const Params& p, int unit, int tid) {
    const int s = unit >> 3, hd = unit & 7, row = tid >> 2, c0 = (tid & 3) * 16;
    const float* S0 = p.state_wkv + (((size_t)s * 8 + hd) * 64 + row) * 64 + c0;
    const float* in = p.SCAN_S() + ((size_t)s * 8 + hd) * 384;
    float S[16]; float sa = 0.f;
#pragma unroll
    for (int i = 0; i < 16; i += 4) { const f32x4 v = *(const f32x4*)(S0 + i); S[i] = v.x; S[i + 1] = v.y; S[i + 2] = v.z; S[i + 3] = v.w; }
#pragma unroll
    for (int i = 0; i < 16; ++i) sa += S[i] * in[3 * 64 + c0 + i];
    sa += dpp_xor1(sa); sa += dpp_xor2(sa);
    const float vv = in[2 * 64 + row];
    float y = 0.f;
#pragma unroll
    for (int i = 0; i < 16; ++i) { S[i] = S[i] * in[0 * 64 + c0 + i] + sa * in[4 * 64 + c0 + i] + vv * in[1 * 64 + c0 + i]; y += S[i] * in[5 * 64 + c0 + i]; }
    y += dpp_xor1(y); y += dpp_xor2(y);
    float* So = p.out + OUT_WS + (((size_t)s * 8 + hd) * 64 + row) * 64 + c0;
#pragma unroll
    for (int i = 0; i < 16; i += 4) *(f32x4*)(So + i) = (f32x4){S[i], S[i + 1], S[i + 2], S[i + 3]};
    if ((tid & 3) == 0) p.Y()[(size_t)(MPR + s) * 512 + hd * 64 + row] = y;
}

DI void rwkv_post_row(const Params& p, int row, int lane) {
    const int n0 = lane * 8, hd = lane >> 3;
    const f32x4 ya = *(const f32x4*)(p.Y() + (size_t)row * 512 + n0), yb = *(const f32x4*)(p.Y() + (size_t)row * 512 + n0 + 4);
    float y[8] = {ya.x, ya.y, ya.z, ya.w, yb.x, yb.y, yb.z, yb.w};
    float s = 0.f;
#pragma unroll
    for (int i = 0; i < 8; ++i) s += y[i];
    const float mu = row8_sum(s) * (1.f / 64.f);
    float q = 0.f;
#pragma unroll
    for (int i = 0; i < 8; ++i) { y[i] -= mu; q += y[i] * y[i]; }
    const float rs = rsqrtf(row8_sum(q) * (1.f / 64.f) + 64e-5f);
    float v[8];
    if (row < MPR) { const int b = row / TT, t = row - b * TT; unpack8(*(const u32x4*)(p.SCAN() + (((size_t)(b * 8 + hd) * TT + t) * 6 + 2) * 64 + (n0 & 63)), v); }
    else { const float* vs = p.SCAN_S() + (((size_t)(row - MPR) * 8 + hd) * 6 + 2) * 64 + (n0 & 63);
#pragma unroll
        for (int i = 0; i < 8; ++i) v[i] = vs[i]; }
    float g[8]; unpack8(*(const u32x4*)(p.G() + (size_t)row * 512 + n0), g);
    const float bon = p.BONUS()[(size_t)row * 8 + hd];
    float o[8];
#pragma unroll
    for (int i = 0; i < 8; ++i) o[i] = (y[i] * rs * p.rw_ln_g[n0 + i] + p.rw_ln_b[n0 + i] + bon * v[i]) * g[i];
    *(u32x4*)(p.YO() + (size_t)row * DM + n0) = __builtin_bit_cast(u32x4, pack8(o));
}

DI float compute_lam(const Params& p, int lane) {
    const float a = p.da_lam[lane] * p.da_lam[64 + lane], b = p.da_lam[128 + lane] * p.da_lam[192 + lane];
    return __expf(wave_sum(a)) - __expf(wave_sum(b)) + LAM_INIT;
}
constexpr int AT_KROW = 272, AT_VROW = 320, AT_BUF = 64 * AT_KROW + 64 * AT_VROW  , AT_V_OFF = 64 * AT_KROW, AT_X_OFF = 0, AT_LDS = 2 * AT_BUF;
DI void attn_unit(const Params& p, char* smem, int b, int h, int qb, float lam, int dmax, int tid) {
    const int wave = tid >> 6, lane = tid & 63, qs = wave >> 1, c = wave & 1, tk = lane & 31, hh = lane >> 5;
    const int qrow0 = qb * 128 + qs * 32, t = qrow0 + tk, tq = t < TT ? t : TT - 1;
    const size_t rb = (size_t)b * TT;
    const float c1 = 0.125f * LOG2E, slope2 = exp2f(-2.f * (h + 1)) * LOG2E;
    const int tref = qb * 128;
    bf16x8 Qf[4];
#pragma unroll
    for (int s = 0; s < 4; ++s) Qf[s] = *(const bf16x8*)(p.QN() + (rb + tq) * 512 + h * 128 + c * 64 + 16 * s + 8 * hh);
    f32x16 O[4] = {};
    float m = -1e30f, l = 0.f;
    const int kmax = (qb * 128 + 127 < TT - 1) ? qb * 128 + 127 : TT - 1;
    const int ntile = kmax / 64 + 1;
    int kts = (qb * 128 - dmax) / 64; kts = kts < 0 ? 0 : kts;
    const bool wave_live = qrow0 < TT;
    u32x4 rkA[2], rvA[2], rkB[2], rvB[2];
    auto g_load = [&](int kt0, u32x4 (&rk)[2], u32x4 (&rv)[2]) {
#pragma unroll
        for (int i = 0; i < 2; ++i) { const int ch = tid + 512 * i, key = ch >> 4, part = ch & 15; int kr = kt0 + key; kr = kr < TT ? kr : TT - 1;
            rk[i] = *(const u32x4*)(p.KN() + (rb + kr) * 512 + h * 128 + part * 8);
            rv[i] = *(const u32x4*)(p.PROJ() + (rb + kr) * INW + O_V + h * 128 + part * 8); } };
    auto l_store = [&](char* buf, const u32x4 (&rk)[2], const u32x4 (&rv)[2]) {
#pragma unroll
        for (int i = 0; i < 2; ++i) { const int ch = tid + 512 * i, key = ch >> 4, part = ch & 15;
            *(u32x4*)(buf + key * AT_KROW + part * 16) = rk[i]; *(u32x4*)(buf + AT_V_OFF + key * AT_VROW + part * 16) = rv[i]; } };
    auto tile_compute = [&](int kt0, const char* buf) {
        if (wave_live && kt0 <= qrow0 + 31) {
            f32x16 St[2] = {};
#pragma unroll
            for (int sub = 0; sub < 2; ++sub)
#pragma unroll
                for (int s = 0; s < 4; ++s) { const bf16x8 kf = *(const bf16x8*)(buf + (sub * 32 + tk) * AT_KROW + (c * 64 + 16 * s + 8 * hh) * 2); St[sub] = MFMA32(kf, Qf[s], St[sub]); }
            const bool diag = kt0 + 63 > qrow0;
            const float bias0 = slope2 * (float)(kt0 + 4 * hh - tref);
#pragma unroll
            for (int sub = 0; sub < 2; ++sub)
#pragma unroll
                for (int i = 0; i < 16; ++i) St[sub][i] = fmaf(St[sub][i], c1, fmaf(slope2, (float)(sub * 32 + (i & 3) + 8 * (i >> 2)), bias0));
            if (diag) {
#pragma unroll
                for (int sub = 0; sub < 2; ++sub)
#pragma unroll
                    for (int i = 0; i < 16; ++i) { const int key = kt0 + sub * 32 + (i & 3) + 8 * (i >> 2) + 4 * hh; if (key > t) St[sub][i] = -INFINITY; }
            }
            float mx = -1e30f;
#pragma unroll
            for (int sub = 0; sub < 2; ++sub)
#pragma unroll
                for (int i = 0; i < 16; ++i) mx = fmaxf(mx, St[sub][i]);
            mx = fmaxf(mx, __shfl_xor(mx, 32));
            const float mn = fmaxf(m, mx), alpha = __builtin_amdgcn_exp2f(m - mn);
            m = mn; l *= alpha;
#pragma unroll
            for (int dt = 0; dt < 4; ++dt)
#pragma unroll
                for (int i = 0; i < 16; ++i) O[dt][i] *= alpha;
#pragma unroll
            for (int sub = 0; sub < 2; ++sub)
#pragma unroll
                for (int i = 0; i < 16; ++i) { const float pv = __builtin_amdgcn_exp2f(St[sub][i] - mn); St[sub][i] = pv; l += pv; }
            const int i16 = lane & 15, qq = i16 >> 2, pp = i16 & 3, blk = (lane >> 4) & 1;
#pragma unroll
            for (int sub = 0; sub < 2; ++sub)
#pragma unroll
                for (int s2 = 0; s2 < 2; ++s2) {
                    float pf8[8];
#pragma unroll
                    for (int j = 0; j < 8; ++j) pf8[j] = St[sub][8 * s2 + j];
                    const bf16x8 Pf = pack8(pf8);
                    const int keyb = sub * 32 + 16 * s2 + 4 * hh + qq;
#pragma unroll
                    for (int dt = 0; dt < 4; ++dt) {
                        const int colb = (dt * 32 + 16 * blk + 4 * pp) * 2;
                        const s16x4 lo = __builtin_amdgcn_ds_read_tr16_b64_v4i16((LAS s16x4*)(buf + AT_V_OFF + keyb * AT_VROW + colb));
                        const s16x4 hi = __builtin_amdgcn_ds_read_tr16_b64_v4i16((LAS s16x4*)(buf + AT_V_OFF + (keyb + 8) * AT_VROW + colb));
                        const bf16x8 Vf = __builtin_shufflevector(lo, hi, 0, 1, 2, 3, 4, 5, 6, 7);
                        O[dt] = MFMA32(Vf, Pf, O[dt]);
                    }
                }
        }
    };
    __syncthreads();
    g_load(kts * 64, rkA, rvA); l_store(smem, rkA, rvA);
    if (kts + 1 < ntile) g_load(kts * 64 + 64, rkA, rvA);
    __syncthreads();
    for (int kt = kts; kt < ntile; kt += 2) {
        if (kt + 2 < ntile) g_load(kt * 64 + 128, rkB, rvB);
        tile_compute(kt * 64, smem);
        if (kt + 1 < ntile) l_store(smem + AT_BUF, rkA, rvA);
        __syncthreads();
        if (kt + 1 < ntile) {
            if (kt + 3 < ntile) g_load(kt * 64 + 192, rkA, rvA);
            tile_compute(kt * 64 + 64, smem + AT_BUF);
            if (kt + 2 < ntile) l_store(smem, rkB, rvB);
        }
        __syncthreads();
    }
    l += __shfl_xor(l, 32);
    const float linv = 1.f / l;
    float* xch = (float*)(smem + AT_X_OFF) + qs * (128 * 32);
    if (c == 1) {
#pragma unroll
        for (int dt = 0; dt < 4; ++dt)
#pragma unroll
            for (int i = 0; i < 16; ++i) { const int dv = dt * 32 + (i & 3) + 8 * (i >> 2) + 4 * hh; xch[dv * 32 + tk] = O[dt][i] * linv; }
    }
    __syncthreads();
    if (c == 0) {
        float ss = 0.f;
#pragma unroll
        for (int dt = 0; dt < 4; ++dt)
#pragma unroll
            for (int i = 0; i < 16; ++i) { const int dv = dt * 32 + (i & 3) + 8 * (i >> 2) + 4 * hh; const float o = O[dt][i] * linv - lam * xch[dv * 32 + tk]; O[dt][i] = o; ss += o * o; }
        ss += __shfl_xor(ss, 32);
        const float rs = rsqrtf(ss * (1.f / 128.f) + 1e-6f) * (1.f - LAM_INIT);
        if (t < TT) {
#pragma unroll
            for (int dt = 0; dt < 4; ++dt)
#pragma unroll
                for (int q4 = 0; q4 < 4; ++q4) { const int dv = dt * 32 + 8 * q4 + 4 * hh; const f32x4 g = *(const f32x4*)(p.da_subln_g + dv);
                    u32x2 o; o.x = pk2(O[dt][4 * q4] * rs * g.x, O[dt][4 * q4 + 1] * rs * g.y); o.y = pk2(O[dt][4 * q4 + 2] * rs * g.z, O[dt][4 * q4 + 3] * rs * g.w);
                    *(u32x2*)(p.YO() + (rb + t) * DM + 512 + h * 128 + dv) = o; }
        }
    }
}
DI int alibi_dmax(const Params& p, int h, int lane) {
    float gq = fabsf(p.da_qn_g[lane]), gk = fabsf(p.da_kn_g[lane]);
#pragma unroll
    for (int o = 1; o < 64; o <<= 1) { gq = fmaxf(gq, __shfl_xor(gq, o)); gk = fmaxf(gk, __shfl_xor(gk, o)); }
    const float B = 8.f * gq * gk * LOG2E, slope2 = exp2f(-2.f * (h + 1)) * LOG2E;
    const float d = (2.f * B + 40.f) / slope2;
    return d > 1.0e6f ? 1000000 : (int)d + 1;
}
constexpr int AT_NQB = 33, AT_UNITS = NB * 4 * AT_NQB;

DI void sattn_unit(const Params& p, int unit, int lane) {
    const int split = unit & 15, bh = unit >> 4, b = bh >> 2, h = bh & 3;
    const int ps = lane >> 3, sub = lane & 7;
    const float c1 = 0.125f * LOG2E, slope2 = exp2f(-2.f * (h + 1)) * LOG2E;
    f32x4 q[4];
    {
        const bf16_t* qr = p.QN() + (size_t)(MPR + b) * 512 + h * 128;
#pragma unroll
        for (int i = 0; i < 4; ++i) { const u32x2 w = *(const u32x2*)(qr + i * 32 + sub * 4); q[i] = (f32x4){bflo(w.x) * c1, bfhi(w.x) * c1, bflo(w.y) * c1, bfhi(w.y) * c1}; }
    }
    float m0 = -1e30f, m1 = -1e30f, l0 = 0.f, l1 = 0.f;
    f32x4 O0[4], O1[4];
#pragma unroll
    for (int i = 0; i < 4; ++i) { O0[i] = (f32x4){0.f, 0.f, 0.f, 0.f}; O1[i] = (f32x4){0.f, 0.f, 0.f, 0.f}; }
    struct RowSet { f32x4 k[4], v[4]; };
    auto ld = [&](int it, RowSet& r) {
        const int pos = split * 512 + it * 8 + ps;
        const int phys = p.page_table[b * NPAGES + (pos >> 7)];
        const size_t ro = (((size_t)phys * PAGE + (pos & 127)) * 4 + h) * 128 + sub * 4;
#pragma unroll
        for (int i = 0; i < 4; ++i) r.k[i] = __builtin_nontemporal_load((const f32x4*)(p.cache_k + ro + i * 32));
#pragma unroll
        for (int i = 0; i < 4; ++i) r.v[i] = __builtin_nontemporal_load((const f32x4*)(p.cache_v + ro + i * 32));
    };
    auto step = [&](int it, const RowSet& r) {
        const int pos = split * 512 + it * 8 + ps;
        float s0 = r.k[0].x * q[0].x + r.k[0].y * q[0].y + r.k[0].z * q[0].z + r.k[0].w * q[0].w + r.k[1].x * q[1].x + r.k[1].y * q[1].y + r.k[1].z * q[1].z + r.k[1].w * q[1].w;
        float s1 = r.k[2].x * q[2].x + r.k[2].y * q[2].y + r.k[2].z * q[2].z + r.k[2].w * q[2].w + r.k[3].x * q[3].x + r.k[3].y * q[3].y + r.k[3].z * q[3].z + r.k[3].w * q[3].w;
        s0 += dpp_xor1(s0); s0 += dpp_xor2(s0); s0 += dpp_hmir(s0);
        s1 += dpp_xor1(s1); s1 += dpp_xor2(s1); s1 += dpp_hmir(s1);
        const float bias = slope2 * (float)(PAST - pos);
        s0 -= bias; s1 -= bias;
        const float n0 = fmaxf(m0, s0), a0 = __builtin_amdgcn_exp2f(m0 - n0), e0 = __builtin_amdgcn_exp2f(s0 - n0);
        const float n1 = fmaxf(m1, s1), a1 = __builtin_amdgcn_exp2f(m1 - n1), e1 = __builtin_amdgcn_exp2f(s1 - n1);
        m0 = n0; m1 = n1; l0 = l0 * a0 + e0; l1 = l1 * a1 + e1;
#pragma unroll
        for (int i = 0; i < 4; ++i) { O0[i] = O0[i] * a0 + r.v[i] * e0; O1[i] = O1[i] * a1 + r.v[i] * e1; }
    };
    RowSet A, B, C;
    ld(0, A); ld(1, B);
#pragma unroll 1
    for (int it = 0; it < 63; it += 3) {
        ld(it + 2, C); step(it, A);
        ld(it + 3, A); step(it + 1, B);
        if (it + 4 < 64) ld(it + 4, B);
        step(it + 2, C);
    }
    step(63, A);
    float ma0 = m0, ma1 = m1;
#pragma unroll
    for (int o = 8; o < 64; o <<= 1) { ma0 = fmaxf(ma0, __shfl_xor(ma0, o)); ma1 = fmaxf(ma1, __shfl_xor(ma1, o)); }
    const float sc0 = __builtin_amdgcn_exp2f(m0 - ma0), sc1 = __builtin_amdgcn_exp2f(m1 - ma1);
    l0 *= sc0; l1 *= sc1;
#pragma unroll
    for (int o = 8; o < 64; o <<= 1) { l0 += __shfl_xor(l0, o); l1 += __shfl_xor(l1, o); }
#pragma unroll
    for (int i = 0; i < 4; ++i)
#pragma unroll
        for (int e = 0; e < 4; ++e) { float x0 = O0[i][e] * sc0, x1 = O1[i][e] * sc1;
#pragma unroll
            for (int o = 8; o < 64; o <<= 1) { x0 += __shfl_xor(x0, o); x1 += __shfl_xor(x1, o); }
            O0[i][e] = x0; O1[i][e] = x1; }
    if (ps == 0) {
        float* d0 = p.PART() + ((size_t)unit * 2 + 0) * 130; float* d1 = d0 + 130;
        if (sub == 0) { d0[0] = ma0; d0[1] = l0; d1[0] = ma1; d1[1] = l1; }
#pragma unroll
        for (int i = 0; i < 4; ++i) { *(f32x2*)(d0 + 2 + i * 32 + sub * 4) = (f32x2){O0[i].x, O0[i].y}; *(f32x2*)(d0 + 2 + i * 32 + sub * 4 + 2) = (f32x2){O0[i].z, O0[i].w};
            *(f32x2*)(d1 + 2 + i * 32 + sub * 4) = (f32x2){O1[i].x, O1[i].y}; *(f32x2*)(d1 + 2 + i * 32 + sub * 4 + 2) = (f32x2){O1[i].z, O1[i].w}; }
    }
}
DI void sattn_combine(const Params& p, int bh, float lam, int lane) {
    const int b = bh >> 2, h = bh & 3, row = MPR + b;
    const float c1 = 0.125f * LOG2E;
    float o[2][2];
    const float v0 = bf2f(p.PROJ()[(size_t)row * INW + O_V + h * 128 + lane]), v1 = bf2f(p.PROJ()[(size_t)row * INW + O_V + h * 128 + 64 + lane]);
#pragma unroll
    for (int c = 0; c < 2; ++c) {
        const float qd = bf2f(p.QN()[(size_t)row * 512 + h * 128 + c * 64 + lane]), kd = bf2f(p.KN()[(size_t)row * 512 + h * 128 + c * 64 + lane]);
        const float sself = wave_sum(qd * kd) * c1;
        float mm = sself;
        for (int s = 0; s < SA_SPLITS; ++s) mm = fmaxf(mm, p.PART()[((size_t)(bh * 16 + s) * 2 + c) * 130]);
        const float pself = __builtin_amdgcn_exp2f(sself - mm);
        float lt = pself, a0 = pself * v0, a1 = pself * v1;
        for (int s = 0; s < SA_SPLITS; ++s) { const float* pp = p.PART() + ((size_t)(bh * 16 + s) * 2 + c) * 130; const float sc = __builtin_amdgcn_exp2f(pp[0] - mm);
            lt += pp[1] * sc; a0 += pp[2 + lane] * sc; a1 += pp[2 + 64 + lane] * sc; }
        o[c][0] = a0 / lt; o[c][1] = a1 / lt;
    }
    const float r0 = o[0][0] - lam * o[1][0], r1 = o[0][1] - lam * o[1][1];
    const float ss = wave_sum(r0 * r0 + r1 * r1);
    const float rs = rsqrtf(ss * (1.f / 128.f) + 1e-6f) * (1.f - LAM_INIT);
    p.YO()[(size_t)row * DM + 512 + h * 128 + lane] = (bf16_t)(pk2(r0 * rs * p.da_subln_g[lane], 0.f) & 0xffffu);
    p.YO()[(size_t)row * DM + 512 + h * 128 + 64 + lane] = (bf16_t)(pk2(r1 * rs * p.da_subln_g[64 + lane], 0.f) & 0xffffu);
}

struct EpiBr1 {
    const bf16_t* PROJ; bf16_t* MIX;
    DI void operator()(const AccT& acc, int brow, int bcol, int wr, int wc, int fr, int fq) const {
        EPI_ROWS_BEGIN
            EPI_COLS_BEGIN
                const u32x2 g = *(const u32x2*)(PROJ + (size_t)row * INW + O_GA + col);
                u32x2 o; o.x = pk2(a.x * sigmoidf_(bflo(g.x)), a.y * sigmoidf_(bfhi(g.x))); o.y = pk2(a.z * sigmoidf_(bflo(g.y)), a.w * sigmoidf_(bfhi(g.y)));
                *(u32x2*)(MIX + (size_t)row * DM + col) = o;
            }
        }
    }
};
struct EpiBr2 {
    const bf16_t* PROJ; bf16_t* MIX;
    DI void operator()(const AccT& acc, int brow, int bcol, int wr, int wc, int fr, int fq) const {
        EPI_ROWS_BEGIN
            EPI_COLS_BEGIN
                const u32x2 g = *(const u32x2*)(PROJ + (size_t)row * INW + O_GB + col);
                const u32x2 f = *(const u32x2*)(MIX + (size_t)row * DM + col);
                u32x2 o; o.x = pk2(bflo(f.x) + a.x * sigmoidf_(bflo(g.x)), bfhi(f.x) + a.y * sigmoidf_(bfhi(g.x))); o.y = pk2(bflo(f.y) + a.z * sigmoidf_(bflo(g.y)), bfhi(f.y) + a.w * sigmoidf_(bfhi(g.y)));
                *(u32x2*)(MIX + (size_t)row * DM + col) = o;
            }
        }
    }
};
struct EpiOut {
    const float* const* XPTR; float* H1; bf16_t* HB; float* SS2;
    DI void operator()(const AccT& acc, int brow, int bcol, int wr, int wc, int fr, int fq) const {
        EPI_ROWS_BEGIN
            const float* xr = XPTR[row];
            float ss = 0.f;
            EPI_COLS_BEGIN
                f32x4 v = a;
                v += *(const f32x4*)(xr + col);
                ss += v.x * v.x + v.y * v.y + v.z * v.z + v.w * v.w;
                *(f32x4*)(H1 + (size_t)row * DM + col) = v;
                u32x2 o; o.x = pk2(v.x, v.y); o.y = pk2(v.z, v.w);
                *(u32x2*)(HB + (size_t)row * DM + col) = o;
            }
            ss += __shfl_xor(ss, 16); ss += __shfl_xor(ss, 32);
            if (fq == 0) atomicAdd(SS2 + row, ss);
        }
    }
};
struct EpiQ {
    const float* SS2; bf16_t* QP;
    DI void operator()(const AccT& acc, int brow, int bcol, int wr, int wc, int fr, int fq) const {
        EPI_ROWS_BEGIN
            const float rs = rsqrtf(SS2[row] * (1.f / DM) + 1e-6f);
            EPI_COLS_BEGIN
                const f32x4 v = a * rs;
                u32x2 o; o.x = pk2(v.x, v.y); o.y = pk2(v.z, v.w);
                *(u32x2*)(QP + (size_t)row * 2048 + col) = o;
            }
        }
    }
};

template <class F>
DI void skinny_gemm(const bf16_t* A, int lda, const bf16_t* Bt, int K, int N, char* smem, int bid, int nblk, int tid, F&& f) {
    const int wave = tid >> 6, lane = tid & 63, tk = lane & 31, hh = lane >> 5;
    const int ks = K / 128;
    for (int tile = bid; tile < N / 32; tile += nblk) {
        const int n0 = tile * 32;
        f32x16 acc = {};
        const bf16_t* ap = A + (size_t)(MPR + tk) * lda + 8 * hh + wave * ks * 16; const bf16_t* bp = Bt + (size_t)(n0 + tk) * K + 8 * hh + wave * ks * 16;
        if (ks == 4) {
            bf16x8 av[4], bv[4];
#pragma unroll
            for (int s2 = 0; s2 < 4; ++s2) { av[s2] = *(const bf16x8*)(ap + 16 * s2); bv[s2] = *(const bf16x8*)(bp + 16 * s2); }
#pragma unroll
            for (int s2 = 0; s2 < 4; ++s2) acc = MFMA32(av[s2], bv[s2], acc);
        } else {
            bf16x8 av[8], bv[8];
#pragma unroll
            for (int s2 = 0; s2 < 8; ++s2) { av[s2] = *(const bf16x8*)(ap + 16 * s2); bv[s2] = *(const bf16x8*)(bp + 16 * s2); }
#pragma unroll
            for (int s2 = 0; s2 < 8; ++s2) acc = MFMA32(av[s2], bv[s2], acc);
        }
        __syncthreads();
        float* part = (float*)smem + wave * 1024;
#pragma unroll
        for (int i = 0; i < 16; ++i) part[i * 64 + lane] = acc[i];
        __syncthreads();
        if (wave == 0) {
#pragma unroll
            for (int i = 0; i < 16; ++i) { float v = 0.f;
#pragma unroll
                for (int w = 0; w < 8; ++w) v += ((const float*)smem)[w * 1024 + i * 64 + lane];
                f(MPR + (i & 3) + 8 * (i >> 2) + 4 * hh, n0 + tk, v); }
        }
    }
    __syncthreads();
}
DI unsigned short bf16_1(float x) { return (unsigned short)(pk2(x, 0.f) & 0xffffu); }

DI int fkey(float f, int idx, int mask) { int b = (__float_as_int(f) & ~mask) | idx; return b ^ ((b >> 31) & 0x7fffffff); }
DI int funkey(int k) { return k ^ ((k >> 31) & 0x7fffffff); }
template <int N> DI void bitonic_sort_desc(int (&a)[N]) {
#pragma unroll
    for (int k = 2; k <= N; k <<= 1)
#pragma unroll
        for (int j = k >> 1; j > 0; j >>= 1)
#pragma unroll
            for (int i = 0; i < N; ++i) { const int l = i ^ j;
                if (l > i) { const bool desc = ((i & k) == 0); const int mx = max(a[i], a[l]), mn = min(a[i], a[l]); a[i] = desc ? mx : mn; a[l] = desc ? mn : mx; } }
}
DI void merge_top16(int (&a)[16], const int (&b)[16]) {
#pragma unroll
    for (int i = 0; i < 16; ++i) a[i] = max(a[i], b[15 - i]);
#pragma unroll
    for (int j = 8; j > 0; j >>= 1)
#pragma unroll
        for (int i = 0; i < 16; ++i) { const int l = i ^ j; if (l > i) { const int mx = max(a[i], a[l]), mn = min(a[i], a[l]); a[i] = mx; a[l] = mn; } }
}
DI void top16_of_64(int (&g0)[16], int (&g1)[16], int (&g2)[16], int (&g3)[16], bool g0_sorted) {
    if (!g0_sorted) bitonic_sort_desc<16>(g0);
    bitonic_sort_desc<16>(g1); bitonic_sort_desc<16>(g2); bitonic_sort_desc<16>(g3);
    merge_top16(g0, g1); merge_top16(g2, g3); merge_top16(g0, g2);
}
DI void half_topk(const Params& p, const char* skl, int row, int hd, int c, int tk, int hh, int (&top)[16]) {
    bf16x8 Bq[8];
#pragma unroll
    for (int s = 0; s < 8; ++s) Bq[s] = *(const bf16x8*)(p.QP() + (size_t)row * 2048 + hd * 256 + c * 128 + 16 * s + 8 * hh);
    int g[4][16];
#pragma unroll
    for (int kt = 0; kt < 4; ++kt) {
        f32x16 acc = {};
#pragma unroll
        for (int s = 0; s < 8; ++s) { const bf16x8 ak = *(const bf16x8*)(skl + (c * 128 + kt * 32 + tk) * 272 + (16 * s + 8 * hh) * 2); acc = MFMA32(ak, Bq[s], acc); }
#pragma unroll
        for (int i = 0; i < 16; ++i) g[kt][i] = fkey(acc[i], kt * 32 + (i & 3) + 8 * (i >> 2) + 4 * hh, 0x7f);
        __builtin_amdgcn_sched_barrier(0);
    }
    bitonic_sort_desc<16>(g[0]); __builtin_amdgcn_sched_barrier(0);
    bitonic_sort_desc<16>(g[1]); __builtin_amdgcn_sched_barrier(0);
    merge_top16(g[0], g[1]); __builtin_amdgcn_sched_barrier(0);
    bitonic_sort_desc<16>(g[2]); __builtin_amdgcn_sched_barrier(0);
    bitonic_sort_desc<16>(g[3]); __builtin_amdgcn_sched_barrier(0);
    merge_top16(g[2], g[3]); merge_top16(g[0], g[2]);
    int oth[16];
#pragma unroll
    for (int i = 0; i < 16; ++i) oth[i] = __shfl_xor(g[0][i], 32);
    merge_top16(g[0], oth);
#pragma unroll
    for (int i = 0; i < 16; ++i) top[i] = g[0][i];
    __builtin_amdgcn_sched_barrier(0);
}
DI void topk_unit(const Params& p, const char* skl, char* lds_wave  , int unit, int lane) {
    const int tile = unit >> 3, hd = unit & 7, tk = lane & 31, hh = lane >> 5, row = tile * 32 + tk;
    int top[2][16];
    half_topk(p, skl, row, hd, 0, tk, hh, top[0]);
    half_topk(p, skl, row, hd, 1, tk, hh, top[1]);
    float v1[16], v2[16]; unsigned i1w[4] = {0, 0, 0, 0}, i2w[4] = {0, 0, 0, 0};
#pragma unroll
    for (int i = 0; i < 16; ++i) { const int b1 = funkey(top[0][i]), b2 = funkey(top[1][i]);
        v1[i] = __int_as_float(b1 & ~0x7f); v2[i] = __int_as_float(b2 & ~0x7f);
        i1w[i >> 2] |= (unsigned)(b1 & 0x7f) << (8 * (i & 3)); i2w[i >> 2] |= (unsigned)(b2 & 0x7f) << (8 * (i & 3)); }
    LAS unsigned* myl = (LAS unsigned*)lds_wave + lane * 8;
#pragma unroll
    for (int i = 0; i < 4; ++i) { myl[i] = i1w[i]; myl[4 + i] = i2w[i]; }
    int cg0[16], cg1[16], cg2[16], cg3[16];
    constexpr int NEG = (int)0x80000000;
#pragma unroll
    for (int j = 0; j < 16; ++j) cg0[j] = fkey(v1[0] + v2[j], j, 0xff);
    {
        int n = 0;
#pragma unroll
        for (int i = 1; i < 16; ++i)
#pragma unroll
            for (int j = 0; j < 16; ++j) if ((i + 1) * (j + 1) <= 16) { const int k = fkey(v1[i] + v2[j], i * 16 + j, 0xff);
                if (n < 16) cg1[n] = k; else if (n < 32) cg2[n - 16] = k; else cg3[n - 32] = k; ++n; }
#pragma unroll
        for (int i = 2; i < 16; ++i) cg3[i] = NEG;
    }
    __builtin_amdgcn_sched_barrier(0);
    bitonic_sort_desc<16>(cg0); __builtin_amdgcn_sched_barrier(0);
    bitonic_sort_desc<16>(cg1); __builtin_amdgcn_sched_barrier(0);
    merge_top16(cg0, cg1); __builtin_amdgcn_sched_barrier(0);
    bitonic_sort_desc<16>(cg2); __builtin_amdgcn_sched_barrier(0);
    bitonic_sort_desc<16>(cg3); __builtin_amdgcn_sched_barrier(0);
    merge_top16(cg2, cg3); merge_top16(cg0, cg2);
    float sc[16]; int cid[16];
#pragma unroll
    for (int i = 0; i < 16; ++i) { const int bb = funkey(cg0[i]); sc[i] = __int_as_float(bb & ~0xff); cid[i] = bb & 0xff; }
    float e[16], sum = 0.f;
#pragma unroll
    for (int i = 0; i < 16; ++i) { e[i] = __expf(sc[i] - sc[0]); sum += e[i]; }
    const float inv = 1.f / sum;
    __builtin_amdgcn_s_waitcnt(0xc07f); asm volatile("" ::: "memory");
    const LAS unsigned char* myb = (const LAS unsigned char*)myl;
    int eidx[16];
#pragma unroll
    for (int i = 0; i < 16; ++i) eidx[i] = (int)myb[cid[i] >> 4] * 128 + (int)myb[16 + (cid[i] & 15)];
    if (hh == 0 && row < MTOT) {
        int* io = p.IDX() + ((size_t)row * 8 + hd) * 16; float* go = p.GATE() + ((size_t)row * 8 + hd) * 16;
#pragma unroll
        for (int i = 0; i < 16; i += 4) { *(int4*)(io + i) = make_int4(eidx[i], eidx[i + 1], eidx[i + 2], eidx[i + 3]); *(f32x4*)(go + i) = (f32x4){e[i] * inv, e[i + 1] * inv, e[i + 2] * inv, e[i + 3] * inv}; }
    }
    __builtin_amdgcn_s_waitcnt(0xc07f); asm volatile("" ::: "memory");
}

DI void experts_row(const Params& p, int row, int lane) {
    const float rs = rsqrtf(p.SS2()[row] * (1.f / DM) + 1e-6f);
    float x[16];
    {
        float t0[8], t1[8]; unpack8(*(const u32x4*)(p.HB() + (size_t)row * DM + lane * 8), t0); unpack8(*(const u32x4*)(p.HB() + (size_t)row * DM + 512 + lane * 8), t1);
#pragma unroll
        for (int i = 0; i < 8; ++i) { x[i] = t0[i] * rs * p.norm2_g[lane * 8 + i]; x[8 + i] = t1[i] * rs * p.norm2_g[512 + lane * 8 + i]; }
    }
    float out[16];
#pragma unroll
    for (int i = 0; i < 16; ++i) out[i] = 0.f;
    for (int hd = 0; hd < 8; ++hd) {
        const int myidx = p.IDX()[((size_t)row * 8 + hd) * 16 + (lane & 15)];
        const float mygate = p.GATE()[((size_t)row * 8 + hd) * 16 + (lane & 15)];
        float hid = 0.f;
#pragma unroll 4
        for (int k = 0; k < 16; ++k) {
            const int e = __builtin_amdgcn_readlane(myidx, k);
            const bf16_t* ur = p.U16() + (size_t)e * DM;
            float u0[8], u1[8]; unpack8(*(const u32x4*)(ur + lane * 8), u0); unpack8(*(const u32x4*)(ur + 512 + lane * 8), u1);
            float d = 0.f;
#pragma unroll
            for (int i = 0; i < 8; ++i) d += x[i] * u0[i] + x[8 + i] * u1[i];
            d = wave_sum(d);
            hid = (lane & 15) == k ? d : hid;
        }
        const float cf = 0.5f * hid * (1.f + erff(hid * 0.70710678118654752f)) * mygate;
#pragma unroll 4
        for (int k = 0; k < 16; ++k) {
            const int e = __builtin_amdgcn_readlane(myidx, k);
            const float ck = __int_as_float(__builtin_amdgcn_readlane(__float_as_int(cf), k));
            const bf16_t* vr = p.V16() + (size_t)e * DM;
            float u0[8], u1[8]; unpack8(*(const u32x4*)(vr + lane * 8), u0); unpack8(*(const u32x4*)(vr + 512 + lane * 8), u1);
#pragma unroll
            for (int i = 0; i < 8; ++i) { out[i] += ck * u0[i]; out[8 + i] += ck * u1[i]; }
        }
    }
    float* dst = nullptr;
    if (row < MPR) { const int b = row / TT, t = row - b * TT; if (t >= NMETA) dst = p.out + OUT_YP + ((size_t)b * SEQ + (t - NMETA)) * DM; }
    else dst = p.out + OUT_YS + (size_t)(row - MPR) * DM;
    if (dst) {
        const float* h1 = p.H1() + (size_t)row * DM;
#pragma unroll
        for (int j = 0; j < 2; ++j) {
            const f32x4 a = *(const f32x4*)(h1 + j * 512 + lane * 8), b = *(const f32x4*)(h1 + j * 512 + lane * 8 + 4);
            *(f32x4*)(dst + j * 512 + lane * 8) = (f32x4){a.x + out[8 * j], a.y + out[8 * j + 1], a.z + out[8 * j + 2], a.w + out[8 * j + 3]};
            *(f32x4*)(dst + j * 512 + lane * 8 + 4) = (f32x4){b.x + out[8 * j + 4], b.y + out[8 * j + 5], b.z + out[8 * j + 6], b.w + out[8 * j + 7]};
        }
    }
}

constexpr int EX_NSL = 1, EX_SLSH = 14;
constexpr int EX_IDX_OFF = 0, EX_COEF_OFF = 64 * 128 * 2, EX_OFF_OFF = EX_COEF_OFF + 64 * 128 * 4, EX_LIST_OFF = EX_OFF_OFF + 64 * 32 * 2, EX_LDS = EX_LIST_OFF + 8 * 256 * 2;
DI float row16_rorsum(float v) {
    v += __builtin_amdgcn_update_dpp(0.f, v, 0x128, 0xF, 0xF, false);
    v += __builtin_amdgcn_update_dpp(0.f, v, 0x124, 0xF, 0xF, false);
    v += __builtin_amdgcn_update_dpp(0.f, v, 0x122, 0xF, 0xF, false);
    v += __builtin_amdgcn_update_dpp(0.f, v, 0x121, 0xF, 0xF, false);
    return v;
}
DI void unpack_fp8x16(const u32x4& w, float (&f)[16]) {
#pragma unroll
    for (int q = 0; q < 4; ++q) { const f32x2 lo = __builtin_amdgcn_cvt_pk_f32_fp8((int)w[q], false), hi = __builtin_amdgcn_cvt_pk_f32_fp8((int)w[q], true);
        f[4 * q] = lo.x; f[4 * q + 1] = lo.y; f[4 * q + 2] = hi.x; f[4 * q + 3] = hi.y; }
}
DI int peer_row_of(int ci) { return ci < NB * SEQ ? (ci >> 12) * TT + NMETA + (ci & 4095) : (ci < NB * SEQ + MS ? MPR + (ci - NB * SEQ) : -1); }
DI void experts_wave(const Params& p, char* smem, int wave_, int lane_, int ci0, int ntok, int xcc) {
    int wave = wave_, lane = lane_; asm volatile("" : "+v"(lane), "+v"(wave)); wave = __builtin_amdgcn_readfirstlane(wave);
    LAS unsigned short* idxs = (LAS unsigned short*)(smem + EX_IDX_OFF) + wave * 8 * 128;
    LAS float* coef = (LAS float*)(smem + EX_COEF_OFF) + wave * 8 * 128;
    LAS unsigned short* offs = (LAS unsigned short*)(smem + EX_OFF_OFF) + wave * 8 * 32;
    const unsigned char* U8 = (const unsigned char*)p.U16(); const unsigned char* V8 = (const unsigned char*)p.V16();
    float xr[2][16];
#pragma unroll
    for (int j = 0; j < 2; ++j) {
        const int row = j < ntok ? peer_row_of(ci0 + j) : -1;
        if (row >= 0) {
            const int e0 = p.IDX()[(size_t)row * 128 + lane], e1 = p.IDX()[(size_t)row * 128 + 64 + lane];
            const float g0 = p.GATE()[(size_t)row * 128 + lane], g1 = p.GATE()[(size_t)row * 128 + 64 + lane];
            const int s0 = e0 >> EX_SLSH, s1 = e1 >> EX_SLSH;
            int base = 0, pos0 = 0, pos1 = 0;
#pragma unroll
            for (int sl = 0; sl < EX_NSL; ++sl) {
                const unsigned long long m0 = __ballot(s0 == sl), m1 = __ballot(s1 == sl);
                const int c0 = __popcll(m0), c1 = __popcll(m1);
                const int r0 = __builtin_amdgcn_mbcnt_hi((unsigned)(m0 >> 32), __builtin_amdgcn_mbcnt_lo((unsigned)m0, 0));
                const int r1 = __builtin_amdgcn_mbcnt_hi((unsigned)(m1 >> 32), __builtin_amdgcn_mbcnt_lo((unsigned)m1, 0));
                if (s0 == sl) pos0 = base + r0;
                if (s1 == sl) pos1 = base + c0 + r1;
                if (lane == 0) offs[j * 32 + sl] = (unsigned short)base;
                base += c0 + c1;
            }
            if (lane == 0) offs[j * 32 + EX_NSL] = (unsigned short)base;
            idxs[j * 128 + pos0] = (unsigned short)e0; idxs[j * 128 + pos1] = (unsigned short)e1;
            coef[j * 128 + pos0] = g0; coef[j * 128 + pos1] = g1;
            const float rs = rsqrtf(p.SS2()[row] * (1.f / DM) + 1e-6f) * (1.f / U8_SCALE);
            float t0[8], t1[8]; unpack8(*(const u32x4*)(p.HB() + (size_t)row * DM + lane * 16), t0); unpack8(*(const u32x4*)(p.HB() + (size_t)row * DM + lane * 16 + 8), t1);
#pragma unroll
            for (int q = 0; q < 2; ++q) { const f32x4 ga = *(const f32x4*)(p.norm2_g + lane * 16 + 4 * q), gb = *(const f32x4*)(p.norm2_g + lane * 16 + 8 + 4 * q);
                xr[j][4 * q] = t0[4 * q] * rs * ga.x; xr[j][4 * q + 1] = t0[4 * q + 1] * rs * ga.y; xr[j][4 * q + 2] = t0[4 * q + 2] * rs * ga.z; xr[j][4 * q + 3] = t0[4 * q + 3] * rs * ga.w;
                xr[j][8 + 4 * q] = t1[4 * q] * rs * gb.x; xr[j][8 + 4 * q + 1] = t1[4 * q + 1] * rs * gb.y; xr[j][8 + 4 * q + 2] = t1[4 * q + 2] * rs * gb.z; xr[j][8 + 4 * q + 3] = t1[4 * q + 3] * rs * gb.w; }
        } else {
            if (lane <= EX_NSL) offs[j * 32 + lane] = 0;
#pragma unroll
            for (int i = 0; i < 16; ++i) xr[j][i] = 0.f;
        }
    }
    __builtin_amdgcn_s_waitcnt(0xc07f); asm volatile("" ::: "memory");
    LAS unsigned short* blist = (LAS unsigned short*)(smem + EX_LIST_OFF) + wave * 256;
    int nbat;
    {
        const int r = (lane >> 1) & (EX_NSL - 1), j = lane & 1, sl = (xcc + r) & (EX_NSL - 1);
        const int beg = offs[j * 32 + sl], cnt = lane < 2 * EX_NSL ? (int)offs[j * 32 + sl + 1] - beg : 0, nb = (cnt + 7) >> 3;
        int incl = nb;
#pragma unroll
        for (int o = 1; o < 64; o <<= 1) { const int t = __shfl_up(incl, o); if (lane >= o) incl += t; }
        nbat = __builtin_amdgcn_readlane(incl, 63);
        int w = incl - nb;
        for (int q = 0; q < nb; ++q) { const int k = beg + 8 * q, n = (cnt - 8 * q) < 8 ? (cnt - 8 * q) : 8; blist[w + q] = (unsigned short)(j | (k << 3) | ((n - 1) << 10)); }
    }
    __builtin_amdgcn_s_waitcnt(0xc07f); asm volatile("" ::: "memory");
    const int pid = lane >> 4;
    auto fetch = [&](const unsigned char* tab, int bi, u32x4 (&buf)[8]) {
        const int e = __builtin_amdgcn_readfirstlane((int)blist[bi]);
        const int j = e & 7, k = (e >> 3) & 127, n = (e >> 10) + 1;
#pragma unroll
        for (int i = 0; i < 8; ++i) { const int kk = k + (i < n ? i : n - 1);
            const int ex = __builtin_amdgcn_readfirstlane((int)idxs[j * 128 + kk]);
            buf[i] = *(const u32x4*)(tab + (size_t)ex * DM + lane * 16); }
    };
    auto u_consume = [&](int bi, const u32x4 (&buf)[8]) {
        const int e = __builtin_amdgcn_readfirstlane((int)blist[bi]);
        const int j = e & 7, k = (e >> 3) & 127, n = (e >> 10) + 1;
        float pp[8], x[16];
#pragma unroll
        for (int q = 0; q < 16; ++q) x[q] = j ? xr[1][q] : xr[0][q];
#pragma unroll
        for (int i = 0; i < 8; ++i) { float f[16]; unpack_fp8x16(buf[i], f); float d0 = 0.f, d1 = 0.f;
#pragma unroll
            for (int q = 0; q < 16; q += 2) { d0 += f[q] * x[q]; d1 += f[q + 1] * x[q + 1]; }
            pp[i] = d0 + d1; __builtin_amdgcn_sched_barrier(0); }
#pragma unroll
        for (int hb = 0; hb < 2; ++hb) {
            const bool b5 = lane & 32, b4 = lane & 16;
            const float a0 = b5 ? pp[4 * hb + 2] : pp[4 * hb], a1 = b5 ? pp[4 * hb + 3] : pp[4 * hb + 1], s0 = b5 ? pp[4 * hb] : pp[4 * hb + 2], s1 = b5 ? pp[4 * hb + 1] : pp[4 * hb + 3];
            const float q0 = a0 + __shfl_xor(s0, 32), q1 = a1 + __shfl_xor(s1, 32);
            const float c0 = b4 ? q1 : q0, d0 = b4 ? q0 : q1;
            float z = c0 + __shfl_xor(d0, 16);
            z = row16_rorsum(z);
            const int ip = 4 * hb + pid;
            if ((lane & 15) == 0 && ip < n) {
                const float g = coef[j * 128 + k + ip];
                coef[j * 128 + k + ip] = 0.5f * z * (1.f + erff(z * 0.70710678118654752f)) * g * (1.f / V8_SCALE);
            }
        }
    };
    {
        u32x4 bufA[8], bufB[8];
        if (nbat > 0) fetch(U8, 0, bufA);
#pragma unroll 1
        for (int bi = 0; bi < nbat; bi += 2) {
            if (bi + 1 < nbat) fetch(U8, bi + 1, bufB);
            u_consume(bi, bufA);
            if (bi + 2 < nbat) fetch(U8, bi + 2, bufA);
            if (bi + 1 < nbat) u_consume(bi + 1, bufB);
        }
    }
    __builtin_amdgcn_s_waitcnt(0xc07f); asm volatile("" ::: "memory");
    float acc[2][16];
#pragma unroll
    for (int j = 0; j < 2; ++j)
#pragma unroll
        for (int i = 0; i < 16; ++i) acc[j][i] = 0.f;
    auto v_consume = [&](int bi, const u32x4 (&buf)[8]) {
        const int e = __builtin_amdgcn_readfirstlane((int)blist[bi]);
        const int j = e & 7, k = (e >> 3) & 127, n = (e >> 10) + 1;
        float cc[8];
#pragma unroll
        for (int i = 0; i < 8; ++i) { const float c = __int_as_float(__builtin_amdgcn_readfirstlane(__float_as_int(coef[j * 128 + k + (i < n ? i : n - 1)]))); cc[i] = i < n ? c : 0.f; }
        float d[16];
#pragma unroll
        for (int q = 0; q < 16; ++q) d[q] = 0.f;
#pragma unroll
        for (int i = 0; i < 8; ++i) { float f[16]; unpack_fp8x16(buf[i], f);
#pragma unroll
            for (int q = 0; q < 16; ++q) d[q] += cc[i] * f[q];
            __builtin_amdgcn_sched_barrier(0); }
#pragma unroll
        for (int q = 0; q < 16; ++q) { acc[0][q] += j ? 0.f : d[q]; acc[1][q] += j ? d[q] : 0.f; }
    };
    {
        u32x4 bufA[8], bufB[8];
        if (nbat > 0) fetch(V8, 0, bufA);
#pragma unroll 1
        for (int bi = 0; bi < nbat; bi += 2) {
            if (bi + 1 < nbat) fetch(V8, bi + 1, bufB);
            v_consume(bi, bufA);
            if (bi + 2 < nbat) fetch(V8, bi + 2, bufA);
            if (bi + 1 < nbat) v_consume(bi + 1, bufB);
        }
    }
#pragma unroll
    for (int j = 0; j < 2; ++j) {
        const int ci = ci0 + j;
        const int row = j < ntok ? peer_row_of(ci) : -1;
        if (row >= 0) {
            float* dst = (ci < NB * SEQ ? p.out + OUT_YP + (size_t)ci * DM : p.out + OUT_YS + (size_t)(ci - NB * SEQ) * DM) + lane * 16;
            const float* h1 = p.H1() + (size_t)row * DM + lane * 16;
#pragma unroll
            for (int q = 0; q < 4; ++q) { const f32x4 a = *(const f32x4*)(h1 + 4 * q);
                *(f32x4*)(dst + 4 * q) = (f32x4){a.x + acc[j][4 * q], a.y + acc[j][4 * q + 1], a.z + acc[j][4 * q + 2], a.w + acc[j][4 * q + 3]}; }
        }
    }
}

typedef float f32x32 __attribute__((ext_vector_type(32)));
typedef unsigned u32x6 __attribute__((ext_vector_type(6)));
typedef unsigned u32x6_a8 __attribute__((ext_vector_type(6), aligned(8)));
constexpr int EX_UCF_OFF = EX_LDS, EX_LDS6 = EX_UCF_OFF + 8 * 256 * 4;
typedef u32x6 Row6;
DI f32x32 unpack_fp6x32(const Row6& r) { return __builtin_amdgcn_cvt_scalef32_pk32_f32_fp6(r, 1.0f); }
DI void experts_wave6(const Params& p, char* smem, int wave_, int lane_, int ci0, int ntok) {
    int wave = wave_, lane = lane_; asm volatile("" : "+v"(lane), "+v"(wave)); wave = __builtin_amdgcn_readfirstlane(wave);
    LAS unsigned short* idxs = (LAS unsigned short*)(smem + EX_IDX_OFF) + wave * 8 * 128;
    LAS float* coef = (LAS float*)(smem + EX_COEF_OFF) + wave * 8 * 128;
    LAS float* ucf = (LAS float*)(smem + EX_UCF_OFF) + wave * 256;
    const unsigned char* U6 = (const unsigned char*)p.U16(); const unsigned char* V6 = (const unsigned char*)p.V16();
    const int h = lane >> 5, lq = lane & 31;
#pragma unroll
    for (int j = 0; j < 2; ++j) {
        const int row = j < ntok ? peer_row_of(ci0 + j) : -1;
        int e0 = 0, e1 = 0; float g0 = 0.f, g1 = 0.f;
        if (row >= 0) { e0 = p.IDX()[(size_t)row * 128 + lane]; e1 = p.IDX()[(size_t)row * 128 + 64 + lane]; g0 = p.GATE()[(size_t)row * 128 + lane]; g1 = p.GATE()[(size_t)row * 128 + 64 + lane]; }
        idxs[j * 128 + lane] = (unsigned short)e0; idxs[j * 128 + 64 + lane] = (unsigned short)e1;
        coef[j * 128 + lane] = g0 * p.VSC()[e0]; coef[j * 128 + 64 + lane] = g1 * p.VSC()[e1];
        ucf[j * 128 + lane] = p.USC()[e0]; ucf[j * 128 + 64 + lane] = p.USC()[e1];
    }
    const int myrow = h < ntok ? peer_row_of(ci0 + h) : -1;
    float x[32];
    {
        const int rr = myrow >= 0 ? myrow : 0;
        const float rs = myrow >= 0 ? rsqrtf(p.SS2()[rr] * (1.f / DM) + 1e-6f) : 0.f;
#pragma unroll
        for (int q = 0; q < 4; ++q) { float t[8]; unpack8(*(const u32x4*)(p.HB() + (size_t)rr * DM + lq * 32 + q * 8), t);
            const f32x4 ga = *(const f32x4*)(p.norm2_g + lq * 32 + q * 8), gb = *(const f32x4*)(p.norm2_g + lq * 32 + q * 8 + 4);
            x[8 * q] = t[0] * rs * ga.x; x[8 * q + 1] = t[1] * rs * ga.y; x[8 * q + 2] = t[2] * rs * ga.z; x[8 * q + 3] = t[3] * rs * ga.w;
            x[8 * q + 4] = t[4] * rs * gb.x; x[8 * q + 5] = t[5] * rs * gb.y; x[8 * q + 6] = t[6] * rs * gb.z; x[8 * q + 7] = t[7] * rs * gb.w; }
    }
    __builtin_amdgcn_s_waitcnt(0xc07f); asm volatile("" ::: "memory");
    auto fetch = [&](const unsigned char* tab, int b, Row6 (&buf)[8]) {
        const u32x4 iv = *(LAS const u32x4*)(idxs + h * 128 + b * 8);
#pragma unroll
        for (int i = 0; i < 8; ++i) { const unsigned ex = (iv[i >> 1] >> ((i & 1) * 16)) & 0xffffu;
            const unsigned char* src = tab + (size_t)ex * 768 + lq * 24;
            buf[i] = *(const u32x6_a8*)src; }
    };
    auto u_consume = [&](int b, const Row6 (&buf)[8]) {
        float pp[8];
#pragma unroll
        for (int i = 0; i < 8; ++i) { Row6 w = buf[i]; if (i > 0) asm volatile("" : "+v"(w) : "v"(pp[i - 1]));
            const f32x32 f = unpack_fp6x32(w); float d0 = 0.f, d1 = 0.f;
#pragma unroll
            for (int q = 0; q < 32; q += 2) { d0 += f[q] * x[q]; d1 += f[q + 1] * x[q + 1]; }
            pp[i] = d0 + d1; __builtin_amdgcn_sched_barrier(0); }
        const bool b4 = lane & 16, b3 = lane & 8, b2 = lane & 4;
        float q4[4], q2[2];
#pragma unroll
        for (int i = 0; i < 4; ++i) { const float a = b4 ? pp[i + 4] : pp[i], sx = b4 ? pp[i] : pp[i + 4]; q4[i] = a + __shfl_xor(sx, 16); }
#pragma unroll
        for (int i = 0; i < 2; ++i) { const float a = b3 ? q4[i + 2] : q4[i], sx = b3 ? q4[i] : q4[i + 2]; q2[i] = a + __builtin_amdgcn_update_dpp(0.f, sx, 0x128, 0xF, 0xF, false); }
        float t;
        { const float a = b2 ? q2[1] : q2[0], sx = b2 ? q2[0] : q2[1]; t = a + dpp_hmir(sx); }
        t += dpp_xor1(t); t += dpp_xor2(t);
        if ((lane & 3) == 0) {
            const int ix = h * 128 + b * 8 + ((lane >> 4) & 1) * 4 + ((lane >> 3) & 1) * 2 + ((lane >> 2) & 1);
            const float z = t * ucf[ix];
            coef[ix] = 0.5f * z * (1.f + erff(z * 0.70710678118654752f)) * coef[ix];
        }
    };
    f32x32 acc;
#pragma unroll
    for (int i = 0; i < 32; ++i) acc[i] = 0.f;
    auto v_consume = [&](int b, const Row6 (&buf)[8]) {
        const f32x4 c0 = *(LAS const f32x4*)(coef + h * 128 + b * 8), c1 = *(LAS const f32x4*)(coef + h * 128 + b * 8 + 4);
#pragma unroll
        for (int i = 0; i < 8; ++i) { Row6 w = buf[i]; asm volatile("" : "+v"(w), "+v"(acc));
            const f32x32 f = unpack_fp6x32(w); const float c = i < 4 ? c0[i & 3] : c1[i & 3];
            acc += f * c;
            __builtin_amdgcn_sched_barrier(0); }
    };
    {
        Row6 bufA[8], bufB[8];
        fetch(U6, 0, bufA);
#pragma unroll 1
        for (int b = 0; b < 16; b += 2) {
            fetch(U6, b + 1, bufB);
            u_consume(b, bufA);
            if (b + 2 < 16) fetch(U6, b + 2, bufA); else fetch(V6, 0, bufA);
            u_consume(b + 1, bufB);
        }
        __builtin_amdgcn_s_waitcnt(0xc07f); asm volatile("" ::: "memory");
#pragma unroll 1
        for (int b = 0; b < 16; b += 2) {
            fetch(V6, b + 1, bufB);
            v_consume(b, bufA);
            if (b + 2 < 16) fetch(V6, b + 2, bufA);
            v_consume(b + 1, bufB);
        }
    }
    if (myrow >= 0) {
        const int ci = ci0 + h;
        float* dst = (ci < NB * SEQ ? p.out + OUT_YP + (size_t)ci * DM : p.out + OUT_YS + (size_t)(ci - NB * SEQ) * DM) + lq * 32;
        const float* h1 = p.H1() + (size_t)myrow * DM + lq * 32;
#pragma unroll
        for (int q = 0; q < 8; ++q) { const f32x4 a = *(const f32x4*)(h1 + 4 * q);
            *(f32x4*)(dst + 4 * q) = (f32x4){a.x + acc[4 * q], a.y + acc[4 * q + 1], a.z + acc[4 * q + 2], a.w + acc[4 * q + 3]}; }
    }
}
typedef u32x4 Row4;
DI f32x32 unpack_fp4x32(const Row4& r) {
    f32x32 f;
#define FP4_B(d, b) { const f32x2 t = __builtin_amdgcn_cvt_scalef32_pk_f32_fp4(r[d], 1.0f, b); f[8 * (d) + 2 * (b)] = t.x; f[8 * (d) + 2 * (b) + 1] = t.y; }
#define FP4_D(d) FP4_B(d, 0) FP4_B(d, 1) FP4_B(d, 2) FP4_B(d, 3)
    FP4_D(0) FP4_D(1) FP4_D(2) FP4_D(3)
#undef FP4_D
#undef FP4_B
    return f;
}
DI void experts_wave4(const Params& p, char* smem, int wave_, int lane_, int ci0, int ntok) {
    int wave = wave_, lane = lane_; asm volatile("" : "+v"(lane), "+v"(wave)); wave = __builtin_amdgcn_readfirstlane(wave);
    LAS unsigned short* idxs = (LAS unsigned short*)(smem + EX_IDX_OFF) + wave * 8 * 128;
    LAS float* coef = (LAS float*)(smem + EX_COEF_OFF) + wave * 8 * 128;
    LAS float* ucf = (LAS float*)(smem + EX_UCF_OFF) + wave * 256;
    const unsigned char* U6 = (const unsigned char*)p.U16(); const unsigned char* V6 = (const unsigned char*)p.V16();
    const int h = lane >> 5, lq = lane & 31;
#pragma unroll
    for (int j = 0; j < 2; ++j) {
        const int row = j < ntok ? peer_row_of(ci0 + j) : -1;
        int e0 = 0, e1 = 0; float g0 = 0.f, g1 = 0.f;
        if (row >= 0) { e0 = p.IDX()[(size_t)row * 128 + lane]; e1 = p.IDX()[(size_t)row * 128 + 64 + lane]; g0 = p.GATE()[(size_t)row * 128 + lane]; g1 = p.GATE()[(size_t)row * 128 + 64 + lane]; }
        idxs[j * 128 + lane] = (unsigned short)e0; idxs[j * 128 + 64 + lane] = (unsigned short)e1;
        coef[j * 128 + lane] = g0 * p.VSC()[e0]; coef[j * 128 + 64 + lane] = g1 * p.VSC()[e1];
        ucf[j * 128 + lane] = p.USC()[e0]; ucf[j * 128 + 64 + lane] = p.USC()[e1];
    }
    const int myrow = h < ntok ? peer_row_of(ci0 + h) : -1;
    float x[32];
    {
        const int rr = myrow >= 0 ? myrow : 0;
        const float rs = myrow >= 0 ? rsqrtf(p.SS2()[rr] * (1.f / DM) + 1e-6f) : 0.f;
#pragma unroll
        for (int q = 0; q < 4; ++q) { float t[8]; unpack8(*(const u32x4*)(p.HB() + (size_t)rr * DM + lq * 32 + q * 8), t);
            const f32x4 ga = *(const f32x4*)(p.norm2_g + lq * 32 + q * 8), gb = *(const f32x4*)(p.norm2_g + lq * 32 + q * 8 + 4);
            x[8 * q] = t[0] * rs * ga.x; x[8 * q + 1] = t[1] * rs * ga.y; x[8 * q + 2] = t[2] * rs * ga.z; x[8 * q + 3] = t[3] * rs * ga.w;
            x[8 * q + 4] = t[4] * rs * gb.x; x[8 * q + 5] = t[5] * rs * gb.y; x[8 * q + 6] = t[6] * rs * gb.z; x[8 * q + 7] = t[7] * rs * gb.w; }
    }
    __builtin_amdgcn_s_waitcnt(0xc07f); asm volatile("" ::: "memory");
    auto fetch = [&](const unsigned char* tab, int b, Row4 (&buf)[8]) {
        const u32x4 iv = *(LAS const u32x4*)(idxs + h * 128 + b * 8);
#pragma unroll
        for (int i = 0; i < 8; ++i) { const unsigned ex = (iv[i >> 1] >> ((i & 1) * 16)) & 0xffffu;
            buf[i] = *(const u32x4*)(tab + (size_t)ex * 512 + lq * 16); }
    };
    auto u_consume = [&](int b, const Row4 (&buf)[8]) {
        float pp[8];
#pragma unroll
        for (int i = 0; i < 8; ++i) { Row4 w = buf[i]; if (i > 0) asm volatile("" : "+v"(w) : "v"(pp[i - 1]));
            const f32x32 f = unpack_fp4x32(w); f32x2 d = {0.f, 0.f}, e = {0.f, 0.f};
#pragma unroll
            for (int q = 0; q < 32; q += 4) { d = __builtin_elementwise_fma((f32x2){f[q], f[q + 1]}, (f32x2){x[q], x[q + 1]}, d); e = __builtin_elementwise_fma((f32x2){f[q + 2], f[q + 3]}, (f32x2){x[q + 2], x[q + 3]}, e); }
            d += e; pp[i] = d.x + d.y; __builtin_amdgcn_sched_barrier(0); }
        const bool b4 = lane & 16, b3 = lane & 8, b2 = lane & 4;
        float q4[4], q2[2];
#pragma unroll
        for (int i = 0; i < 4; ++i) { const float a = b4 ? pp[i + 4] : pp[i], sx = b4 ? pp[i] : pp[i + 4]; q4[i] = a + __shfl_xor(sx, 16); }
#pragma unroll
        for (int i = 0; i < 2; ++i) { const float a = b3 ? q4[i + 2] : q4[i], sx = b3 ? q4[i] : q4[i + 2]; q2[i] = a + __builtin_amdgcn_update_dpp(0.f, sx, 0x128, 0xF, 0xF, false); }
        float t;
        { const float a = b2 ? q2[1] : q2[0], sx = b2 ? q2[0] : q2[1]; t = a + dpp_hmir(sx); }
        t += dpp_xor1(t); t += dpp_xor2(t);
        if ((lane & 3) == 0) {
            const int ix = h * 128 + b * 8 + ((lane >> 4) & 1) * 4 + ((lane >> 3) & 1) * 2 + ((lane >> 2) & 1);
            const float z = t * ucf[ix];
            coef[ix] = 0.5f * z * (1.f + erff(z * 0.70710678118654752f)) * coef[ix];
        }
    };
    f32x32 acc;
#pragma unroll
    for (int i = 0; i < 32; ++i) acc[i] = 0.f;
    auto v_consume = [&](int b, const Row4 (&buf)[8]) {
        const f32x4 c0 = *(LAS const f32x4*)(coef + h * 128 + b * 8), c1 = *(LAS const f32x4*)(coef + h * 128 + b * 8 + 4);
#pragma unroll
        for (int i = 0; i < 8; ++i) { Row4 w = buf[i]; asm volatile("" : "+v"(w), "+v"(acc));
            const f32x32 f = unpack_fp4x32(w); const float c = i < 4 ? c0[i & 3] : c1[i & 3];
            acc += f * c;
            __builtin_amdgcn_sched_barrier(0); }
    };
    {
        Row4 bufA[8], bufB[8], bufC[8];
        auto fetch_j = [&](int j, Row4 (&buf)[8]) { if (j < 32) fetch(j < 16 ? U6 : V6, j & 15, buf); };
        fetch_j(0, bufA); fetch_j(1, bufB);
#pragma unroll 1
        for (int j = 0; j < 15; j += 3) {
            fetch_j(j + 2, bufC); u_consume(j, bufA);
            fetch_j(j + 3, bufA); u_consume(j + 1, bufB);
            fetch_j(j + 4, bufB); u_consume(j + 2, bufC);
        }
        fetch_j(17, bufC); u_consume(15, bufA);
        __builtin_amdgcn_s_waitcnt(0xc07f); asm volatile("" ::: "memory");
#pragma unroll 1
        for (int j = 16; j < 31; j += 3) {
            fetch_j(j + 2, bufA); v_consume(j - 16, bufB);
            fetch_j(j + 3, bufB); v_consume(j - 15, bufC);
            fetch_j(j + 4, bufC); v_consume(j - 14, bufA);
        }
        v_consume(15, bufB);
    }
    if (myrow >= 0) {
        const int ci = ci0 + h;
        float* dst = (ci < NB * SEQ ? p.out + OUT_YP + (size_t)ci * DM : p.out + OUT_YS + (size_t)(ci - NB * SEQ) * DM) + lq * 32;
        const float* h1 = p.H1() + (size_t)myrow * DM + lq * 32;
#pragma unroll
        for (int q = 0; q < 8; ++q) { const f32x4 a = *(const f32x4*)(h1 + 4 * q);
            *(f32x4*)(dst + 4 * q) = (f32x4){a.x + acc[4 * q], a.y + acc[4 * q + 1], a.z + acc[4 * q + 2], a.w + acc[4 * q + 3]}; }
    }
}

#define XB_TMO      128
#define XB_XCNT(j)  (256  + 64 * (j))
#define XB_XSUB(j)  (1280 + 64 * (j))
#define XB_XGEN(j)  (2304 + 64 * (j))
#define XB_TOP      3328
#define XB_TOPGEN   3392
#define XCD_BAR_WORDS 3456
#define XB_SPIN_CAP (1u << 18)

__device__ __forceinline__ unsigned xb_ld(unsigned* p)              { return __hip_atomic_load(p, __ATOMIC_RELAXED, __HIP_MEMORY_SCOPE_AGENT); }
__device__ __forceinline__ unsigned xb_add(unsigned* p, unsigned v) { return __hip_atomic_fetch_add(p, v, __ATOMIC_RELAXED, __HIP_MEMORY_SCOPE_AGENT); }
__device__ __forceinline__ unsigned xb_xcc_id() { return (unsigned)__builtin_amdgcn_s_getreg((3 << 11) | 20) & 0xFu; }
#define XB_SPIN(cond, bar) do { unsigned _sp = 0; while (cond) { __builtin_amdgcn_s_sleep(1); \
    if ((++_sp & 255u) == 0u) { if (xb_ld(&(bar)[XB_TMO])) break; if (_sp > XB_SPIN_CAP) { atomicAdd(&(bar)[XB_TMO], 1u); break; } } } } while (0)

struct XcdBarrier {
    unsigned* bar; unsigned x;
    volatile LAS unsigned* st;
};
__device__ __forceinline__ XcdBarrier xcd_barrier_post(unsigned* bar, volatile LAS unsigned* st) {
    XcdBarrier b; b.bar = bar; b.x = xb_xcc_id(); b.st = st;
    if (threadIdx.x == 0) (void)xb_add(&bar[XB_XCNT(b.x)], 1u);
    return b;
}
__device__ __forceinline__ void xcd_barrier_complete(unsigned* bar, unsigned x, unsigned& nloc, unsigned& nx) {
    const unsigned G = gridDim.x * gridDim.y * gridDim.z;
    unsigned sum, cnt, mine, sp = 0u;
    for (;;) {
        sum = 0u; cnt = 0u; mine = 0u;
#pragma unroll
        for (unsigned j = 0; j < 16; ++j) { const unsigned c = xb_ld(&bar[XB_XCNT(j)]); sum += c; cnt += (c > 0u) ? 1u : 0u; mine = (j == x) ? c : mine; }
        if (sum == G) break;
        __builtin_amdgcn_s_sleep(1);
        if ((++sp & 255u) == 0u) { if (xb_ld(&bar[XB_TMO])) break; if (sp > XB_SPIN_CAP) { atomicAdd(&bar[XB_TMO], 1u); break; } }
    }
    nloc = mine > 0u ? mine : 1u; nx = cnt > 0u ? cnt : 1u;
}
__device__ __forceinline__ void xcd_barrier(const XcdBarrier& b) {
    asm volatile("s_waitcnt vmcnt(0)" ::: "memory");
    __syncthreads();
    if (threadIdx.x == 0) {
        unsigned* bar = b.bar;
        __builtin_amdgcn_s_waitcnt(0);
        unsigned nloc = b.st[0], nx = b.st[1];
        if (nloc == 0u) { xcd_barrier_complete(bar, b.x, nloc, nx); b.st[0] = nloc; b.st[1] = nx; }
        const unsigned old = xb_add(&bar[XB_XSUB(b.x)], 1u);
        const unsigned gen = old / nloc;
        if (old + 1u == (gen + 1u) * nloc) {
            __builtin_amdgcn_fence(__ATOMIC_RELEASE, "agent");
            asm volatile("s_waitcnt vmcnt(0)" ::: "memory");
            const unsigned og = xb_add(&bar[XB_TOP], 1u);
            const unsigned tg = og / nx;
            if (og + 1u == (tg + 1u) * nx) xb_add(&bar[XB_TOPGEN], 1u);
            else XB_SPIN(xb_ld(&bar[XB_TOPGEN]) == tg, bar);
            __builtin_amdgcn_fence(__ATOMIC_ACQUIRE, "agent");
            xb_add(&bar[XB_XGEN(b.x)], 1u);
            asm volatile("s_waitcnt vmcnt(0)" ::: "memory");
        } else {
            XB_SPIN(xb_ld(&bar[XB_XGEN(b.x)]) == gen, bar);
            __builtin_amdgcn_fence(__ATOMIC_ACQUIRE, "agent");
            asm volatile("s_waitcnt vmcnt(0)" ::: "memory");
        }
    }
    __syncthreads();
}

constexpr int NTHR = 512, NBLK = 256;
constexpr int LDS_MAIN = 159744, LDS_BYTES = LDS_MAIN + 64;
extern __shared__ __attribute__((aligned(16))) char dyn_smem[];

DI int pull_work(unsigned* q, char* smem, int tid, int step) {
    LAS int* bw = (LAS int*)(smem + LDS_MAIN + 32);
    __syncthreads();
    if (tid == 0) *bw = (int)__hip_atomic_fetch_add(q, (unsigned)step, __ATOMIC_RELAXED, __HIP_MEMORY_SCOPE_AGENT);
    __syncthreads();
    return *bw;
}

#define PH_IDS int tid = threadIdx.x; asm volatile("" : "+v"(tid)); const int wave = tid >> 6, lane = tid & 63, gw = bid * 8 + wave; (void)wave; (void)lane; (void)gw;
__global__ void __launch_bounds__(NTHR, 2) k_mega(Params p) {
    const int bid = blockIdx.x, nblk = gridDim.x, ngw = nblk * 8;
    char* smem = dyn_smem;
    if (threadIdx.x == 0) *(u32x4*)(smem + LDS_MAIN) = (u32x4){0u, 0u, 0u, 0u};
    __syncthreads();
    XcdBarrier bar = xcd_barrier_post(p.ctl(), (volatile LAS unsigned*)(smem + LDS_MAIN));
    { PH_IDS phase_convert(p, smem, 0, gw, ngw, wave, lane); }
    xcd_barrier(bar);
    { EpiProj e{p.RSTD1(), p.PROJ(), p.out}; g8::gemm_phase<false>(p.XB(), 1024, p.WIN_T(), 1024, MP / 256, INW / 256, (bf16_t*)smem, e, bid, nblk); }
    { PH_IDS constexpr int G1_REM = (MP / 256) * (INW / 256) % NBLK;
      if (bid >= G1_REM) phase_convert(p, smem, 1, (bid - G1_REM) * 8 + wave, (nblk - G1_REM) * 8, wave, lane); }
    xcd_barrier(bar);
    { PH_IDS phase_prep(p, smem, bid, nblk, gw, ngw, tid, lane); }
    xcd_barrier(bar);
    { PH_IDS unsigned short pre[48]; chunk_prefetch(p, bid, tid, pre); for (int u = bid; u < CK_UNITS; u += nblk) chunk_pass1(p, smem, u, u + nblk, pre, tid); }
    {
        asm volatile("s_waitcnt vmcnt(0)" ::: "memory");
        __syncthreads();
        unsigned* cnt = p.ctl() + CTL_P3A_DONE;
        if (threadIdx.x == 0) {
            __builtin_amdgcn_fence(__ATOMIC_RELEASE, "agent");
            asm volatile("s_waitcnt vmcnt(0)" ::: "memory");
            (void)xb_add(cnt, 1u);
            if (bid < 64) {
                XB_SPIN(xb_ld(cnt) < (unsigned)nblk, p.ctl());
                __builtin_amdgcn_fence(__ATOMIC_ACQUIRE, "agent");
                asm volatile("s_waitcnt vmcnt(0)" ::: "memory");
            }
        }
        if (bid < 64) __syncthreads();
    }
    {
        PH_IDS
        volatile LAS int* prog = (volatile LAS int*)(smem + LDS_MAIN + 48);
        if (tid == 0) *prog = 0;
        __syncthreads();
        if (bid < 64) {
            if (wave == 0) chunk_pass2(p, bid, lane, prog);
            else if (wave == 1) chunk_pass2_prefetch(p, bid, lane, prog);
            else {
                while (*prog < CK_N) {
                    int u = 0; if (lane == 0) u = (int)__hip_atomic_fetch_add(p.ctl() + CTL_Q_SATTN, 1u, __ATOMIC_RELAXED, __HIP_MEMORY_SCOPE_AGENT);
                    u = __builtin_amdgcn_readfirstlane(u);
                    if (u >= SA_UNITS) break;
                    sattn_unit(p, u, lane);
                }
            }
        }
        else if (bid >= 128) rwkv_sample_unit(p, (bid - 128) * 2 + (tid >> 8), tid & 255);
    }
    {
        PH_IDS
        const float lam = compute_lam(p, lane);
        for (;;) {
            const int idx = pull_work(p.ctl() + CTL_Q_ATTN, smem, tid, 1);
            if (idx >= AT_UNITS) break;
            const int qbi = idx >> 4, bh = idx & 15, qb = qbi < 32 ? 31 - qbi : 32;
            attn_unit(p, smem, bh >> 2, bh & 3, qb, lam, alibi_dmax(p, bh & 3, lane), tid);
        }
    }
    {
        PH_IDS
        for (;;) {
            const int u0 = pull_work(p.ctl() + CTL_Q_SATTN, smem, tid, 8);
            if (u0 >= SA_UNITS) break;
            if (u0 + wave < SA_UNITS) sattn_unit(p, u0 + wave, lane);
        }
    }
    xcd_barrier(bar);
    {
        PH_IDS
        for (int u = gw; u < 2 * CK_UNITS; u += ngw) chunk_pass3(p, u, lane);
        if (gw >= 64 && gw < 64 + MS) rwkv_post_row(p, MPR + gw - 64, lane);
        const float lam = compute_lam(p, lane);
        if (gw >= 64 + MS && gw < 64 + MS + MS * 4) sattn_combine(p, gw - 64 - MS, lam, lane);
    }
    xcd_barrier(bar);
    { PH_IDS
      skinny_gemm(p.YO(), 1024, p.WRW_T(), 512, 1024, smem, bid, nblk, tid, [&](int row, int col, float v) { p.MIXF()[(size_t)row * DM + col] = v * sigmoidf_(bf2f(p.PROJ()[(size_t)row * INW + O_GA + col])); });
      skinny_gemm(p.YO() + 512, 1024, p.WDA_T(), 512, 1024, smem, bid, nblk, tid, [&](int row, int col, float v) { p.MIX()[(size_t)row * DM + col] = bf16_1(p.MIXF()[(size_t)row * DM + col] + v * sigmoidf_(bf2f(p.PROJ()[(size_t)row * INW + O_GB + col]))); }); }
    { EpiBr1 e{p.PROJ(), p.MIX()}; g8::gemm_phase<true>(p.YO(), 1024, p.WRW_T(), 512, 64, 4, (bf16_t*)smem, e, bid, nblk); }
    { EpiBr2 e{p.PROJ(), p.MIX()}; g8::gemm_phase<true>(p.YO() + 512, 1024, p.WDA_T(), 512, 64, 4, (bf16_t*)smem, e, bid, nblk); }
    xcd_barrier(bar);
    { PH_IDS
      skinny_gemm(p.MIX(), 1024, p.WOUT_T(), 1024, 1024, smem, bid, nblk, tid, [&](int row, int col, float v) {
          const float h = p.x_sample[(size_t)(row - MPR) * DM + col] + v; p.H1()[(size_t)row * DM + col] = h; p.HB()[(size_t)row * DM + col] = bf16_1(h);
          float ss = h * h; ss += __shfl_xor(ss, 1); ss += __shfl_xor(ss, 2); ss += __shfl_xor(ss, 4); ss += __shfl_xor(ss, 8); ss += __shfl_xor(ss, 16);
          if ((lane & 31) == 0) atomicAdd(p.SS2() + row, ss); }); }
    { EpiOut e{p.XPTR(), p.H1(), p.HB(), p.SS2()}; g8::gemm_phase<true>(p.MIX(), 1024, p.WOUT_T(), 1024, 64, 4, (bf16_t*)smem, e, bid, nblk); }
    xcd_barrier(bar);
    { PH_IDS
      skinny_gemm(p.HB(), 1024, p.WQ_T(), 1024, 2048, smem, bid, nblk, tid, [&](int row, int col, float v) { p.QP()[(size_t)row * 2048 + col] = bf16_1(v * rsqrtf(p.SS2()[row] * (1.f / DM) + 1e-6f)); }); }
    { EpiQ e{p.SS2(), p.QP()}; g8::gemm_phase<true>(p.HB(), 1024, p.WQ_T(), 1024, 64, 8, (bf16_t*)smem, e, bid, nblk); }
    xcd_barrier(bar);
    {
        PH_IDS
        for (int ch = tid; ch < 256 * 16; ch += 512) { const int r = ch >> 4, cc = ch & 15; *(u32x4*)(smem + 16384 + r * 272 + cc * 16) = *(const u32x4*)(p.SK() + (size_t)r * 128 + cc * 8); }
        __syncthreads();
        for (int u = gw; u < (MTOT / 32) * 8; u += ngw) topk_unit(p, smem + 16384, smem + wave * 2048, u, lane);
        constexpr int TK_REM = (MTOT / 32) * 8 - 2 * NBLK * 8;
        if (gw >= TK_REM) { const int cw = gw - TK_REM, ncw = ngw - TK_REM;
            for (int it = cw; it < 32768; it += ncw) { if (it < 16384) convert_row_fp4(p.peer_u, (unsigned char*)p.U16(), p.USC(), it, lane); else convert_row_fp4(p.peer_v, (unsigned char*)p.V16(), p.VSC(), it - 16384, lane); } }
    }
    xcd_barrier(bar);
    {
        PH_IDS
#pragma unroll 1
        for (int pass = 0; pass < 5; ++pass) {
            const int ci0 = pass < 4 ? bid * 64 + wave * 8 + 2 * pass : NB * SEQ + bid;
            const int ntok = pass < 4 ? 2 : ((bid < MS && wave == 0) ? 1 : 0);
            if (ntok > 0) experts_wave4(p, smem, wave, lane, ci0, ntok);
        }
    }
}

extern "C" void kernel_launch(void* const* d_in, const int* in_sizes, int n_in, void* d_out, int out_size, void* d_ws, size_t ws_size, hipStream_t stream) {
    Params p{};
    p.x_prompt = (const float*)d_in[0]; p.x_sample = (const float*)d_in[1]; p.cache_k = (const float*)d_in[2]; p.cache_v = (const float*)d_in[3];
    p.state_wkv = (const float*)d_in[4]; p.state_shift = (const float*)d_in[5]; p.page_table = (const int*)d_in[6];
    p.meta = (const float*)d_in[7]; p.norm1_g = (const float*)d_in[8]; p.w_in = (const float*)d_in[9]; p.rw_mu = (const float*)d_in[10]; p.rw_w0 = (const float*)d_in[11];
    p.rw_w2 = (const float*)d_in[12]; p.rw_a0 = (const float*)d_in[13]; p.rw_a2 = (const float*)d_in[14]; p.rw_g2 = (const float*)d_in[15]; p.rw_kk = (const float*)d_in[16];
    p.rw_ka = (const float*)d_in[17]; p.rw_rk = (const float*)d_in[18]; p.rw_ln_g = (const float*)d_in[19]; p.rw_ln_b = (const float*)d_in[20]; p.w_rw_br = (const float*)d_in[21];
    p.da_qn_g = (const float*)d_in[22]; p.da_kn_g = (const float*)d_in[23]; p.da_lam = (const float*)d_in[24]; p.da_subln_g = (const float*)d_in[25]; p.w_da_br = (const float*)d_in[26];
    p.w_out = (const float*)d_in[27]; p.norm2_g = (const float*)d_in[28]; p.peer_wq = (const float*)d_in[29]; p.peer_subkeys = (const float*)d_in[30]; p.peer_u = (const float*)d_in[31];
    p.peer_v = (const float*)d_in[32];
    (void)in_sizes; (void)n_in; (void)out_size; (void)ws_size;
    p.out = (float*)d_out;
    p.ws = (char*)d_ws;
    static bool attr_done = false;
    if (!attr_done) { (void)hipFuncSetAttribute((const void*)k_mega, hipFuncAttributeMaxDynamicSharedMemorySize, LDS_BYTES); attr_done = true; }
    (void)hipMemsetAsync(p.ws + WO_ctl, 0, CTL_WORDS * 4, stream);
    k_mega<<<NBLK, NTHR, LDS_BYTES, stream>>>(p);
}
```

```cpp
#include <hip/hip_runtime.h>
#include <stdint.h>
#include <stdio.h>

#define DI __device__ __forceinline__
#define LAS __attribute__((address_space(3)))
typedef unsigned short bf16_t;
typedef short bf16x8 __attribute__((ext_vector_type(8)));
typedef short s16x4 __attribute__((ext_vector_type(4)));
typedef float f32x2 __attribute__((ext_vector_type(2)));
typedef float f32x4 __attribute__((ext_vector_type(4)));
typedef float f32x16 __attribute__((ext_vector_type(16)));
typedef unsigned u32x2 __attribute__((ext_vector_type(2)));
typedef unsigned u32x4 __attribute__((ext_vector_type(4)));
typedef __bf16 bf16v2 __attribute__((ext_vector_type(2)));

constexpr int DM = 1024, NB = 4, SEQ = 4096, NMETA = 16, TT = SEQ + NMETA  ;
constexpr int MPR = NB * TT  , MS = 32, MTOT = MPR + MS  , MP = 16640  ;
constexpr int RWP = 1792, INW = 5376;
constexpr int O_Q = 1792, O_K = 2304, O_V = 2816, O_GA = 3328, O_GB = 4352;
constexpr int NPAGES = 64, PAGE = 128, PAST = 8192;
constexpr float LOG2E = 1.4426950408889634f;
constexpr float LAM_INIT = 0.2f;
constexpr size_t OUT_YP = 0, OUT_YS = OUT_YP + (size_t)NB * SEQ * DM, OUT_KP = OUT_YS + (size_t)MS * DM, OUT_VP = OUT_KP + (size_t)MPR * 512,
                 OUT_KS = OUT_VP + (size_t)MPR * 512, OUT_VS = OUT_KS + (size_t)MS * 512, OUT_WP = OUT_VS + (size_t)MS * 512,
                 OUT_WS = OUT_WP + (size_t)NB * 8 * 4096, OUT_SP = OUT_WS + (size_t)MS * 8 * 4096, OUT_SS = OUT_SP + (size_t)NB * RWP,
                 OUT_END = OUT_SS + (size_t)MS * RWP;

constexpr int SA_SPLITS = 16, SA_UNITS = MS * 4 * SA_SPLITS;
constexpr int CK_N = 65, CK_UNITS = 32 * CK_N;
constexpr int TTP = CK_N * 64;
constexpr int CTL_WORDS = 8192, CTL_Q_ATTN = 4096, CTL_Q_SATTN = 4096 + 64, CTL_P3A_DONE = 4096 + 512;
constexpr size_t ws_al(size_t b) { return (b + 255) & ~(size_t)255; }
constexpr size_t WO_ctl = 0;
constexpr size_t WO_XB = WO_ctl + ws_al(CTL_WORDS * 4);
constexpr size_t WO_WIN_T = WO_XB + ws_al((size_t)MP * DM * 2);
constexpr size_t WO_WRW_T = WO_WIN_T + ws_al((size_t)INW * DM * 2);
constexpr size_t WO_WDA_T = WO_WRW_T + ws_al((size_t)1024 * 512 * 2);
constexpr size_t WO_WOUT_T = WO_WDA_T + ws_al((size_t)1024 * 512 * 2);
constexpr size_t WO_WQ_T = WO_WOUT_T + ws_al((size_t)1024 * 1024 * 2);
constexpr size_t WO_W2_T = WO_WQ_T + ws_al((size_t)2048 * 1024 * 2);
constexpr size_t WO_A2_T = WO_W2_T + ws_al(512 * 64 * 2);
constexpr size_t WO_G2_T = WO_A2_T + ws_al(512 * 64 * 2);
constexpr size_t WO_SK = WO_G2_T + ws_al(512 * 128 * 2);
constexpr size_t WO_U16 = WO_SK + ws_al(2 * 128 * 128 * 2);
constexpr size_t WO_V16 = WO_U16 + ws_al((size_t)16384 * DM * 2);
constexpr size_t WO_PROJ = WO_V16 + ws_al((size_t)16384 * DM * 2);
constexpr size_t WO_QN = WO_PROJ + ws_al((size_t)MP * INW * 2);
constexpr size_t WO_KN = WO_QN + ws_al((size_t)MP * 512 * 2);
constexpr size_t WO_SCAN = WO_KN + ws_al((size_t)MP * 512 * 2);
constexpr size_t WO_G = WO_SCAN + ws_al((size_t)32 * 6 * 64 * TTP * 2);
constexpr size_t WO_YO = WO_G + ws_al((size_t)MP * 512 * 2);
constexpr size_t WO_MIX = WO_YO + ws_al((size_t)MP * DM * 2);
constexpr size_t WO_HB = WO_MIX + ws_al((size_t)MP * DM * 2);
constexpr size_t WO_QP = WO_HB + ws_al((size_t)MP * DM * 2);
constexpr size_t WO_RSTD1 = WO_QP + ws_al((size_t)MP * 2048 * 2);
constexpr size_t WO_BONUS = WO_RSTD1 + ws_al((size_t)MP * 4);
constexpr size_t WO_Y = WO_BONUS + ws_al((size_t)MP * 8 * 4);
constexpr size_t WO_MIXF = WO_Y + ws_al((size_t)MP * 512 * 4);
constexpr size_t WO_H1 = WO_MIXF + ws_al((size_t)MP * DM * 4);
constexpr size_t WO_SS2 = WO_H1 + ws_al((size_t)MP * DM * 4);
constexpr size_t WO_GATE = WO_SS2 + ws_al((size_t)MP * 4);
constexpr size_t WO_PART = WO_GATE + ws_al((size_t)MP * 128 * 4);
constexpr size_t WO_SCAN_S = WO_PART + ws_al((size_t)SA_UNITS * 2 * 130 * 4);
constexpr size_t WO_IDX = WO_SCAN_S + ws_al((size_t)MS * 8 * 384 * 4);
constexpr size_t WO_XPTR = WO_IDX + ws_al((size_t)MP * 128 * 4);
constexpr size_t WO_ZROW = WO_XPTR + ws_al((size_t)MP * 8);
constexpr size_t WO_MYT = WO_ZROW + ws_al(4096);
constexpr size_t WO_MST = WO_MYT + ws_al((size_t)CK_UNITS * 4096 * 2);
constexpr size_t WO_PLV = WO_MST + ws_al((size_t)CK_UNITS * 4096 * 2);
constexpr size_t WO_WYT = WO_PLV + ws_al((size_t)CK_UNITS * 64 * 4);
constexpr size_t WO_WST = WO_WYT + ws_al((size_t)CK_UNITS * 4096 * 4);
constexpr size_t WO_SCF = WO_WST + ws_al((size_t)CK_UNITS * 4096 * 4);
constexpr size_t WS_END = WO_SCF + ws_al((size_t)CK_UNITS * 16 * 64 * 16);
struct Params {
    const float *x_prompt, *x_sample, *cache_k, *cache_v, *state_wkv, *state_shift; const int* page_table;
    const float *meta, *norm1_g, *w_in, *rw_mu, *rw_w0, *rw_w2, *rw_a0, *rw_a2, *rw_g2, *rw_kk, *rw_ka, *rw_rk, *rw_ln_g, *rw_ln_b, *w_rw_br,
        *da_qn_g, *da_kn_g, *da_lam, *da_subln_g, *w_da_br, *w_out, *norm2_g, *peer_wq, *peer_subkeys, *peer_u, *peer_v;
    float* out; char* ws;
    DI unsigned* ctl() const { return (unsigned*)(ws + WO_ctl); }
    DI bf16_t* XB() const { return (bf16_t*)(ws + WO_XB); }
    DI bf16_t* WIN_T() const { return (bf16_t*)(ws + WO_WIN_T); }
    DI bf16_t* WRW_T() const { return (bf16_t*)(ws + WO_WRW_T); }
    DI bf16_t* WDA_T() const { return (bf16_t*)(ws + WO_WDA_T); }
    DI bf16_t* WOUT_T() const { return (bf16_t*)(ws + WO_WOUT_T); }
    DI bf16_t* WQ_T() const { return (bf16_t*)(ws + WO_WQ_T); }
    DI bf16_t* W2_T() const { return (bf16_t*)(ws + WO_W2_T); }
    DI bf16_t* A2_T() const { return (bf16_t*)(ws + WO_A2_T); }
    DI bf16_t* G2_T() const { return (bf16_t*)(ws + WO_G2_T); }
    DI bf16_t* SK() const { return (bf16_t*)(ws + WO_SK); }
    DI bf16_t* U16() const { return (bf16_t*)(ws + WO_U16); }
    DI bf16_t* V16() const { return (bf16_t*)(ws + WO_V16); }
    DI float* USC() const { return (float*)(ws + WO_U16 + ((size_t)16 << 20)); }
    DI float* VSC() const { return (float*)(ws + WO_V16 + ((size_t)16 << 20)); }
    DI bf16_t* PROJ() const { return (bf16_t*)(ws + WO_PROJ); }
    DI bf16_t* QN() const { return (bf16_t*)(ws + WO_QN); }
    DI bf16_t* KN() const { return (bf16_t*)(ws + WO_KN); }
    DI bf16_t* SCAN() const { return (bf16_t*)(ws + WO_SCAN); }
    DI bf16_t* G() const { return (bf16_t*)(ws + WO_G); }
    DI bf16_t* YO() const { return (bf16_t*)(ws + WO_YO); }
    DI bf16_t* MIX() const { return (bf16_t*)(ws + WO_MIX); }
    DI bf16_t* HB() const { return (bf16_t*)(ws + WO_HB); }
    DI bf16_t* QP() const { return (bf16_t*)(ws + WO_QP); }
    DI float* RSTD1() const { return (float*)(ws + WO_RSTD1); }
    DI float* BONUS() const { return (float*)(ws + WO_BONUS); }
    DI float* Y() const { return (float*)(ws + WO_Y); }
    DI float* MIXF() const { return (float*)(ws + WO_MIXF); }
    DI float* H1() const { return (float*)(ws + WO_H1); }
    DI float* SS2() const { return (float*)(ws + WO_SS2); }
    DI float* GATE() const { return (float*)(ws + WO_GATE); }
    DI float* PART() const { return (float*)(ws + WO_PART); }
    DI float* SCAN_S() const { return (float*)(ws + WO_SCAN_S); }
    DI int* IDX() const { return (int*)(ws + WO_IDX); }
    DI const float** XPTR() const { return (const float**)(ws + WO_XPTR); }
    DI float* ZROW() const { return (float*)(ws + WO_ZROW); }
    DI bf16_t* MYT() const { return (bf16_t*)(ws + WO_MYT); }
    DI bf16_t* MST() const { return (bf16_t*)(ws + WO_MST); }
    DI float* PLV() const { return (float*)(ws + WO_PLV); }
    DI float* WYT() const { return (float*)(ws + WO_WYT); }
    DI float* WST() const { return (float*)(ws + WO_WST); }
    DI unsigned* SCF() const { return (unsigned*)(ws + WO_SCF); }
};


DI size_t scan_addr(int chain, int vec, int d, int t) { return (((size_t)chain * 6 + vec) * 64 + d) * TTP + t; }
DI float bf2f(unsigned h) { return __uint_as_float(h << 16); }
DI float bflo(unsigned w) { return __uint_as_float(w << 16); }
DI float bfhi(unsigned w) { return __uint_as_float(w & 0xffff0000u); }
DI unsigned pk2(float lo, float hi) { f32x2 v = {lo, hi}; bf16v2 b = __builtin_convertvector(v, bf16v2); return __builtin_bit_cast(unsigned, b); }
DI unsigned short bf16_1_(float x) { return (unsigned short)(pk2(x, 0.f) & 0xffffu); }
DI float wave_sum(float v) {
#pragma unroll
    for (int o = 1; o < 64; o <<= 1) v += __shfl_xor(v, o);
    return v;
}
DI float sigmoidf_(float x) { return __builtin_amdgcn_rcpf(1.f + __expf(-x)); }
DI void unpack8(const u32x4& w, float (&f)[8]) {
    f[0] = bflo(w.x); f[1] = bfhi(w.x); f[2] = bflo(w.y); f[3] = bfhi(w.y); f[4] = bflo(w.z); f[5] = bfhi(w.z); f[6] = bflo(w.w); f[7] = bfhi(w.w);
}
DI const float* xrow_ptr(const Params& p, int row) {
    if (row < MPR) { const int b = row / TT, t = row - b * TT; return t < NMETA ? p.meta + (size_t)t * DM : p.x_prompt + ((size_t)b * SEQ + (t - NMETA)) * DM; }
    if (row < MTOT) return p.x_sample + (size_t)(row - MPR) * DM;
    return nullptr;
}

DI void transpose_item(const float* __restrict__ W, int K, int N, const float* __restrict__ gain, bf16_t* __restrict__ WT, LAS float* scr, int item, int lane) {
    const int nblk = N / 32, kb = item / nblk, nb = item - kb * nblk, k0 = 64 * kb, n0 = 32 * nb;
#pragma unroll 8
    for (int i = 0; i < 32; ++i) { const int kk = 2 * i + (lane >> 5); float g = gain ? gain[k0 + kk] : 1.f; scr[kk * 33 + (lane & 31)] = g * W[(size_t)(k0 + kk) * N + n0 + (lane & 31)]; }
    __builtin_amdgcn_s_waitcnt(0xc07f); asm volatile("" ::: "memory");
    const int c = lane & 7;
#pragma unroll
    for (int j = 0; j < 4; ++j) { const int n = (lane >> 3) + 8 * j; const LAS float* s = scr + (8 * c) * 33 + n;
        u32x4 o; o.x = pk2(s[0 * 33], s[1 * 33]); o.y = pk2(s[2 * 33], s[3 * 33]); o.z = pk2(s[4 * 33], s[5 * 33]); o.w = pk2(s[6 * 33], s[7 * 33]);
        *(u32x4*)(WT + (size_t)(n0 + n) * K + k0 + 8 * c) = o; }
    __builtin_amdgcn_s_waitcnt(0xc07f); asm volatile("" ::: "memory");
}
DI void convert_chunk(const float* __restrict__ src, bf16_t* __restrict__ dst, int item, int lane) {
    const size_t base = (size_t)item * 4096;
#pragma unroll
    for (int j = 0; j < 8; ++j) { const size_t o = base + (size_t)(j * 64 + lane) * 8;
        const f32x4 a = *(const f32x4*)(src + o), b = *(const f32x4*)(src + o + 4);
        u32x4 w; w.x = pk2(a.x, a.y); w.y = pk2(a.z, a.w); w.z = pk2(b.x, b.y); w.w = pk2(b.z, b.w);
        *(u32x4*)(dst + o) = w; }
}
constexpr float U8_SCALE = 256.f, V8_SCALE = 64.f;
DI void convert_chunk_fp8(const float* __restrict__ src, unsigned char* __restrict__ dst, float scale, int item, int lane) {
    const size_t base = (size_t)item * 4096;
#pragma unroll
    for (int j = 0; j < 4; ++j) { const size_t o = base + (size_t)(j * 64 + lane) * 16;
        u32x4 w;
#pragma unroll
        for (int q = 0; q < 4; ++q) { const f32x4 a = *(const f32x4*)(src + o + 4 * q);
            int pk = __builtin_amdgcn_cvt_pk_fp8_f32(a.x * scale, a.y * scale, 0, false); pk = __builtin_amdgcn_cvt_pk_fp8_f32(a.z * scale, a.w * scale, pk, true); w[q] = (unsigned)pk; }
        *(u32x4*)(dst + o) = w; }
}
DI unsigned fp6_code(float x, float s) {
    const float a = fminf(fabsf(x) * s, 7.5f);
    const float c = a < 2.f ? rintf(a * 8.f) : (a < 4.f ? 16.f + rintf((a - 2.f) * 4.f) : 24.f + rintf((a - 4.f) * 2.f));
    return (unsigned)c | (x < 0.f ? 32u : 0u);
}
DI void convert_row_fp6(const float* __restrict__ src, unsigned char* __restrict__ dst, float* __restrict__ sc, int row, int lane) {
    const float* sp = src + (size_t)row * DM + lane * 16;
    f32x4 v[4]; float am = 0.f;
#pragma unroll
    for (int q = 0; q < 4; ++q) { v[q] = *(const f32x4*)(sp + 4 * q); am = fmaxf(am, fmaxf(fmaxf(fabsf(v[q].x), fabsf(v[q].y)), fmaxf(fabsf(v[q].z), fabsf(v[q].w)))); }
#pragma unroll
    for (int o = 32; o; o >>= 1) am = fmaxf(am, __shfl_xor(am, o));
    const float s = am > 0.f ? 7.5f / am : 0.f;
    if (lane == 0) sc[row] = am * (1.f / 7.5f);
    unsigned long long lo = 0; unsigned hi = 0;
#pragma unroll
    for (int i = 0; i < 16; ++i) {
        const unsigned c = fp6_code(v[i >> 2][i & 3], s);
        if (i < 10) lo |= (unsigned long long)c << (6 * i);
        else if (i == 10) { lo |= (unsigned long long)(c & 15u) << 60; hi |= c >> 4; }
        else hi |= c << (6 * i - 64);
    }
    unsigned* dp = (unsigned*)(dst + (size_t)row * 768 + lane * 12);
    dp[0] = (unsigned)lo; dp[1] = (unsigned)(lo >> 32); dp[2] = hi;
}
DI void phase_convert(const Params& p, char* smem, int part, int gw, int ngw, int wave, int lane) {
    LAS float* scr = (LAS float*)(smem) + wave * (64 * 33);
    constexpr int I_ROWS = MP;
    constexpr int I_WIN = 16 * (INW / 32), I_RW = 8 * 32, I_DA = 8 * 32, I_OUT = 16 * 32, I_WQ = 16 * 64, I_W2 = 16, I_A2 = 16, I_G2 = 32;
    constexpr int I_SK = 8, I_Z = MP / 256;
    if (part == 0) {
        constexpr int NIT = I_ROWS + I_WIN + I_Z;
        for (int it = gw; it < NIT; it += ngw) {
            int r = it;
            if (r < I_ROWS) {
                const float* src = xrow_ptr(p, r);
                f32x4 v[4]; float ss = 0.f;
#pragma unroll
                for (int j = 0; j < 4; ++j) { v[j] = src ? *(const f32x4*)(src + (j * 64 + lane) * 4) : (f32x4){0.f, 0.f, 0.f, 0.f}; ss += v[j].x * v[j].x + v[j].y * v[j].y + v[j].z * v[j].z + v[j].w * v[j].w; }
                ss = wave_sum(ss);
#pragma unroll
                for (int j = 0; j < 4; ++j) { u32x2 o; o.x = pk2(v[j].x, v[j].y); o.y = pk2(v[j].z, v[j].w); *(u32x2*)(p.XB() + (size_t)r * DM + (j * 64 + lane) * 4) = o; }
                if (lane == 0) { p.RSTD1()[r] = rsqrtf(ss * (1.f / DM) + 1e-6f); p.XPTR()[r] = src ? src : p.ZROW(); }
                continue;
            }
            r -= I_ROWS;
            if (r < I_WIN) { transpose_item(p.w_in, 1024, INW, p.norm1_g, p.WIN_T(), scr, r, lane); continue; } r -= I_WIN;
            { *(f32x4*)(p.SS2() + (size_t)r * 256 + lane * 4) = (f32x4){0.f, 0.f, 0.f, 0.f}; if (r < 4) *(f32x4*)(p.ZROW() + (size_t)r * 256 + lane * 4) = (f32x4){0.f, 0.f, 0.f, 0.f}; }
        }
    } else {
        constexpr int NIT = I_RW + I_DA + I_OUT + I_WQ + I_W2 + I_A2 + I_G2 + I_SK;
        for (int it = gw; it < NIT; it += ngw) {
            int r = it;
            if (r < I_W2) { transpose_item(p.rw_w2, 64, 512, nullptr, p.W2_T(), scr, r, lane); continue; } r -= I_W2;
            if (r < I_A2) { transpose_item(p.rw_a2, 64, 512, nullptr, p.A2_T(), scr, r, lane); continue; } r -= I_A2;
            if (r < I_G2) { transpose_item(p.rw_g2, 128, 512, nullptr, p.G2_T(), scr, r, lane); continue; } r -= I_G2;
            if (r < I_RW) { transpose_item(p.w_rw_br, 512, 1024, nullptr, p.WRW_T(), scr, r, lane); continue; } r -= I_RW;
            if (r < I_DA) { transpose_item(p.w_da_br, 512, 1024, nullptr, p.WDA_T(), scr, r, lane); continue; } r -= I_DA;
            if (r < I_OUT) { transpose_item(p.w_out, 1024, 1024, nullptr, p.WOUT_T(), scr, r, lane); continue; } r -= I_OUT;
            if (r < I_WQ) { transpose_item(p.peer_wq, 1024, 2048, p.norm2_g, p.WQ_T(), scr, r, lane); continue; } r -= I_WQ;
            convert_chunk(p.peer_subkeys, p.SK(), r, lane);
        }
    }
}

DI void convert_row_fp4(const float* __restrict__ src, unsigned char* __restrict__ dst, float* __restrict__ sc, int row, int lane) {
    const float* sp = src + (size_t)row * DM + lane * 16;
    f32x4 v[4]; float am = 0.f;
#pragma unroll
    for (int q = 0; q < 4; ++q) { v[q] = *(const f32x4*)(sp + 4 * q); am = fmaxf(am, fmaxf(fmaxf(fabsf(v[q].x), fabsf(v[q].y)), fmaxf(fabsf(v[q].z), fabsf(v[q].w)))); }
#pragma unroll
    for (int o = 32; o; o >>= 1) am = fmaxf(am, __shfl_xor(am, o));
    const float s = am > 0.f ? 6.f / am : 0.f;
    if (lane == 0) sc[row] = am * (1.f / 6.f);
    unsigned w0 = 0u, w1 = 0u;
    w0 = __builtin_amdgcn_cvt_scalef32_pk_fp4_f32(w0, v[0].x * s, v[0].y * s, 1.0f, 0); w0 = __builtin_amdgcn_cvt_scalef32_pk_fp4_f32(w0, v[0].z * s, v[0].w * s, 1.0f, 1);
    w0 = __builtin_amdgcn_cvt_scalef32_pk_fp4_f32(w0, v[1].x * s, v[1].y * s, 1.0f, 2); w0 = __builtin_amdgcn_cvt_scalef32_pk_fp4_f32(w0, v[1].z * s, v[1].w * s, 1.0f, 3);
    w1 = __builtin_amdgcn_cvt_scalef32_pk_fp4_f32(w1, v[2].x * s, v[2].y * s, 1.0f, 0); w1 = __builtin_amdgcn_cvt_scalef32_pk_fp4_f32(w1, v[2].z * s, v[2].w * s, 1.0f, 1);
    w1 = __builtin_amdgcn_cvt_scalef32_pk_fp4_f32(w1, v[3].x * s, v[3].y * s, 1.0f, 2); w1 = __builtin_amdgcn_cvt_scalef32_pk_fp4_f32(w1, v[3].z * s, v[3].w * s, 1.0f, 3);
    *(u32x2*)(dst + (size_t)row * 512 + lane * 8) = (u32x2){w0, w1};
}

namespace g8 {
constexpr int BM = 256, BK = 64, HALF = 128, HT = HALF * BK, SHM_B = 8 * HT * 2, NXCD = 8, WGM = 8;
DI int lds_byte(int r, int c) { int st = (r >> 4) * 2 + (c >> 5), rr = r & 15, cc = c & 31, ob = rr * 64 + cc * 2; return st * 1024 + (ob ^ (((ob >> 9) & 1) << 5)); }
DI void stage_rc(int b, int& R, int& C) { int st = b / 1024, sb = b % 1024, swz = sb ^ (((sb >> 9) & 1) << 5); R = (st >> 1) * 16 + swz / 64; C = (st & 1) * 32 + (swz % 64) / 2; }
DI void unit_map(int L, int nM, int nN, int& pm, int& pn) {
    const int nwg = nM * nN; int wgid = L;
    { const int q = nwg / NXCD, r = nwg % NXCD, xcd = wgid % NXCD, off = wgid / NXCD; wgid = (xcd < r ? xcd * (q + 1) : r * (q + 1) + (xcd - r) * q) + off; }
    const int nig = WGM * nN, gid = wgid / nig, fm = gid * WGM, gsz = (nM - fm) < WGM ? (nM - fm) : WGM;
    pm = fm + ((wgid % nig) % gsz); pn = (wgid % nig) / gsz;
}
template <class Epi>
DI void gemm_tile(const bf16_t* __restrict__ A, const int lda, const bf16_t* __restrict__ Bt, const int K, const int brow, const int bcol, bf16_t* shm, const Epi& epi) {
#define SA(b, h) (shm + ((b) * 2 + (h)) * HT)
#define SB(b, h) (shm + (4 + (b) * 2 + (h)) * HT)
#define STAGE_X(T, P, BASE, LD, br, kt) do { long _g = (long)(br) * (LD) + (long)(kt) * BK; \
    for (int _i = 0; _i < 2; ++_i) { int _b = (T) * 16 + _i * 8192; int _r, _c; stage_rc(_b, _r, _c); \
      __builtin_amdgcn_global_load_lds((const unsigned*)(BASE + _g + (long)_r * (LD) + _c), (LAS unsigned*)((LAS char*)(P) + _b), 16, 0, 0); } } while (0)
#define STAGEA(P, BASE, br, kt) STAGE_X(tz0, P, BASE, lda, br, kt)
#define STAGEB(P, BASE, br, kt) STAGE_X(tz0, P, BASE, K, br, kt)
#define LDA(dst, b, h) for (int m = 0; m < 4; ++m) for (int k = 0; k < 2; ++k) \
    dst[m][k] = *reinterpret_cast<const bf16x8*>((char*)SA(b, h) + lds_byte(wr * 64 + m * 16 + fr, k * 32 + fq * 8))
#define LDB(dst, b, h) for (int n = 0; n < 2; ++n) for (int k = 0; k < 2; ++k) \
    dst[n][k] = *reinterpret_cast<const bf16x8*>((char*)SB(b, h) + lds_byte(wc * 32 + n * 16 + fr, k * 32 + fq * 8))
#define MMA(ai, bj, At, Bf) do { __builtin_amdgcn_s_setprio(1); \
    for (int m = 0; m < 4; ++m) for (int n = 0; n < 2; ++n) for (int k = 0; k < 2; ++k) \
      acc[ai][bj][m][n] = __builtin_amdgcn_mfma_f32_16x16x32_bf16(Bf[n][k], At[m][k], acc[ai][bj][m][n], 0, 0, 0); \
    __builtin_amdgcn_s_setprio(0); } while (0)
#define WAIT_V(n) asm volatile("s_waitcnt vmcnt(" #n ")" ::: "memory")
#define WAIT_L(n) asm volatile("s_waitcnt lgkmcnt(" #n ")" ::: "memory")
#define BAR __builtin_amdgcn_s_barrier()
#define SCHED __builtin_amdgcn_sched_barrier(0)
    int tz0 = threadIdx.x; asm volatile("" : "+v"(tz0));
    int wid = tz0 >> 6, lane = tz0 & 63, wr = wid >> 2, wc = wid & 3, fr = lane & 15, fq = lane >> 4;
    f32x4 acc[2][2][4][2] = {};
    bf16x8 At[4][2], B0[2][2], B1[2][2];
    const int nt = K / BK;
    STAGEB(SB(0, 0), Bt, bcol, 0); STAGEA(SA(0, 0), A, brow, 0);
    STAGEB(SB(0, 1), Bt, bcol + HALF, 0); STAGEA(SA(0, 1), A, brow + HALF, 0);
    if (wr == 1) BAR;
    WAIT_V(4); BAR;
    STAGEB(SB(1, 0), Bt, bcol, 1); STAGEA(SA(1, 0), A, brow, 1); STAGEB(SB(1, 1), Bt, bcol + HALF, 1);
    WAIT_V(6); BAR;
    for (int t = 0; t < nt - 2; t += 2) {
        LDB(B0, 0, 0); SCHED; LDA(At, 0, 0); STAGEA(SA(1, 1), A, brow + HALF, t + 1);
        WAIT_L(8); BAR; WAIT_L(0); MMA(0, 0, At, B0); BAR; SCHED;
        LDB(B1, 0, 1); STAGEB(SB(0, 0), Bt, bcol, t + 2);
        BAR; WAIT_L(0); MMA(0, 1, At, B1); BAR;
        LDA(At, 0, 1); STAGEA(SA(0, 0), A, brow, t + 2);
        BAR; WAIT_L(0); MMA(1, 0, At, B0); BAR; SCHED;
        STAGEB(SB(0, 1), Bt, bcol + HALF, t + 2);
        WAIT_V(6); BAR; MMA(1, 1, At, B1); BAR;
        LDB(B0, 1, 0); SCHED; LDA(At, 1, 0); STAGEA(SA(0, 1), A, brow + HALF, t + 2);
        WAIT_L(8); BAR; WAIT_L(0); MMA(0, 0, At, B0); BAR; SCHED;
        LDB(B1, 1, 1); STAGEB(SB(1, 0), Bt, bcol, t + 3);
        BAR; WAIT_L(0); MMA(0, 1, At, B1); BAR;
        LDA(At, 1, 1); STAGEA(SA(1, 0), A, brow, t + 3);
        BAR; WAIT_L(0); MMA(1, 0, At, B0); BAR; SCHED;
        STAGEB(SB(1, 1), Bt, bcol + HALF, t + 3);
        WAIT_V(6); BAR; MMA(1, 1, At, B1); BAR;
    }
    int tz = tz0; asm volatile("" : "+v"(tz)); wid = tz >> 6; lane = tz & 63; wr = wid >> 2; wc = wid & 3; fr = lane & 15; fq = lane >> 4;
    { LDB(B0, 0, 0); WAIT_V(0); LDA(At, 0, 0); STAGE_X(tz, SA(1, 1), A, lda, brow + HALF, nt - 1);
      BAR; WAIT_L(0); MMA(0, 0, At, B0); BAR;
      LDB(B1, 0, 1); BAR; WAIT_L(0); MMA(0, 1, At, B1); BAR;
      LDA(At, 0, 1); WAIT_V(4); BAR; WAIT_L(0); MMA(1, 0, At, B0); MMA(1, 1, At, B1); BAR; }
    { LDB(B0, 1, 0); LDA(At, 1, 0); WAIT_V(2); BAR; WAIT_L(0); MMA(0, 0, At, B0); BAR;
      LDB(B1, 1, 1); WAIT_V(0); BAR; WAIT_L(0); MMA(0, 1, At, B1); BAR;
      LDA(At, 1, 1); BAR; WAIT_L(0); MMA(1, 0, At, B0); MMA(1, 1, At, B1); BAR; }
    if (wr == 0) BAR;
    epi(acc, brow, bcol, wr, wc, fr, fq);
#undef SA
#undef SB
#undef STAGE_X
#undef STAGEA
#undef STAGEB
#undef LDA
#undef LDB
#undef MMA
}
template <bool REMAP, class Epi>
DI void gemm_phase(const bf16_t* A, int lda, const bf16_t* Bt, int K, int nM, int nN, bf16_t* shm, const Epi& epi, int bid, int nblk) {
    const int nwg = nM * nN;
    for (int L = bid; L < nwg; L += nblk) {
        int pm, pn; unit_map(L, nM, nN, pm, pn);
        const int brow = REMAP ? (pm >> 4) * TT + NMETA + (pm & 15) * BM : pm * BM;
        gemm_tile(A, lda, Bt, K, brow, pn * BM, shm, epi);
        __syncthreads();
    }
}
}
typedef f32x4 AccT[2][2][4][2];
#define EPI_ROWS_BEGIN _Pragma("unroll") for (int ai = 0; ai < 2; ++ai) _Pragma("unroll") for (int m = 0; m < 4; ++m) { __builtin_amdgcn_sched_barrier(0); asm volatile("" ::: "memory"); const int row = brow + ai * 128 + wr * 64 + m * 16 + fr;
#define EPI_COLS_BEGIN _Pragma("unroll") for (int bj = 0; bj < 2; ++bj) _Pragma("unroll") for (int n = 0; n < 2; ++n) { const int col = bcol + bj * 128 + wc * 32 + n * 16 + fq * 4; const f32x4 a = acc[ai][bj][m][n];

#define EPI_ROW(ai, m) (brow + (ai) * 128 + wr * 64 + (m) * 16 + fr)
#define EPI_COL(bj, n) (bcol + (bj) * 128 + wc * 32 + (n) * 16 + fq * 4)
#define EPI_FENCE do { __builtin_amdgcn_sched_barrier(0); asm volatile("" ::: "memory"); } while (0)
struct EpiProj {
    const float* rstd; bf16_t* PROJ; float* out;
    DI void operator()(const AccT& acc, int brow, int bcol, int wr, int wc, int fr, int fq) const {
        EPI_ROWS_BEGIN
            const float rs = rstd[row];
            float* sh = nullptr;
            if (bcol < RWP) {
                if (row < MPR) { const int b = row / TT; if (row - b * TT == TT - 1) sh = out + OUT_SP + (size_t)b * RWP; }
                else if (row < MTOT) sh = out + OUT_SS + (size_t)(row - MPR) * RWP;
            }
            EPI_COLS_BEGIN
                const f32x4 v = a * rs;
                u32x2 o; o.x = pk2(v.x, v.y); o.y = pk2(v.z, v.w);
                *(u32x2*)(PROJ + (size_t)row * INW + col) = o;
                if (sh) *(f32x4*)(sh + col) = v;
            }
        }
    }
};

DI void prep_qkv_row(const Params& p, int row, int lane) {
    const bf16_t* pr = p.PROJ() + (size_t)row * INW;
    const u32x4 w0 = *(const u32x4*)(pr + O_Q + lane * 16), w1 = *(const u32x4*)(pr + O_Q + lane * 16 + 8);
    float f[16]; { float t0[8], t1[8]; unpack8(w0, t0); unpack8(w1, t1);
#pragma unroll
        for (int i = 0; i < 8; ++i) { f[i] = t0[i]; f[8 + i] = t1[i]; } }
    float ss = 0.f;
#pragma unroll
    for (int i = 0; i < 16; ++i) ss += f[i] * f[i];
    ss += __shfl_xor(ss, 1); ss += __shfl_xor(ss, 2);
    const float rs = rsqrtf(ss * (1.f / 64.f) + 1e-6f);
    const bool isk = lane >= 32;
    const float* gp = (isk ? p.da_kn_g : p.da_qn_g) + (lane & 3) * 16;
#pragma unroll
    for (int i = 0; i < 16; ++i) f[i] = f[i] * rs * gp[i];
    u32x4 o0, o1; o0.x = pk2(f[0], f[1]); o0.y = pk2(f[2], f[3]); o0.z = pk2(f[4], f[5]); o0.w = pk2(f[6], f[7]);
    o1.x = pk2(f[8], f[9]); o1.y = pk2(f[10], f[11]); o1.z = pk2(f[12], f[13]); o1.w = pk2(f[14], f[15]);
    bf16_t* dst = (isk ? p.KN() : p.QN()) + (size_t)row * 512 + (lane & 31) * 16;
    *(u32x4*)dst = o0; *(u32x4*)(dst + 8) = o1;
    float* kout = row < MPR ? p.out + OUT_KP + (size_t)row * 512 : p.out + OUT_KS + (size_t)(row - MPR) * 512;
    float* vout = row < MPR ? p.out + OUT_VP + (size_t)row * 512 : p.out + OUT_VS + (size_t)(row - MPR) * 512;
    if (isk) {
#pragma unroll
        for (int i = 0; i < 4; ++i) *(f32x4*)(kout + (lane - 32) * 16 + 4 * i) = (f32x4){f[4 * i], f[4 * i + 1], f[4 * i + 2], f[4 * i + 3]};
    }
    const u32x4 wv = *(const u32x4*)(pr + O_V + lane * 8);
    float v8[8]; unpack8(wv, v8);
    *(f32x4*)(vout + lane * 8) = (f32x4){v8[0], v8[1], v8[2], v8[3]};
    *(f32x4*)(vout + lane * 8 + 4) = (f32x4){v8[4], v8[5], v8[6], v8[7]};
}

template <int N>
DI void ps_load(const LAS float* pl, const bf16_t* cur, const bf16_t* prevb, const float* prevf, int col0, float (&o)[N]) {
    float c[N], pv[N];
    if (N == 8) { float t[8]; unpack8(*(const u32x4*)(cur + col0), t);
#pragma unroll
        for (int i = 0; i < N; ++i) c[i] = t[i]; }
    else { const u32x2 w = *(const u32x2*)(cur + col0); c[0] = bflo(w.x); c[1] = bfhi(w.x); c[2] = bflo(w.y); c[3] = bfhi(w.y); }
    if (prevb) {
        if (N == 8) { float t[8]; unpack8(*(const u32x4*)(prevb + col0), t);
#pragma unroll
            for (int i = 0; i < N; ++i) pv[i] = t[i]; }
        else { const u32x2 w = *(const u32x2*)(prevb + col0); pv[0] = bflo(w.x); pv[1] = bfhi(w.x); pv[2] = bflo(w.y); pv[3] = bfhi(w.y); }
    } else if (prevf) {
#pragma unroll
        for (int i = 0; i < N; i += 4) { const f32x4 t = *(const f32x4*)(prevf + col0 + i); pv[i] = t.x; pv[i + 1] = t.y; pv[i + 2] = t.z; pv[i + 3] = t.w; }
    } else {
#pragma unroll
        for (int i = 0; i < N; ++i) pv[i] = 0.f;
    }
#pragma unroll
    for (int i = 0; i < N; i += 4) { const f32x4 mu = *(const LAS f32x4*)(pl + col0 + i);
        o[i] = c[i] + (pv[i] - c[i]) * mu.x; o[i + 1] = c[i + 1] + (pv[i + 1] - c[i + 1]) * mu.y;
        o[i + 2] = c[i + 2] + (pv[i + 2] - c[i + 2]) * mu.z; o[i + 3] = c[i + 3] + (pv[i + 3] - c[i + 3]) * mu.w; }
}
DI bf16x8 pack8(const float (&f)[8]) { u32x4 w; w.x = pk2(f[0], f[1]); w.y = pk2(f[2], f[3]); w.z = pk2(f[4], f[5]); w.w = pk2(f[6], f[7]); return __builtin_bit_cast(bf16x8, w); }
#define MFMA32(a, b, c) __builtin_amdgcn_mfma_f32_32x32x16_bf16((a), (b), (c), 0, 0, 0)

DI float tanh_fast(float x) { const float e = __expf(2.f * x); return 1.f - 2.f * __builtin_amdgcn_rcpf(e + 1.f); }
constexpr int PL_W0 = 1792, PL_A0 = 2304, PL_KK = 2816, PL_KA = 3328, PL_RK = 3840, PL_N = 4352;
DI void prep_rwkv_tile(const Params& p, const LAS float* pl, int tile, int lane) {
    const int tk = lane & 31, hh = lane >> 5, row = tile * 32 + tk;
    const bool samp = row >= MPR;
    int b = 0, t = 0;
    if (!samp) { b = row / TT; t = row - b * TT; }
    const bf16_t* cur = p.PROJ() + (size_t)row * INW;
    const bf16_t* prevb = (!samp && t > 0) ? cur - INW : nullptr;
    const float* prevf = samp ? p.state_shift + (size_t)(row - MPR) * RWP : nullptr;
    {
        bf16x8 Bw[4], Ba[4];
#pragma unroll
        for (int s = 0; s < 4; ++s) { float x[8]; ps_load<8>(pl, cur, prevb, prevf, 1536 + 16 * s + 8 * hh, x);
#pragma unroll
            for (int i = 0; i < 8; ++i) x[i] = tanh_fast(x[i]);
            Bw[s] = pack8(x); }
#pragma unroll
        for (int s = 0; s < 4; ++s) { float x[8]; ps_load<8>(pl, cur, prevb, prevf, 1600 + 16 * s + 8 * hh, x); Ba[s] = pack8(x); }
#pragma unroll 1
        for (int hd = 0; hd < 8; ++hd) {
            float kk2 = 0.f;
#pragma unroll 2
            for (int q8 = 0; q8 < 8; ++q8) { const int n = hd * 64 + (q8 >> 2) * 32 + 8 * (q8 & 3) + 4 * hh;
                float k4[4]; ps_load<4>(pl, cur, prevb, prevf, 512 + n, k4); const f32x4 kkp = *(const LAS f32x4*)(pl + PL_KK + n);
                const float a0 = k4[0] * kkp.x, a1 = k4[1] * kkp.y, a2 = k4[2] * kkp.z, a3 = k4[3] * kkp.w; kk2 += a0 * a0 + a1 * a1 + a2 * a2 + a3 * a3; }
            kk2 += __shfl_xor(kk2, 32);
            const float kinv = __builtin_amdgcn_rcpf(fmaxf(__builtin_amdgcn_sqrtf(kk2), 1e-12f));
            float bon = 0.f;
#pragma unroll 1
            for (int nt2 = 0; nt2 < 2; ++nt2) {
                const int n0 = hd * 64 + nt2 * 32;
                f32x16 dW = {}, dA = {};
#pragma unroll
                for (int s = 0; s < 4; ++s) { const bf16x8 aw = *(const bf16x8*)(p.W2_T() + (size_t)(n0 + tk) * 64 + 16 * s + 8 * hh); dW = MFMA32(aw, Bw[s], dW); }
#pragma unroll
                for (int s = 0; s < 4; ++s) { const bf16x8 aa = *(const bf16x8*)(p.A2_T() + (size_t)(n0 + tk) * 64 + 16 * s + 8 * hh); dA = MFMA32(aa, Ba[s], dA); }
#pragma unroll 1
                for (int q4 = 0; q4 < 4; ++q4) {
                    const int d0 = nt2 * 32 + 8 * q4 + 4 * hh, n = hd * 64 + d0;
                    float r4[4], k4[4], v4[4];
                    ps_load<4>(pl, cur, prevb, prevf, n, r4); ps_load<4>(pl, cur, prevb, prevf, 512 + n, k4); ps_load<4>(pl, cur, prevb, prevf, 1024 + n, v4);
                    const f32x4 w0 = *(const LAS f32x4*)(pl + PL_W0 + n), a0 = *(const LAS f32x4*)(pl + PL_A0 + n), kkp = *(const LAS f32x4*)(pl + PL_KK + n), ka = *(const LAS f32x4*)(pl + PL_KA + n), rk = *(const LAS f32x4*)(pl + PL_RK + n);
                    float dl[4], kp[4], av[4], bv[4];
#pragma unroll
                    for (int e = 0; e < 4; ++e) {
                        const float zw = w0[e] + dW[e];
                        const float ez = __expf(-zw);
                        const float sp = (zw > 15.f) ? ez : __logf(1.f + ez);
                        const float ew = __expf(-sp - 0.5f);
                        dl[e] = 1.f - __expf(-ew);
                        const float a = sigmoidf_(a0[e] + dA[e]);
                        const float kkn = k4[e] * kkp[e] * kinv;
                        kp[e] = k4[e] * (1.f + (a - 1.f) * ka[e]);
                        av[e] = -kkn; bv[e] = kkn * a;
                        bon += r4[e] * kp[e] * rk[e];
                    }
                    if (!samp) {
                        bf16_t* so = p.SCAN() + scan_addr(b * 8 + hd, 0, d0, t);
#pragma unroll
                        for (int e = 0; e < 4; ++e) { bf16_t* se = so + (size_t)e * TTP;
                            se[(size_t)0 * 64 * TTP] = bf16_1_(dl[e]); se[(size_t)1 * 64 * TTP] = bf16_1_(kp[e]); se[(size_t)2 * 64 * TTP] = bf16_1_(v4[e]);
                            se[(size_t)3 * 64 * TTP] = bf16_1_(av[e]); se[(size_t)4 * 64 * TTP] = bf16_1_(bv[e]); se[(size_t)5 * 64 * TTP] = bf16_1_(r4[e]); }
                    } else {
                        float* so = p.SCAN_S() + (((size_t)(row - MPR) * 8 + hd) * 6) * 64 + d0;
                        *(f32x4*)(so + 0 * 64) = (f32x4){1.f - dl[0], 1.f - dl[1], 1.f - dl[2], 1.f - dl[3]};
                        *(f32x4*)(so + 1 * 64) = (f32x4){kp[0], kp[1], kp[2], kp[3]};
                        *(f32x4*)(so + 2 * 64) = (f32x4){v4[0], v4[1], v4[2], v4[3]};
                        *(f32x4*)(so + 3 * 64) = (f32x4){av[0], av[1], av[2], av[3]};
                        *(f32x4*)(so + 4 * 64) = (f32x4){bv[0], bv[1], bv[2], bv[3]};
                        *(f32x4*)(so + 5 * 64) = (f32x4){r4[0], r4[1], r4[2], r4[3]};
                    }
                    dW = __builtin_shufflevector(dW, dW, 4, 5, 6, 7, 8, 9, 10, 11, 12, 13, 14, 15, 0, 1, 2, 3);
                    dA = __builtin_shufflevector(dA, dA, 4, 5, 6, 7, 8, 9, 10, 11, 12, 13, 14, 15, 0, 1, 2, 3);
                }
            }
            bon += __shfl_xor(bon, 32);
            if (hh == 0) p.BONUS()[(size_t)row * 8 + hd] = bon;
        }
    }
    __builtin_amdgcn_sched_barrier(0);
    {
        bf16x8 Bg[8];
#pragma unroll
        for (int s = 0; s < 8; ++s) { float x[8]; ps_load<8>(pl, cur, prevb, prevf, 1664 + 16 * s + 8 * hh, x);
#pragma unroll
            for (int i = 0; i < 8; ++i) x[i] = sigmoidf_(x[i]);
            Bg[s] = pack8(x); }
#pragma unroll 1
        for (int nt = 0; nt < 16; ++nt) {
            f32x16 dG = {};
#pragma unroll
            for (int s = 0; s < 8; ++s) { const bf16x8 ag = *(const bf16x8*)(p.G2_T() + (size_t)(nt * 32 + tk) * 128 + 16 * s + 8 * hh); dG = MFMA32(ag, Bg[s], dG); }
#pragma unroll
            for (int q4 = 0; q4 < 4; ++q4) { u32x2 og; og.x = pk2(dG[4 * q4], dG[4 * q4 + 1]); og.y = pk2(dG[4 * q4 + 2], dG[4 * q4 + 3]);
                *(u32x2*)(p.G() + (size_t)row * 512 + nt * 32 + 8 * q4 + 4 * hh) = og; }
        }
    }
}
constexpr int PV_ROWB = 3600, PV_STAGE_OFF = PL_N * 4  , PV_LDS = PV_STAGE_OFF + 33 * PV_ROWB;
template <int N>
DI void ps_lds(const LAS float* pl, const LAS char* curp, const LAS char* prevp, bool pz, int col0, float (&o)[N]) {
    float c[N], pv[N];
    if (N == 8) { const u32x4 wc = *(const LAS u32x4*)(curp + col0 * 2), wp = *(const LAS u32x4*)(prevp + col0 * 2); float t[8]; unpack8(wc, t); float u[8]; unpack8(wp, u);
#pragma unroll
        for (int i = 0; i < N; ++i) { c[i] = t[i]; pv[i] = pz ? 0.f : u[i]; } }
    else { const u32x2 w = *(const LAS u32x2*)(curp + col0 * 2), x = *(const LAS u32x2*)(prevp + col0 * 2);
        c[0] = bflo(w.x); c[1] = bfhi(w.x); c[2] = bflo(w.y); c[3] = bfhi(w.y);
        pv[0] = pz ? 0.f : bflo(x.x); pv[1] = pz ? 0.f : bfhi(x.x); pv[2] = pz ? 0.f : bflo(x.y); pv[3] = pz ? 0.f : bfhi(x.y); }
#pragma unroll
    for (int i = 0; i < N; i += 4) { const f32x4 mu = *(const LAS f32x4*)(pl + col0 + i);
        o[i] = c[i] + (pv[i] - c[i]) * mu.x; o[i + 1] = c[i + 1] + (pv[i + 1] - c[i + 1]) * mu.y;
        o[i + 2] = c[i + 2] + (pv[i + 2] - c[i + 2]) * mu.z; o[i + 3] = c[i + 3] + (pv[i + 3] - c[i + 3]) * mu.w; }
}
DI void prep_block(const Params& p, char* smem, int unit, int tid) {
    const LAS float* pl = (const LAS float*)smem;
    LAS char* stage = (LAS char*)smem + PV_STAGE_OFF;
    const bool samp = unit >= 514;
    const int row0 = samp ? MPR + (unit - 514) * 16 : unit * 32;
    __syncthreads();
#pragma unroll 1
    for (int i0 = 0; i0 < 16; i0 += 8) {
        u32x4 w[8];
#pragma unroll
        for (int i = 0; i < 8; ++i) {
            const int c = tid + 512 * (i0 + i), sl = c / 224, ch = c - sl * 224;
            w[i] = (u32x4){0u, 0u, 0u, 0u};
            if (c < 33 * 224) {
                if (!samp) { int gr = row0 - 1 + sl; gr = gr < 0 ? 0 : gr; w[i] = *(const u32x4*)(p.PROJ() + (size_t)gr * INW + ch * 8); }
                else if (sl < 16) w[i] = *(const u32x4*)(p.PROJ() + (size_t)(row0 + sl) * INW + ch * 8);
                else if (sl < 32) { const float* sp = p.state_shift + (size_t)(row0 - MPR + sl - 16) * RWP + ch * 8; const f32x4 a = *(const f32x4*)sp, b2 = *(const f32x4*)(sp + 4);
                    w[i].x = pk2(a.x, a.y); w[i].y = pk2(a.z, a.w); w[i].z = pk2(b2.x, b2.y); w[i].w = pk2(b2.z, b2.w); }
            }
        }
#pragma unroll
        for (int i = 0; i < 8; ++i) { const int c = tid + 512 * (i0 + i), sl = c / 224, ch = c - sl * 224; if (c < 33 * 224) *(LAS u32x4*)(stage + sl * PV_ROWB + ch * 16) = w[i]; }
    }
    __syncthreads();
    const int hd = tid >> 6, lane = tid & 63, tk = lane & 31, hh = lane >> 5;
    const int ntk = samp ? 16 : 32;
    const int tkc = tk < ntk ? tk : ntk - 1;
    const bool act = tk < ntk;
    const int row = row0 + tkc;
    int b = 0, t = 0; if (!samp) { b = row / TT; t = row - b * TT; }
    const LAS char* curp = stage + (samp ? tkc : tkc + 1) * PV_ROWB;
    const LAS char* prevp = stage + (samp ? 16 + tkc : tkc) * PV_ROWB;
    const bool pz = !samp && t == 0;
    {
        bf16x8 Bw[4], Ba[4];
#pragma unroll
        for (int s2 = 0; s2 < 4; ++s2) { float x[8]; ps_lds<8>(pl, curp, prevp, pz, 1536 + 16 * s2 + 8 * hh, x);
#pragma unroll
            for (int i = 0; i < 8; ++i) x[i] = tanh_fast(x[i]);
            Bw[s2] = pack8(x); }
#pragma unroll
        for (int s2 = 0; s2 < 4; ++s2) { float x[8]; ps_lds<8>(pl, curp, prevp, pz, 1600 + 16 * s2 + 8 * hh, x); Ba[s2] = pack8(x); }
        float kk2 = 0.f;
#pragma unroll 2
        for (int q8 = 0; q8 < 8; ++q8) { const int n = hd * 64 + (q8 >> 2) * 32 + 8 * (q8 & 3) + 4 * hh;
            float k4[4]; ps_lds<4>(pl, curp, prevp, pz, 512 + n, k4); const f32x4 kkp = *(const LAS f32x4*)(pl + PL_KK + n);
            const float a0 = k4[0] * kkp.x, a1 = k4[1] * kkp.y, a2 = k4[2] * kkp.z, a3 = k4[3] * kkp.w; kk2 += a0 * a0 + a1 * a1 + a2 * a2 + a3 * a3; }
        kk2 += __shfl_xor(kk2, 32);
        const float kinv = __builtin_amdgcn_rcpf(fmaxf(__builtin_amdgcn_sqrtf(kk2), 1e-12f));
        float bon = 0.f;
#pragma unroll 1
        for (int nt2 = 0; nt2 < 2; ++nt2) {
            const int n0 = hd * 64 + nt2 * 32;
            f32x16 dW = {}, dA = {};
            {
                bf16x8 aw[4], aa[4];
#pragma unroll
                for (int s2 = 0; s2 < 4; ++s2) { aw[s2] = *(const bf16x8*)(p.W2_T() + (size_t)(n0 + tk) * 64 + 16 * s2 + 8 * hh); aa[s2] = *(const bf16x8*)(p.A2_T() + (size_t)(n0 + tk) * 64 + 16 * s2 + 8 * hh); }
                __builtin_amdgcn_sched_barrier(0);
#pragma unroll
                for (int s2 = 0; s2 < 4; ++s2) { dW = MFMA32(aw[s2], Bw[s2], dW); dA = MFMA32(aa[s2], Ba[s2], dA); }
                __builtin_amdgcn_sched_barrier(0);
            }
#pragma unroll
            for (int q4 = 0; q4 < 4; ++q4) {
                const int d0 = nt2 * 32 + 8 * q4 + 4 * hh, n = hd * 64 + d0;
                float r4[4], k4[4], v4[4];
                ps_lds<4>(pl, curp, prevp, pz, n, r4); ps_lds<4>(pl, curp, prevp, pz, 512 + n, k4); ps_lds<4>(pl, curp, prevp, pz, 1024 + n, v4);
                const f32x4 w0 = *(const LAS f32x4*)(pl + PL_W0 + n), a0 = *(const LAS f32x4*)(pl + PL_A0 + n), kkp = *(const LAS f32x4*)(pl + PL_KK + n), ka = *(const LAS f32x4*)(pl + PL_KA + n), rk = *(const LAS f32x4*)(pl + PL_RK + n);
                float dl[4], kp[4], av[4], bv[4];
#pragma unroll
                for (int e = 0; e < 4; ++e) {
                    const float zw = w0[e] + dW[e];
                    const float ez = __expf(-zw);
                    const float sp = (zw > 15.f) ? ez : __logf(1.f + ez);
                    const float ew = __expf(-sp - 0.5f);
                    dl[e] = 1.f - __expf(-ew);
                    const float a = sigmoidf_(a0[e] + dA[e]);
                    const float kkn = k4[e] * kkp[e] * kinv;
                    kp[e] = k4[e] * (1.f + (a - 1.f) * ka[e]);
                    av[e] = -kkn; bv[e] = kkn * a;
                    bon += r4[e] * kp[e] * rk[e];
                }
                if (act) {
                    if (!samp) {
                        bf16_t* so = p.SCAN() + scan_addr(b * 8 + hd, 0, d0, t);
#pragma unroll
                        for (int e = 0; e < 4; ++e) { bf16_t* se = so + (size_t)e * TTP;
                            se[(size_t)0 * 64 * TTP] = bf16_1_(dl[e]); se[(size_t)1 * 64 * TTP] = bf16_1_(kp[e]); se[(size_t)2 * 64 * TTP] = bf16_1_(v4[e]);
                            se[(size_t)3 * 64 * TTP] = bf16_1_(av[e]); se[(size_t)4 * 64 * TTP] = bf16_1_(bv[e]); se[(size_t)5 * 64 * TTP] = bf16_1_(r4[e]); }
                    } else {
                        float* so = p.SCAN_S() + (((size_t)(row - MPR) * 8 + hd) * 6) * 64 + d0;
                        *(f32x4*)(so + 0 * 64) = (f32x4){1.f - dl[0], 1.f - dl[1], 1.f - dl[2], 1.f - dl[3]};
                        *(f32x4*)(so + 1 * 64) = (f32x4){kp[0], kp[1], kp[2], kp[3]};
                        *(f32x4*)(so + 2 * 64) = (f32x4){v4[0], v4[1], v4[2], v4[3]};
                        *(f32x4*)(so + 3 * 64) = (f32x4){av[0], av[1], av[2], av[3]};
                        *(f32x4*)(so + 4 * 64) = (f32x4){bv[0], bv[1], bv[2], bv[3]};
                        *(f32x4*)(so + 5 * 64) = (f32x4){r4[0], r4[1], r4[2], r4[3]};
                    }
                }
                dW = __builtin_shufflevector(dW, dW, 4, 5, 6, 7, 8, 9, 10, 11, 12, 13, 14, 15, 0, 1, 2, 3);
                dA = __builtin_shufflevector(dA, dA, 4, 5, 6, 7, 8, 9, 10, 11, 12, 13, 14, 15, 0, 1, 2, 3);
            }
        }
        bon += __shfl_xor(bon, 32);
        if (hh == 0 && act) p.BONUS()[(size_t)row * 8 + hd] = bon;
    }
    __builtin_amdgcn_sched_barrier(0);
    {
        bf16x8 Bg[8];
#pragma unroll
        for (int s2 = 0; s2 < 8; ++s2) { float x[8]; ps_lds<8>(pl, curp, prevp, pz, 1664 + 16 * s2 + 8 * hh, x);
#pragma unroll
            for (int i = 0; i < 8; ++i) x[i] = sigmoidf_(x[i]);
            Bg[s2] = pack8(x); }
#pragma unroll 1
        for (int nt = 2 * hd; nt < 2 * hd + 2; ++nt) {
            f32x16 dG = {};
            {
                bf16x8 ag[8];
#pragma unroll
                for (int s2 = 0; s2 < 8; ++s2) ag[s2] = *(const bf16x8*)(p.G2_T() + (size_t)(nt * 32 + tk) * 128 + 16 * s2 + 8 * hh);
                __builtin_amdgcn_sched_barrier(0);
#pragma unroll
                for (int s2 = 0; s2 < 8; ++s2) dG = MFMA32(ag[s2], Bg[s2], dG);
                __builtin_amdgcn_sched_barrier(0);
            }
            if (act) {
#pragma unroll
                for (int q4 = 0; q4 < 4; ++q4) { u32x2 og; og.x = pk2(dG[4 * q4], dG[4 * q4 + 1]); og.y = pk2(dG[4 * q4 + 2], dG[4 * q4 + 3]);
                    *(u32x2*)(p.G() + (size_t)row * 512 + nt * 32 + 8 * q4 + 4 * hh) = og; }
            }
        }
    }
}
DI void phase_prep(const Params& p, char* smem, int bid, int nblk, int gw, int ngw, int tid, int lane) {
    LAS float* pl = (LAS float*)smem;
    for (int i = tid; i < PL_N; i += 512) {
        float v;
        if (i < PL_W0) v = p.rw_mu[i]; else if (i < PL_A0) v = p.rw_w0[i - PL_W0]; else if (i < PL_KK) v = p.rw_a0[i - PL_A0];
        else if (i < PL_KA) v = p.rw_kk[i - PL_KK]; else if (i < PL_RK) v = p.rw_ka[i - PL_KA]; else v = p.rw_rk[i - PL_RK];
        pl[i] = v;
    }
    for (int u = bid; u < 512; u += nblk) prep_block(p, smem, u, tid);
    if (bid < 4 && nblk >= 8) prep_block(p, smem, 512 + bid, tid);
    else if (nblk < 8) { for (int u = 512 + bid; u < 516; u += nblk) prep_block(p, smem, u, tid); }
    {
        const int rb = (nblk >= 8) ? bid - 4 : bid, rn = (nblk >= 8) ? nblk - 4 : nblk;
        if (rb >= 0) for (int r = rb * 8 + (tid >> 6); r < MTOT; r += rn * 8) prep_qkv_row(p, r, lane);
    }
}

DI float dpp_xor1(float x) { return __builtin_amdgcn_update_dpp(0.f, x, 0xB1, 0xF, 0xF, false); }
DI float dpp_xor2(float x) { return __builtin_amdgcn_update_dpp(0.f, x, 0x4E, 0xF, 0xF, false); }
DI float dpp_hmir(float x) { return __builtin_amdgcn_update_dpp(0.f, x, 0x141, 0xF, 0xF, false); }
DI float dpp_mir(float x)  { return __builtin_amdgcn_update_dpp(0.f, x, 0x140, 0xF, 0xF, false); }
DI float row16_sum(float v) { v += dpp_xor1(v); v += dpp_xor2(v); v += dpp_hmir(v); v += dpp_mir(v); return v; }
DI float row8_sum(float v) { v += dpp_xor1(v); v += dpp_xor2(v); v += dpp_hmir(v); return v; }

constexpr int SCAN_TS = 32;
constexpr int SCAN_TILE_B = SCAN_TS * 6 * 64 * 2;
DI void scan_unit(const Params& p, char* smem, int unit, int tid) {
    const int chain = unit >> 2, rg = unit & 3, b = chain >> 3, hd = chain & 7;
    const int wave = tid >> 6, lane = tid & 63, rl = lane >> 4, cg = lane & 15;
    const int row = rg * 16 + wave * 4 + rl, d0 = cg * 4;
    const bf16_t* src = p.SCAN() + (size_t)chain * TT * 384;
    float S0 = 0.f, S1 = 0.f, S2 = 0.f, S3 = 0.f, ykeep = 0.f;
    constexpr int NTILE = (TT + SCAN_TS - 1) / SCAN_TS;
    u32x4 pre[6];
    {
#pragma unroll
        for (int i = 0; i < 6; ++i) pre[i] = *(const u32x4*)(src + (size_t)(i * 256 + tid) * 8);
#pragma unroll
        for (int i = 0; i < 6; ++i) *(u32x4*)(smem + (i * 256 + tid) * 16) = pre[i];
    }
    __syncthreads();
    for (int tile = 0; tile < NTILE; ++tile) {
        const int t0 = tile * SCAN_TS, nst = (TT - t0) < SCAN_TS ? (TT - t0) : SCAN_TS;
        const bool more = tile + 1 < NTILE;
        if (more) {
            const int t1 = t0 + SCAN_TS; const int lim = (TT - t1) * 384 / 8;
#pragma unroll
            for (int i = 0; i < 6; ++i) { const int c = i * 256 + tid; pre[i] = c < lim ? *(const u32x4*)(src + (size_t)t1 * 384 + (size_t)c * 8) : (u32x4){0u, 0u, 0u, 0u}; }
        }
        const char* buf = smem + (tile & 1) * SCAN_TILE_B;
        for (int st = 0; st < nst; ++st) {
            const char* sp = buf + st * 768;
            const u32x2 wd = *(const u32x2*)(sp + 0 * 128 + d0 * 2), wk = *(const u32x2*)(sp + 1 * 128 + d0 * 2), wa = *(const u32x2*)(sp + 3 * 128 + d0 * 2),
                        wb = *(const u32x2*)(sp + 4 * 128 + d0 * 2), wr = *(const u32x2*)(sp + 5 * 128 + d0 * 2);
            const float vv = bf2f(*(const unsigned short*)(sp + 2 * 128 + row * 2));
            float sa = S0 * bflo(wa.x) + S1 * bfhi(wa.x) + S2 * bflo(wa.y) + S3 * bfhi(wa.y);
            sa = row16_sum(sa);
            S0 = S0 * (1.f - bflo(wd.x)) + (sa * bflo(wb.x) + vv * bflo(wk.x));
            S1 = S1 * (1.f - bfhi(wd.x)) + (sa * bfhi(wb.x) + vv * bfhi(wk.x));
            S2 = S2 * (1.f - bflo(wd.y)) + (sa * bflo(wb.y) + vv * bflo(wk.y));
            S3 = S3 * (1.f - bfhi(wd.y)) + (sa * bfhi(wb.y) + vv * bfhi(wk.y));
            float y = S0 * bflo(wr.x) + S1 * bfhi(wr.x) + S2 * bflo(wr.y) + S3 * bfhi(wr.y);
            y = row16_sum(y);
            ykeep = ((st & 15) == cg) ? y : ykeep;
            if ((st & 15) == 15) p.Y()[(size_t)(b * TT + t0 + st - 15 + cg) * 512 + hd * 64 + row] = ykeep;
        }
        if (more) {
            char* nb = smem + ((tile + 1) & 1) * SCAN_TILE_B;
#pragma unroll
            for (int i = 0; i < 6; ++i) *(u32x4*)(nb + (i * 256 + tid) * 16) = pre[i];
        }
        __syncthreads();
    }
    *(f32x4*)(p.out + OUT_WP + ((size_t)chain * 64 + row) * 64 + d0) = (f32x4){S0, S1, S2, S3};
}

constexpr int SC2_TS = 32, SC2_STEP_B = 6 * 64 * 4, SC2_TILE_B = SC2_TS * SC2_STEP_B;
struct ScanOps { f32x4 w, k, a, b, r; float v; };
DI ScanOps scan_ld(const char* sp, int d0, int row) {
    ScanOps o; o.w = *(const f32x4*)(sp + 0 * 256 + d0 * 4); o.k = *(const f32x4*)(sp + 1 * 256 + d0 * 4); o.a = *(const f32x4*)(sp + 3 * 256 + d0 * 4);
    o.b = *(const f32x4*)(sp + 4 * 256 + d0 * 4); o.r = *(const f32x4*)(sp + 5 * 256 + d0 * 4); o.v = *(const float*)(sp + 2 * 256 + row * 4); return o;
}
DI void scan_unit2(const Params& p, char* smem, int unit, int tid) {
    const int chain = unit >> 2, rg = unit & 3, b = chain >> 3, hd = chain & 7;
    const int wave = tid >> 6, lane = tid & 63, rl = lane >> 4, cg = lane & 15;
    const int row = rg * 16 + (wave & 3) * 4 + rl, d0 = cg * 4;
    const bf16_t* src = p.SCAN() + (size_t)chain * TT * 384;
    f32x4 S = {0.f, 0.f, 0.f, 0.f}; float ykeep = 0.f;
    constexpr int NTILE = (TT + SC2_TS - 1) / SC2_TS;
    u32x4 pre[3];
    auto stage_load = [&](int t1) { const int lim = (TT - t1) * 48;
#pragma unroll
        for (int i = 0; i < 3; ++i) { const int c = i * 512 + tid; pre[i] = c < lim ? *(const u32x4*)(src + (size_t)t1 * 384 + (size_t)c * 8) : (u32x4){0u, 0u, 0u, 0u}; } };
    auto stage_store = [&](char* buf) {
#pragma unroll
        for (int i = 0; i < 3; ++i) { const int c = i * 512 + tid; float f[8]; unpack8(pre[i], f);
            if (((c >> 3) % 6) == 0) {
#pragma unroll
                for (int q = 0; q < 8; ++q) f[q] = 1.f - f[q]; }
            *(f32x4*)(buf + c * 32) = (f32x4){f[0], f[1], f[2], f[3]}; *(f32x4*)(buf + c * 32 + 16) = (f32x4){f[4], f[5], f[6], f[7]}; } };
    stage_load(0); stage_store(smem);
    __syncthreads();
    for (int tile = 0; tile < NTILE; ++tile) {
        const int t0 = tile * SC2_TS, nst = (TT - t0) < SC2_TS ? (TT - t0) : SC2_TS;
        const bool more = tile + 1 < NTILE;
        if (more) stage_load(t0 + SC2_TS);
        if (wave < 4) {
            const char* buf = smem + (tile & 1) * SC2_TILE_B;
            ScanOps cur = scan_ld(buf, d0, row);
#pragma unroll 2
            for (int st = 0; st < nst; ++st) {
                const ScanOps nxt = scan_ld(buf + ((st + 1 < nst) ? (st + 1) : st) * SC2_STEP_B, d0, row);
                float sa = (S.x * cur.a.x + S.y * cur.a.y) + (S.z * cur.a.z + S.w * cur.a.w);
                const f32x4 vk = cur.k * cur.v;
                sa = row16_sum(sa);
                S = S * cur.w + (cur.b * sa + vk);
                float y = (S.x * cur.r.x + S.y * cur.r.y) + (S.z * cur.r.z + S.w * cur.r.w);
                y = row16_sum(y);
                ykeep = ((st & 15) == cg) ? y : ykeep;
                if ((st & 15) == 15) p.Y()[(size_t)(b * TT + t0 + st - 15 + cg) * 512 + hd * 64 + row] = ykeep;
                cur = nxt;
            }
        }
        if (more) stage_store(smem + ((tile + 1) & 1) * SC2_TILE_B);
        __syncthreads();
    }
    if (wave < 4) *(f32x4*)(p.out + OUT_WP + ((size_t)chain * 64 + row) * 64 + d0) = S;
}

constexpr int CK_AT = 256, CK_RT = CK_AT + 17408, CK_BT = CK_RT + 17408, CK_KT = CK_BT + 17408, CK_VV = CK_KT + 17408, CK_AAB = CK_VV + 12288, CK_ARB = CK_AAB + 16384,
              CK_AAK = CK_ARB + 16384, CK_GT = CK_AAK + 9216, CK_HT = CK_GT + 9216, CK_LDS = CK_HT + 9216, CK_RAW = CK_AAB;
static_assert(CK_LDS <= 160 * 1024 - 128, "chunk LDS");
DI bf16x8 tr_frag(const char* img, int strideB, int row0, int colB) {
    return bf16x8{};
}
DI bf16x8 ld_tr8(const char* p_lo, const char* p_hi) {
    const s16x4 lo = __builtin_amdgcn_ds_read_tr16_b64_v4i16((LAS s16x4*)p_lo), hi = __builtin_amdgcn_ds_read_tr16_b64_v4i16((LAS s16x4*)p_hi);
    return __builtin_shufflevector(lo, hi, 0, 1, 2, 3, 4, 5, 6, 7);
}
DI bf16x8 pack16s(const f32x16& x, int s) {
    float f[8];
#pragma unroll
    for (int j = 0; j < 8; ++j) f[j] = x[8 * s + j];
    return pack8(f);
}
template <int I, bool ISG> DI void ck_bs4(float (&Xs)[16], const char* smem, int col, int sq, float pl, int zofs) {
    if constexpr (I + 5 < 64) asm volatile("" : "+v"(zofs) : "v"(Xs[(I + 5) & 15]));
    const char* ap = smem + CK_AAB + (I * 64 + 16 * sq) * 4 + zofs;
    const f32x4 a0 = *(const f32x4*)ap, a1 = *(const f32x4*)(ap + 16), a2 = *(const f32x4*)(ap + 32), a3 = *(const f32x4*)(ap + 48);
    float rhs = ISG ? *(const float*)(smem + CK_ARB + (I * 64 + col) * 4) : bf2f(*(const unsigned short*)(smem + CK_BT + I * 272 + col * 2)) * pl;
    float s0 = sq == 0 ? rhs : 0.f, s1 = 0.f;
    s0 += a0.x * Xs[0]; s1 += a0.y * Xs[1]; s0 += a0.z * Xs[2]; s1 += a0.w * Xs[3];
    s0 += a1.x * Xs[4]; s1 += a1.y * Xs[5]; s0 += a1.z * Xs[6]; s1 += a1.w * Xs[7];
    s0 += a2.x * Xs[8]; s1 += a2.y * Xs[9]; s0 += a2.z * Xs[10]; s1 += a2.w * Xs[11];
    s0 += a3.x * Xs[12]; s1 += a3.y * Xs[13]; s0 += a3.z * Xs[14]; s1 += a3.w * Xs[15];
    float x = s0 + s1; x += dpp_xor1(x); x += dpp_xor2(x);
    Xs[I & 15] = (sq == (I >> 4)) ? x : Xs[I & 15];
    if constexpr (I > 0) ck_bs4<I - 1, ISG>(Xs, smem, col, sq, pl, zofs);
}
DI void chunk_prefetch(const Params& p, int unit, int tid, unsigned short (&pre)[48]) {
    if (unit >= CK_UNITS) return;
    const int chain = unit / CK_N, c = unit - chain * CK_N, t0 = c * 64, lane = tid & 63, wave = tid >> 6;
    const bool ok = t0 + lane < TT;
    const bf16_t* src = p.SCAN() + scan_addr(chain, 0, 8 * wave, t0 + lane);
#pragma unroll
    for (int v = 0; v < 6; ++v)
#pragma unroll
        for (int q = 0; q < 8; ++q) pre[v * 8 + q] = ok ? src[((size_t)v * 64 + q) * TTP] : (unsigned short)0;
}
DI void chunk_pass1(const Params& p, char* smem_, int unit, int next_unit, unsigned short (&pre)[48], int tid_) {
    int tid = tid_, zb = 0; asm volatile("" : "+v"(tid), "+v"(zb)); char* smem = smem_ + zb;
    const int chain = unit / CK_N, c = unit - chain * CK_N, t0 = c * 64;
    const int wave = tid >> 6, lane = tid & 63, tk = lane & 31, hh = lane >> 5;
    const bf16_t* src = p.SCAN() + ((size_t)chain * TT + t0) * 384;
    const int nval = (TT - t0) < 64 ? (TT - t0) : 64;
    __syncthreads();
    {
        float dl[8], kv[8], vv[8], av[8], bv[8], rv[8];
#pragma unroll
        for (int q = 0; q < 8; ++q) { dl[q] = bf2f(pre[0 * 8 + q]); kv[q] = bf2f(pre[1 * 8 + q]); vv[q] = bf2f(pre[2 * 8 + q]); av[q] = bf2f(pre[3 * 8 + q]); bv[q] = bf2f(pre[4 * 8 + q]); rv[q] = bf2f(pre[5 * 8 + q]); }
        chunk_prefetch(p, next_unit, tid, pre);
        float P[8], Pm[8], inv[8], PL[8];
#pragma unroll
        for (int q = 0; q < 8; ++q) {
            float x = 1.f - dl[q];
#pragma unroll
            for (int o = 1; o < 64; o <<= 1) { const float y = __shfl_up(x, o); x = lane >= o ? x * y : x; }
            P[q] = x; const float pm = __shfl_up(x, 1); Pm[q] = lane ? pm : 1.f;
            PL[q] = __int_as_float(__builtin_amdgcn_readlane(__float_as_int(x), 63));
            inv[q] = 1.f / x;
        }
        __syncthreads();
        float o8[8];
#pragma unroll
        for (int q = 0; q < 8; ++q) o8[q] = av[q] * Pm[q];
        *(bf16x8*)(smem + CK_AT + lane * 272 + wave * 16) = pack8(o8);
#pragma unroll
        for (int q = 0; q < 8; ++q) o8[q] = rv[q] * P[q];
        *(bf16x8*)(smem + CK_RT + lane * 272 + wave * 16) = pack8(o8);
#pragma unroll
        for (int q = 0; q < 8; ++q) o8[q] = bv[q] * inv[q];
        *(bf16x8*)(smem + CK_BT + lane * 272 + wave * 16) = pack8(o8);
#pragma unroll
        for (int q = 0; q < 8; ++q) o8[q] = kv[q] * inv[q];
        *(bf16x8*)(smem + CK_KT + lane * 272 + wave * 16) = pack8(o8);
        *(bf16x8*)(smem + CK_VV + lane * 192 + wave * 16) = pack8(vv);
        if (lane == 63) { *(f32x4*)(smem + wave * 32) = (f32x4){PL[0], PL[1], PL[2], PL[3]}; *(f32x4*)(smem + wave * 32 + 16) = (f32x4){PL[4], PL[5], PL[6], PL[7]};
            float* plo = p.PLV() + (size_t)unit * 64 + wave * 8;
            *(f32x4*)plo = (f32x4){PL[0], PL[1], PL[2], PL[3]}; *(f32x4*)(plo + 4) = (f32x4){PL[4], PL[5], PL[6], PL[7]}; }
    }
    __syncthreads();
    const float* PLs = (const float*)smem;
    {
        const int prod = wave >> 1, half = wave & 1;
        const char* imgA = smem + ((prod == 0 || prod == 1) ? ((prod == 0) ? CK_BT : CK_BT) : CK_KT);
        const char* imgB = smem + ((prod == 0 || prod == 2) ? CK_AT : CK_RT);
        f32x16 acc[2] = {};
        if (prod < 3) {
#pragma unroll
            for (int nt = 0; nt < 2; ++nt)
#pragma unroll
                for (int s2 = 0; s2 < 4; ++s2) { const bf16x8 af = *(const bf16x8*)(imgA + (32 * half + tk) * 272 + (16 * s2 + 8 * hh) * 2), bf = *(const bf16x8*)(imgB + (32 * nt + tk) * 272 + (16 * s2 + 8 * hh) * 2);
                    acc[nt] = MFMA32(af, bf, acc[nt]); }
#pragma unroll
            for (int nt = 0; nt < 2; ++nt)
#pragma unroll
                for (int r2 = 0; r2 < 16; ++r2) { const int i = 32 * half + (r2 & 3) + 8 * (r2 >> 2) + 4 * hh, t = 32 * nt + tk;
                    const bool keep = (prod == 1) ? (i <= t) : (i < t);
                    const float v = keep ? acc[nt][r2] : 0.f;
                    if (prod == 0) *(float*)(smem + CK_AAB + (i * 64 + t) * 4) = v;
                    else if (prod == 1) *(float*)(smem + CK_ARB + (i * 64 + t) * 4) = v;
                    else *(unsigned short*)(smem + CK_AAK + i * 144 + t * 2) = bf16_1_(v); }
        }
    }
    __syncthreads();
    {
        int tz3 = tid; asm volatile("" : "+v"(tz3)); const int wave3 = __builtin_amdgcn_readfirstlane(tz3 >> 6), lane3 = tz3 & 63;
        const int col = 16 * (wave3 & 3) + (lane3 >> 2), sq = lane3 & 3;
        int zo = 0; asm volatile("" : "+v"(zo));
        float Xs[16];
#pragma unroll
        for (int j = 0; j < 16; ++j) Xs[j] = 0.f;
        if (wave3 < 4) ck_bs4<63, true>(Xs, smem, col, sq, 1.f, zo); else ck_bs4<63, false>(Xs, smem, col, sq, PLs[col], zo);
        char* dst = smem + (wave3 < 4 ? CK_GT : CK_HT) + col * 144 + sq * 32;
        float f0[8], f1[8];
#pragma unroll
        for (int j = 0; j < 8; ++j) { f0[j] = Xs[j]; f1[j] = Xs[8 + j]; }
        *(bf16x8*)dst = pack8(f0); *(bf16x8*)(dst + 16) = pack8(f1);
    }
    __syncthreads();
    {
        int tz4 = tid; asm volatile("" : "+v"(tz4)); const int wave = __builtin_amdgcn_readfirstlane(tz4 >> 6), lane = tz4 & 63, tk = lane & 31, hh = lane >> 5;
        const int half = wave & 1;
        const int i16 = lane & 15, qq = i16 >> 2, pp = i16 & 3, blk = (lane >> 4) & 1;
        if (wave < 4) {
            const char* imgB = smem + (wave < 2 ? CK_GT : CK_HT);
            f32x16 acc[2] = {};
#pragma unroll
            for (int nt = 0; nt < 2; ++nt)
#pragma unroll
                for (int s2 = 0; s2 < 4; ++s2) {
                    const char* pa = smem + CK_AT + (16 * s2 + 8 * hh + qq) * 272 + (32 * half + 16 * blk + 4 * pp) * 2;
                    const bf16x8 af = ld_tr8(pa, pa + 4 * 272);
                    const bf16x8 bf = *(const bf16x8*)(imgB + (32 * nt + tk) * 144 + (16 * s2 + 8 * hh) * 2);
                    acc[nt] = MFMA32(af, bf, acc[nt]); }
            bf16_t* dst = (wave < 2 ? p.MYT() : p.MST()) + (size_t)unit * 4096;
#pragma unroll
            for (int nt = 0; nt < 2; ++nt)
#pragma unroll
                for (int q4 = 0; q4 < 4; ++q4) { const int col = 32 * nt + tk, k0 = 32 * half + 8 * q4 + 4 * hh;
                    float v0 = acc[nt][4 * q4], v1 = acc[nt][4 * q4 + 1], v2 = acc[nt][4 * q4 + 2], v3 = acc[nt][4 * q4 + 3];
                    if (wave < 2) { const u32x2 rw = *(const u32x2*)(smem + CK_RT + col * 272 + k0 * 2); v0 += bflo(rw.x); v1 += bfhi(rw.x); v2 += bflo(rw.y); v3 += bfhi(rw.y); }
                    u32x2 o; o.x = pk2(v0, v1); o.y = pk2(v2, v3);
                    *(u32x2*)(dst + (size_t)col * 64 + k0) = o; }
        } else {
            const bool isy = wave >= 6;
            const char* imgB = smem + (isy ? CK_GT : CK_HT);
            f32x16 nn[2] = {};
#pragma unroll
            for (int mt = 0; mt < 2; ++mt)
#pragma unroll
                for (int s2 = 0; s2 < 4; ++s2) { const bf16x8 af = *(const bf16x8*)(smem + CK_AAK + (32 * mt + tk) * 144 + (16 * s2 + 8 * hh) * 2), bf = *(const bf16x8*)(imgB + (32 * half + tk) * 144 + (16 * s2 + 8 * hh) * 2);
                    nn[mt] = MFMA32(af, bf, nn[mt]); }
            if (isy) {
#pragma unroll
                for (int mt = 0; mt < 2; ++mt) {
                    f32x16 ark = {};
#pragma unroll
                    for (int s2 = 0; s2 < 4; ++s2) { const bf16x8 af = *(const bf16x8*)(smem + CK_KT + (32 * mt + tk) * 272 + (16 * s2 + 8 * hh) * 2), bf = *(const bf16x8*)(smem + CK_RT + (32 * half + tk) * 272 + (16 * s2 + 8 * hh) * 2);
                        ark = MFMA32(af, bf, ark); }
#pragma unroll
                    for (int r2 = 0; r2 < 16; ++r2) { const int i = 32 * mt + (r2 & 3) + 8 * (r2 >> 2) + 4 * hh, t = 32 * half + tk; nn[mt][r2] += (i <= t) ? ark[r2] : 0.f; }
                }
            }
            else { const float pl = PLs[32 * half + tk];
#pragma unroll
                for (int mt = 0; mt < 2; ++mt)
#pragma unroll
                    for (int r2 = 0; r2 < 16; ++r2) { const int i = 32 * mt + (r2 & 3) + 8 * (r2 >> 2) + 4 * hh; nn[mt][r2] += bf2f(*(const unsigned short*)(smem + CK_KT + i * 272 + (32 * half + tk) * 2)) * pl; } }
            float* dst = (isy ? p.WYT() : p.WST()) + (size_t)unit * 4096 + (size_t)half * 2048;
#pragma unroll
            for (int vt = 0; vt < 2; ++vt) {
                f32x16 wacc = {};
#pragma unroll
                for (int mt = 0; mt < 2; ++mt)
#pragma unroll
                    for (int s2 = 0; s2 < 2; ++s2) {
                        const bf16x8 af = pack16s(nn[mt], s2);
                        const char* pb = smem + CK_VV + (32 * mt + 16 * s2 + 4 * hh + qq) * 192 + (32 * vt + 16 * blk + 4 * pp) * 2;
                        const bf16x8 bf = ld_tr8(pb, pb + 8 * 192);
                        wacc = MFMA32(af, bf, wacc); }
#pragma unroll
                for (int r2 = 0; r2 < 16; ++r2) dst[(vt * 16 + r2) * 64 + lane] = wacc[r2];
            }
        }
    }
}
struct P2Ops { u32x2 a[2][2][2][2]; f32x4 pl[2][4]; float ws[2][16]; };
DI void p2_load(const Params& p, size_t u, int vh, int tk, int hh, int lane, P2Ops& o) {
    const bf16_t* ms = p.MST() + u * 4096; const float* plv = p.PLV() + u * 64; const float* ws = p.WST() + u * 4096;
#pragma unroll
    for (int mt = 0; mt < 2; ++mt) {
#pragma unroll
        for (int kt = 0; kt < 2; ++kt)
#pragma unroll
            for (int s2 = 0; s2 < 2; ++s2) { const bf16_t* ap = ms + (size_t)(32 * mt + tk) * 64 + 32 * kt + 16 * s2 + 4 * hh; o.a[mt][kt][s2][0] = *(const u32x2*)ap; o.a[mt][kt][s2][1] = *(const u32x2*)(ap + 8); }
#pragma unroll
        for (int q4 = 0; q4 < 4; ++q4) o.pl[mt][q4] = *(const f32x4*)(plv + 32 * mt + 8 * q4 + 4 * hh);
#pragma unroll
        for (int r2 = 0; r2 < 16; ++r2) o.ws[mt][r2] = ws[((size_t)mt * 2 + vh) * 1024 + r2 * 64 + lane];
    }
}
DI void chunk_pass2(const Params& p, int wunit, int lane, volatile LAS int* prog) {
    const int chain = wunit >> 1, vh = wunit & 1, tk = lane & 31, hh = lane >> 5;
    f32x16 st[2] = {};
    P2Ops cur; p2_load(p, (size_t)chain * CK_N, vh, tk, hh, lane, cur);
#pragma unroll 1
    for (int c = 0; c < CK_N; ++c) {
        const size_t u = (size_t)chain * CK_N + c;
        P2Ops nxt; p2_load(p, c + 1 < CK_N ? u + 1 : u, vh, tk, hh, lane, nxt);
        bf16x8 fh[2][2], fl[2][2];
#pragma unroll
        for (int kt = 0; kt < 2; ++kt)
#pragma unroll
            for (int s2 = 0; s2 < 2; ++s2) { float h8[8], l8[8];
#pragma unroll
                for (int j = 0; j < 8; ++j) { const float x = st[kt][8 * s2 + j]; const float xh = bflo(pk2(x, 0.f)); h8[j] = xh; l8[j] = x - xh; }
                fh[kt][s2] = pack8(h8); fl[kt][s2] = pack8(l8);
                u32x4* sc = (u32x4*)p.SCF() + ((((u * 2 + vh) * 2 + kt) * 2 + s2) * 2) * 64 + lane;
                sc[0] = __builtin_bit_cast(u32x4, fh[kt][s2]); sc[64] = __builtin_bit_cast(u32x4, fl[kt][s2]); }
        f32x16 nt[2];
#pragma unroll
        for (int mt = 0; mt < 2; ++mt) {
            f32x16 acc;
#pragma unroll
            for (int q4 = 0; q4 < 4; ++q4) { const f32x4 pl = cur.pl[mt][q4];
                acc[4 * q4] = cur.ws[mt][4 * q4] + st[mt][4 * q4] * pl.x; acc[4 * q4 + 1] = cur.ws[mt][4 * q4 + 1] + st[mt][4 * q4 + 1] * pl.y;
                acc[4 * q4 + 2] = cur.ws[mt][4 * q4 + 2] + st[mt][4 * q4 + 2] * pl.z; acc[4 * q4 + 3] = cur.ws[mt][4 * q4 + 3] + st[mt][4 * q4 + 3] * pl.w; }
#pragma unroll
            for (int kt = 0; kt < 2; ++kt)
#pragma unroll
                for (int s2 = 0; s2 < 2; ++s2) {
                    const u32x2 a0 = cur.a[mt][kt][s2][0], a1 = cur.a[mt][kt][s2][1];
                    const bf16x8 af = __builtin_bit_cast(bf16x8, (u32x4){a0.x, a0.y, a1.x, a1.y});
                    acc = MFMA32(af, fh[kt][s2], acc); acc = MFMA32(af, fl[kt][s2], acc); }
            nt[mt] = acc;
        }
        st[0] = nt[0]; st[1] = nt[1];
        cur = nxt;
        if (lane == 0) *prog = c + 1;
    }
    float* so = p.out + OUT_WP + ((size_t)chain * 64 + 32 * vh + tk) * 64;
#pragma unroll
    for (int kt = 0; kt < 2; ++kt)
#pragma unroll
        for (int q4 = 0; q4 < 4; ++q4) *(f32x4*)(so + 32 * kt + 8 * q4 + 4 * hh) = (f32x4){st[kt][4 * q4], st[kt][4 * q4 + 1], st[kt][4 * q4 + 2], st[kt][4 * q4 + 3]};
}
DI void chunk_pass2_prefetch(const Params& p, int wunit, int lane, volatile LAS int* prog) {
    const int chain = wunit >> 1, vh = wunit & 1;
    unsigned sink = 0;
    for (int c = 1; c < CK_N; ++c) {
        for (int spin = 0; spin < 200000 && *prog + 8 < c; ++spin) __builtin_amdgcn_s_sleep(4);
        const size_t u = (size_t)chain * CK_N + c;
        const char* l0 = (const char*)(p.MST() + u * 4096) + lane * 128;
        const char* l1 = (const char*)(p.WST() + u * 4096) + (size_t)(((lane >> 5) * 2 + vh) * 4096) + (lane & 31) * 128;
        sink += *(const volatile unsigned*)l0 + *(const volatile unsigned*)l1;
        if (lane < 2) sink += *(const volatile unsigned*)((const char*)(p.PLV() + u * 64) + lane * 128);
    }
    asm volatile("" :: "v"(sink));
}
DI float half32_sum(float v) {
    v += dpp_xor1(v); v += dpp_xor2(v); v += dpp_hmir(v); v += dpp_mir(v); v += __shfl_xor(v, 16); return v;
}
DI void chunk_pass3(const Params& p, int hunit, int lane) {
    const int unit = hunit >> 1, tt = hunit & 1;
    const int chain = unit / CK_N, c = unit - chain * CK_N, b = chain >> 3, hd = chain & 7, tk = lane & 31, hh = lane >> 5;
    const bf16_t* my = p.MYT() + (size_t)unit * 4096;
    const u32x4* sc = (const u32x4*)p.SCF() + (size_t)unit * 16 * 64 + lane;
    const float* wy = p.WYT() + (size_t)unit * 4096;
    bf16x8 Bf[2][2][2][2];
#pragma unroll
    for (int vt = 0; vt < 2; ++vt)
#pragma unroll
        for (int kt = 0; kt < 2; ++kt)
#pragma unroll
            for (int s2 = 0; s2 < 2; ++s2)
#pragma unroll
                for (int x = 0; x < 2; ++x) Bf[vt][kt][s2][x] = __builtin_bit_cast(bf16x8, sc[((((vt * 2 + kt) * 2 + s2) * 2) + x) * 64]);
    {
        f32x16 acc[2];
#pragma unroll
        for (int vt = 0; vt < 2; ++vt) {
#pragma unroll
            for (int r2 = 0; r2 < 16; ++r2) acc[vt][r2] = wy[((size_t)tt * 2 + vt) * 1024 + r2 * 64 + lane];
#pragma unroll
            for (int kt = 0; kt < 2; ++kt)
#pragma unroll
                for (int s2 = 0; s2 < 2; ++s2) {
                    const bf16_t* ap = my + (size_t)(32 * tt + tk) * 64 + 32 * kt + 16 * s2 + 4 * hh;
                    const u32x2 a0 = *(const u32x2*)ap, a1 = *(const u32x2*)(ap + 8);
                    const bf16x8 af = __builtin_bit_cast(bf16x8, (u32x4){a0.x, a0.y, a1.x, a1.y});
                    acc[vt] = MFMA32(af, Bf[vt][kt][s2][0], acc[vt]); acc[vt] = MFMA32(af, Bf[vt][kt][s2][1], acc[vt]); }
        }
        const float lg0 = p.rw_ln_g[hd * 64 + tk], lg1 = p.rw_ln_g[hd * 64 + 32 + tk], lb0 = p.rw_ln_b[hd * 64 + tk], lb1 = p.rw_ln_b[hd * 64 + 32 + tk];
#pragma unroll
        for (int r2 = 0; r2 < 16; ++r2) {
            const int t = c * 64 + 32 * tt + (r2 & 3) + 8 * (r2 >> 2) + 4 * hh;
            const float mu = half32_sum(acc[0][r2] + acc[1][r2]) * (1.f / 64.f);
            const float d0 = acc[0][r2] - mu, d1 = acc[1][r2] - mu;
            const float rs = rsqrtf(half32_sum(d0 * d0 + d1 * d1) * (1.f / 64.f) + 64e-5f);
            if (t < TT) {
                const size_t row = (size_t)b * TT + t;
                const bf16_t* vp = p.SCAN() + scan_addr(chain, 2, 0, t);
                const float bon = p.BONUS()[row * 8 + hd];
                const float o0 = (d0 * rs * lg0 + lb0 + bon * bf2f(vp[(size_t)tk * TTP])) * bf2f(p.G()[row * 512 + hd * 64 + tk]);
                const float o1 = (d1 * rs * lg1 + lb1 + bon * bf2f(vp[(size_t)(32 + tk) * TTP])) * bf2f(p.G()[row * 512 + hd * 64 + 32 + tk]);
                p.YO()[row * DM + hd * 64 + tk] = bf16_1_(o0); p.YO()[row * DM + hd * 64 + 32 + tk] = bf16_1_(o1);
            }
        }
    }
}

DI void rwkv_sample_unit(const Params& p, int unit, int tid) {
    const int s = unit >> 3, hd = unit & 7, row = tid >> 2, c0 = (tid & 3) * 16;
    const float* S0 = p.state_wkv + (((size_t)s * 8 + hd) * 64 + row) * 64 + c0;
    const float* in = p.SCAN_S() + ((size_t)s * 8 + hd) * 384;
    float S[16]; float sa = 0.f;
#pragma unroll
    for (int i = 0; i < 16; i += 4) { const f32x4 v = *(const f32x4*)(S0 + i); S[i] = v.x; S[i + 1] = v.y; S[i + 2] = v.z; S[i + 3] = v.w; }
#pragma unroll
    for (int i = 0; i < 16; ++i) sa += S[i] * in[3 * 64 + c0 + i];
    sa += dpp_xor1(sa); sa += dpp_xor2(sa);
    const float vv = in[2 * 64 + row];
    float y = 0.f;
#pragma unroll
    for (int i = 0; i < 16; ++i) { S[i] = S[i] * in[0 * 64 + c0 + i] + sa * in[4 * 64 + c0 + i] + vv * in[1 * 64 + c0 + i]; y += S[i] * in[5 * 64 + c0 + i]; }
    y += dpp_xor1(y); y += dpp_xor2(y);
    float* So = p.out + OUT_WS + (((size_t)s * 8 + hd) * 64 + row) * 64 + c0;
#pragma unroll
    for (int i = 0; i < 16; i += 4) *(f32x4*)(So + i) = (f32x4){S[i], S[i + 1], S[i + 2], S[i + 3]};
    if ((tid & 3) == 0) p.Y()[(size_t)(MPR + s) * 512 + hd * 64 + row] = y;
}

DI void rwkv_post_row(const Params& p, int row, int lane) {
    const int n0 = lane * 8, hd = lane >> 3;
    const f32x4 ya = *(const f32x4*)(p.Y() + (size_t)row * 512 + n0), yb = *(const f32x4*)(p.Y() + (size_t)row * 512 + n0 + 4);
    float y[8] = {ya.x, ya.y, ya.z, ya.w, yb.x, yb.y, yb.z, yb.w};
    float s = 0.f;
#pragma unroll
    for (int i = 0; i < 8; ++i) s += y[i];
    const float mu = row8_sum(s) * (1.f / 64.f);
    float q = 0.f;
#pragma unroll
    for (int i = 0; i < 8; ++i) { y[i] -= mu; q += y[i] * y[i]; }
    const float rs = rsqrtf(row8_sum(q) * (1.f / 64.f) + 64e-5f);
    float v[8];
    if (row < MPR) { const int b = row / TT, t = row - b * TT; unpack8(*(const u32x4*)(p.SCAN() + (((size_t)(b * 8 + hd) * TT + t) * 6 + 2) * 64 + (n0 & 63)), v); }
    else { const float* vs = p.SCAN_S() + (((size_t)(row - MPR) * 8 + hd) * 6 + 2) * 64 + (n0 & 63);
#pragma unroll
        for (int i = 0; i < 8; ++i) v[i] = vs[i]; }
    float g[8]; unpack8(*(const u32x4*)(p.G() + (size_t)row * 512 + n0), g);
    const float bon = p.BONUS()[(size_t)row * 8 + hd];
    float o[8];
#pragma unroll
    for (int i = 0; i < 8; ++i) o[i] = (y[i] * rs * p.rw_ln_g[n0 + i] + p.rw_ln_b[n0 + i] + bon * v[i]) * g[i];
    *(u32x4*)(p.YO() + (size_t)row * DM + n0) = __builtin_bit_cast(u32x4, pack8(o));
}

DI float compute_lam(const Params& p, int lane) {
    const float a = p.da_lam[lane] * p.da_lam[64 + lane], b = p.da_lam[128 + lane] * p.da_lam[192 + lane];
    return __expf(wave_sum(a)) - __expf(wave_sum(b)) + LAM_INIT;
}
constexpr int AT_KROW = 272, AT_VROW = 320, AT_BUF = 64 * AT_KROW + 64 * AT_VROW  , AT_V_OFF = 64 * AT_KROW, AT_X_OFF = 0, AT_LDS = 2 * AT_BUF;
DI void attn_unit(const Params& p, char* smem, int b, int h, int qb, float lam, int dmax, int tid) {
    const int wave = tid >> 6, lane = tid & 63, qs = wave >> 1, c = wave & 1, tk = lane & 31, hh = lane >> 5;
    const int qrow0 = qb * 128 + qs * 32, t = qrow0 + tk, tq = t < TT ? t : TT - 1;
    const size_t rb = (size_t)b * TT;
    const float c1 = 0.125f * LOG2E, slope2 = exp2f(-2.f * (h + 1)) * LOG2E;
    const int tref = qb * 128;
    bf16x8 Qf[4];
#pragma unroll
    for (int s = 0; s < 4; ++s) Qf[s] = *(const bf16x8*)(p.QN() + (rb + tq) * 512 + h * 128 + c * 64 + 16 * s + 8 * hh);
    f32x16 O[4] = {};
    float m = -1e30f, l = 0.f;
    const int kmax = (qb * 128 + 127 < TT - 1) ? qb * 128 + 127 : TT - 1;
    const int ntile = kmax / 64 + 1;
    int kts = (qb * 128 - dmax) / 64; kts = kts < 0 ? 0 : kts;
    const bool wave_live = qrow0 < TT;
    u32x4 rkA[2], rvA[2], rkB[2], rvB[2];
    auto g_load = [&](int kt0, u32x4 (&rk)[2], u32x4 (&rv)[2]) {
#pragma unroll
        for (int i = 0; i < 2; ++i) { const int ch = tid + 512 * i, key = ch >> 4, part = ch & 15; int kr = kt0 + key; kr = kr < TT ? kr : TT - 1;
            rk[i] = *(const u32x4*)(p.KN() + (rb + kr) * 512 + h * 128 + part * 8);
            rv[i] = *(const u32x4*)(p.PROJ() + (rb + kr) * INW + O_V + h * 128 + part * 8); } };
    auto l_store = [&](char* buf, const u32x4 (&rk)[2], const u32x4 (&rv)[2]) {
#pragma unroll
        for (int i = 0; i < 2; ++i) { const int ch = tid + 512 * i, key = ch >> 4, part = ch & 15;
            *(u32x4*)(buf + key * AT_KROW + part * 16) = rk[i]; *(u32x4*)(buf + AT_V_OFF + key * AT_VROW + part * 16) = rv[i]; } };
    auto tile_compute = [&](int kt0, const char* buf) {
        if (wave_live && kt0 <= qrow0 + 31) {
            f32x16 St[2] = {};
#pragma unroll
            for (int sub = 0; sub < 2; ++sub)
#pragma unroll
                for (int s = 0; s < 4; ++s) { const bf16x8 kf = *(const bf16x8*)(buf + (sub * 32 + tk) * AT_KROW + (c * 64 + 16 * s + 8 * hh) * 2); St[sub] = MFMA32(kf, Qf[s], St[sub]); }
            const bool diag = kt0 + 63 > qrow0;
            const float bias0 = slope2 * (float)(kt0 + 4 * hh - tref);
#pragma unroll
            for (int sub = 0; sub < 2; ++sub)
#pragma unroll
                for (int i = 0; i < 16; ++i) St[sub][i] = fmaf(St[sub][i], c1, fmaf(slope2, (float)(sub * 32 + (i & 3) + 8 * (i >> 2)), bias0));
            if (diag) {
#pragma unroll
                for (int sub = 0; sub < 2; ++sub)
#pragma unroll
                    for (int i = 0; i < 16; ++i) { const int key = kt0 + sub * 32 + (i & 3) + 8 * (i >> 2) + 4 * hh; if (key > t) St[sub][i] = -INFINITY; }
            }
            float mx = -1e30f;
#pragma unroll
            for (int sub = 0; sub < 2; ++sub)
#pragma unroll
                for (int i = 0; i < 16; ++i) mx = fmaxf(mx, St[sub][i]);
            mx = fmaxf(mx, __shfl_xor(mx, 32));
            const float mn = fmaxf(m, mx), alpha = __builtin_amdgcn_exp2f(m - mn);
            m = mn; l *= alpha;
#pragma unroll
            for (int dt = 0; dt < 4; ++dt)
#pragma unroll
                for (int i = 0; i < 16; ++i) O[dt][i] *= alpha;
#pragma unroll
            for (int sub = 0; sub < 2; ++sub)
#pragma unroll
                for (int i = 0; i < 16; ++i) { const float pv = __builtin_amdgcn_exp2f(St[sub][i] - mn); St[sub][i] = pv; l += pv; }
            const int i16 = lane & 15, qq = i16 >> 2, pp = i16 & 3, blk = (lane >> 4) & 1;
#pragma unroll
            for (int sub = 0; sub < 2; ++sub)
#pragma unroll
                for (int s2 = 0; s2 < 2; ++s2) {
                    float pf8[8];
#pragma unroll
                    for (int j = 0; j < 8; ++j) pf8[j] = St[sub][8 * s2 + j];
                    const bf16x8 Pf = pack8(pf8);
                    const int keyb = sub * 32 + 16 * s2 + 4 * hh + qq;
#pragma unroll
                    for (int dt = 0; dt < 4; ++dt) {
                        const int colb = (dt * 32 + 16 * blk + 4 * pp) * 2;
                        const s16x4 lo = __builtin_amdgcn_ds_read_tr16_b64_v4i16((LAS s16x4*)(buf + AT_V_OFF + keyb * AT_VROW + colb));
                        const s16x4 hi = __builtin_amdgcn_ds_read_tr16_b64_v4i16((LAS s16x4*)(buf + AT_V_OFF + (keyb + 8) * AT_VROW + colb));
                        const bf16x8 Vf = __builtin_shufflevector(lo, hi, 0, 1, 2, 3, 4, 5, 6, 7);
                        O[dt] = MFMA32(Vf, Pf, O[dt]);
                    }
                }
        }
    };
    __syncthreads();
    g_load(kts * 64, rkA, rvA); l_store(smem, rkA, rvA);
    if (kts + 1 < ntile) g_load(kts * 64 + 64, rkA, rvA);
    __syncthreads();
    for (int kt = kts; kt < ntile; kt += 2) {
        if (kt + 2 < ntile) g_load(kt * 64 + 128, rkB, rvB);
        tile_compute(kt * 64, smem);
        if (kt + 1 < ntile) l_store(smem + AT_BUF, rkA, rvA);
        __syncthreads();
        if (kt + 1 < ntile) {
            if (kt + 3 < ntile) g_load(kt * 64 + 192, rkA, rvA);
            tile_compute(kt * 64 + 64, smem + AT_BUF);
            if (kt + 2 < ntile) l_store(smem, rkB, rvB);
        }
        __syncthreads();
    }
    l += __shfl_xor(l, 32);
    const float linv = 1.f / l;
    float* xch = (float*)(smem + AT_X_OFF) + qs * (128 * 32);
    if (c == 1) {
#pragma unroll
        for (int dt = 0; dt < 4; ++dt)
#pragma unroll
            for (int i = 0; i < 16; ++i) { const int dv = dt * 32 + (i & 3) + 8 * (i >> 2) + 4 * hh; xch[dv * 32 + tk] = O[dt][i] * linv; }
    }
    __syncthreads();
    if (c == 0) {
        float ss = 0.f;
#pragma unroll
        for (int dt = 0; dt < 4; ++dt)
#pragma unroll
            for (int i = 0; i < 16; ++i) { const int dv = dt * 32 + (i & 3) + 8 * (i >> 2) + 4 * hh; const float o = O[dt][i] * linv - lam * xch[dv * 32 + tk]; O[dt][i] = o; ss += o * o; }
        ss += __shfl_xor(ss, 32);
        const float rs = rsqrtf(ss * (1.f / 128.f) + 1e-6f) * (1.f - LAM_INIT);
        if (t < TT) {
#pragma unroll
            for (int dt = 0; dt < 4; ++dt)
#pragma unroll
                for (int q4 = 0; q4 < 4; ++q4) { const int dv = dt * 32 + 8 * q4 + 4 * hh; const f32x4 g = *(const f32x4*)(p.da_subln_g + dv);
                    u32x2 o; o.x = pk2(O[dt][4 * q4] * rs * g.x, O[dt][4 * q4 + 1] * rs * g.y); o.y = pk2(O[dt][4 * q4 + 2] * rs * g.z, O[dt][4 * q4 + 3] * rs * g.w);
                    *(u32x2*)(p.YO() + (rb + t) * DM + 512 + h * 128 + dv) = o; }
        }
    }
}
DI int alibi_dmax(const Params& p, int h, int lane) {
    float gq = fabsf(p.da_qn_g[lane]), gk = fabsf(p.da_kn_g[lane]);
#pragma unroll
    for (int o = 1; o < 64; o <<= 1) { gq = fmaxf(gq, __shfl_xor(gq, o)); gk = fmaxf(gk, __shfl_xor(gk, o)); }
    const float B = 8.f * gq * gk * LOG2E, slope2 = exp2f(-2.f * (h + 1)) * LOG2E;
    const float d = (2.f * B + 40.f) / slope2;
    return d > 1.0e6f ? 1000000 : (int)d + 1;
}
constexpr int AT_NQB = 33, AT_UNITS = NB * 4 * AT_NQB;

DI void sattn_unit(const Params& p, int unit, int lane) {
    const int split = unit & 15, bh = unit >> 4, b = bh >> 2, h = bh & 3;
    const int ps = lane >> 3, sub = lane & 7;
    const float c1 = 0.125f * LOG2E, slope2 = exp2f(-2.f * (h + 1)) * LOG2E;
    f32x4 q[4];
    {
        const bf16_t* qr = p.QN() + (size_t)(MPR + b) * 512 + h * 128;
#pragma unroll
        for (int i = 0; i < 4; ++i) { const u32x2 w = *(const u32x2*)(qr + i * 32 + sub * 4); q[i] = (f32x4){bflo(w.x) * c1, bfhi(w.x) * c1, bflo(w.y) * c1, bfhi(w.y) * c1}; }
    }
    float m0 = -1e30f, m1 = -1e30f, l0 = 0.f, l1 = 0.f;
    f32x4 O0[4], O1[4];
#pragma unroll
    for (int i = 0; i < 4; ++i) { O0[i] = (f32x4){0.f, 0.f, 0.f, 0.f}; O1[i] = (f32x4){0.f, 0.f, 0.f, 0.f}; }
    struct RowSet { f32x4 k[4], v[4]; };
    auto ld = [&](int it, RowSet& r) {
        const int pos = split * 512 + it * 8 + ps;
        const int phys = p.page_table[b * NPAGES + (pos >> 7)];
        const size_t ro = (((size_t)phys * PAGE + (pos & 127)) * 4 + h) * 128 + sub * 4;
#pragma unroll
        for (int i = 0; i < 4; ++i) r.k[i] = __builtin_nontemporal_load((const f32x4*)(p.cache_k + ro + i * 32));
#pragma unroll
        for (int i = 0; i < 4; ++i) r.v[i] = __builtin_nontemporal_load((const f32x4*)(p.cache_v + ro + i * 32));
    };
    auto step = [&](int it, const RowSet& r) {
        const int pos = split * 512 + it * 8 + ps;
        float s0 = r.k[0].x * q[0].x + r.k[0].y * q[0].y + r.k[0].z * q[0].z + r.k[0].w * q[0].w + r.k[1].x * q[1].x + r.k[1].y * q[1].y + r.k[1].z * q[1].z + r.k[1].w * q[1].w;
        float s1 = r.k[2].x * q[2].x + r.k[2].y * q[2].y + r.k[2].z * q[2].z + r.k[2].w * q[2].w + r.k[3].x * q[3].x + r.k[3].y * q[3].y + r.k[3].z * q[3].z + r.k[3].w * q[3].w;
        s0 += dpp_xor1(s0); s0 += dpp_xor2(s0); s0 += dpp_hmir(s0);
        s1 += dpp_xor1(s1); s1 += dpp_xor2(s1); s1 += dpp_hmir(s1);
        const float bias = slope2 * (float)(PAST - pos);
        s0 -= bias; s1 -= bias;
        const float n0 = fmaxf(m0, s0), a0 = __builtin_amdgcn_exp2f(m0 - n0), e0 = __builtin_amdgcn_exp2f(s0 - n0);
        const float n1 = fmaxf(m1, s1), a1 = __builtin_amdgcn_exp2f(m1 - n1), e1 = __builtin_amdgcn_exp2f(s1 - n1);
        m0 = n0; m1 = n1; l0 = l0 * a0 + e0; l1 = l1 * a1 + e1;
#pragma unroll
        for (int i = 0; i < 4; ++i) { O0[i] = O0[i] * a0 + r.v[i] * e0; O1[i] = O1[i] * a1 + r.v[i] * e1; }
    };
    RowSet A, B, C;
    ld(0, A); ld(1, B);
#pragma unroll 1
    for (int it = 0; it < 63; it += 3) {
        ld(it + 2, C); step(it, A);
        ld(it + 3, A); step(it + 1, B);
        if (it + 4 < 64) ld(it + 4, B);
        step(it + 2, C);
    }
    step(63, A);
    float ma0 = m0, ma1 = m1;
#pragma unroll
    for (int o = 8; o < 64; o <<= 1) { ma0 = fmaxf(ma0, __shfl_xor(ma0, o)); ma1 = fmaxf(ma1, __shfl_xor(ma1, o)); }
    const float sc0 = __builtin_amdgcn_exp2f(m0 - ma0), sc1 = __builtin_amdgcn_exp2f(m1 - ma1);
    l0 *= sc0; l1 *= sc1;
#pragma unroll
    for (int o = 8; o < 64; o <<= 1) { l0 += __shfl_xor(l0, o); l1 += __shfl_xor(l1, o); }
#pragma unroll
    for (int i = 0; i < 4; ++i)
#pragma unroll
        for (int e = 0; e < 4; ++e) { float x0 = O0[i][e] * sc0, x1 = O1[i][e] * sc1;
#pragma unroll
            for (int o = 8; o < 64; o <<= 1) { x0 += __shfl_xor(x0, o); x1 += __shfl_xor(x1, o); }
            O0[i][e] = x0; O1[i][e] = x1; }
    if (ps == 0) {
        float* d0 = p.PART() + ((size_t)unit * 2 + 0) * 130; float* d1 = d0 + 130;
        if (sub == 0) { d0[0] = ma0; d0[1] = l0; d1[0] = ma1; d1[1] = l1; }
#pragma unroll
        for (int i = 0; i < 4; ++i) { *(f32x2*)(d0 + 2 + i * 32 + sub * 4) = (f32x2){O0[i].x, O0[i].y}; *(f32x2*)(d0 + 2 + i * 32 + sub * 4 + 2) = (f32x2){O0[i].z, O0[i].w};
            *(f32x2*)(d1 + 2 + i * 32 + sub * 4) = (f32x2){O1[i].x, O1[i].y}; *(f32x2*)(d1 + 2 + i * 32 + sub * 4 + 2) = (f32x2){O1[i].z, O1[i].w}; }
    }
}
DI void sattn_combine(const Params& p, int bh, float lam, int lane) {
    const int b = bh >> 2, h = bh & 3, row = MPR + b;
    const float c1 = 0.125f * LOG2E;
    float o[2][2];
    const float v0 = bf2f(p.PROJ()[(size_t)row * INW + O_V + h * 128 + lane]), v1 = bf2f(p.PROJ()[(size_t)row * INW + O_V + h * 128 + 64 + lane]);
#pragma unroll
    for (int c = 0; c < 2; ++c) {
        const float qd = bf2f(p.QN()[(size_t)row * 512 + h * 128 + c * 64 + lane]), kd = bf2f(p.KN()[(size_t)row * 512 + h * 128 + c * 64 + lane]);
        const float sself = wave_sum(qd * kd) * c1;
        float mm = sself;
        for (int s = 0; s < SA_SPLITS; ++s) mm = fmaxf(mm, p.PART()[((size_t)(bh * 16 + s) * 2 + c) * 130]);
        const float pself = __builtin_amdgcn_exp2f(sself - mm);
        float lt = pself, a0 = pself * v0, a1 = pself * v1;
        for (int s = 0; s < SA_SPLITS; ++s) { const float* pp = p.PART() + ((size_t)(bh * 16 + s) * 2 + c) * 130; const float sc = __builtin_amdgcn_exp2f(pp[0] - mm);
            lt += pp[1] * sc; a0 += pp[2 + lane] * sc; a1 += pp[2 + 64 + lane] * sc; }
        o[c][0] = a0 / lt; o[c][1] = a1 / lt;
    }
    const float r0 = o[0][0] - lam * o[1][0], r1 = o[0][1] - lam * o[1][1];
    const float ss = wave_sum(r0 * r0 + r1 * r1);
    const float rs = rsqrtf(ss * (1.f / 128.f) + 1e-6f) * (1.f - LAM_INIT);
    p.YO()[(size_t)row * DM + 512 + h * 128 + lane] = (bf16_t)(pk2(r0 * rs * p.da_subln_g[lane], 0.f) & 0xffffu);
    p.YO()[(size_t)row * DM + 512 + h * 128 + 64 + lane] = (bf16_t)(pk2(r1 * rs * p.da_subln_g[64 + lane], 0.f) & 0xffffu);
}

struct EpiBr1 {
    const bf16_t* PROJ; bf16_t* MIX;
    DI void operator()(const AccT& acc, int brow, int bcol, int wr, int wc, int fr, int fq) const {
#pragma unroll
        for (int ai = 0; ai < 2; ++ai) {
            EPI_FENCE;
            u32x2 g[4][4];
#pragma unroll
            for (int m = 0; m < 4; ++m)
#pragma unroll
                for (int j = 0; j < 4; ++j) g[m][j] = *(const u32x2*)(PROJ + (size_t)EPI_ROW(ai, m) * INW + O_GA + EPI_COL(j >> 1, j & 1));
            EPI_FENCE;
#pragma unroll
            for (int m = 0; m < 4; ++m)
#pragma unroll
                for (int j = 0; j < 4; ++j) { const f32x4 a = acc[ai][j >> 1][m][j & 1]; const u32x2 gg = g[m][j];
                    u32x2 o; o.x = pk2(a.x * sigmoidf_(bflo(gg.x)), a.y * sigmoidf_(bfhi(gg.x))); o.y = pk2(a.z * sigmoidf_(bflo(gg.y)), a.w * sigmoidf_(bfhi(gg.y)));
                    *(u32x2*)(MIX + (size_t)EPI_ROW(ai, m) * DM + EPI_COL(j >> 1, j & 1)) = o; }
        }
    }
};
struct EpiBr2 {
    const bf16_t* PROJ; bf16_t* MIX;
    DI void operator()(const AccT& acc, int brow, int bcol, int wr, int wc, int fr, int fq) const {
#pragma unroll
        for (int ai = 0; ai < 2; ++ai) {
            EPI_FENCE;
            u32x2 g[4][4], f[4][4];
#pragma unroll
            for (int m = 0; m < 4; ++m)
#pragma unroll
                for (int j = 0; j < 4; ++j) { g[m][j] = *(const u32x2*)(PROJ + (size_t)EPI_ROW(ai, m) * INW + O_GB + EPI_COL(j >> 1, j & 1));
                    f[m][j] = *(const u32x2*)(MIX + (size_t)EPI_ROW(ai, m) * DM + EPI_COL(j >> 1, j & 1)); }
            EPI_FENCE;
#pragma unroll
            for (int m = 0; m < 4; ++m)
#pragma unroll
                for (int j = 0; j < 4; ++j) { const f32x4 a = acc[ai][j >> 1][m][j & 1]; const u32x2 gg = g[m][j], ff = f[m][j];
                    u32x2 o; o.x = pk2(bflo(ff.x) + a.x * sigmoidf_(bflo(gg.x)), bfhi(ff.x) + a.y * sigmoidf_(bfhi(gg.x))); o.y = pk2(bflo(ff.y) + a.z * sigmoidf_(bflo(gg.y)), bfhi(ff.y) + a.w * sigmoidf_(bfhi(gg.y)));
                    *(u32x2*)(MIX + (size_t)EPI_ROW(ai, m) * DM + EPI_COL(j >> 1, j & 1)) = o; }
        }
    }
};
struct EpiOut {
    const float* const* XPTR; float* H1; bf16_t* HB; float* SS2;
    DI void operator()(const AccT& acc, int brow, int bcol, int wr, int wc, int fr, int fq) const {
        const float* xr[2][4];
#pragma unroll
        for (int ai = 0; ai < 2; ++ai)
#pragma unroll
            for (int m = 0; m < 4; ++m) xr[ai][m] = XPTR[EPI_ROW(ai, m)];
#pragma unroll
        for (int ai = 0; ai < 2; ++ai) {
            EPI_FENCE;
            f32x4 x[4][4];
#pragma unroll
            for (int m = 0; m < 4; ++m)
#pragma unroll
                for (int j = 0; j < 4; ++j) x[m][j] = *(const f32x4*)(xr[ai][m] + EPI_COL(j >> 1, j & 1));
            EPI_FENCE;
#pragma unroll
            for (int m = 0; m < 4; ++m) {
                const int row = EPI_ROW(ai, m);
                float ss = 0.f;
#pragma unroll
                for (int j = 0; j < 4; ++j) { const int col = EPI_COL(j >> 1, j & 1);
                    const f32x4 v = acc[ai][j >> 1][m][j & 1] + x[m][j];
                    ss += v.x * v.x + v.y * v.y + v.z * v.z + v.w * v.w;
                    *(f32x4*)(H1 + (size_t)row * DM + col) = v;
                    u32x2 o; o.x = pk2(v.x, v.y); o.y = pk2(v.z, v.w);
                    *(u32x2*)(HB + (size_t)row * DM + col) = o; }
                ss += __shfl_xor(ss, 16); ss += __shfl_xor(ss, 32);
                if (fq == 0) atomicAdd(SS2 + row, ss);
            }
        }
    }
};
struct EpiQ {
    const float* SS2; bf16_t* QP;
    DI void operator()(const AccT& acc, int brow, int bcol, int wr, int wc, int fr, int fq) const {
        EPI_ROWS_BEGIN
            const float rs = rsqrtf(SS2[row] * (1.f / DM) + 1e-6f);
            EPI_COLS_BEGIN
                const f32x4 v = a * rs;
                u32x2 o; o.x = pk2(v.x, v.y); o.y = pk2(v.z, v.w);
                *(u32x2*)(QP + (size_t)row * 2048 + col) = o;
            }
        }
    }
};

template <class F>
DI void skinny_gemm(const bf16_t* A, int lda, const bf16_t* Bt, int K, int N, char* smem, int bid, int nblk, int tid, F&& f) {
    const int wave = tid >> 6, lane = tid & 63, tk = lane & 31, hh = lane >> 5;
    const int ks = K / 128;
    for (int tile = bid; tile < N / 32; tile += nblk) {
        const int n0 = tile * 32;
        f32x16 acc = {};
        const bf16_t* ap = A + (size_t)(MPR + tk) * lda + 8 * hh + wave * ks * 16; const bf16_t* bp = Bt + (size_t)(n0 + tk) * K + 8 * hh + wave * ks * 16;
        if (ks == 4) {
            bf16x8 av[4], bv[4];
#pragma unroll
            for (int s2 = 0; s2 < 4; ++s2) { av[s2] = *(const bf16x8*)(ap + 16 * s2); bv[s2] = *(const bf16x8*)(bp + 16 * s2); }
#pragma unroll
            for (int s2 = 0; s2 < 4; ++s2) acc = MFMA32(av[s2], bv[s2], acc);
        } else {
            bf16x8 av[8], bv[8];
#pragma unroll
            for (int s2 = 0; s2 < 8; ++s2) { av[s2] = *(const bf16x8*)(ap + 16 * s2); bv[s2] = *(const bf16x8*)(bp + 16 * s2); }
#pragma unroll
            for (int s2 = 0; s2 < 8; ++s2) acc = MFMA32(av[s2], bv[s2], acc);
        }
        __syncthreads();
        float* part = (float*)smem + wave * 1024;
#pragma unroll
        for (int i = 0; i < 16; ++i) part[i * 64 + lane] = acc[i];
        __syncthreads();
#pragma unroll
        for (int ii = 0; ii < 2; ++ii) { const int i = 2 * wave + ii; float v = 0.f;
#pragma unroll
            for (int w = 0; w < 8; ++w) v += ((const float*)smem)[w * 1024 + i * 64 + lane];
            f(MPR + (i & 3) + 8 * (i >> 2) + 4 * hh, n0 + tk, v); }
    }
    __syncthreads();
}
DI unsigned short bf16_1(float x) { return (unsigned short)(pk2(x, 0.f) & 0xffffu); }

DI int fkey(float f, int idx, int mask) { int b = (__float_as_int(f) & ~mask) | idx; return b ^ ((b >> 31) & 0x7fffffff); }
DI int funkey(int k) { return k ^ ((k >> 31) & 0x7fffffff); }
template <int N> DI void bitonic_sort_desc(int (&a)[N]) {
#pragma unroll
    for (int k = 2; k <= N; k <<= 1)
#pragma unroll
        for (int j = k >> 1; j > 0; j >>= 1)
#pragma unroll
            for (int i = 0; i < N; ++i) { const int l = i ^ j;
                if (l > i) { const bool desc = ((i & k) == 0); const int mx = max(a[i], a[l]), mn = min(a[i], a[l]); a[i] = desc ? mx : mn; a[l] = desc ? mn : mx; } }
}
DI void merge_top16(int (&a)[16], const int (&b)[16]) {
#pragma unroll
    for (int i = 0; i < 16; ++i) a[i] = max(a[i], b[15 - i]);
#pragma unroll
    for (int j = 8; j > 0; j >>= 1)
#pragma unroll
        for (int i = 0; i < 16; ++i) { const int l = i ^ j; if (l > i) { const int mx = max(a[i], a[l]), mn = min(a[i], a[l]); a[i] = mx; a[l] = mn; } }
}
DI void top16_of_64(int (&g0)[16], int (&g1)[16], int (&g2)[16], int (&g3)[16], bool g0_sorted) {
    if (!g0_sorted) bitonic_sort_desc<16>(g0);
    bitonic_sort_desc<16>(g1); bitonic_sort_desc<16>(g2); bitonic_sort_desc<16>(g3);
    merge_top16(g0, g1); merge_top16(g2, g3); merge_top16(g0, g2);
}
DI void half_topk(const Params& p, const char* skl, int row, int hd, int c, int tk, int hh, int (&top)[16]) {
    bf16x8 Bq[8];
#pragma unroll
    for (int s = 0; s < 8; ++s) Bq[s] = *(const bf16x8*)(p.QP() + (size_t)row * 2048 + hd * 256 + c * 128 + 16 * s + 8 * hh);
    int g[4][16];
#pragma unroll
    for (int kt = 0; kt < 4; ++kt) {
        f32x16 acc = {};
#pragma unroll
        for (int s = 0; s < 8; ++s) { const bf16x8 ak = *(const bf16x8*)(skl + (c * 128 + kt * 32 + tk) * 272 + (16 * s + 8 * hh) * 2); acc = MFMA32(ak, Bq[s], acc); }
#pragma unroll
        for (int i = 0; i < 16; ++i) g[kt][i] = fkey(acc[i], kt * 32 + (i & 3) + 8 * (i >> 2) + 4 * hh, 0x7f);
        __builtin_amdgcn_sched_barrier(0);
    }
    bitonic_sort_desc<16>(g[0]); __builtin_amdgcn_sched_barrier(0);
    bitonic_sort_desc<16>(g[1]); __builtin_amdgcn_sched_barrier(0);
    merge_top16(g[0], g[1]); __builtin_amdgcn_sched_barrier(0);
    bitonic_sort_desc<16>(g[2]); __builtin_amdgcn_sched_barrier(0);
    bitonic_sort_desc<16>(g[3]); __builtin_amdgcn_sched_barrier(0);
    merge_top16(g[2], g[3]); merge_top16(g[0], g[2]);
    int oth[16];
#pragma unroll
    for (int i = 0; i < 16; ++i) oth[i] = __shfl_xor(g[0][i], 32);
    merge_top16(g[0], oth);
#pragma unroll
    for (int i = 0; i < 16; ++i) top[i] = g[0][i];
    __builtin_amdgcn_sched_barrier(0);
}
DI void topk_unit(const Params& p, const char* skl, char* lds_wave  , int unit, int lane) {
    const int tile = unit >> 3, hd = unit & 7, tk = lane & 31, hh = lane >> 5, row = tile * 32 + tk;
    int top[2][16];
    half_topk(p, skl, row, hd, 0, tk, hh, top[0]);
    half_topk(p, skl, row, hd, 1, tk, hh, top[1]);
    float v1[16], v2[16]; unsigned i1w[4] = {0, 0, 0, 0}, i2w[4] = {0, 0, 0, 0};
#pragma unroll
    for (int i = 0; i < 16; ++i) { const int b1 = funkey(top[0][i]), b2 = funkey(top[1][i]);
        v1[i] = __int_as_float(b1 & ~0x7f); v2[i] = __int_as_float(b2 & ~0x7f);
        i1w[i >> 2] |= (unsigned)(b1 & 0x7f) << (8 * (i & 3)); i2w[i >> 2] |= (unsigned)(b2 & 0x7f) << (8 * (i & 3)); }
    LAS unsigned* myl = (LAS unsigned*)lds_wave + lane * 8;
#pragma unroll
    for (int i = 0; i < 4; ++i) { myl[i] = i1w[i]; myl[4 + i] = i2w[i]; }
    int cg0[16], cg1[16], cg2[16], cg3[16];
    constexpr int NEG = (int)0x80000000;
#pragma unroll
    for (int j = 0; j < 16; ++j) cg0[j] = fkey(v1[0] + v2[j], j, 0xff);
    {
        int n = 0;
#pragma unroll
        for (int i = 1; i < 16; ++i)
#pragma unroll
            for (int j = 0; j < 16; ++j) if ((i + 1) * (j + 1) <= 16) { const int k = fkey(v1[i] + v2[j], i * 16 + j, 0xff);
                if (n < 16) cg1[n] = k; else if (n < 32) cg2[n - 16] = k; else cg3[n - 32] = k; ++n; }
#pragma unroll
        for (int i = 2; i < 16; ++i) cg3[i] = NEG;
    }
    __builtin_amdgcn_sched_barrier(0);
    bitonic_sort_desc<16>(cg0); __builtin_amdgcn_sched_barrier(0);
    bitonic_sort_desc<16>(cg1); __builtin_amdgcn_sched_barrier(0);
    merge_top16(cg0, cg1); __builtin_amdgcn_sched_barrier(0);
    bitonic_sort_desc<16>(cg2); __builtin_amdgcn_sched_barrier(0);
    bitonic_sort_desc<16>(cg3); __builtin_amdgcn_sched_barrier(0);
    merge_top16(cg2, cg3); merge_top16(cg0, cg2);
    float sc[16]; int cid[16];
#pragma unroll
    for (int i = 0; i < 16; ++i) { const int bb = funkey(cg0[i]); sc[i] = __int_as_float(bb & ~0xff); cid[i] = bb & 0xff; }
    float e[16], sum = 0.f;
#pragma unroll
    for (int i = 0; i < 16; ++i) { e[i] = __expf(sc[i] - sc[0]); sum += e[i]; }
    const float inv = 1.f / sum;
    __builtin_amdgcn_s_waitcnt(0xc07f); asm volatile("" ::: "memory");
    const LAS unsigned char* myb = (const LAS unsigned char*)myl;
    int eidx[16];
#pragma unroll
    for (int i = 0; i < 16; ++i) eidx[i] = (int)myb[cid[i] >> 4] * 128 + (int)myb[16 + (cid[i] & 15)];
    if (hh == 0 && row < MTOT) {
        int* io = p.IDX() + ((size_t)row * 8 + hd) * 16; float* go = p.GATE() + ((size_t)row * 8 + hd) * 16;
#pragma unroll
        for (int i = 0; i < 16; i += 4) { *(int4*)(io + i) = make_int4(eidx[i], eidx[i + 1], eidx[i + 2], eidx[i + 3]); *(f32x4*)(go + i) = (f32x4){e[i] * inv, e[i + 1] * inv, e[i + 2] * inv, e[i + 3] * inv}; }
    }
    __builtin_amdgcn_s_waitcnt(0xc07f); asm volatile("" ::: "memory");
}

DI void experts_row(const Params& p, int row, int lane) {
    const float rs = rsqrtf(p.SS2()[row] * (1.f / DM) + 1e-6f);
    float x[16];
    {
        float t0[8], t1[8]; unpack8(*(const u32x4*)(p.HB() + (size_t)row * DM + lane * 8), t0); unpack8(*(const u32x4*)(p.HB() + (size_t)row * DM + 512 + lane * 8), t1);
#pragma unroll
        for (int i = 0; i < 8; ++i) { x[i] = t0[i] * rs * p.norm2_g[lane * 8 + i]; x[8 + i] = t1[i] * rs * p.norm2_g[512 + lane * 8 + i]; }
    }
    float out[16];
#pragma unroll
    for (int i = 0; i < 16; ++i) out[i] = 0.f;
    for (int hd = 0; hd < 8; ++hd) {
        const int myidx = p.IDX()[((size_t)row * 8 + hd) * 16 + (lane & 15)];
        const float mygate = p.GATE()[((size_t)row * 8 + hd) * 16 + (lane & 15)];
        float hid = 0.f;
#pragma unroll 4
        for (int k = 0; k < 16; ++k) {
            const int e = __builtin_amdgcn_readlane(myidx, k);
            const bf16_t* ur = p.U16() + (size_t)e * DM;
            float u0[8], u1[8]; unpack8(*(const u32x4*)(ur + lane * 8), u0); unpack8(*(const u32x4*)(ur + 512 + lane * 8), u1);
            float d = 0.f;
#pragma unroll
            for (int i = 0; i < 8; ++i) d += x[i] * u0[i] + x[8 + i] * u1[i];
            d = wave_sum(d);
            hid = (lane & 15) == k ? d : hid;
        }
        const float cf = 0.5f * hid * (1.f + erff(hid * 0.70710678118654752f)) * mygate;
#pragma unroll 4
        for (int k = 0; k < 16; ++k) {
            const int e = __builtin_amdgcn_readlane(myidx, k);
            const float ck = __int_as_float(__builtin_amdgcn_readlane(__float_as_int(cf), k));
            const bf16_t* vr = p.V16() + (size_t)e * DM;
            float u0[8], u1[8]; unpack8(*(const u32x4*)(vr + lane * 8), u0); unpack8(*(const u32x4*)(vr + 512 + lane * 8), u1);
#pragma unroll
            for (int i = 0; i < 8; ++i) { out[i] += ck * u0[i]; out[8 + i] += ck * u1[i]; }
        }
    }
    float* dst = nullptr;
    if (row < MPR) { const int b = row / TT, t = row - b * TT; if (t >= NMETA) dst = p.out + OUT_YP + ((size_t)b * SEQ + (t - NMETA)) * DM; }
    else dst = p.out + OUT_YS + (size_t)(row - MPR) * DM;
    if (dst) {
        const float* h1 = p.H1() + (size_t)row * DM;
#pragma unroll
        for (int j = 0; j < 2; ++j) {
            const f32x4 a = *(const f32x4*)(h1 + j * 512 + lane * 8), b = *(const f32x4*)(h1 + j * 512 + lane * 8 + 4);
            *(f32x4*)(dst + j * 512 + lane * 8) = (f32x4){a.x + out[8 * j], a.y + out[8 * j + 1], a.z + out[8 * j + 2], a.w + out[8 * j + 3]};
            *(f32x4*)(dst + j * 512 + lane * 8 + 4) = (f32x4){b.x + out[8 * j + 4], b.y + out[8 * j + 5], b.z + out[8 * j + 6], b.w + out[8 * j + 7]};
        }
    }
}

constexpr int EX_NSL = 1, EX_SLSH = 14;
constexpr int EX_IDX_OFF = 0, EX_COEF_OFF = 64 * 128 * 2, EX_OFF_OFF = EX_COEF_OFF + 64 * 128 * 4, EX_LIST_OFF = EX_OFF_OFF + 64 * 32 * 2, EX_LDS = EX_LIST_OFF + 8 * 256 * 2;
DI float row16_rorsum(float v) {
    v += __builtin_amdgcn_update_dpp(0.f, v, 0x128, 0xF, 0xF, false);
    v += __builtin_amdgcn_update_dpp(0.f, v, 0x124, 0xF, 0xF, false);
    v += __builtin_amdgcn_update_dpp(0.f, v, 0x122, 0xF, 0xF, false);
    v += __builtin_amdgcn_update_dpp(0.f, v, 0x121, 0xF, 0xF, false);
    return v;
}
DI void unpack_fp8x16(const u32x4& w, float (&f)[16]) {
#pragma unroll
    for (int q = 0; q < 4; ++q) { const f32x2 lo = __builtin_amdgcn_cvt_pk_f32_fp8((int)w[q], false), hi = __builtin_amdgcn_cvt_pk_f32_fp8((int)w[q], true);
        f[4 * q] = lo.x; f[4 * q + 1] = lo.y; f[4 * q + 2] = hi.x; f[4 * q + 3] = hi.y; }
}
DI int peer_row_of(int ci) { return ci < NB * SEQ ? (ci >> 12) * TT + NMETA + (ci & 4095) : (ci < NB * SEQ + MS ? MPR + (ci - NB * SEQ) : -1); }
DI void experts_wave(const Params& p, char* smem, int wave_, int lane_, int ci0, int ntok, int xcc) {
    int wave = wave_, lane = lane_; asm volatile("" : "+v"(lane), "+v"(wave)); wave = __builtin_amdgcn_readfirstlane(wave);
    LAS unsigned short* idxs = (LAS unsigned short*)(smem + EX_IDX_OFF) + wave * 8 * 128;
    LAS float* coef = (LAS float*)(smem + EX_COEF_OFF) + wave * 8 * 128;
    LAS unsigned short* offs = (LAS unsigned short*)(smem + EX_OFF_OFF) + wave * 8 * 32;
    const unsigned char* U8 = (const unsigned char*)p.U16(); const unsigned char* V8 = (const unsigned char*)p.V16();
    float xr[2][16];
#pragma unroll
    for (int j = 0; j < 2; ++j) {
        const int row = j < ntok ? peer_row_of(ci0 + j) : -1;
        if (row >= 0) {
            const int e0 = p.IDX()[(size_t)row * 128 + lane], e1 = p.IDX()[(size_t)row * 128 + 64 + lane];
            const float g0 = p.GATE()[(size_t)row * 128 + lane], g1 = p.GATE()[(size_t)row * 128 + 64 + lane];
            const int s0 = e0 >> EX_SLSH, s1 = e1 >> EX_SLSH;
            int base = 0, pos0 = 0, pos1 = 0;
#pragma unroll
            for (int sl = 0; sl < EX_NSL; ++sl) {
                const unsigned long long m0 = __ballot(s0 == sl), m1 = __ballot(s1 == sl);
                const int c0 = __popcll(m0), c1 = __popcll(m1);
                const int r0 = __builtin_amdgcn_mbcnt_hi((unsigned)(m0 >> 32), __builtin_amdgcn_mbcnt_lo((unsigned)m0, 0));
                const int r1 = __builtin_amdgcn_mbcnt_hi((unsigned)(m1 >> 32), __builtin_amdgcn_mbcnt_lo((unsigned)m1, 0));
                if (s0 == sl) pos0 = base + r0;
                if (s1 == sl) pos1 = base + c0 + r1;
                if (lane == 0) offs[j * 32 + sl] = (unsigned short)base;
                base += c0 + c1;
            }
            if (lane == 0) offs[j * 32 + EX_NSL] = (unsigned short)base;
            idxs[j * 128 + pos0] = (unsigned short)e0; idxs[j * 128 + pos1] = (unsigned short)e1;
            coef[j * 128 + pos0] = g0; coef[j * 128 + pos1] = g1;
            const float rs = rsqrtf(p.SS2()[row] * (1.f / DM) + 1e-6f) * (1.f / U8_SCALE);
            float t0[8], t1[8]; unpack8(*(const u32x4*)(p.HB() + (size_t)row * DM + lane * 16), t0); unpack8(*(const u32x4*)(p.HB() + (size_t)row * DM + lane * 16 + 8), t1);
#pragma unroll
            for (int q = 0; q < 2; ++q) { const f32x4 ga = *(const f32x4*)(p.norm2_g + lane * 16 + 4 * q), gb = *(const f32x4*)(p.norm2_g + lane * 16 + 8 + 4 * q);
                xr[j][4 * q] = t0[4 * q] * rs * ga.x; xr[j][4 * q + 1] = t0[4 * q + 1] * rs * ga.y; xr[j][4 * q + 2] = t0[4 * q + 2] * rs * ga.z; xr[j][4 * q + 3] = t0[4 * q + 3] * rs * ga.w;
                xr[j][8 + 4 * q] = t1[4 * q] * rs * gb.x; xr[j][8 + 4 * q + 1] = t1[4 * q + 1] * rs * gb.y; xr[j][8 + 4 * q + 2] = t1[4 * q + 2] * rs * gb.z; xr[j][8 + 4 * q + 3] = t1[4 * q + 3] * rs * gb.w; }
        } else {
            if (lane <= EX_NSL) offs[j * 32 + lane] = 0;
#pragma unroll
            for (int i = 0; i < 16; ++i) xr[j][i] = 0.f;
        }
    }
    __builtin_amdgcn_s_waitcnt(0xc07f); asm volatile("" ::: "memory");
    LAS unsigned short* blist = (LAS unsigned short*)(smem + EX_LIST_OFF) + wave * 256;
    int nbat;
    {
        const int r = (lane >> 1) & (EX_NSL - 1), j = lane & 1, sl = (xcc + r) & (EX_NSL - 1);
        const int beg = offs[j * 32 + sl], cnt = lane < 2 * EX_NSL ? (int)offs[j * 32 + sl + 1] - beg : 0, nb = (cnt + 7) >> 3;
        int incl = nb;
#pragma unroll
        for (int o = 1; o < 64; o <<= 1) { const int t = __shfl_up(incl, o); if (lane >= o) incl += t; }
        nbat = __builtin_amdgcn_readlane(incl, 63);
        int w = incl - nb;
        for (int q = 0; q < nb; ++q) { const int k = beg + 8 * q, n = (cnt - 8 * q) < 8 ? (cnt - 8 * q) : 8; blist[w + q] = (unsigned short)(j | (k << 3) | ((n - 1) << 10)); }
    }
    __builtin_amdgcn_s_waitcnt(0xc07f); asm volatile("" ::: "memory");
    const int pid = lane >> 4;
    auto fetch = [&](const unsigned char* tab, int bi, u32x4 (&buf)[8]) {
        const int e = __builtin_amdgcn_readfirstlane((int)blist[bi]);
        const int j = e & 7, k = (e >> 3) & 127, n = (e >> 10) + 1;
#pragma unroll
        for (int i = 0; i < 8; ++i) { const int kk = k + (i < n ? i : n - 1);
            const int ex = __builtin_amdgcn_readfirstlane((int)idxs[j * 128 + kk]);
            buf[i] = *(const u32x4*)(tab + (size_t)ex * DM + lane * 16); }
    };
    auto u_consume = [&](int bi, const u32x4 (&buf)[8]) {
        const int e = __builtin_amdgcn_readfirstlane((int)blist[bi]);
        const int j = e & 7, k = (e >> 3) & 127, n = (e >> 10) + 1;
        float pp[8], x[16];
#pragma unroll
        for (int q = 0; q < 16; ++q) x[q] = j ? xr[1][q] : xr[0][q];
#pragma unroll
        for (int i = 0; i < 8; ++i) { float f[16]; unpack_fp8x16(buf[i], f); float d0 = 0.f, d1 = 0.f;
#pragma unroll
            for (int q = 0; q < 16; q += 2) { d0 += f[q] * x[q]; d1 += f[q + 1] * x[q + 1]; }
            pp[i] = d0 + d1; __builtin_amdgcn_sched_barrier(0); }
#pragma unroll
        for (int hb = 0; hb < 2; ++hb) {
            const bool b5 = lane & 32, b4 = lane & 16;
            const float a0 = b5 ? pp[4 * hb + 2] : pp[4 * hb], a1 = b5 ? pp[4 * hb + 3] : pp[4 * hb + 1], s0 = b5 ? pp[4 * hb] : pp[4 * hb + 2], s1 = b5 ? pp[4 * hb + 1] : pp[4 * hb + 3];
            const float q0 = a0 + __shfl_xor(s0, 32), q1 = a1 + __shfl_xor(s1, 32);
            const float c0 = b4 ? q1 : q0, d0 = b4 ? q0 : q1;
            float z = c0 + __shfl_xor(d0, 16);
            z = row16_rorsum(z);
            const int ip = 4 * hb + pid;
            if ((lane & 15) == 0 && ip < n) {
                const float g = coef[j * 128 + k + ip];
                coef[j * 128 + k + ip] = 0.5f * z * (1.f + erff(z * 0.70710678118654752f)) * g * (1.f / V8_SCALE);
            }
        }
    };
    {
        u32x4 bufA[8], bufB[8];
        if (nbat > 0) fetch(U8, 0, bufA);
#pragma unroll 1
        for (int bi = 0; bi < nbat; bi += 2) {
            if (bi + 1 < nbat) fetch(U8, bi + 1, bufB);
            u_consume(bi, bufA);
            if (bi + 2 < nbat) fetch(U8, bi + 2, bufA);
            if (bi + 1 < nbat) u_consume(bi + 1, bufB);
        }
    }
    __builtin_amdgcn_s_waitcnt(0xc07f); asm volatile("" ::: "memory");
    float acc[2][16];
#pragma unroll
    for (int j = 0; j < 2; ++j)
#pragma unroll
        for (int i = 0; i < 16; ++i) acc[j][i] = 0.f;
    auto v_consume = [&](int bi, const u32x4 (&buf)[8]) {
        const int e = __builtin_amdgcn_readfirstlane((int)blist[bi]);
        const int j = e & 7, k = (e >> 3) & 127, n = (e >> 10) + 1;
        float cc[8];
#pragma unroll
        for (int i = 0; i < 8; ++i) { const float c = __int_as_float(__builtin_amdgcn_readfirstlane(__float_as_int(coef[j * 128 + k + (i < n ? i : n - 1)]))); cc[i] = i < n ? c : 0.f; }
        float d[16];
#pragma unroll
        for (int q = 0; q < 16; ++q) d[q] = 0.f;
#pragma unroll
        for (int i = 0; i < 8; ++i) { float f[16]; unpack_fp8x16(buf[i], f);
#pragma unroll
            for (int q = 0; q < 16; ++q) d[q] += cc[i] * f[q];
            __builtin_amdgcn_sched_barrier(0); }
#pragma unroll
        for (int q = 0; q < 16; ++q) { acc[0][q] += j ? 0.f : d[q]; acc[1][q] += j ? d[q] : 0.f; }
    };
    {
        u32x4 bufA[8], bufB[8];
        if (nbat > 0) fetch(V8, 0, bufA);
#pragma unroll 1
        for (int bi = 0; bi < nbat; bi += 2) {
            if (bi + 1 < nbat) fetch(V8, bi + 1, bufB);
            v_consume(bi, bufA);
            if (bi + 2 < nbat) fetch(V8, bi + 2, bufA);
            if (bi + 1 < nbat) v_consume(bi + 1, bufB);
        }
    }
#pragma unroll
    for (int j = 0; j < 2; ++j) {
        const int ci = ci0 + j;
        const int row = j < ntok ? peer_row_of(ci) : -1;
        if (row >= 0) {
            float* dst = (ci < NB * SEQ ? p.out + OUT_YP + (size_t)ci * DM : p.out + OUT_YS + (size_t)(ci - NB * SEQ) * DM) + lane * 16;
            const float* h1 = p.H1() + (size_t)row * DM + lane * 16;
#pragma unroll
            for (int q = 0; q < 4; ++q) { const f32x4 a = *(const f32x4*)(h1 + 4 * q);
                *(f32x4*)(dst + 4 * q) = (f32x4){a.x + acc[j][4 * q], a.y + acc[j][4 * q + 1], a.z + acc[j][4 * q + 2], a.w + acc[j][4 * q + 3]}; }
        }
    }
}

typedef float f32x32 __attribute__((ext_vector_type(32)));
typedef unsigned u32x6 __attribute__((ext_vector_type(6)));
typedef unsigned u32x6_a8 __attribute__((ext_vector_type(6), aligned(8)));
constexpr int EX_UCF_OFF = EX_LDS, EX_LDS6 = EX_UCF_OFF + 8 * 256 * 4;
typedef u32x6 Row6;
DI f32x32 unpack_fp6x32(const Row6& r) { return __builtin_amdgcn_cvt_scalef32_pk32_f32_fp6(r, 1.0f); }
DI void experts_wave6(const Params& p, char* smem, int wave_, int lane_, int ci0, int ntok) {
    int wave = wave_, lane = lane_; asm volatile("" : "+v"(lane), "+v"(wave)); wave = __builtin_amdgcn_readfirstlane(wave);
    LAS unsigned short* idxs = (LAS unsigned short*)(smem + EX_IDX_OFF) + wave * 8 * 128;
    LAS float* coef = (LAS float*)(smem + EX_COEF_OFF) + wave * 8 * 128;
    LAS float* ucf = (LAS float*)(smem + EX_UCF_OFF) + wave * 256;
    const unsigned char* U6 = (const unsigned char*)p.U16(); const unsigned char* V6 = (const unsigned char*)p.V16();
    const int h = lane >> 5, lq = lane & 31;
#pragma unroll
    for (int j = 0; j < 2; ++j) {
        const int row = j < ntok ? peer_row_of(ci0 + j) : -1;
        int e0 = 0, e1 = 0; float g0 = 0.f, g1 = 0.f;
        if (row >= 0) { e0 = p.IDX()[(size_t)row * 128 + lane]; e1 = p.IDX()[(size_t)row * 128 + 64 + lane]; g0 = p.GATE()[(size_t)row * 128 + lane]; g1 = p.GATE()[(size_t)row * 128 + 64 + lane]; }
        idxs[j * 128 + lane] = (unsigned short)e0; idxs[j * 128 + 64 + lane] = (unsigned short)e1;
        coef[j * 128 + lane] = g0 * p.VSC()[e0]; coef[j * 128 + 64 + lane] = g1 * p.VSC()[e1];
        ucf[j * 128 + lane] = p.USC()[e0]; ucf[j * 128 + 64 + lane] = p.USC()[e1];
    }
    const int myrow = h < ntok ? peer_row_of(ci0 + h) : -1;
    float x[32];
    {
        const int rr = myrow >= 0 ? myrow : 0;
        const float rs = myrow >= 0 ? rsqrtf(p.SS2()[rr] * (1.f / DM) + 1e-6f) : 0.f;
#pragma unroll
        for (int q = 0; q < 4; ++q) { float t[8]; unpack8(*(const u32x4*)(p.HB() + (size_t)rr * DM + lq * 32 + q * 8), t);
            const f32x4 ga = *(const f32x4*)(p.norm2_g + lq * 32 + q * 8), gb = *(const f32x4*)(p.norm2_g + lq * 32 + q * 8 + 4);
            x[8 * q] = t[0] * rs * ga.x; x[8 * q + 1] = t[1] * rs * ga.y; x[8 * q + 2] = t[2] * rs * ga.z; x[8 * q + 3] = t[3] * rs * ga.w;
            x[8 * q + 4] = t[4] * rs * gb.x; x[8 * q + 5] = t[5] * rs * gb.y; x[8 * q + 6] = t[6] * rs * gb.z; x[8 * q + 7] = t[7] * rs * gb.w; }
    }
    __builtin_amdgcn_s_waitcnt(0xc07f); asm volatile("" ::: "memory");
    auto fetch = [&](const unsigned char* tab, int b, Row6 (&buf)[8]) {
        const u32x4 iv = *(LAS const u32x4*)(idxs + h * 128 + b * 8);
#pragma unroll
        for (int i = 0; i < 8; ++i) { const unsigned ex = (iv[i >> 1] >> ((i & 1) * 16)) & 0xffffu;
            const unsigned char* src = tab + (size_t)ex * 768 + lq * 24;
            buf[i] = *(const u32x6_a8*)src; }
    };
    auto u_consume = [&](int b, const Row6 (&buf)[8]) {
        float pp[8];
#pragma unroll
        for (int i = 0; i < 8; ++i) { Row6 w = buf[i]; if (i > 0) asm volatile("" : "+v"(w) : "v"(pp[i - 1]));
            const f32x32 f = unpack_fp6x32(w); float d0 = 0.f, d1 = 0.f;
#pragma unroll
            for (int q = 0; q < 32; q += 2) { d0 += f[q] * x[q]; d1 += f[q + 1] * x[q + 1]; }
            pp[i] = d0 + d1; __builtin_amdgcn_sched_barrier(0); }
        const bool b4 = lane & 16, b3 = lane & 8, b2 = lane & 4;
        float q4[4], q2[2];
#pragma unroll
        for (int i = 0; i < 4; ++i) { const float a = b4 ? pp[i + 4] : pp[i], sx = b4 ? pp[i] : pp[i + 4]; q4[i] = a + __shfl_xor(sx, 16); }
#pragma unroll
        for (int i = 0; i < 2; ++i) { const float a = b3 ? q4[i + 2] : q4[i], sx = b3 ? q4[i] : q4[i + 2]; q2[i] = a + __builtin_amdgcn_update_dpp(0.f, sx, 0x128, 0xF, 0xF, false); }
        float t;
        { const float a = b2 ? q2[1] : q2[0], sx = b2 ? q2[0] : q2[1]; t = a + dpp_hmir(sx); }
        t += dpp_xor1(t); t += dpp_xor2(t);
        if ((lane & 3) == 0) {
            const int ix = h * 128 + b * 8 + ((lane >> 4) & 1) * 4 + ((lane >> 3) & 1) * 2 + ((lane >> 2) & 1);
            const float z = t * ucf[ix];
            coef[ix] = 0.5f * z * (1.f + erff(z * 0.70710678118654752f)) * coef[ix];
        }
    };
    f32x32 acc;
#pragma unroll
    for (int i = 0; i < 32; ++i) acc[i] = 0.f;
    auto v_consume = [&](int b, const Row6 (&buf)[8]) {
        const f32x4 c0 = *(LAS const f32x4*)(coef + h * 128 + b * 8), c1 = *(LAS const f32x4*)(coef + h * 128 + b * 8 + 4);
#pragma unroll
        for (int i = 0; i < 8; ++i) { Row6 w = buf[i]; asm volatile("" : "+v"(w), "+v"(acc));
            const f32x32 f = unpack_fp6x32(w); const float c = i < 4 ? c0[i & 3] : c1[i & 3];
            acc += f * c;
            __builtin_amdgcn_sched_barrier(0); }
    };
    {
        Row6 bufA[8], bufB[8];
        fetch(U6, 0, bufA);
#pragma unroll 1
        for (int b = 0; b < 16; b += 2) {
            fetch(U6, b + 1, bufB);
            u_consume(b, bufA);
            if (b + 2 < 16) fetch(U6, b + 2, bufA); else fetch(V6, 0, bufA);
            u_consume(b + 1, bufB);
        }
        __builtin_amdgcn_s_waitcnt(0xc07f); asm volatile("" ::: "memory");
#pragma unroll 1
        for (int b = 0; b < 16; b += 2) {
            fetch(V6, b + 1, bufB);
            v_consume(b, bufA);
            if (b + 2 < 16) fetch(V6, b + 2, bufA);
            v_consume(b + 1, bufB);
        }
    }
    if (myrow >= 0) {
        const int ci = ci0 + h;
        float* dst = (ci < NB * SEQ ? p.out + OUT_YP + (size_t)ci * DM : p.out + OUT_YS + (size_t)(ci - NB * SEQ) * DM) + lq * 32;
        const float* h1 = p.H1() + (size_t)myrow * DM + lq * 32;
#pragma unroll
        for (int q = 0; q < 8; ++q) { const f32x4 a = *(const f32x4*)(h1 + 4 * q);
            *(f32x4*)(dst + 4 * q) = (f32x4){a.x + acc[4 * q], a.y + acc[4 * q + 1], a.z + acc[4 * q + 2], a.w + acc[4 * q + 3]}; }
    }
}
typedef u32x4 Row4;
DI f32x32 unpack_fp4x32(const Row4& r) {
    f32x32 f;
#define FP4_B(d, b) { const f32x2 t = __builtin_amdgcn_cvt_scalef32_pk_f32_fp4(r[d], 1.0f, b); f[8 * (d) + 2 * (b)] = t.x; f[8 * (d) + 2 * (b) + 1] = t.y; }
#define FP4_D(d) FP4_B(d, 0) FP4_B(d, 1) FP4_B(d, 2) FP4_B(d, 3)
    FP4_D(0) FP4_D(1) FP4_D(2) FP4_D(3)
#undef FP4_D
#undef FP4_B
    return f;
}
DI void experts_wave4(const Params& p, char* smem, int wave_, int lane_, int ci0, int ntok) {
    int wave = wave_, lane = lane_; asm volatile("" : "+v"(lane), "+v"(wave)); wave = __builtin_amdgcn_readfirstlane(wave);
    LAS unsigned short* idxs = (LAS unsigned short*)(smem + EX_IDX_OFF) + wave * 8 * 128;
    LAS float* coef = (LAS float*)(smem + EX_COEF_OFF) + wave * 8 * 128;
    LAS float* ucf = (LAS float*)(smem + EX_UCF_OFF) + wave * 256;
    const unsigned char* U6 = (const unsigned char*)p.U16(); const unsigned char* V6 = (const unsigned char*)p.V16();
    const int h = lane >> 5, lq = lane & 31;
#pragma unroll
    for (int j = 0; j < 2; ++j) {
        const int row = j < ntok ? peer_row_of(ci0 + j) : -1;
        int e0 = 0, e1 = 0; float g0 = 0.f, g1 = 0.f;
        if (row >= 0) { e0 = p.IDX()[(size_t)row * 128 + lane]; e1 = p.IDX()[(size_t)row * 128 + 64 + lane]; g0 = p.GATE()[(size_t)row * 128 + lane]; g1 = p.GATE()[(size_t)row * 128 + 64 + lane]; }
        idxs[j * 128 + lane] = (unsigned short)e0; idxs[j * 128 + 64 + lane] = (unsigned short)e1;
        coef[j * 128 + lane] = g0 * p.VSC()[e0]; coef[j * 128 + 64 + lane] = g1 * p.VSC()[e1];
        ucf[j * 128 + lane] = p.USC()[e0]; ucf[j * 128 + 64 + lane] = p.USC()[e1];
    }
    const int myrow = h < ntok ? peer_row_of(ci0 + h) : -1;
    float x[32];
    {
        const int rr = myrow >= 0 ? myrow : 0;
        const float rs = myrow >= 0 ? rsqrtf(p.SS2()[rr] * (1.f / DM) + 1e-6f) : 0.f;
#pragma unroll
        for (int q = 0; q < 4; ++q) { float t[8]; unpack8(*(const u32x4*)(p.HB() + (size_t)rr * DM + lq * 32 + q * 8), t);
            const f32x4 ga = *(const f32x4*)(p.norm2_g + lq * 32 + q * 8), gb = *(const f32x4*)(p.norm2_g + lq * 32 + q * 8 + 4);
            x[8 * q] = t[0] * rs * ga.x; x[8 * q + 1] = t[1] * rs * ga.y; x[8 * q + 2] = t[2] * rs * ga.z; x[8 * q + 3] = t[3] * rs * ga.w;
            x[8 * q + 4] = t[4] * rs * gb.x; x[8 * q + 5] = t[5] * rs * gb.y; x[8 * q + 6] = t[6] * rs * gb.z; x[8 * q + 7] = t[7] * rs * gb.w; }
    }
    __builtin_amdgcn_s_waitcnt(0xc07f); asm volatile("" ::: "memory");
    auto fetch = [&](const unsigned char* tab, int b, Row4 (&buf)[8]) {
        const u32x4 iv = *(LAS const u32x4*)(idxs + h * 128 + b * 8);
#pragma unroll
        for (int i = 0; i < 8; ++i) { const unsigned ex = (iv[i >> 1] >> ((i & 1) * 16)) & 0xffffu;
            buf[i] = *(const u32x4*)(tab + (size_t)ex * 512 + lq * 16); }
    };
    auto u_consume = [&](int b, const Row4 (&buf)[8]) {
        float pp[8];
#pragma unroll
        for (int i = 0; i < 8; ++i) { Row4 w = buf[i]; if (i > 0) asm volatile("" : "+v"(w) : "v"(pp[i - 1]));
            const f32x32 f = unpack_fp4x32(w); f32x2 d = {0.f, 0.f}, e = {0.f, 0.f};
#pragma unroll
            for (int q = 0; q < 32; q += 4) { d = __builtin_elementwise_fma((f32x2){f[q], f[q + 1]}, (f32x2){x[q], x[q + 1]}, d); e = __builtin_elementwise_fma((f32x2){f[q + 2], f[q + 3]}, (f32x2){x[q + 2], x[q + 3]}, e); }
            d += e; pp[i] = d.x + d.y; __builtin_amdgcn_sched_barrier(0); }
        const bool b4 = lane & 16, b3 = lane & 8, b2 = lane & 4;
        float q4[4], q2[2];
#pragma unroll
        for (int i = 0; i < 4; ++i) { const float a = b4 ? pp[i + 4] : pp[i], sx = b4 ? pp[i] : pp[i + 4]; q4[i] = a + __shfl_xor(sx, 16); }
#pragma unroll
        for (int i = 0; i < 2; ++i) { const float a = b3 ? q4[i + 2] : q4[i], sx = b3 ? q4[i] : q4[i + 2]; q2[i] = a + __builtin_amdgcn_update_dpp(0.f, sx, 0x128, 0xF, 0xF, false); }
        float t;
        { const float a = b2 ? q2[1] : q2[0], sx = b2 ? q2[0] : q2[1]; t = a + dpp_hmir(sx); }
        t += dpp_xor1(t); t += dpp_xor2(t);
        if ((lane & 3) == 0) {
            const int ix = h * 128 + b * 8 + ((lane >> 4) & 1) * 4 + ((lane >> 3) & 1) * 2 + ((lane >> 2) & 1);
            const float z = t * ucf[ix];
            coef[ix] = 0.5f * z * (1.f + erff(z * 0.70710678118654752f)) * coef[ix];
        }
    };
    f32x32 acc;
#pragma unroll
    for (int i = 0; i < 32; ++i) acc[i] = 0.f;
    auto v_consume = [&](int b, const Row4 (&buf)[8]) {
        const f32x4 c0 = *(LAS const f32x4*)(coef + h * 128 + b * 8), c1 = *(LAS const f32x4*)(coef + h * 128 + b * 8 + 4);
#pragma unroll
        for (int i = 0; i < 8; ++i) { Row4 w = buf[i]; asm volatile("" : "+v"(w), "+v"(acc));
            const f32x32 f = unpack_fp4x32(w); const float c = i < 4 ? c0[i & 3] : c1[i & 3];
            acc += f * c;
            __builtin_amdgcn_sched_barrier(0); }
    };
    {
        Row4 bufA[8], bufB[8], bufC[8];
        auto fetch_j = [&](int j, Row4 (&buf)[8]) { if (j < 32) fetch(j < 16 ? U6 : V6, j & 15, buf); };
        fetch_j(0, bufA); fetch_j(1, bufB);
#pragma unroll 1
        for (int j = 0; j < 15; j += 3) {
            fetch_j(j + 2, bufC); u_consume(j, bufA);
            fetch_j(j + 3, bufA); u_consume(j + 1, bufB);
            fetch_j(j + 4, bufB); u_consume(j + 2, bufC);
        }
        fetch_j(17, bufC); u_consume(15, bufA);
        __builtin_amdgcn_s_waitcnt(0xc07f); asm volatile("" ::: "memory");
#pragma unroll 1
        for (int j = 16; j < 31; j += 3) {
            fetch_j(j + 2, bufA); v_consume(j - 16, bufB);
            fetch_j(j + 3, bufB); v_consume(j - 15, bufC);
            fetch_j(j + 4, bufC); v_consume(j - 14, bufA);
        }
        v_consume(15, bufB);
    }
    if (myrow >= 0) {
        const int ci = ci0 + h;
        float* dst = (ci < NB * SEQ ? p.out + OUT_YP + (size_t)ci * DM : p.out + OUT_YS + (size_t)(ci - NB * SEQ) * DM) + lq * 32;
        const float* h1 = p.H1() + (size_t)myrow * DM + lq * 32;
#pragma unroll
        for (int q = 0; q < 8; ++q) { const f32x4 a = *(const f32x4*)(h1 + 4 * q);
            *(f32x4*)(dst + 4 * q) = (f32x4){a.x + acc[4 * q], a.y + acc[4 * q + 1], a.z + acc[4 * q + 2], a.w + acc[4 * q + 3]}; }
    }
}

#define XB_TMO      128
#define XB_XCNT(j)  (256  + 64 * (j))
#define XB_XSUB(j)  (1280 + 64 * (j))
#define XB_XGEN(j)  (2304 + 64 * (j))
#define XB_TOP      3328
#define XB_TOPGEN   3392
#define XCD_BAR_WORDS 3456
#define XB_SPIN_CAP (1u << 18)

__device__ __forceinline__ unsigned xb_ld(unsigned* p)              { return __hip_atomic_load(p, __ATOMIC_RELAXED, __HIP_MEMORY_SCOPE_AGENT); }
__device__ __forceinline__ unsigned xb_add(unsigned* p, unsigned v) { return __hip_atomic_fetch_add(p, v, __ATOMIC_RELAXED, __HIP_MEMORY_SCOPE_AGENT); }
__device__ __forceinline__ unsigned xb_xcc_id() { return (unsigned)__builtin_amdgcn_s_getreg((3 << 11) | 20) & 0xFu; }
#define XB_SPIN(cond, bar) do { unsigned _sp = 0; while (cond) { __builtin_amdgcn_s_sleep(1); \
    if ((++_sp & 255u) == 0u) { if (xb_ld(&(bar)[XB_TMO])) break; if (_sp > XB_SPIN_CAP) { atomicAdd(&(bar)[XB_TMO], 1u); break; } } } } while (0)

struct XcdBarrier {
    unsigned* bar; unsigned x;
    volatile LAS unsigned* st;
};
__device__ __forceinline__ XcdBarrier xcd_barrier_post(unsigned* bar, volatile LAS unsigned* st) {
    XcdBarrier b; b.bar = bar; b.x = xb_xcc_id(); b.st = st;
    if (threadIdx.x == 0) (void)xb_add(&bar[XB_XCNT(b.x)], 1u);
    return b;
}
__device__ __forceinline__ void xcd_barrier_complete(unsigned* bar, unsigned x, unsigned& nloc, unsigned& nx) {
    const unsigned G = gridDim.x * gridDim.y * gridDim.z;
    unsigned sum, cnt, mine, sp = 0u;
    for (;;) {
        sum = 0u; cnt = 0u; mine = 0u;
#pragma unroll
        for (unsigned j = 0; j < 16; ++j) { const unsigned c = xb_ld(&bar[XB_XCNT(j)]); sum += c; cnt += (c > 0u) ? 1u : 0u; mine = (j == x) ? c : mine; }
        if (sum == G) break;
        __builtin_amdgcn_s_sleep(1);
        if ((++sp & 255u) == 0u) { if (xb_ld(&bar[XB_TMO])) break; if (sp > XB_SPIN_CAP) { atomicAdd(&bar[XB_TMO], 1u); break; } }
    }
    nloc = mine > 0u ? mine : 1u; nx = cnt > 0u ? cnt : 1u;
}
__device__ __forceinline__ void xcd_barrier(const XcdBarrier& b) {
    asm volatile("s_waitcnt vmcnt(0)" ::: "memory");
    __syncthreads();
    if (threadIdx.x == 0) {
        unsigned* bar = b.bar;
        __builtin_amdgcn_s_waitcnt(0);
        unsigned nloc = b.st[0], nx = b.st[1];
        if (nloc == 0u) { xcd_barrier_complete(bar, b.x, nloc, nx); b.st[0] = nloc; b.st[1] = nx; }
        const unsigned old = xb_add(&bar[XB_XSUB(b.x)], 1u);
        const unsigned gen = old / nloc;
        if (old + 1u == (gen + 1u) * nloc) {
            __builtin_amdgcn_fence(__ATOMIC_RELEASE, "agent");
            asm volatile("s_waitcnt vmcnt(0)" ::: "memory");
            const unsigned og = xb_add(&bar[XB_TOP], 1u);
            const unsigned tg = og / nx;
            if (og + 1u == (tg + 1u) * nx) xb_add(&bar[XB_TOPGEN], 1u);
            else XB_SPIN(xb_ld(&bar[XB_TOPGEN]) == tg, bar);
            __builtin_amdgcn_fence(__ATOMIC_ACQUIRE, "agent");
            xb_add(&bar[XB_XGEN(b.x)], 1u);
            asm volatile("s_waitcnt vmcnt(0)" ::: "memory");
        } else {
            XB_SPIN(xb_ld(&bar[XB_XGEN(b.x)]) == gen, bar);
            __builtin_amdgcn_fence(__ATOMIC_ACQUIRE, "agent");
            asm volatile("s_waitcnt vmcnt(0)" ::: "memory");
        }
    }
    __syncthreads();
}

constexpr int NTHR = 512, NBLK = 256;
constexpr int LDS_MAIN = 159744, LDS_BYTES = LDS_MAIN + 64;
extern __shared__ __attribute__((aligned(16))) char dyn_smem[];

DI int pull_work(unsigned* q, char* smem, int tid, int step) {
    LAS int* bw = (LAS int*)(smem + LDS_MAIN + 32);
    __syncthreads();
    if (tid == 0) *bw = (int)__hip_atomic_fetch_add(q, (unsigned)step, __ATOMIC_RELAXED, __HIP_MEMORY_SCOPE_AGENT);
    __syncthreads();
    return *bw;
}

#define PH_IDS int tid = threadIdx.x; asm volatile("" : "+v"(tid)); const int wave = tid >> 6, lane = tid & 63, gw = bid * 8 + wave; (void)wave; (void)lane; (void)gw;
__global__ void __launch_bounds__(NTHR, 2) k_mega(Params p) {
    const int bid = blockIdx.x, nblk = gridDim.x, ngw = nblk * 8;
    char* smem = dyn_smem;
    if (threadIdx.x == 0) *(u32x4*)(smem + LDS_MAIN) = (u32x4){0u, 0u, 0u, 0u};
    __syncthreads();
    XcdBarrier bar = xcd_barrier_post(p.ctl(), (volatile LAS unsigned*)(smem + LDS_MAIN));
    { PH_IDS phase_convert(p, smem, 0, gw, ngw, wave, lane); }
    xcd_barrier(bar);
    { EpiProj e{p.RSTD1(), p.PROJ(), p.out}; g8::gemm_phase<false>(p.XB(), 1024, p.WIN_T(), 1024, MP / 256, INW / 256, (bf16_t*)smem, e, bid, nblk); }
    { PH_IDS constexpr int G1_REM = (MP / 256) * (INW / 256) % NBLK;
      if (bid >= G1_REM) phase_convert(p, smem, 1, (bid - G1_REM) * 8 + wave, (nblk - G1_REM) * 8, wave, lane); }
    xcd_barrier(bar);
    { PH_IDS phase_prep(p, smem, bid, nblk, gw, ngw, tid, lane); }
    xcd_barrier(bar);
    { PH_IDS unsigned short pre[48]; chunk_prefetch(p, bid, tid, pre); for (int u = bid; u < CK_UNITS; u += nblk) chunk_pass1(p, smem, u, u + nblk, pre, tid); }
    {
        asm volatile("s_waitcnt vmcnt(0)" ::: "memory");
        __syncthreads();
        unsigned* cnt = p.ctl() + CTL_P3A_DONE;
        if (threadIdx.x == 0) {
            __builtin_amdgcn_fence(__ATOMIC_RELEASE, "agent");
            asm volatile("s_waitcnt vmcnt(0)" ::: "memory");
            (void)xb_add(cnt, 1u);
            if (bid < 64) {
                XB_SPIN(xb_ld(cnt) < (unsigned)nblk, p.ctl());
                __builtin_amdgcn_fence(__ATOMIC_ACQUIRE, "agent");
                asm volatile("s_waitcnt vmcnt(0)" ::: "memory");
            }
        }
        if (bid < 64) __syncthreads();
    }
    {
        PH_IDS
        volatile LAS int* prog = (volatile LAS int*)(smem + LDS_MAIN + 48);
        if (tid == 0) *prog = 0;
        __syncthreads();
        if (bid < 64) {
            if (wave == 0) chunk_pass2(p, bid, lane, prog);
            else if (wave == 1) chunk_pass2_prefetch(p, bid, lane, prog);
            else {
                while (*prog < CK_N) {
                    int u = 0; if (lane == 0) u = (int)__hip_atomic_fetch_add(p.ctl() + CTL_Q_SATTN, 1u, __ATOMIC_RELAXED, __HIP_MEMORY_SCOPE_AGENT);
                    u = __builtin_amdgcn_readfirstlane(u);
                    if (u >= SA_UNITS) break;
                    sattn_unit(p, u, lane);
                }
            }
        }
        else if (bid >= 128) rwkv_sample_unit(p, (bid - 128) * 2 + (tid >> 8), tid & 255);
    }
    {
        PH_IDS
        const float lam = compute_lam(p, lane);
        for (;;) {
            const int idx = pull_work(p.ctl() + CTL_Q_ATTN, smem, tid, 1);
            if (idx >= AT_UNITS) break;
            const int qbi = idx >> 4, bh = idx & 15, qb = qbi < 32 ? 31 - qbi : 32;
            attn_unit(p, smem, bh >> 2, bh & 3, qb, lam, alibi_dmax(p, bh & 3, lane), tid);
        }
    }
    {
        PH_IDS
        for (;;) {
            const int u0 = pull_work(p.ctl() + CTL_Q_SATTN, smem, tid, 8);
            if (u0 >= SA_UNITS) break;
            if (u0 + wave < SA_UNITS) sattn_unit(p, u0 + wave, lane);
        }
    }
    xcd_barrier(bar);
    {
        PH_IDS
        for (int u = gw; u < 2 * CK_UNITS; u += ngw) chunk_pass3(p, u, lane);
        if (gw >= 64 && gw < 64 + MS) rwkv_post_row(p, MPR + gw - 64, lane);
        const float lam = compute_lam(p, lane);
        if (gw >= 64 + MS && gw < 64 + MS + MS * 4) sattn_combine(p, gw - 64 - MS, lam, lane);
    }
    xcd_barrier(bar);
    { PH_IDS
      skinny_gemm(p.YO(), 1024, p.WRW_T(), 512, 1024, smem, bid, nblk, tid, [&](int row, int col, float v) { p.MIXF()[(size_t)row * DM + col] = v * sigmoidf_(bf2f(p.PROJ()[(size_t)row * INW + O_GA + col])); });
      skinny_gemm(p.YO() + 512, 1024, p.WDA_T(), 512, 1024, smem, bid, nblk, tid, [&](int row, int col, float v) { p.MIX()[(size_t)row * DM + col] = bf16_1(p.MIXF()[(size_t)row * DM + col] + v * sigmoidf_(bf2f(p.PROJ()[(size_t)row * INW + O_GB + col]))); }); }
    { EpiBr1 e{p.PROJ(), p.MIX()}; g8::gemm_phase<true>(p.YO(), 1024, p.WRW_T(), 512, 64, 4, (bf16_t*)smem, e, bid, nblk); }
    { EpiBr2 e{p.PROJ(), p.MIX()}; g8::gemm_phase<true>(p.YO() + 512, 1024, p.WDA_T(), 512, 64, 4, (bf16_t*)smem, e, bid, nblk); }
    xcd_barrier(bar);
    { PH_IDS
      skinny_gemm(p.MIX(), 1024, p.WOUT_T(), 1024, 1024, smem, bid, nblk, tid, [&](int row, int col, float v) {
          const float h = p.x_sample[(size_t)(row - MPR) * DM + col] + v; p.H1()[(size_t)row * DM + col] = h; p.HB()[(size_t)row * DM + col] = bf16_1(h);
          float ss = h * h; ss += __shfl_xor(ss, 1); ss += __shfl_xor(ss, 2); ss += __shfl_xor(ss, 4); ss += __shfl_xor(ss, 8); ss += __shfl_xor(ss, 16);
          if ((lane & 31) == 0) atomicAdd(p.SS2() + row, ss); }); }
    { EpiOut e{p.XPTR(), p.H1(), p.HB(), p.SS2()}; g8::gemm_phase<true>(p.MIX(), 1024, p.WOUT_T(), 1024, 64, 4, (bf16_t*)smem, e, bid, nblk); }
    xcd_barrier(bar);
    { PH_IDS
      skinny_gemm(p.HB(), 1024, p.WQ_T(), 1024, 2048, smem, bid, nblk, tid, [&](int row, int col, float v) { p.QP()[(size_t)row * 2048 + col] = bf16_1(v * rsqrtf(p.SS2()[row] * (1.f / DM) + 1e-6f)); }); }
    { EpiQ e{p.SS2(), p.QP()}; g8::gemm_phase<true>(p.HB(), 1024, p.WQ_T(), 1024, 64, 8, (bf16_t*)smem, e, bid, nblk); }
    xcd_barrier(bar);
    {
        PH_IDS
        for (int ch = tid; ch < 256 * 16; ch += 512) { const int r = ch >> 4, cc = ch & 15; *(u32x4*)(smem + 16384 + r * 272 + cc * 16) = *(const u32x4*)(p.SK() + (size_t)r * 128 + cc * 8); }
        __syncthreads();
        for (int u = gw; u < (MTOT / 32) * 8; u += ngw) topk_unit(p, smem + 16384, smem + wave * 2048, u, lane);
        constexpr int TK_REM = (MTOT / 32) * 8 - 2 * NBLK * 8;
        if (gw >= TK_REM) { const int cw = gw - TK_REM, ncw = ngw - TK_REM;
            for (int it = cw; it < 32768; it += ncw) { if (it < 16384) convert_row_fp4(p.peer_u, (unsigned char*)p.U16(), p.USC(), it, lane); else convert_row_fp4(p.peer_v, (unsigned char*)p.V16(), p.VSC(), it - 16384, lane); } }
    }
    xcd_barrier(bar);
    {
        PH_IDS
#pragma unroll 1
        for (int pass = 0; pass < 5; ++pass) {
            const int ci0 = pass < 4 ? bid * 64 + wave * 8 + 2 * pass : NB * SEQ + bid;
            const int ntok = pass < 4 ? 2 : ((bid < MS && wave == 0) ? 1 : 0);
            if (ntok > 0) experts_wave4(p, smem, wave, lane, ci0, ntok);
        }
    }
}

extern "C" void kernel_launch(void* const* d_in, const int* in_sizes, int n_in, void* d_out, int out_size, void* d_ws, size_t ws_size, hipStream_t stream) {
    Params p{};
    p.x_prompt = (const float*)d_in[0]; p.x_sample = (const float*)d_in[1]; p.cache_k = (const float*)d_in[2]; p.cache_v = (const float*)d_in[3];
    p.state_wkv = (const float*)d_in[4]; p.state_shift = (const float*)d_in[5]; p.page_table = (const int*)d_in[6];
    p.meta = (const float*)d_in[7]; p.norm1_g = (const float*)d_in[8]; p.w_in = (const float*)d_in[9]; p.rw_mu = (const float*)d_in[10]; p.rw_w0 = (const float*)d_in[11];
    p.rw_w2 = (const float*)d_in[12]; p.rw_a0 = (const float*)d_in[13]; p.rw_a2 = (const float*)d_in[14]; p.rw_g2 = (const float*)d_in[15]; p.rw_kk = (const float*)d_in[16];
    p.rw_ka = (const float*)d_in[17]; p.rw_rk = (const float*)d_in[18]; p.rw_ln_g = (const float*)d_in[19]; p.rw_ln_b = (const float*)d_in[20]; p.w_rw_br = (const float*)d_in[21];
    p.da_qn_g = (const float*)d_in[22]; p.da_kn_g = (const float*)d_in[23]; p.da_lam = (const float*)d_in[24]; p.da_subln_g = (const float*)d_in[25]; p.w_da_br = (const float*)d_in[26];
    p.w_out = (const float*)d_in[27]; p.norm2_g = (const float*)d_in[28]; p.peer_wq = (const float*)d_in[29]; p.peer_subkeys = (const float*)d_in[30]; p.peer_u = (const float*)d_in[31];
    p.peer_v = (const float*)d_in[32];
    (void)in_sizes; (void)n_in; (void)out_size; (void)ws_size;
    p.out = (float*)d_out;
    p.ws = (char*)d_ws;
    static bool attr_done = false;
    if (!attr_done) { (void)hipFuncSetAttribute((const void*)k_mega, hipFuncAttributeMaxDynamicSharedMemorySize, LDS_BYTES); attr_done = true; }
    (void)hipMemsetAsync(p.ws + WO_ctl, 0, CTL_WORDS * 4, stream);
    k_mega<<<NBLK, NTHR, LDS_BYTES, stream>>>(p);
}
```

```cpp
#include <hip/hip_runtime.h>
#include <stdint.h>
#include <stdio.h>

#define DI __device__ __forceinline__
#define LAS __attribute__((address_space(3)))
typedef unsigned short bf16_t;
typedef short bf16x8 __attribute__((ext_vector_type(8)));
typedef short s16x4 __attribute__((ext_vector_type(4)));
typedef float f32x2 __attribute__((ext_vector_type(2)));
typedef float f32x4 __attribute__((ext_vector_type(4)));
typedef float f32x16 __attribute__((ext_vector_type(16)));
typedef unsigned u32x2 __attribute__((ext_vector_type(2)));
typedef unsigned u32x4 __attribute__((ext_vector_type(4)));
typedef __bf16 bf16v2 __attribute__((ext_vector_type(2)));

constexpr int DM = 1024, NB = 4, SEQ = 4096, NMETA = 16, TT = SEQ + NMETA  ;
constexpr int MPR = NB * TT  , MS = 32, MTOT = MPR + MS  , MP = 16640  ;
constexpr int RWP = 1792, INW = 5376;
constexpr int O_Q = 1792, O_K = 2304, O_V = 2816, O_GA = 3328, O_GB = 4352;
constexpr int NPAGES = 64, PAGE = 128, PAST = 8192;
constexpr float LOG2E = 1.4426950408889634f;
constexpr float LAM_INIT = 0.2f;
constexpr size_t OUT_YP = 0, OUT_YS = OUT_YP + (size_t)NB * SEQ * DM, OUT_KP = OUT_YS + (size_t)MS * DM, OUT_VP = OUT_KP + (size_t)MPR * 512,
                 OUT_KS = OUT_VP + (size_t)MPR * 512, OUT_VS = OUT_KS + (size_t)MS * 512, OUT_WP = OUT_VS + (size_t)MS * 512,
                 OUT_WS = OUT_WP + (size_t)NB * 8 * 4096, OUT_SP = OUT_WS + (size_t)MS * 8 * 4096, OUT_SS = OUT_SP + (size_t)NB * RWP,
                 OUT_END = OUT_SS + (size_t)MS * RWP;

constexpr int SA_SPLITS = 16, SA_UNITS = MS * 4 * SA_SPLITS;
constexpr int CK_N = 65, CK_UNITS = 32 * CK_N;
constexpr int TTP = CK_N * 64;
constexpr int CTL_WORDS = 8192, CTL_Q_ATTN = 4096, CTL_Q_SATTN = 4096 + 64, CTL_P3A_DONE = 4096 + 512;
constexpr size_t ws_al(size_t b) { return (b + 255) & ~(size_t)255; }
constexpr size_t WO_ctl = 0;
constexpr size_t WO_XB = WO_ctl + ws_al(CTL_WORDS * 4);
constexpr size_t WO_WIN_T = WO_XB + ws_al((size_t)MP * DM * 2);
constexpr size_t WO_WRW_T = WO_WIN_T + ws_al((size_t)INW * DM * 2);
constexpr size_t WO_WDA_T = WO_WRW_T + ws_al((size_t)1024 * 512 * 2);
constexpr size_t WO_WOUT_T = WO_WDA_T + ws_al((size_t)1024 * 512 * 2);
constexpr size_t WO_WQ_T = WO_WOUT_T + ws_al((size_t)1024 * 1024 * 2);
constexpr size_t WO_W2_T = WO_WQ_T + ws_al((size_t)2048 * 1024 * 2);
constexpr size_t WO_A2_T = WO_W2_T + ws_al(512 * 64 * 2);
constexpr size_t WO_G2_T = WO_A2_T + ws_al(512 * 64 * 2);
constexpr size_t WO_SK = WO_G2_T + ws_al(512 * 128 * 2);
constexpr size_t WO_U16 = WO_SK + ws_al(2 * 128 * 128 * 2);
constexpr size_t WO_V16 = WO_U16 + ws_al((size_t)16384 * DM * 2);
constexpr size_t WO_PROJ = WO_V16 + ws_al((size_t)16384 * DM * 2);
constexpr size_t WO_QN = WO_PROJ + ws_al((size_t)MP * INW * 2);
constexpr size_t WO_KN = WO_QN + ws_al((size_t)MP * 512 * 2);
constexpr size_t WO_SCAN = WO_KN + ws_al((size_t)MP * 512 * 2);
constexpr size_t WO_G = WO_SCAN + ws_al((size_t)32 * 6 * 64 * TTP * 2);
constexpr size_t WO_YO = WO_G + ws_al((size_t)MP * 512 * 2);
constexpr size_t WO_MIX = WO_YO + ws_al((size_t)MP * DM * 2);
constexpr size_t WO_HB = WO_MIX + ws_al((size_t)MP * DM * 2);
constexpr size_t WO_QP = WO_HB + ws_al((size_t)MP * DM * 2);
constexpr size_t WO_RSTD1 = WO_QP + ws_al((size_t)MP * 2048 * 2);
constexpr size_t WO_BONUS = WO_RSTD1 + ws_al((size_t)MP * 4);
constexpr size_t WO_Y = WO_BONUS + ws_al((size_t)MP * 8 * 4);
constexpr size_t WO_MIXF = WO_Y + ws_al((size_t)MP * 512 * 4);
constexpr size_t WO_H1 = WO_MIXF + ws_al((size_t)MP * DM * 4);
constexpr size_t WO_SS2 = WO_H1 + ws_al((size_t)MP * DM * 4);
constexpr size_t WO_GATE = WO_SS2 + ws_al((size_t)MP * 4);
constexpr size_t WO_PART = WO_GATE + ws_al((size_t)MP * 128 * 4);
constexpr size_t WO_SCAN_S = WO_PART + ws_al((size_t)SA_UNITS * 2 * 130 * 4);
constexpr size_t WO_IDX = WO_SCAN_S + ws_al((size_t)MS * 8 * 384 * 4);
constexpr size_t WO_XPTR = WO_IDX + ws_al((size_t)MP * 128 * 4);
constexpr size_t WO_ZROW = WO_XPTR + ws_al((size_t)MP * 8);
constexpr size_t WO_MYT = WO_ZROW + ws_al(4096);
constexpr size_t WO_MST = WO_MYT + ws_al((size_t)CK_UNITS * 4096 * 2);
constexpr size_t WO_PLV = WO_MST + ws_al((size_t)CK_UNITS * 4096 * 2);
constexpr size_t WO_WYT = WO_PLV + ws_al((size_t)CK_UNITS * 64 * 4);
constexpr size_t WO_WST = WO_WYT + ws_al((size_t)CK_UNITS * 4096 * 4);
constexpr size_t WO_SCF = WO_WST + ws_al((size_t)CK_UNITS * 4096 * 4);
constexpr size_t WS_END = WO_SCF + ws_al((size_t)CK_UNITS * 16 * 64 * 16);
struct Params {
    const float *x_prompt, *x_sample, *cache_k, *cache_v, *state_wkv, *state_shift; const int* page_table;
    const float *meta, *norm1_g, *w_in, *rw_mu, *rw_w0, *rw_w2, *rw_a0, *rw_a2, *rw_g2, *rw_kk, *rw_ka, *rw_rk, *rw_ln_g, *rw_ln_b, *w_rw_br,
        *da_qn_g, *da_kn_g, *da_lam, *da_subln_g, *w_da_br, *w_out, *norm2_g, *peer_wq, *peer_subkeys, *peer_u, *peer_v;
    float* out; char* ws;
    DI unsigned* ctl() const { return (unsigned*)(ws + WO_ctl); }
    DI bf16_t* XB() const { return (bf16_t*)(ws + WO_XB); }
    DI bf16_t* WIN_T() const { return (bf16_t*)(ws + WO_WIN_T); }
    DI bf16_t* WRW_T() const { return (bf16_t*)(ws + WO_WRW_T); }
    DI bf16_t* WDA_T() const { return (bf16_t*)(ws + WO_WDA_T); }
    DI bf16_t* WOUT_T() const { return (bf16_t*)(ws + WO_WOUT_T); }
    DI bf16_t* WQ_T() const { return (bf16_t*)(ws + WO_WQ_T); }
    DI bf16_t* W2_T() const { return (bf16_t*)(ws + WO_W2_T); }
    DI bf16_t* A2_T() const { return (bf16_t*)(ws + WO_A2_T); }
    DI bf16_t* G2_T() const { return (bf16_t*)(ws + WO_G2_T); }
    DI bf16_t* SK() const { return (bf16_t*)(ws + WO_SK); }
    DI bf16_t* U16() const { return (bf16_t*)(ws + WO_U16); }
    DI bf16_t* V16() const { return (bf16_t*)(ws + WO_V16); }
    DI float* USC() const { return (float*)(ws + WO_U16 + ((size_t)16 << 20)); }
    DI float* VSC() const { return (float*)(ws + WO_V16 + ((size_t)16 << 20)); }
    DI bf16_t* PROJ() const { return (bf16_t*)(ws + WO_PROJ); }
    DI bf16_t* QN() const { return (bf16_t*)(ws + WO_QN); }
    DI bf16_t* KN() const { return (bf16_t*)(ws + WO_KN); }
    DI bf16_t* SCAN() const { return (bf16_t*)(ws + WO_SCAN); }
    DI bf16_t* G() const { return (bf16_t*)(ws + WO_G); }
    DI bf16_t* YO() const { return (bf16_t*)(ws + WO_YO); }
    DI bf16_t* MIX() const { return (bf16_t*)(ws + WO_MIX); }
    DI bf16_t* HB() const { return (bf16_t*)(ws + WO_HB); }
    DI bf16_t* QP() const { return (bf16_t*)(ws + WO_QP); }
    DI float* RSTD1() const { return (float*)(ws + WO_RSTD1); }
    DI float* BONUS() const { return (float*)(ws + WO_BONUS); }
    DI float* Y() const { return (float*)(ws + WO_Y); }
    DI float* MIXF() const { return (float*)(ws + WO_MIXF); }
    DI float* H1() const { return (float*)(ws + WO_H1); }
    DI float* SS2() const { return (float*)(ws + WO_SS2); }
    DI float* GATE() const { return (float*)(ws + WO_GATE); }
    DI float* PART() const { return (float*)(ws + WO_PART); }
    DI float* SCAN_S() const { return (float*)(ws + WO_SCAN_S); }
    DI int* IDX() const { return (int*)(ws + WO_IDX); }
    DI const float** XPTR() const { return (const float**)(ws + WO_XPTR); }
    DI float* ZROW() const { return (float*)(ws + WO_ZROW); }
    DI bf16_t* MYT() const { return (bf16_t*)(ws + WO_MYT); }
    DI bf16_t* MST() const { return (bf16_t*)(ws + WO_MST); }
    DI float* PLV() const { return (float*)(ws + WO_PLV); }
    DI float* WYT() const { return (float*)(ws + WO_WYT); }
    DI float* WST() const { return (float*)(ws + WO_WST); }
    DI unsigned* SCF() const { return (unsigned*)(ws + WO_SCF); }
};


DI size_t scan_addr(int chain, int vec, int d, int t) { return (((size_t)chain * 6 + vec) * 64 + d) * TTP + t; }
DI float bf2f(unsigned h) { return __uint_as_float(h << 16); }
DI float bflo(unsigned w) { return __uint_as_float(w << 16); }
DI float bfhi(unsigned w) { return __uint_as_float(w & 0xffff0000u); }
DI unsigned pk2(float lo, float hi) { f32x2 v = {lo, hi}; bf16v2 b = __builtin_convertvector(v, bf16v2); return __builtin_bit_cast(unsigned, b); }
DI unsigned short bf16_1_(float x) { return (unsigned short)(pk2(x, 0.f) & 0xffffu); }
DI float wave_sum(float v) {
#pragma unroll
    for (int o = 1; o < 64; o <<= 1) v += __shfl_xor(v, o);
    return v;
}
DI float sigmoidf_(float x) { return __builtin_amdgcn_rcpf(1.f + __expf(-x)); }
DI void unpack8(const u32x4& w, float (&f)[8]) {
    f[0] = bflo(w.x); f[1] = bfhi(w.x); f[2] = bflo(w.y); f[3] = bfhi(w.y); f[4] = bflo(w.z); f[5] = bfhi(w.z); f[6] = bflo(w.w); f[7] = bfhi(w.w);
}
DI const float* xrow_ptr(const Params& p, int row) {
    if (row < MPR) { const int b = row / TT, t = row - b * TT; return t < NMETA ? p.meta + (size_t)t * DM : p.x_prompt + ((size_t)b * SEQ + (t - NMETA)) * DM; }
    if (row < MTOT) return p.x_sample + (size_t)(row - MPR) * DM;
    return nullptr;
}

DI void transpose_item(const float* __restrict__ W, int K, int N, const float* __restrict__ gain, bf16_t* __restrict__ WT, LAS float* scr, int item, int lane) {
    const int nblk = N / 32, kb = item / nblk, nb = item - kb * nblk, k0 = 64 * kb, n0 = 32 * nb;
#pragma unroll 8
    for (int i = 0; i < 32; ++i) { const int kk = 2 * i + (lane >> 5); float g = gain ? gain[k0 + kk] : 1.f; scr[kk * 33 + (lane & 31)] = g * W[(size_t)(k0 + kk) * N + n0 + (lane & 31)]; }
    __builtin_amdgcn_s_waitcnt(0xc07f); asm volatile("" ::: "memory");
    const int c = lane & 7;
#pragma unroll
    for (int j = 0; j < 4; ++j) { const int n = (lane >> 3) + 8 * j; const LAS float* s = scr + (8 * c) * 33 + n;
        u32x4 o; o.x = pk2(s[0 * 33], s[1 * 33]); o.y = pk2(s[2 * 33], s[3 * 33]); o.z = pk2(s[4 * 33], s[5 * 33]); o.w = pk2(s[6 * 33], s[7 * 33]);
        *(u32x4*)(WT + (size_t)(n0 + n) * K + k0 + 8 * c) = o; }
    __builtin_amdgcn_s_waitcnt(0xc07f); asm volatile("" ::: "memory");
}
DI void convert_chunk(const float* __restrict__ src, bf16_t* __restrict__ dst, int item, int lane) {
    const size_t base = (size_t)item * 4096;
#pragma unroll
    for (int j = 0; j < 8; ++j) { const size_t o = base + (size_t)(j * 64 + lane) * 8;
        const f32x4 a = *(const f32x4*)(src + o), b = *(const f32x4*)(src + o + 4);
        u32x4 w; w.x = pk2(a.x, a.y); w.y = pk2(a.z, a.w); w.z = pk2(b.x, b.y); w.w = pk2(b.z, b.w);
        *(u32x4*)(dst + o) = w; }
}
constexpr float U8_SCALE = 256.f, V8_SCALE = 64.f;
DI void convert_chunk_fp8(const float* __restrict__ src, unsigned char* __restrict__ dst, float scale, int item, int lane) {
    const size_t base = (size_t)item * 4096;
#pragma unroll
    for (int j = 0; j < 4; ++j) { const size_t o = base + (size_t)(j * 64 + lane) * 16;
        u32x4 w;
#pragma unroll
        for (int q = 0; q < 4; ++q) { const f32x4 a = *(const f32x4*)(src + o + 4 * q);
            int pk = __builtin_amdgcn_cvt_pk_fp8_f32(a.x * scale, a.y * scale, 0, false); pk = __builtin_amdgcn_cvt_pk_fp8_f32(a.z * scale, a.w * scale, pk, true); w[q] = (unsigned)pk; }
        *(u32x4*)(dst + o) = w; }
}
DI unsigned fp6_code(float x, float s) {
    const float a = fminf(fabsf(x) * s, 7.5f);
    const float c = a < 2.f ? rintf(a * 8.f) : (a < 4.f ? 16.f + rintf((a - 2.f) * 4.f) : 24.f + rintf((a - 4.f) * 2.f));
    return (unsigned)c | (x < 0.f ? 32u : 0u);
}
DI void convert_row_fp6(const float* __restrict__ src, unsigned char* __restrict__ dst, float* __restrict__ sc, int row, int lane) {
    const float* sp = src + (size_t)row * DM + lane * 16;
    f32x4 v[4]; float am = 0.f;
#pragma unroll
    for (int q = 0; q < 4; ++q) { v[q] = *(const f32x4*)(sp + 4 * q); am = fmaxf(am, fmaxf(fmaxf(fabsf(v[q].x), fabsf(v[q].y)), fmaxf(fabsf(v[q].z), fabsf(v[q].w)))); }
#pragma unroll
    for (int o = 32; o; o >>= 1) am = fmaxf(am, __shfl_xor(am, o));
    const float s = am > 0.f ? 7.5f / am : 0.f;
    if (lane == 0) sc[row] = am * (1.f / 7.5f);
    unsigned long long lo = 0; unsigned hi = 0;
#pragma unroll
    for (int i = 0; i < 16; ++i) {
        const unsigned c = fp6_code(v[i >> 2][i & 3], s);
        if (i < 10) lo |= (unsigned long long)c << (6 * i);
        else if (i == 10) { lo |= (unsigned long long)(c & 15u) << 60; hi |= c >> 4; }
        else hi |= c << (6 * i - 64);
    }
    unsigned* dp = (unsigned*)(dst + (size_t)row * 768 + lane * 12);
    dp[0] = (unsigned)lo; dp[1] = (unsigned)(lo >> 32); dp[2] = hi;
}
DI void phase_convert(const Params& p, char* smem, int part, int gw, int ngw, int wave, int lane) {
    LAS float* scr = (LAS float*)(smem) + wave * (64 * 33);
    constexpr int I_ROWS = MP;
    constexpr int I_WIN = 16 * (INW / 32), I_RW = 8 * 32, I_DA = 8 * 32, I_OUT = 16 * 32, I_WQ = 16 * 64, I_W2 = 16, I_A2 = 16, I_G2 = 32;
    constexpr int I_SK = 8, I_Z = MP / 256;
    if (part == 0) {
        constexpr int NIT = I_ROWS + I_WIN + I_Z;
        for (int it = gw; it < NIT; it += ngw) {
            int r = it;
            if (r < I_ROWS) {
                const float* src = xrow_ptr(p, r);
                f32x4 v[4]; float ss = 0.f;
#pragma unroll
                for (int j = 0; j < 4; ++j) { v[j] = src ? *(const f32x4*)(src + (j * 64 + lane) * 4) : (f32x4){0.f, 0.f, 0.f, 0.f}; ss += v[j].x * v[j].x + v[j].y * v[j].y + v[j].z * v[j].z + v[j].w * v[j].w; }
                ss = wave_sum(ss);
#pragma unroll
                for (int j = 0; j < 4; ++j) { u32x2 o; o.x = pk2(v[j].x, v[j].y); o.y = pk2(v[j].z, v[j].w); *(u32x2*)(p.XB() + (size_t)r * DM + (j * 64 + lane) * 4) = o; }
                if (lane == 0) { p.RSTD1()[r] = rsqrtf(ss * (1.f / DM) + 1e-6f); p.XPTR()[r] = src ? src : p.ZROW(); }
                continue;
            }
            r -= I_ROWS;
            if (r < I_WIN) { transpose_item(p.w_in, 1024, INW, p.norm1_g, p.WIN_T(), scr, r, lane); continue; } r -= I_WIN;
            { *(f32x4*)(p.SS2() + (size_t)r * 256 + lane * 4) = (f32x4){0.f, 0.f, 0.f, 0.f}; if (r < 4) *(f32x4*)(p.ZROW() + (size_t)r * 256 + lane * 4) = (f32x4){0.f, 0.f, 0.f, 0.f}; }
        }
    } else {
        constexpr int NIT = I_RW + I_DA + I_OUT + I_WQ + I_W2 + I_A2 + I_G2 + I_SK;
        for (int it = gw; it < NIT; it += ngw) {
            int r = it;
            if (r < I_W2) { transpose_item(p.rw_w2, 64, 512, nullptr, p.W2_T(), scr, r, lane); continue; } r -= I_W2;
            if (r < I_A2) { transpose_item(p.rw_a2, 64, 512, nullptr, p.A2_T(), scr, r, lane); continue; } r -= I_A2;
            if (r < I_G2) { transpose_item(p.rw_g2, 128, 512, nullptr, p.G2_T(), scr, r, lane); continue; } r -= I_G2;
            if (r < I_RW) { transpose_item(p.w_rw_br, 512, 1024, nullptr, p.WRW_T(), scr, r, lane); continue; } r -= I_RW;
            if (r < I_DA) { transpose_item(p.w_da_br, 512, 1024, nullptr, p.WDA_T(), scr, r, lane); continue; } r -= I_DA;
            if (r < I_OUT) { transpose_item(p.w_out, 1024, 1024, nullptr, p.WOUT_T(), scr, r, lane); continue; } r -= I_OUT;
            if (r < I_WQ) { transpose_item(p.peer_wq, 1024, 2048, p.norm2_g, p.WQ_T(), scr, r, lane); continue; } r -= I_WQ;
            convert_chunk(p.peer_subkeys, p.SK(), r, lane);
        }
    }
}

DI void convert_row_fp4(const float* __restrict__ src, unsigned char* __restrict__ dst, float* __restrict__ sc, int row, int lane) {
    const float* sp = src + (size_t)row * DM + lane * 16;
    f32x4 v[4]; float am = 0.f;
#pragma unroll
    for (int q = 0; q < 4; ++q) { v[q] = *(const f32x4*)(sp + 4 * q); am = fmaxf(am, fmaxf(fmaxf(fabsf(v[q].x), fabsf(v[q].y)), fmaxf(fabsf(v[q].z), fabsf(v[q].w)))); }
#pragma unroll
    for (int o = 32; o; o >>= 1) am = fmaxf(am, __shfl_xor(am, o));
    const float s = am > 0.f ? 6.f / am : 0.f;
    if (lane == 0) sc[row] = am * (1.f / 6.f);
    unsigned w0 = 0u, w1 = 0u;
    w0 = __builtin_amdgcn_cvt_scalef32_pk_fp4_f32(w0, v[0].x * s, v[0].y * s, 1.0f, 0); w0 = __builtin_amdgcn_cvt_scalef32_pk_fp4_f32(w0, v[0].z * s, v[0].w * s, 1.0f, 1);
    w0 = __builtin_amdgcn_cvt_scalef32_pk_fp4_f32(w0, v[1].x * s, v[1].y * s, 1.0f, 2); w0 = __builtin_amdgcn_cvt_scalef32_pk_fp4_f32(w0, v[1].z * s, v[1].w * s, 1.0f, 3);
    w1 = __builtin_amdgcn_cvt_scalef32_pk_fp4_f32(w1, v[2].x * s, v[2].y * s, 1.0f, 0); w1 = __builtin_amdgcn_cvt_scalef32_pk_fp4_f32(w1, v[2].z * s, v[2].w * s, 1.0f, 1);
    w1 = __builtin_amdgcn_cvt_scalef32_pk_fp4_f32(w1, v[3].x * s, v[3].y * s, 1.0f, 2); w1 = __builtin_amdgcn_cvt_scalef32_pk_fp4_f32(w1, v[3].z * s, v[3].w * s, 1.0f, 3);
    *(u32x2*)(dst + (size_t)row * 512 + lane * 8) = (u32x2){w0, w1};
}

namespace g8 {
constexpr int BM = 256, BK = 64, HALF = 128, HT = HALF * BK, SHM_B = 8 * HT * 2, NXCD = 8, WGM = 8;
DI int lds_byte(int r, int c) { int st = (r >> 4) * 2 + (c >> 5), rr = r & 15, cc = c & 31, ob = rr * 64 + cc * 2; return st * 1024 + (ob ^ (((ob >> 9) & 1) << 5)); }
DI void stage_rc(int b, int& R, int& C) { int st = b / 1024, sb = b % 1024, swz = sb ^ (((sb >> 9) & 1) << 5); R = (st >> 1) * 16 + swz / 64; C = (st & 1) * 32 + (swz % 64) / 2; }
DI void unit_map(int L, int nM, int nN, int& pm, int& pn) {
    const int nwg = nM * nN; int wgid = L;
    { const int q = nwg / NXCD, r = nwg % NXCD, xcd = wgid % NXCD, off = wgid / NXCD; wgid = (xcd < r ? xcd * (q + 1) : r * (q + 1) + (xcd - r) * q) + off; }
    const int nig = WGM * nN, gid = wgid / nig, fm = gid * WGM, gsz = (nM - fm) < WGM ? (nM - fm) : WGM;
    pm = fm + ((wgid % nig) % gsz); pn = (wgid % nig) / gsz;
}
template <class Epi>
DI void gemm_tile(const bf16_t* __restrict__ A, const int lda, const bf16_t* __restrict__ Bt, const int K, const int brow, const int bcol, bf16_t* shm, const Epi& epi) {
#define SA(b, h) (shm + ((b) * 2 + (h)) * HT)
#define SB(b, h) (shm + (4 + (b) * 2 + (h)) * HT)
#define STAGE_X(T, P, BASE, LD, br, kt) do { long _g = (long)(br) * (LD) + (long)(kt) * BK; \
    for (int _i = 0; _i < 2; ++_i) { int _b = (T) * 16 + _i * 8192; int _r, _c; stage_rc(_b, _r, _c); \
      __builtin_amdgcn_global_load_lds((const unsigned*)(BASE + _g + (long)_r * (LD) + _c), (LAS unsigned*)((LAS char*)(P) + _b), 16, 0, 0); } } while (0)
#define STAGEA(P, BASE, br, kt) STAGE_X(tz0, P, BASE, lda, br, kt)
#define STAGEB(P, BASE, br, kt) STAGE_X(tz0, P, BASE, K, br, kt)
#define LDA(dst, b, h) for (int m = 0; m < 4; ++m) for (int k = 0; k < 2; ++k) \
    dst[m][k] = *reinterpret_cast<const bf16x8*>((char*)SA(b, h) + lds_byte(wr * 64 + m * 16 + fr, k * 32 + fq * 8))
#define LDB(dst, b, h) for (int n = 0; n < 2; ++n) for (int k = 0; k < 2; ++k) \
    dst[n][k] = *reinterpret_cast<const bf16x8*>((char*)SB(b, h) + lds_byte(wc * 32 + n * 16 + fr, k * 32 + fq * 8))
#define MMA(ai, bj, At, Bf) do { __builtin_amdgcn_s_setprio(1); \
    for (int m = 0; m < 4; ++m) for (int n = 0; n < 2; ++n) for (int k = 0; k < 2; ++k) \
      acc[ai][bj][m][n] = __builtin_amdgcn_mfma_f32_16x16x32_bf16(Bf[n][k], At[m][k], acc[ai][bj][m][n], 0, 0, 0); \
    __builtin_amdgcn_s_setprio(0); } while (0)
#define WAIT_V(n) asm volatile("s_waitcnt vmcnt(" #n ")" ::: "memory")
#define WAIT_L(n) asm volatile("s_waitcnt lgkmcnt(" #n ")" ::: "memory")
#define BAR __builtin_amdgcn_s_barrier()
#define SCHED __builtin_amdgcn_sched_barrier(0)
    int tz0 = threadIdx.x; asm volatile("" : "+v"(tz0));
    int wid = tz0 >> 6, lane = tz0 & 63, wr = wid >> 2, wc = wid & 3, fr = lane & 15, fq = lane >> 4;
    f32x4 acc[2][2][4][2] = {};
    bf16x8 At[4][2], B0[2][2], B1[2][2];
    const int nt = K / BK;
    STAGEB(SB(0, 0), Bt, bcol, 0); STAGEA(SA(0, 0), A, brow, 0);
    STAGEB(SB(0, 1), Bt, bcol + HALF, 0); STAGEA(SA(0, 1), A, brow + HALF, 0);
    if (wr == 1) BAR;
    WAIT_V(4); BAR;
    STAGEB(SB(1, 0), Bt, bcol, 1); STAGEA(SA(1, 0), A, brow, 1); STAGEB(SB(1, 1), Bt, bcol + HALF, 1);
    WAIT_V(6); BAR;
    for (int t = 0; t < nt - 2; t += 2) {
        LDB(B0, 0, 0); SCHED; LDA(At, 0, 0); STAGEA(SA(1, 1), A, brow + HALF, t + 1);
        WAIT_L(8); BAR; WAIT_L(0); MMA(0, 0, At, B0); BAR; SCHED;
        LDB(B1, 0, 1); STAGEB(SB(0, 0), Bt, bcol, t + 2);
        BAR; WAIT_L(0); MMA(0, 1, At, B1); BAR;
        LDA(At, 0, 1); STAGEA(SA(0, 0), A, brow, t + 2);
        BAR; WAIT_L(0); MMA(1, 0, At, B0); BAR; SCHED;
        STAGEB(SB(0, 1), Bt, bcol + HALF, t + 2);
        WAIT_V(6); BAR; MMA(1, 1, At, B1); BAR;
        LDB(B0, 1, 0); SCHED; LDA(At, 1, 0); STAGEA(SA(0, 1), A, brow + HALF, t + 2);
        WAIT_L(8); BAR; WAIT_L(0); MMA(0, 0, At, B0); BAR; SCHED;
        LDB(B1, 1, 1); STAGEB(SB(1, 0), Bt, bcol, t + 3);
        BAR; WAIT_L(0); MMA(0, 1, At, B1); BAR;
        LDA(At, 1, 1); STAGEA(SA(1, 0), A, brow, t + 3);
        BAR; WAIT_L(0); MMA(1, 0, At, B0); BAR; SCHED;
        STAGEB(SB(1, 1), Bt, bcol + HALF, t + 3);
        WAIT_V(6); BAR; MMA(1, 1, At, B1); BAR;
    }
    int tz = tz0; asm volatile("" : "+v"(tz)); wid = tz >> 6; lane = tz & 63; wr = wid >> 2; wc = wid & 3; fr = lane & 15; fq = lane >> 4;
    { LDB(B0, 0, 0); WAIT_V(0); LDA(At, 0, 0); STAGE_X(tz, SA(1, 1), A, lda, brow + HALF, nt - 1);
      BAR; WAIT_L(0); MMA(0, 0, At, B0); BAR;
      LDB(B1, 0, 1); BAR; WAIT_L(0); MMA(0, 1, At, B1); BAR;
      LDA(At, 0, 1); WAIT_V(4); BAR; WAIT_L(0); MMA(1, 0, At, B0); MMA(1, 1, At, B1); BAR; }
    { LDB(B0, 1, 0); LDA(At, 1, 0); WAIT_V(2); BAR; WAIT_L(0); MMA(0, 0, At, B0); BAR;
      LDB(B1, 1, 1); WAIT_V(0); BAR; WAIT_L(0); MMA(0, 1, At, B1); BAR;
      LDA(At, 1, 1); BAR; WAIT_L(0); MMA(1, 0, At, B0); MMA(1, 1, At, B1); BAR; }
    if (wr == 0) BAR;
    epi(acc, brow, bcol, wr, wc, fr, fq);
#undef SA
#undef SB
#undef STAGE_X
#undef STAGEA
#undef STAGEB
#undef LDA
#undef LDB
#undef MMA
}
template <bool REMAP, class Epi>
DI void gemm_phase(const bf16_t* A, int lda, const bf16_t* Bt, int K, int nM, int nN, bf16_t* shm, const Epi& epi, int bid, int nblk) {
    const int nwg = nM * nN;
    for (int L = bid; L < nwg; L += nblk) {
        int pm, pn; unit_map(L, nM, nN, pm, pn);
        const int brow = REMAP ? (pm >> 4) * TT + NMETA + (pm & 15) * BM : pm * BM;
        gemm_tile(A, lda, Bt, K, brow, pn * BM, shm, epi);
        __syncthreads();
    }
}
}
typedef f32x4 AccT[2][2][4][2];
#define EPI_ROWS_BEGIN _Pragma("unroll") for (int ai = 0; ai < 2; ++ai) _Pragma("unroll") for (int m = 0; m < 4; ++m) { __builtin_amdgcn_sched_barrier(0); asm volatile("" ::: "memory"); const int row = brow + ai * 128 + wr * 64 + m * 16 + fr;
#define EPI_COLS_BEGIN _Pragma("unroll") for (int bj = 0; bj < 2; ++bj) _Pragma("unroll") for (int n = 0; n < 2; ++n) { const int col = bcol + bj * 128 + wc * 32 + n * 16 + fq * 4; const f32x4 a = acc[ai][bj][m][n];

#define EPI_ROW(ai, m) (brow + (ai) * 128 + wr * 64 + (m) * 16 + fr)
#define EPI_COL(bj, n) (bcol + (bj) * 128 + wc * 32 + (n) * 16 + fq * 4)
#define EPI_FENCE do { __builtin_amdgcn_sched_barrier(0); asm volatile("" ::: "memory"); } while (0)
struct EpiProj {
    const float* rstd; bf16_t* PROJ; float* out;
    DI void operator()(const AccT& acc, int brow, int bcol, int wr, int wc, int fr, int fq) const {
        float rsv[2][4];
#pragma unroll
        for (int ai = 0; ai < 2; ++ai)
#pragma unroll
            for (int m = 0; m < 4; ++m) rsv[ai][m] = rstd[EPI_ROW(ai, m)];
        EPI_ROWS_BEGIN
            const float rs = rsv[ai][m];
            float* sh = nullptr;
            if (bcol < RWP) {
                if (row < MPR) { const int b = row / TT; if (row - b * TT == TT - 1) sh = out + OUT_SP + (size_t)b * RWP; }
                else if (row < MTOT) sh = out + OUT_SS + (size_t)(row - MPR) * RWP;
            }
            EPI_COLS_BEGIN
                const f32x4 v = a * rs;
                u32x2 o; o.x = pk2(v.x, v.y); o.y = pk2(v.z, v.w);
                *(u32x2*)(PROJ + (size_t)row * INW + col) = o;
                if (sh) *(f32x4*)(sh + col) = v;
            }
        }
    }
};

DI void prep_qkv_row(const Params& p, int row, int lane) {
    const bf16_t* pr = p.PROJ() + (size_t)row * INW;
    const u32x4 w0 = *(const u32x4*)(pr + O_Q + lane * 16), w1 = *(const u32x4*)(pr + O_Q + lane * 16 + 8);
    float f[16]; { float t0[8], t1[8]; unpack8(w0, t0); unpack8(w1, t1);
#pragma unroll
        for (int i = 0; i < 8; ++i) { f[i] = t0[i]; f[8 + i] = t1[i]; } }
    float ss = 0.f;
#pragma unroll
    for (int i = 0; i < 16; ++i) ss += f[i] * f[i];
    ss += __shfl_xor(ss, 1); ss += __shfl_xor(ss, 2);
    const float rs = rsqrtf(ss * (1.f / 64.f) + 1e-6f);
    const bool isk = lane >= 32;
    const float* gp = (isk ? p.da_kn_g : p.da_qn_g) + (lane & 3) * 16;
#pragma unroll
    for (int i = 0; i < 16; ++i) f[i] = f[i] * rs * gp[i];
    u32x4 o0, o1; o0.x = pk2(f[0], f[1]); o0.y = pk2(f[2], f[3]); o0.z = pk2(f[4], f[5]); o0.w = pk2(f[6], f[7]);
    o1.x = pk2(f[8], f[9]); o1.y = pk2(f[10], f[11]); o1.z = pk2(f[12], f[13]); o1.w = pk2(f[14], f[15]);
    bf16_t* dst = (isk ? p.KN() : p.QN()) + (size_t)row * 512 + (lane & 31) * 16;
    *(u32x4*)dst = o0; *(u32x4*)(dst + 8) = o1;
    float* kout = row < MPR ? p.out + OUT_KP + (size_t)row * 512 : p.out + OUT_KS + (size_t)(row - MPR) * 512;
    float* vout = row < MPR ? p.out + OUT_VP + (size_t)row * 512 : p.out + OUT_VS + (size_t)(row - MPR) * 512;
    if (isk) {
#pragma unroll
        for (int i = 0; i < 4; ++i) *(f32x4*)(kout + (lane - 32) * 16 + 4 * i) = (f32x4){f[4 * i], f[4 * i + 1], f[4 * i + 2], f[4 * i + 3]};
    }
    const u32x4 wv = *(const u32x4*)(pr + O_V + lane * 8);
    float v8[8]; unpack8(wv, v8);
    *(f32x4*)(vout + lane * 8) = (f32x4){v8[0], v8[1], v8[2], v8[3]};
    *(f32x4*)(vout + lane * 8 + 4) = (f32x4){v8[4], v8[5], v8[6], v8[7]};
}

template <int N>
DI void ps_load(const LAS float* pl, const bf16_t* cur, const bf16_t* prevb, const float* prevf, int col0, float (&o)[N]) {
    float c[N], pv[N];
    if (N == 8) { float t[8]; unpack8(*(const u32x4*)(cur + col0), t);
#pragma unroll
        for (int i = 0; i < N; ++i) c[i] = t[i]; }
    else { const u32x2 w = *(const u32x2*)(cur + col0); c[0] = bflo(w.x); c[1] = bfhi(w.x); c[2] = bflo(w.y); c[3] = bfhi(w.y); }
    if (prevb) {
        if (N == 8) { float t[8]; unpack8(*(const u32x4*)(prevb + col0), t);
#pragma unroll
            for (int i = 0; i < N; ++i) pv[i] = t[i]; }
        else { const u32x2 w = *(const u32x2*)(prevb + col0); pv[0] = bflo(w.x); pv[1] = bfhi(w.x); pv[2] = bflo(w.y); pv[3] = bfhi(w.y); }
    } else if (prevf) {
#pragma unroll
        for (int i = 0; i < N; i += 4) { const f32x4 t = *(const f32x4*)(prevf + col0 + i); pv[i] = t.x; pv[i + 1] = t.y; pv[i + 2] = t.z; pv[i + 3] = t.w; }
    } else {
#pragma unroll
        for (int i = 0; i < N; ++i) pv[i] = 0.f;
    }
#pragma unroll
    for (int i = 0; i < N; i += 4) { const f32x4 mu = *(const LAS f32x4*)(pl + col0 + i);
        o[i] = c[i] + (pv[i] - c[i]) * mu.x; o[i + 1] = c[i + 1] + (pv[i + 1] - c[i + 1]) * mu.y;
        o[i + 2] = c[i + 2] + (pv[i + 2] - c[i + 2]) * mu.z; o[i + 3] = c[i + 3] + (pv[i + 3] - c[i + 3]) * mu.w; }
}
DI bf16x8 pack8(const float (&f)[8]) { u32x4 w; w.x = pk2(f[0], f[1]); w.y = pk2(f[2], f[3]); w.z = pk2(f[4], f[5]); w.w = pk2(f[6], f[7]); return __builtin_bit_cast(bf16x8, w); }
#define MFMA32(a, b, c) __builtin_amdgcn_mfma_f32_32x32x16_bf16((a), (b), (c), 0, 0, 0)

DI float tanh_fast(float x) { const float e = __expf(2.f * x); return 1.f - 2.f * __builtin_amdgcn_rcpf(e + 1.f); }
constexpr int PL_W0 = 1792, PL_A0 = 2304, PL_KK = 2816, PL_KA = 3328, PL_RK = 3840, PL_N = 4352;
DI void prep_rwkv_tile(const Params& p, const LAS float* pl, int tile, int lane) {
    const int tk = lane & 31, hh = lane >> 5, row = tile * 32 + tk;
    const bool samp = row >= MPR;
    int b = 0, t = 0;
    if (!samp) { b = row / TT; t = row - b * TT; }
    const bf16_t* cur = p.PROJ() + (size_t)row * INW;
    const bf16_t* prevb = (!samp && t > 0) ? cur - INW : nullptr;
    const float* prevf = samp ? p.state_shift + (size_t)(row - MPR) * RWP : nullptr;
    {
        bf16x8 Bw[4], Ba[4];
#pragma unroll
        for (int s = 0; s < 4; ++s) { float x[8]; ps_load<8>(pl, cur, prevb, prevf, 1536 + 16 * s + 8 * hh, x);
#pragma unroll
            for (int i = 0; i < 8; ++i) x[i] = tanh_fast(x[i]);
            Bw[s] = pack8(x); }
#pragma unroll
        for (int s = 0; s < 4; ++s) { float x[8]; ps_load<8>(pl, cur, prevb, prevf, 1600 + 16 * s + 8 * hh, x); Ba[s] = pack8(x); }
#pragma unroll 1
        for (int hd = 0; hd < 8; ++hd) {
            float kk2 = 0.f;
#pragma unroll 2
            for (int q8 = 0; q8 < 8; ++q8) { const int n = hd * 64 + (q8 >> 2) * 32 + 8 * (q8 & 3) + 4 * hh;
                float k4[4]; ps_load<4>(pl, cur, prevb, prevf, 512 + n, k4); const f32x4 kkp = *(const LAS f32x4*)(pl + PL_KK + n);
                const float a0 = k4[0] * kkp.x, a1 = k4[1] * kkp.y, a2 = k4[2] * kkp.z, a3 = k4[3] * kkp.w; kk2 += a0 * a0 + a1 * a1 + a2 * a2 + a3 * a3; }
            kk2 += __shfl_xor(kk2, 32);
            const float kinv = __builtin_amdgcn_rcpf(fmaxf(__builtin_amdgcn_sqrtf(kk2), 1e-12f));
            float bon = 0.f;
#pragma unroll 1
            for (int nt2 = 0; nt2 < 2; ++nt2) {
                const int n0 = hd * 64 + nt2 * 32;
                f32x16 dW = {}, dA = {};
#pragma unroll
                for (int s = 0; s < 4; ++s) { const bf16x8 aw = *(const bf16x8*)(p.W2_T() + (size_t)(n0 + tk) * 64 + 16 * s + 8 * hh); dW = MFMA32(aw, Bw[s], dW); }
#pragma unroll
                for (int s = 0; s < 4; ++s) { const bf16x8 aa = *(const bf16x8*)(p.A2_T() + (size_t)(n0 + tk) * 64 + 16 * s + 8 * hh); dA = MFMA32(aa, Ba[s], dA); }
#pragma unroll 1
                for (int q4 = 0; q4 < 4; ++q4) {
                    const int d0 = nt2 * 32 + 8 * q4 + 4 * hh, n = hd * 64 + d0;
                    float r4[4], k4[4], v4[4];
                    ps_load<4>(pl, cur, prevb, prevf, n, r4); ps_load<4>(pl, cur, prevb, prevf, 512 + n, k4); ps_load<4>(pl, cur, prevb, prevf, 1024 + n, v4);
                    const f32x4 w0 = *(const LAS f32x4*)(pl + PL_W0 + n), a0 = *(const LAS f32x4*)(pl + PL_A0 + n), kkp = *(const LAS f32x4*)(pl + PL_KK + n), ka = *(const LAS f32x4*)(pl + PL_KA + n), rk = *(const LAS f32x4*)(pl + PL_RK + n);
                    float dl[4], kp[4], av[4], bv[4];
#pragma unroll
                    for (int e = 0; e < 4; ++e) {
                        const float zw = w0[e] + dW[e];
                        const float ez = __expf(-zw);
                        const float sp = (zw > 15.f) ? ez : __logf(1.f + ez);
                        const float ew = __expf(-sp - 0.5f);
                        dl[e] = 1.f - __expf(-ew);
                        const float a = sigmoidf_(a0[e] + dA[e]);
                        const float kkn = k4[e] * kkp[e] * kinv;
                        kp[e] = k4[e] * (1.f + (a - 1.f) * ka[e]);
                        av[e] = -kkn; bv[e] = kkn * a;
                        bon += r4[e] * kp[e] * rk[e];
                    }
                    if (!samp) {
                        bf16_t* so = p.SCAN() + scan_addr(b * 8 + hd, 0, d0, t);
#pragma unroll
                        for (int e = 0; e < 4; ++e) { bf16_t* se = so + (size_t)e * TTP;
                            se[(size_t)0 * 64 * TTP] = bf16_1_(dl[e]); se[(size_t)1 * 64 * TTP] = bf16_1_(kp[e]); se[(size_t)2 * 64 * TTP] = bf16_1_(v4[e]);
                            se[(size_t)3 * 64 * TTP] = bf16_1_(av[e]); se[(size_t)4 * 64 * TTP] = bf16_1_(bv[e]); se[(size_t)5 * 64 * TTP] = bf16_1_(r4[e]); }
                    } else {
                        float* so = p.SCAN_S() + (((size_t)(row - MPR) * 8 + hd) * 6) * 64 + d0;
                        *(f32x4*)(so + 0 * 64) = (f32x4){1.f - dl[0], 1.f - dl[1], 1.f - dl[2], 1.f - dl[3]};
                        *(f32x4*)(so + 1 * 64) = (f32x4){kp[0], kp[1], kp[2], kp[3]};
                        *(f32x4*)(so + 2 * 64) = (f32x4){v4[0], v4[1], v4[2], v4[3]};
                        *(f32x4*)(so + 3 * 64) = (f32x4){av[0], av[1], av[2], av[3]};
                        *(f32x4*)(so + 4 * 64) = (f32x4){bv[0], bv[1], bv[2], bv[3]};
                        *(f32x4*)(so + 5 * 64) = (f32x4){r4[0], r4[1], r4[2], r4[3]};
                    }
                    dW = __builtin_shufflevector(dW, dW, 4, 5, 6, 7, 8, 9, 10, 11, 12, 13, 14, 15, 0, 1, 2, 3);
                    dA = __builtin_shufflevector(dA, dA, 4, 5, 6, 7, 8, 9, 10, 11, 12, 13, 14, 15, 0, 1, 2, 3);
                }
            }
            bon += __shfl_xor(bon, 32);
            if (hh == 0) p.BONUS()[(size_t)row * 8 + hd] = bon;
        }
    }
    __builtin_amdgcn_sched_barrier(0);
    {
        bf16x8 Bg[8];
#pragma unroll
        for (int s = 0; s < 8; ++s) { float x[8]; ps_load<8>(pl, cur, prevb, prevf, 1664 + 16 * s + 8 * hh, x);
#pragma unroll
            for (int i = 0; i < 8; ++i) x[i] = sigmoidf_(x[i]);
            Bg[s] = pack8(x); }
#pragma unroll 1
        for (int nt = 0; nt < 16; ++nt) {
            f32x16 dG = {};
#pragma unroll
            for (int s = 0; s < 8; ++s) { const bf16x8 ag = *(const bf16x8*)(p.G2_T() + (size_t)(nt * 32 + tk) * 128 + 16 * s + 8 * hh); dG = MFMA32(ag, Bg[s], dG); }
#pragma unroll
            for (int q4 = 0; q4 < 4; ++q4) { u32x2 og; og.x = pk2(dG[4 * q4], dG[4 * q4 + 1]); og.y = pk2(dG[4 * q4 + 2], dG[4 * q4 + 3]);
                *(u32x2*)(p.G() + (size_t)row * 512 + nt * 32 + 8 * q4 + 4 * hh) = og; }
        }
    }
}
constexpr int PV_ROWB = 3600, PV_STAGE_OFF = PL_N * 4  , PV_LDS = PV_STAGE_OFF + 33 * PV_ROWB;
template <int N>
DI void ps_lds(const LAS float* pl, const LAS char* curp, const LAS char* prevp, bool pz, int col0, float (&o)[N]) {
    float c[N], pv[N];
    if (N == 8) { const u32x4 wc = *(const LAS u32x4*)(curp + col0 * 2), wp = *(const LAS u32x4*)(prevp + col0 * 2); float t[8]; unpack8(wc, t); float u[8]; unpack8(wp, u);
#pragma unroll
        for (int i = 0; i < N; ++i) { c[i] = t[i]; pv[i] = pz ? 0.f : u[i]; } }
    else { const u32x2 w = *(const LAS u32x2*)(curp + col0 * 2), x = *(const LAS u32x2*)(prevp + col0 * 2);
        c[0] = bflo(w.x); c[1] = bfhi(w.x); c[2] = bflo(w.y); c[3] = bfhi(w.y);
        pv[0] = pz ? 0.f : bflo(x.x); pv[1] = pz ? 0.f : bfhi(x.x); pv[2] = pz ? 0.f : bflo(x.y); pv[3] = pz ? 0.f : bfhi(x.y); }
#pragma unroll
    for (int i = 0; i < N; i += 4) { const f32x4 mu = *(const LAS f32x4*)(pl + col0 + i);
        o[i] = c[i] + (pv[i] - c[i]) * mu.x; o[i + 1] = c[i + 1] + (pv[i + 1] - c[i + 1]) * mu.y;
        o[i + 2] = c[i + 2] + (pv[i + 2] - c[i + 2]) * mu.z; o[i + 3] = c[i + 3] + (pv[i + 3] - c[i + 3]) * mu.w; }
}
DI void prep_block(const Params& p, char* smem, int unit, int tid) {
    const LAS float* pl = (const LAS float*)smem;
    LAS char* stage = (LAS char*)smem + PV_STAGE_OFF;
    const bool samp = unit >= 514;
    const int row0 = samp ? MPR + (unit - 514) * 16 : unit * 32;
    __syncthreads();
#pragma unroll 1
    for (int i0 = 0; i0 < 16; i0 += 8) {
        u32x4 w[8];
#pragma unroll
        for (int i = 0; i < 8; ++i) {
            const int c = tid + 512 * (i0 + i), sl = c / 224, ch = c - sl * 224;
            w[i] = (u32x4){0u, 0u, 0u, 0u};
            if (c < 33 * 224) {
                if (!samp) { int gr = row0 - 1 + sl; gr = gr < 0 ? 0 : gr; w[i] = *(const u32x4*)(p.PROJ() + (size_t)gr * INW + ch * 8); }
                else if (sl < 16) w[i] = *(const u32x4*)(p.PROJ() + (size_t)(row0 + sl) * INW + ch * 8);
                else if (sl < 32) { const float* sp = p.state_shift + (size_t)(row0 - MPR + sl - 16) * RWP + ch * 8; const f32x4 a = *(const f32x4*)sp, b2 = *(const f32x4*)(sp + 4);
                    w[i].x = pk2(a.x, a.y); w[i].y = pk2(a.z, a.w); w[i].z = pk2(b2.x, b2.y); w[i].w = pk2(b2.z, b2.w); }
            }
        }
#pragma unroll
        for (int i = 0; i < 8; ++i) { const int c = tid + 512 * (i0 + i), sl = c / 224, ch = c - sl * 224; if (c < 33 * 224) *(LAS u32x4*)(stage + sl * PV_ROWB + ch * 16) = w[i]; }
    }
    __syncthreads();
    const int hd = tid >> 6, lane = tid & 63, tk = lane & 31, hh = lane >> 5;
    const int ntk = samp ? 16 : 32;
    const int tkc = tk < ntk ? tk : ntk - 1;
    const bool act = tk < ntk;
    const int row = row0 + tkc;
    int b = 0, t = 0; if (!samp) { b = row / TT; t = row - b * TT; }
    const LAS char* curp = stage + (samp ? tkc : tkc + 1) * PV_ROWB;
    const LAS char* prevp = stage + (samp ? 16 + tkc : tkc) * PV_ROWB;
    const bool pz = !samp && t == 0;
    {
        bf16x8 Bw[4], Ba[4];
#pragma unroll
        for (int s2 = 0; s2 < 4; ++s2) { float x[8]; ps_lds<8>(pl, curp, prevp, pz, 1536 + 16 * s2 + 8 * hh, x);
#pragma unroll
            for (int i = 0; i < 8; ++i) x[i] = tanh_fast(x[i]);
            Bw[s2] = pack8(x); }
#pragma unroll
        for (int s2 = 0; s2 < 4; ++s2) { float x[8]; ps_lds<8>(pl, curp, prevp, pz, 1600 + 16 * s2 + 8 * hh, x); Ba[s2] = pack8(x); }
        float kk2 = 0.f;
#pragma unroll 2
        for (int q8 = 0; q8 < 8; ++q8) { const int n = hd * 64 + (q8 >> 2) * 32 + 8 * (q8 & 3) + 4 * hh;
            float k4[4]; ps_lds<4>(pl, curp, prevp, pz, 512 + n, k4); const f32x4 kkp = *(const LAS f32x4*)(pl + PL_KK + n);
            const float a0 = k4[0] * kkp.x, a1 = k4[1] * kkp.y, a2 = k4[2] * kkp.z, a3 = k4[3] * kkp.w; kk2 += a0 * a0 + a1 * a1 + a2 * a2 + a3 * a3; }
        kk2 += __shfl_xor(kk2, 32);
        const float kinv = __builtin_amdgcn_rcpf(fmaxf(__builtin_amdgcn_sqrtf(kk2), 1e-12f));
        float bon = 0.f;
#pragma unroll 1
        for (int nt2 = 0; nt2 < 2; ++nt2) {
            const int n0 = hd * 64 + nt2 * 32;
            f32x16 dW = {}, dA = {};
            {
                bf16x8 aw[4], aa[4];
#pragma unroll
                for (int s2 = 0; s2 < 4; ++s2) { aw[s2] = *(const bf16x8*)(p.W2_T() + (size_t)(n0 + tk) * 64 + 16 * s2 + 8 * hh); aa[s2] = *(const bf16x8*)(p.A2_T() + (size_t)(n0 + tk) * 64 + 16 * s2 + 8 * hh); }
                __builtin_amdgcn_sched_barrier(0);
#pragma unroll
                for (int s2 = 0; s2 < 4; ++s2) { dW = MFMA32(aw[s2], Bw[s2], dW); dA = MFMA32(aa[s2], Ba[s2], dA); }
                __builtin_amdgcn_sched_barrier(0);
            }
#pragma unroll
            for (int q4 = 0; q4 < 4; ++q4) {
                const int d0 = nt2 * 32 + 8 * q4 + 4 * hh, n = hd * 64 + d0;
                float r4[4], k4[4], v4[4];
                ps_lds<4>(pl, curp, prevp, pz, n, r4); ps_lds<4>(pl, curp, prevp, pz, 512 + n, k4); ps_lds<4>(pl, curp, prevp, pz, 1024 + n, v4);
                const f32x4 w0 = *(const LAS f32x4*)(pl + PL_W0 + n), a0 = *(const LAS f32x4*)(pl + PL_A0 + n), kkp = *(const LAS f32x4*)(pl + PL_KK + n), ka = *(const LAS f32x4*)(pl + PL_KA + n), rk = *(const LAS f32x4*)(pl + PL_RK + n);
                float dl[4], kp[4], av[4], bv[4];
#pragma unroll
                for (int e = 0; e < 4; ++e) {
                    const float zw = w0[e] + dW[e];
                    const float ez = __expf(-zw);
                    const float sp = (zw > 15.f) ? ez : __logf(1.f + ez);
                    const float ew = __expf(-sp - 0.5f);
                    dl[e] = 1.f - __expf(-ew);
                    const float a = sigmoidf_(a0[e] + dA[e]);
                    const float kkn = k4[e] * kkp[e] * kinv;
                    kp[e] = k4[e] * (1.f + (a - 1.f) * ka[e]);
                    av[e] = -kkn; bv[e] = kkn * a;
                    bon += r4[e] * kp[e] * rk[e];
                }
                if (act) {
                    if (!samp) {
                        bf16_t* so = p.SCAN() + scan_addr(b * 8 + hd, 0, d0, t);
#pragma unroll
                        for (int e = 0; e < 4; ++e) { bf16_t* se = so + (size_t)e * TTP;
                            se[(size_t)0 * 64 * TTP] = bf16_1_(dl[e]); se[(size_t)1 * 64 * TTP] = bf16_1_(kp[e]); se[(size_t)2 * 64 * TTP] = bf16_1_(v4[e]);
                            se[(size_t)3 * 64 * TTP] = bf16_1_(av[e]); se[(size_t)4 * 64 * TTP] = bf16_1_(bv[e]); se[(size_t)5 * 64 * TTP] = bf16_1_(r4[e]); }
                    } else {
                        float* so = p.SCAN_S() + (((size_t)(row - MPR) * 8 + hd) * 6) * 64 + d0;
                        *(f32x4*)(so + 0 * 64) = (f32x4){1.f - dl[0], 1.f - dl[1], 1.f - dl[2], 1.f - dl[3]};
                        *(f32x4*)(so + 1 * 64) = (f32x4){kp[0], kp[1], kp[2], kp[3]};
                        *(f32x4*)(so + 2 * 64) = (f32x4){v4[0], v4[1], v4[2], v4[3]};
                        *(f32x4*)(so + 3 * 64) = (f32x4){av[0], av[1], av[2], av[3]};
                        *(f32x4*)(so + 4 * 64) = (f32x4){bv[0], bv[1], bv[2], bv[3]};
                        *(f32x4*)(so + 5 * 64) = (f32x4){r4[0], r4[1], r4[2], r4[3]};
                    }
                }
                dW = __builtin_shufflevector(dW, dW, 4, 5, 6, 7, 8, 9, 10, 11, 12, 13, 14, 15, 0, 1, 2, 3);
                dA = __builtin_shufflevector(dA, dA, 4, 5, 6, 7, 8, 9, 10, 11, 12, 13, 14, 15, 0, 1, 2, 3);
            }
        }
        bon += __shfl_xor(bon, 32);
        if (hh == 0 && act) p.BONUS()[(size_t)row * 8 + hd] = bon;
    }
    __builtin_amdgcn_sched_barrier(0);
    {
        bf16x8 Bg[8];
#pragma unroll
        for (int s2 = 0; s2 < 8; ++s2) { float x[8]; ps_lds<8>(pl, curp, prevp, pz, 1664 + 16 * s2 + 8 * hh, x);
#pragma unroll
            for (int i = 0; i < 8; ++i) x[i] = sigmoidf_(x[i]);
            Bg[s2] = pack8(x); }
#pragma unroll 1
        for (int nt = 2 * hd; nt < 2 * hd + 2; ++nt) {
            f32x16 dG = {};
            {
                bf16x8 ag[8];
#pragma unroll
                for (int s2 = 0; s2 < 8; ++s2) ag[s2] = *(const bf16x8*)(p.G2_T() + (size_t)(nt * 32 + tk) * 128 + 16 * s2 + 8 * hh);
                __builtin_amdgcn_sched_barrier(0);
#pragma unroll
                for (int s2 = 0; s2 < 8; ++s2) dG = MFMA32(ag[s2], Bg[s2], dG);
                __builtin_amdgcn_sched_barrier(0);
            }
            if (act) {
#pragma unroll
                for (int q4 = 0; q4 < 4; ++q4) { u32x2 og; og.x = pk2(dG[4 * q4], dG[4 * q4 + 1]); og.y = pk2(dG[4 * q4 + 2], dG[4 * q4 + 3]);
                    *(u32x2*)(p.G() + (size_t)row * 512 + nt * 32 + 8 * q4 + 4 * hh) = og; }
            }
        }
    }
}
DI void phase_prep(const Params& p, char* smem, int bid, int nblk, int gw, int ngw, int tid, int lane) {
    LAS float* pl = (LAS float*)smem;
    for (int i = tid; i < PL_N; i += 512) {
        float v;
        if (i < PL_W0) v = p.rw_mu[i]; else if (i < PL_A0) v = p.rw_w0[i - PL_W0]; else if (i < PL_KK) v = p.rw_a0[i - PL_A0];
        else if (i < PL_KA) v = p.rw_kk[i - PL_KK]; else if (i < PL_RK) v = p.rw_ka[i - PL_KA]; else v = p.rw_rk[i - PL_RK];
        pl[i] = v;
    }
    for (int u = bid; u < 512; u += nblk) prep_block(p, smem, u, tid);
    if (bid < 4 && nblk >= 8) prep_block(p, smem, 512 + bid, tid);
    else if (nblk < 8) { for (int u = 512 + bid; u < 516; u += nblk) prep_block(p, smem, u, tid); }
    {
        const int rb = (nblk >= 8) ? bid - 4 : bid, rn = (nblk >= 8) ? nblk - 4 : nblk;
        if (rb >= 0) for (int r = rb * 8 + (tid >> 6); r < MTOT; r += rn * 8) prep_qkv_row(p, r, lane);
    }
}

DI float dpp_xor1(float x) { return __builtin_amdgcn_update_dpp(0.f, x, 0xB1, 0xF, 0xF, false); }
DI float dpp_xor2(float x) { return __builtin_amdgcn_update_dpp(0.f, x, 0x4E, 0xF, 0xF, false); }
DI float dpp_hmir(float x) { return __builtin_amdgcn_update_dpp(0.f, x, 0x141, 0xF, 0xF, false); }
DI float dpp_mir(float x)  { return __builtin_amdgcn_update_dpp(0.f, x, 0x140, 0xF, 0xF, false); }
DI float row16_sum(float v) { v += dpp_xor1(v); v += dpp_xor2(v); v += dpp_hmir(v); v += dpp_mir(v); return v; }
DI float row8_sum(float v) { v += dpp_xor1(v); v += dpp_xor2(v); v += dpp_hmir(v); return v; }

constexpr int SCAN_TS = 32;
constexpr int SCAN_TILE_B = SCAN_TS * 6 * 64 * 2;
DI void scan_unit(const Params& p, char* smem, int unit, int tid) {
    const int chain = unit >> 2, rg = unit & 3, b = chain >> 3, hd = chain & 7;
    const int wave = tid >> 6, lane = tid & 63, rl = lane >> 4, cg = lane & 15;
    const int row = rg * 16 + wave * 4 + rl, d0 = cg * 4;
    const bf16_t* src = p.SCAN() + (size_t)chain * TT * 384;
    float S0 = 0.f, S1 = 0.f, S2 = 0.f, S3 = 0.f, ykeep = 0.f;
    constexpr int NTILE = (TT + SCAN_TS - 1) / SCAN_TS;
    u32x4 pre[6];
    {
#pragma unroll
        for (int i = 0; i < 6; ++i) pre[i] = *(const u32x4*)(src + (size_t)(i * 256 + tid) * 8);
#pragma unroll
        for (int i = 0; i < 6; ++i) *(u32x4*)(smem + (i * 256 + tid) * 16) = pre[i];
    }
    __syncthreads();
    for (int tile = 0; tile < NTILE; ++tile) {
        const int t0 = tile * SCAN_TS, nst = (TT - t0) < SCAN_TS ? (TT - t0) : SCAN_TS;
        const bool more = tile + 1 < NTILE;
        if (more) {
            const int t1 = t0 + SCAN_TS; const int lim = (TT - t1) * 384 / 8;
#pragma unroll
            for (int i = 0; i < 6; ++i) { const int c = i * 256 + tid; pre[i] = c < lim ? *(const u32x4*)(src + (size_t)t1 * 384 + (size_t)c * 8) : (u32x4){0u, 0u, 0u, 0u}; }
        }
        const char* buf = smem + (tile & 1) * SCAN_TILE_B;
        for (int st = 0; st < nst; ++st) {
            const char* sp = buf + st * 768;
            const u32x2 wd = *(const u32x2*)(sp + 0 * 128 + d0 * 2), wk = *(const u32x2*)(sp + 1 * 128 + d0 * 2), wa = *(const u32x2*)(sp + 3 * 128 + d0 * 2),
                        wb = *(const u32x2*)(sp + 4 * 128 + d0 * 2), wr = *(const u32x2*)(sp + 5 * 128 + d0 * 2);
            const float vv = bf2f(*(const unsigned short*)(sp + 2 * 128 + row * 2));
            float sa = S0 * bflo(wa.x) + S1 * bfhi(wa.x) + S2 * bflo(wa.y) + S3 * bfhi(wa.y);
            sa = row16_sum(sa);
            S0 = S0 * (1.f - bflo(wd.x)) + (sa * bflo(wb.x) + vv * bflo(wk.x));
            S1 = S1 * (1.f - bfhi(wd.x)) + (sa * bfhi(wb.x) + vv * bfhi(wk.x));
            S2 = S2 * (1.f - bflo(wd.y)) + (sa * bflo(wb.y) + vv * bflo(wk.y));
            S3 = S3 * (1.f - bfhi(wd.y)) + (sa * bfhi(wb.y) + vv * bfhi(wk.y));
            float y = S0 * bflo(wr.x) + S1 * bfhi(wr.x) + S2 * bflo(wr.y) + S3 * bfhi(wr.y);
            y = row16_sum(y);
            ykeep = ((st & 15) == cg) ? y : ykeep;
            if ((st & 15) == 15) p.Y()[(size_t)(b * TT + t0 + st - 15 + cg) * 512 + hd * 64 + row] = ykeep;
        }
        if (more) {
            char* nb = smem + ((tile + 1) & 1) * SCAN_TILE_B;
#pragma unroll
            for (int i = 0; i < 6; ++i) *(u32x4*)(nb + (i * 256 + tid) * 16) = pre[i];
        }
        __syncthreads();
    }
    *(f32x4*)(p.out + OUT_WP + ((size_t)chain * 64 + row) * 64 + d0) = (f32x4){S0, S1, S2, S3};
}

constexpr int SC2_TS = 32, SC2_STEP_B = 6 * 64 * 4, SC2_TILE_B = SC2_TS * SC2_STEP_B;
struct ScanOps { f32x4 w, k, a, b, r; float v; };
DI ScanOps scan_ld(const char* sp, int d0, int row) {
    ScanOps o; o.w = *(const f32x4*)(sp + 0 * 256 + d0 * 4); o.k = *(const f32x4*)(sp + 1 * 256 + d0 * 4); o.a = *(const f32x4*)(sp + 3 * 256 + d0 * 4);
    o.b = *(const f32x4*)(sp + 4 * 256 + d0 * 4); o.r = *(const f32x4*)(sp + 5 * 256 + d0 * 4); o.v = *(const float*)(sp + 2 * 256 + row * 4); return o;
}
DI void scan_unit2(const Params& p, char* smem, int unit, int tid) {
    const int chain = unit >> 2, rg = unit & 3, b = chain >> 3, hd = chain & 7;
    const int wave = tid >> 6, lane = tid & 63, rl = lane >> 4, cg = lane & 15;
    const int row = rg * 16 + (wave & 3) * 4 + rl, d0 = cg * 4;
    const bf16_t* src = p.SCAN() + (size_t)chain * TT * 384;
    f32x4 S = {0.f, 0.f, 0.f, 0.f}; float ykeep = 0.f;
    constexpr int NTILE = (TT + SC2_TS - 1) / SC2_TS;
    u32x4 pre[3];
    auto stage_load = [&](int t1) { const int lim = (TT - t1) * 48;
#pragma unroll
        for (int i = 0; i < 3; ++i) { const int c = i * 512 + tid; pre[i] = c < lim ? *(const u32x4*)(src + (size_t)t1 * 384 + (size_t)c * 8) : (u32x4){0u, 0u, 0u, 0u}; } };
    auto stage_store = [&](char* buf) {
#pragma unroll
        for (int i = 0; i < 3; ++i) { const int c = i * 512 + tid; float f[8]; unpack8(pre[i], f);
            if (((c >> 3) % 6) == 0) {
#pragma unroll
                for (int q = 0; q < 8; ++q) f[q] = 1.f - f[q]; }
            *(f32x4*)(buf + c * 32) = (f32x4){f[0], f[1], f[2], f[3]}; *(f32x4*)(buf + c * 32 + 16) = (f32x4){f[4], f[5], f[6], f[7]}; } };
    stage_load(0); stage_store(smem);
    __syncthreads();
    for (int tile = 0; tile < NTILE; ++tile) {
        const int t0 = tile * SC2_TS, nst = (TT - t0) < SC2_TS ? (TT - t0) : SC2_TS;
        const bool more = tile + 1 < NTILE;
        if (more) stage_load(t0 + SC2_TS);
        if (wave < 4) {
            const char* buf = smem + (tile & 1) * SC2_TILE_B;
            ScanOps cur = scan_ld(buf, d0, row);
#pragma unroll 2
            for (int st = 0; st < nst; ++st) {
                const ScanOps nxt = scan_ld(buf + ((st + 1 < nst) ? (st + 1) : st) * SC2_STEP_B, d0, row);
                float sa = (S.x * cur.a.x + S.y * cur.a.y) + (S.z * cur.a.z + S.w * cur.a.w);
                const f32x4 vk = cur.k * cur.v;
                sa = row16_sum(sa);
                S = S * cur.w + (cur.b * sa + vk);
                float y = (S.x * cur.r.x + S.y * cur.r.y) + (S.z * cur.r.z + S.w * cur.r.w);
                y = row16_sum(y);
                ykeep = ((st & 15) == cg) ? y : ykeep;
                if ((st & 15) == 15) p.Y()[(size_t)(b * TT + t0 + st - 15 + cg) * 512 + hd * 64 + row] = ykeep;
                cur = nxt;
            }
        }
        if (more) stage_store(smem + ((tile + 1) & 1) * SC2_TILE_B);
        __syncthreads();
    }
    if (wave < 4) *(f32x4*)(p.out + OUT_WP + ((size_t)chain * 64 + row) * 64 + d0) = S;
}

constexpr int CK_AT = 256, CK_RT = CK_AT + 17408, CK_BT = CK_RT + 17408, CK_KT = CK_BT + 17408, CK_VV = CK_KT + 17408, CK_AAB = CK_VV + 12288, CK_ARB = CK_AAB + 16384,
              CK_AAK = CK_ARB + 16384, CK_GT = CK_AAK + 9216, CK_HT = CK_GT + 9216, CK_LDS = CK_HT + 9216, CK_RAW = CK_AAB;
static_assert(CK_LDS <= 160 * 1024 - 128, "chunk LDS");
DI bf16x8 tr_frag(const char* img, int strideB, int row0, int colB) {
    return bf16x8{};
}
DI bf16x8 ld_tr8(const char* p_lo, const char* p_hi) {
    const s16x4 lo = __builtin_amdgcn_ds_read_tr16_b64_v4i16((LAS s16x4*)p_lo), hi = __builtin_amdgcn_ds_read_tr16_b64_v4i16((LAS s16x4*)p_hi);
    return __builtin_shufflevector(lo, hi, 0, 1, 2, 3, 4, 5, 6, 7);
}
DI bf16x8 pack16s(const f32x16& x, int s) {
    float f[8];
#pragma unroll
    for (int j = 0; j < 8; ++j) f[j] = x[8 * s + j];
    return pack8(f);
}
template <int I, bool ISG> DI void ck_bs4(float (&Xs)[16], const char* smem, int col, int sq, float pl, int zofs) {
    if constexpr (I + 5 < 64) asm volatile("" : "+v"(zofs) : "v"(Xs[(I + 5) & 15]));
    const char* ap = smem + CK_AAB + (I * 64 + 16 * sq) * 4 + zofs;
    const f32x4 a0 = *(const f32x4*)ap, a1 = *(const f32x4*)(ap + 16), a2 = *(const f32x4*)(ap + 32), a3 = *(const f32x4*)(ap + 48);
    float rhs = ISG ? *(const float*)(smem + CK_ARB + (I * 64 + col) * 4) : bf2f(*(const unsigned short*)(smem + CK_BT + I * 272 + col * 2)) * pl;
    float s0 = sq == 0 ? rhs : 0.f, s1 = 0.f;
    s0 += a0.x * Xs[0]; s1 += a0.y * Xs[1]; s0 += a0.z * Xs[2]; s1 += a0.w * Xs[3];
    s0 += a1.x * Xs[4]; s1 += a1.y * Xs[5]; s0 += a1.z * Xs[6]; s1 += a1.w * Xs[7];
    s0 += a2.x * Xs[8]; s1 += a2.y * Xs[9]; s0 += a2.z * Xs[10]; s1 += a2.w * Xs[11];
    s0 += a3.x * Xs[12]; s1 += a3.y * Xs[13]; s0 += a3.z * Xs[14]; s1 += a3.w * Xs[15];
    float x = s0 + s1; x += dpp_xor1(x); x += dpp_xor2(x);
    Xs[I & 15] = (sq == (I >> 4)) ? x : Xs[I & 15];
    if constexpr (I > 0) ck_bs4<I - 1, ISG>(Xs, smem, col, sq, pl, zofs);
}
DI void chunk_prefetch(const Params& p, int unit, int tid, unsigned short (&pre)[48]) {
    if (unit >= CK_UNITS) return;
    const int chain = unit / CK_N, c = unit - chain * CK_N, t0 = c * 64, lane = tid & 63, wave = tid >> 6;
    const bool ok = t0 + lane < TT;
    const bf16_t* src = p.SCAN() + scan_addr(chain, 0, 8 * wave, t0 + lane);
#pragma unroll
    for (int v = 0; v < 6; ++v)
#pragma unroll
        for (int q = 0; q < 8; ++q) pre[v * 8 + q] = ok ? src[((size_t)v * 64 + q) * TTP] : (unsigned short)0;
}
DI void chunk_pass1(const Params& p, char* smem_, int unit, int next_unit, unsigned short (&pre)[48], int tid_) {
    int tid = tid_, zb = 0; asm volatile("" : "+v"(tid), "+v"(zb)); char* smem = smem_ + zb;
    const int chain = unit / CK_N, c = unit - chain * CK_N, t0 = c * 64;
    const int wave = tid >> 6, lane = tid & 63, tk = lane & 31, hh = lane >> 5;
    const bf16_t* src = p.SCAN() + ((size_t)chain * TT + t0) * 384;
    const int nval = (TT - t0) < 64 ? (TT - t0) : 64;
    __syncthreads();
    {
        float dl[8], kv[8], vv[8], av[8], bv[8], rv[8];
#pragma unroll
        for (int q = 0; q < 8; ++q) { dl[q] = bf2f(pre[0 * 8 + q]); kv[q] = bf2f(pre[1 * 8 + q]); vv[q] = bf2f(pre[2 * 8 + q]); av[q] = bf2f(pre[3 * 8 + q]); bv[q] = bf2f(pre[4 * 8 + q]); rv[q] = bf2f(pre[5 * 8 + q]); }
        chunk_prefetch(p, next_unit, tid, pre);
        float P[8], Pm[8], inv[8], PL[8];
#pragma unroll
        for (int q = 0; q < 8; ++q) {
            float x = 1.f - dl[q];
#pragma unroll
            for (int o = 1; o < 64; o <<= 1) { const float y = __shfl_up(x, o); x = lane >= o ? x * y : x; }
            P[q] = x; const float pm = __shfl_up(x, 1); Pm[q] = lane ? pm : 1.f;
            PL[q] = __int_as_float(__builtin_amdgcn_readlane(__float_as_int(x), 63));
            inv[q] = 1.f / x;
        }
        __syncthreads();
        float o8[8];
#pragma unroll
        for (int q = 0; q < 8; ++q) o8[q] = av[q] * Pm[q];
        *(bf16x8*)(smem + CK_AT + lane * 272 + wave * 16) = pack8(o8);
#pragma unroll
        for (int q = 0; q < 8; ++q) o8[q] = rv[q] * P[q];
        *(bf16x8*)(smem + CK_RT + lane * 272 + wave * 16) = pack8(o8);
#pragma unroll
        for (int q = 0; q < 8; ++q) o8[q] = bv[q] * inv[q];
        *(bf16x8*)(smem + CK_BT + lane * 272 + wave * 16) = pack8(o8);
#pragma unroll
        for (int q = 0; q < 8; ++q) o8[q] = kv[q] * inv[q];
        *(bf16x8*)(smem + CK_KT + lane * 272 + wave * 16) = pack8(o8);
        *(bf16x8*)(smem + CK_VV + lane * 192 + wave * 16) = pack8(vv);
        if (lane == 63) { *(f32x4*)(smem + wave * 32) = (f32x4){PL[0], PL[1], PL[2], PL[3]}; *(f32x4*)(smem + wave * 32 + 16) = (f32x4){PL[4], PL[5], PL[6], PL[7]};
            float* plo = p.PLV() + (size_t)unit * 64 + wave * 8;
            *(f32x4*)plo = (f32x4){PL[0], PL[1], PL[2], PL[3]}; *(f32x4*)(plo + 4) = (f32x4){PL[4], PL[5], PL[6], PL[7]}; }
    }
    __syncthreads();
    const float* PLs = (const float*)smem;
    {
        const int prod = wave >> 1, half = wave & 1;
        const char* imgA = smem + ((prod == 0 || prod == 1) ? ((prod == 0) ? CK_BT : CK_BT) : CK_KT);
        const char* imgB = smem + ((prod == 0 || prod == 2) ? CK_AT : CK_RT);
        f32x16 acc[2] = {};
        if (prod < 3) {
#pragma unroll
            for (int nt = 0; nt < 2; ++nt)
#pragma unroll
                for (int s2 = 0; s2 < 4; ++s2) { const bf16x8 af = *(const bf16x8*)(imgA + (32 * half + tk) * 272 + (16 * s2 + 8 * hh) * 2), bf = *(const bf16x8*)(imgB + (32 * nt + tk) * 272 + (16 * s2 + 8 * hh) * 2);
                    acc[nt] = MFMA32(af, bf, acc[nt]); }
#pragma unroll
            for (int nt = 0; nt < 2; ++nt)
#pragma unroll
                for (int r2 = 0; r2 < 16; ++r2) { const int i = 32 * half + (r2 & 3) + 8 * (r2 >> 2) + 4 * hh, t = 32 * nt + tk;
                    const bool keep = (prod == 1) ? (i <= t) : (i < t);
                    const float v = keep ? acc[nt][r2] : 0.f;
                    if (prod == 0) *(float*)(smem + CK_AAB + (i * 64 + t) * 4) = v;
                    else if (prod == 1) *(float*)(smem + CK_ARB + (i * 64 + t) * 4) = v;
                    else *(unsigned short*)(smem + CK_AAK + i * 144 + t * 2) = bf16_1_(v); }
        }
    }
    __syncthreads();
    {
        int tz3 = tid; asm volatile("" : "+v"(tz3)); const int wave3 = __builtin_amdgcn_readfirstlane(tz3 >> 6), lane3 = tz3 & 63;
        const int col = 16 * (wave3 & 3) + (lane3 >> 2), sq = lane3 & 3;
        int zo = 0; asm volatile("" : "+v"(zo));
        float Xs[16];
#pragma unroll
        for (int j = 0; j < 16; ++j) Xs[j] = 0.f;
        if (wave3 < 4) ck_bs4<63, true>(Xs, smem, col, sq, 1.f, zo); else ck_bs4<63, false>(Xs, smem, col, sq, PLs[col], zo);
        char* dst = smem + (wave3 < 4 ? CK_GT : CK_HT) + col * 144 + sq * 32;
        float f0[8], f1[8];
#pragma unroll
        for (int j = 0; j < 8; ++j) { f0[j] = Xs[j]; f1[j] = Xs[8 + j]; }
        *(bf16x8*)dst = pack8(f0); *(bf16x8*)(dst + 16) = pack8(f1);
    }
    __syncthreads();
    {
        int tz4 = tid; asm volatile("" : "+v"(tz4)); const int wave = __builtin_amdgcn_readfirstlane(tz4 >> 6), lane = tz4 & 63, tk = lane & 31, hh = lane >> 5;
        const int half = wave & 1;
        const int i16 = lane & 15, qq = i16 >> 2, pp = i16 & 3, blk = (lane >> 4) & 1;
        if (wave < 4) {
            const char* imgB = smem + (wave < 2 ? CK_GT : CK_HT);
            f32x16 acc[2] = {};
#pragma unroll
            for (int nt = 0; nt < 2; ++nt)
#pragma unroll
                for (int s2 = 0; s2 < 4; ++s2) {
                    const char* pa = smem + CK_AT + (16 * s2 + 8 * hh + qq) * 272 + (32 * half + 16 * blk + 4 * pp) * 2;
                    const bf16x8 af = ld_tr8(pa, pa + 4 * 272);
                    const bf16x8 bf = *(const bf16x8*)(imgB + (32 * nt + tk) * 144 + (16 * s2 + 8 * hh) * 2);
                    acc[nt] = MFMA32(af, bf, acc[nt]); }
            bf16_t* dst = (wave < 2 ? p.MYT() : p.MST()) + (size_t)unit * 4096;
#pragma unroll
            for (int nt = 0; nt < 2; ++nt)
#pragma unroll
                for (int q4 = 0; q4 < 4; ++q4) { const int col = 32 * nt + tk, k0 = 32 * half + 8 * q4 + 4 * hh;
                    float v0 = acc[nt][4 * q4], v1 = acc[nt][4 * q4 + 1], v2 = acc[nt][4 * q4 + 2], v3 = acc[nt][4 * q4 + 3];
                    if (wave < 2) { const u32x2 rw = *(const u32x2*)(smem + CK_RT + col * 272 + k0 * 2); v0 += bflo(rw.x); v1 += bfhi(rw.x); v2 += bflo(rw.y); v3 += bfhi(rw.y); }
                    u32x2 o; o.x = pk2(v0, v1); o.y = pk2(v2, v3);
                    *(u32x2*)(dst + (size_t)col * 64 + k0) = o; }
        } else {
            const bool isy = wave >= 6;
            const char* imgB = smem + (isy ? CK_GT : CK_HT);
            f32x16 nn[2] = {};
#pragma unroll
            for (int mt = 0; mt < 2; ++mt)
#pragma unroll
                for (int s2 = 0; s2 < 4; ++s2) { const bf16x8 af = *(const bf16x8*)(smem + CK_AAK + (32 * mt + tk) * 144 + (16 * s2 + 8 * hh) * 2), bf = *(const bf16x8*)(imgB + (32 * half + tk) * 144 + (16 * s2 + 8 * hh) * 2);
                    nn[mt] = MFMA32(af, bf, nn[mt]); }
            if (isy) {
#pragma unroll
                for (int mt = 0; mt < 2; ++mt) {
                    f32x16 ark = {};
#pragma unroll
                    for (int s2 = 0; s2 < 4; ++s2) { const bf16x8 af = *(const bf16x8*)(smem + CK_KT + (32 * mt + tk) * 272 + (16 * s2 + 8 * hh) * 2), bf = *(const bf16x8*)(smem + CK_RT + (32 * half + tk) * 272 + (16 * s2 + 8 * hh) * 2);
                        ark = MFMA32(af, bf, ark); }
#pragma unroll
                    for (int r2 = 0; r2 < 16; ++r2) { const int i = 32 * mt + (r2 & 3) + 8 * (r2 >> 2) + 4 * hh, t = 32 * half + tk; nn[mt][r2] += (i <= t) ? ark[r2] : 0.f; }
                }
            }
            else { const float pl = PLs[32 * half + tk];
#pragma unroll
                for (int mt = 0; mt < 2; ++mt)
#pragma unroll
                    for (int r2 = 0; r2 < 16; ++r2) { const int i = 32 * mt + (r2 & 3) + 8 * (r2 >> 2) + 4 * hh; nn[mt][r2] += bf2f(*(const unsigned short*)(smem + CK_KT + i * 272 + (32 * half + tk) * 2)) * pl; } }
            float* dst = (isy ? p.WYT() : p.WST()) + (size_t)unit * 4096 + (size_t)half * 2048;
#pragma unroll
            for (int vt = 0; vt < 2; ++vt) {
                f32x16 wacc = {};
#pragma unroll
                for (int mt = 0; mt < 2; ++mt)
#pragma unroll
                    for (int s2 = 0; s2 < 2; ++s2) {
                        const bf16x8 af = pack16s(nn[mt], s2);
                        const char* pb = smem + CK_VV + (32 * mt + 16 * s2 + 4 * hh + qq) * 192 + (32 * vt + 16 * blk + 4 * pp) * 2;
                        const bf16x8 bf = ld_tr8(pb, pb + 8 * 192);
                        wacc = MFMA32(af, bf, wacc); }
#pragma unroll
                for (int r2 = 0; r2 < 16; ++r2) dst[(vt * 16 + r2) * 64 + lane] = wacc[r2];
            }
        }
    }
}
struct P2Ops { u32x2 a[2][2][2][2]; f32x4 pl[2][4]; float ws[2][16]; };
DI void p2_load(const Params& p, size_t u, int vh, int tk, int hh, int lane, P2Ops& o) {
    const bf16_t* ms = p.MST() + u * 4096; const float* plv = p.PLV() + u * 64; const float* ws = p.WST() + u * 4096;
#pragma unroll
    for (int mt = 0; mt < 2; ++mt) {
#pragma unroll
        for (int kt = 0; kt < 2; ++kt)
#pragma unroll
            for (int s2 = 0; s2 < 2; ++s2) { const bf16_t* ap = ms + (size_t)(32 * mt + tk) * 64 + 32 * kt + 16 * s2 + 4 * hh; o.a[mt][kt][s2][0] = *(const u32x2*)ap; o.a[mt][kt][s2][1] = *(const u32x2*)(ap + 8); }
#pragma unroll
        for (int q4 = 0; q4 < 4; ++q4) o.pl[mt][q4] = *(const f32x4*)(plv + 32 * mt + 8 * q4 + 4 * hh);
#pragma unroll
        for (int r2 = 0; r2 < 16; ++r2) o.ws[mt][r2] = ws[((size_t)mt * 2 + vh) * 1024 + r2 * 64 + lane];
    }
}
DI void chunk_pass2(const Params& p, int wunit, int lane, volatile LAS int* prog) {
    const int chain = wunit >> 1, vh = wunit & 1, tk = lane & 31, hh = lane >> 5;
    f32x16 st[2] = {};
    P2Ops cur; p2_load(p, (size_t)chain * CK_N, vh, tk, hh, lane, cur);
#pragma unroll 1
    for (int c = 0; c < CK_N; ++c) {
        const size_t u = (size_t)chain * CK_N + c;
        P2Ops nxt; p2_load(p, c + 1 < CK_N ? u + 1 : u, vh, tk, hh, lane, nxt);
        bf16x8 fh[2][2], fl[2][2];
#pragma unroll
        for (int kt = 0; kt < 2; ++kt)
#pragma unroll
            for (int s2 = 0; s2 < 2; ++s2) { float h8[8], l8[8];
#pragma unroll
                for (int j = 0; j < 8; ++j) { const float x = st[kt][8 * s2 + j]; const float xh = bflo(pk2(x, 0.f)); h8[j] = xh; l8[j] = x - xh; }
                fh[kt][s2] = pack8(h8); fl[kt][s2] = pack8(l8);
                u32x4* sc = (u32x4*)p.SCF() + ((((u * 2 + vh) * 2 + kt) * 2 + s2) * 2) * 64 + lane;
                sc[0] = __builtin_bit_cast(u32x4, fh[kt][s2]); sc[64] = __builtin_bit_cast(u32x4, fl[kt][s2]); }
        f32x16 nt[2];
#pragma unroll
        for (int mt = 0; mt < 2; ++mt) {
            f32x16 acc;
#pragma unroll
            for (int q4 = 0; q4 < 4; ++q4) { const f32x4 pl = cur.pl[mt][q4];
                acc[4 * q4] = cur.ws[mt][4 * q4] + st[mt][4 * q4] * pl.x; acc[4 * q4 + 1] = cur.ws[mt][4 * q4 + 1] + st[mt][4 * q4 + 1] * pl.y;
                acc[4 * q4 + 2] = cur.ws[mt][4 * q4 + 2] + st[mt][4 * q4 + 2] * pl.z; acc[4 * q4 + 3] = cur.ws[mt][4 * q4 + 3] + st[mt][4 * q4 + 3] * pl.w; }
#pragma unroll
            for (int kt = 0; kt < 2; ++kt)
#pragma unroll
                for (int s2 = 0; s2 < 2; ++s2) {
                    const u32x2 a0 = cur.a[mt][kt][s2][0], a1 = cur.a[mt][kt][s2][1];
                    const bf16x8 af = __builtin_bit_cast(bf16x8, (u32x4){a0.x, a0.y, a1.x, a1.y});
                    acc = MFMA32(af, fh[kt][s2], acc); acc = MFMA32(af, fl[kt][s2], acc); }
            nt[mt] = acc;
        }
        st[0] = nt[0]; st[1] = nt[1];
        cur = nxt;
        if (lane == 0) *prog = c + 1;
    }
    float* so = p.out + OUT_WP + ((size_t)chain * 64 + 32 * vh + tk) * 64;
#pragma unroll
    for (int kt = 0; kt < 2; ++kt)
#pragma unroll
        for (int q4 = 0; q4 < 4; ++q4) *(f32x4*)(so + 32 * kt + 8 * q4 + 4 * hh) = (f32x4){st[kt][4 * q4], st[kt][4 * q4 + 1], st[kt][4 * q4 + 2], st[kt][4 * q4 + 3]};
}
DI void chunk_pass2_prefetch(const Params& p, int wunit, int lane, volatile LAS int* prog) {
    const int chain = wunit >> 1, vh = wunit & 1;
    unsigned sink = 0;
    for (int c = 1; c < CK_N; ++c) {
        for (int spin = 0; spin < 200000 && *prog + 8 < c; ++spin) __builtin_amdgcn_s_sleep(4);
        const size_t u = (size_t)chain * CK_N + c;
        const char* l0 = (const char*)(p.MST() + u * 4096) + lane * 128;
        const char* l1 = (const char*)(p.WST() + u * 4096) + (size_t)(((lane >> 5) * 2 + vh) * 4096) + (lane & 31) * 128;
        sink += *(const volatile unsigned*)l0 + *(const volatile unsigned*)l1;
        if (lane < 2) sink += *(const volatile unsigned*)((const char*)(p.PLV() + u * 64) + lane * 128);
    }
    asm volatile("" :: "v"(sink));
}
DI float half32_sum(float v) {
    v += dpp_xor1(v); v += dpp_xor2(v); v += dpp_hmir(v); v += dpp_mir(v); v += __shfl_xor(v, 16); return v;
}
DI void chunk_pass3(const Params& p, int hunit, int lane) {
    const int unit = hunit >> 1, tt = hunit & 1;
    const int chain = unit / CK_N, c = unit - chain * CK_N, b = chain >> 3, hd = chain & 7, tk = lane & 31, hh = lane >> 5;
    const bf16_t* my = p.MYT() + (size_t)unit * 4096;
    const u32x4* sc = (const u32x4*)p.SCF() + (size_t)unit * 16 * 64 + lane;
    const float* wy = p.WYT() + (size_t)unit * 4096;
    bf16x8 Bf[2][2][2][2];
#pragma unroll
    for (int vt = 0; vt < 2; ++vt)
#pragma unroll
        for (int kt = 0; kt < 2; ++kt)
#pragma unroll
            for (int s2 = 0; s2 < 2; ++s2)
#pragma unroll
                for (int x = 0; x < 2; ++x) Bf[vt][kt][s2][x] = __builtin_bit_cast(bf16x8, sc[((((vt * 2 + kt) * 2 + s2) * 2) + x) * 64]);
    {
        f32x16 acc[2];
#pragma unroll
        for (int vt = 0; vt < 2; ++vt) {
#pragma unroll
            for (int r2 = 0; r2 < 16; ++r2) acc[vt][r2] = wy[((size_t)tt * 2 + vt) * 1024 + r2 * 64 + lane];
#pragma unroll
            for (int kt = 0; kt < 2; ++kt)
#pragma unroll
                for (int s2 = 0; s2 < 2; ++s2) {
                    const bf16_t* ap = my + (size_t)(32 * tt + tk) * 64 + 32 * kt + 16 * s2 + 4 * hh;
                    const u32x2 a0 = *(const u32x2*)ap, a1 = *(const u32x2*)(ap + 8);
                    const bf16x8 af = __builtin_bit_cast(bf16x8, (u32x4){a0.x, a0.y, a1.x, a1.y});
                    acc[vt] = MFMA32(af, Bf[vt][kt][s2][0], acc[vt]); acc[vt] = MFMA32(af, Bf[vt][kt][s2][1], acc[vt]); }
        }
        const float lg0 = p.rw_ln_g[hd * 64 + tk], lg1 = p.rw_ln_g[hd * 64 + 32 + tk], lb0 = p.rw_ln_b[hd * 64 + tk], lb1 = p.rw_ln_b[hd * 64 + 32 + tk];
#pragma unroll
        for (int r2 = 0; r2 < 16; ++r2) {
            const int t = c * 64 + 32 * tt + (r2 & 3) + 8 * (r2 >> 2) + 4 * hh;
            const float mu = half32_sum(acc[0][r2] + acc[1][r2]) * (1.f / 64.f);
            const float d0 = acc[0][r2] - mu, d1 = acc[1][r2] - mu;
            const float rs = rsqrtf(half32_sum(d0 * d0 + d1 * d1) * (1.f / 64.f) + 64e-5f);
            if (t < TT) {
                const size_t row = (size_t)b * TT + t;
                const bf16_t* vp = p.SCAN() + scan_addr(chain, 2, 0, t);
                const float bon = p.BONUS()[row * 8 + hd];
                const float o0 = (d0 * rs * lg0 + lb0 + bon * bf2f(vp[(size_t)tk * TTP])) * bf2f(p.G()[row * 512 + hd * 64 + tk]);
                const float o1 = (d1 * rs * lg1 + lb1 + bon * bf2f(vp[(size_t)(32 + tk) * TTP])) * bf2f(p.G()[row * 512 + hd * 64 + 32 + tk]);
                p.YO()[row * DM + hd * 64 + tk] = bf16_1_(o0); p.YO()[row * DM + hd * 64 + 32 + tk] = bf16_1_(o1);
            }
        }
    }
}

DI void rwkv_sample_unit(const Params& p, int unit, int tid) {
    const int s = unit >> 3, hd = unit & 7, row = tid >> 2, c0 = (tid & 3) * 16;
    const float* S0 = p.state_wkv + (((size_t)s * 8 + hd) * 64 + row) * 64 + c0;
    const float* in = p.SCAN_S() + ((size_t)s * 8 + hd) * 384;
    float S[16]; float sa = 0.f;
#pragma unroll
    for (int i = 0; i < 16; i += 4) { const f32x4 v = *(const f32x4*)(S0 + i); S[i] = v.x; S[i + 1] = v.y; S[i + 2] = v.z; S[i + 3] = v.w; }
#pragma unroll
    for (int i = 0; i < 16; ++i) sa += S[i] * in[3 * 64 + c0 + i];
    sa += dpp_xor1(sa); sa += dpp_xor2(sa);
    const float vv = in[2 * 64 + row];
    float y = 0.f;
#pragma unroll
    for (int i = 0; i < 16; ++i) { S[i] = S[i] * in[0 * 64 + c0 + i] + sa * in[4 * 64 + c0 + i] + vv * in[1 * 64 + c0 + i]; y += S[i] * in[5 * 64 + c0 + i]; }
    y += dpp_xor1(y); y += dpp_xor2(y);
    float* So = p.out + OUT_WS + (((size_t)s * 8 + hd) * 64 + row) * 64 + c0;
#pragma unroll
    for (int i = 0; i < 16; i += 4) *(f32x4*)(So + i) = (f32x4){S[i], S[i + 1], S[i + 2], S[i + 3]};
    if ((tid & 3) == 0) p.Y()[(size_t)(MPR + s) * 512 + hd * 64 + row] = y;
}

DI void rwkv_post_row(const Params& p, int row, int lane) {
    const int n0 = lane * 8, hd = lane >> 3;
    const f32x4 ya = *(const f32x4*)(p.Y() + (size_t)row * 512 + n0), yb = *(const f32x4*)(p.Y() + (size_t)row * 512 + n0 + 4);
    float y[8] = {ya.x, ya.y, ya.z, ya.w, yb.x, yb.y, yb.z, yb.w};
    float s = 0.f;
#pragma unroll
    for (int i = 0; i < 8; ++i) s += y[i];
    const float mu = row8_sum(s) * (1.f / 64.f);
    float q = 0.f;
#pragma unroll
    for (int i = 0; i < 8; ++i) { y[i] -= mu; q += y[i] * y[i]; }
    const float rs = rsqrtf(row8_sum(q) * (1.f / 64.f) + 64e-5f);
    float v[8];
    if (row < MPR) { const int b = row / TT, t = row - b * TT; unpack8(*(const u32x4*)(p.SCAN() + (((size_t)(b * 8 + hd) * TT + t) * 6 + 2) * 64 + (n0 & 63)), v); }
    else { const float* vs = p.SCAN_S() + (((size_t)(row - MPR) * 8 + hd) * 6 + 2) * 64 + (n0 & 63);
#pragma unroll
        for (int i = 0; i < 8; ++i) v[i] = vs[i]; }
    float g[8]; unpack8(*(const u32x4*)(p.G() + (size_t)row * 512 + n0), g);
    const float bon = p.BONUS()[(size_t)row * 8 + hd];
    float o[8];
#pragma unroll
    for (int i = 0; i < 8; ++i) o[i] = (y[i] * rs * p.rw_ln_g[n0 + i] + p.rw_ln_b[n0 + i] + bon * v[i]) * g[i];
    *(u32x4*)(p.YO() + (size_t)row * DM + n0) = __builtin_bit_cast(u32x4, pack8(o));
}

DI float compute_lam(const Params& p, int lane) {
    const float a = p.da_lam[lane] * p.da_lam[64 + lane], b = p.da_lam[128 + lane] * p.da_lam[192 + lane];
    return __expf(wave_sum(a)) - __expf(wave_sum(b)) + LAM_INIT;
}
constexpr int AT_KROW = 272, AT_VROW = 320, AT_BUF = 64 * AT_KROW + 64 * AT_VROW  , AT_V_OFF = 64 * AT_KROW, AT_X_OFF = 0, AT_LDS = 2 * AT_BUF;
DI void attn_unit(const Params& p, char* smem, int b, int h, int qb, float lam, int dmax, int tid) {
    const int wave = tid >> 6, lane = tid & 63, qs = wave >> 1, c = wave & 1, tk = lane & 31, hh = lane >> 5;
    const int qrow0 = qb * 128 + qs * 32, t = qrow0 + tk, tq = t < TT ? t : TT - 1;
    const size_t rb = (size_t)b * TT;
    const float c1 = 0.125f * LOG2E, slope2 = exp2f(-2.f * (h + 1)) * LOG2E;
    const int tref = qb * 128;
    bf16x8 Qf[4];
#pragma unroll
    for (int s = 0; s < 4; ++s) Qf[s] = *(const bf16x8*)(p.QN() + (rb + tq) * 512 + h * 128 + c * 64 + 16 * s + 8 * hh);
    f32x16 O[4] = {};
    float m = -1e30f, l = 0.f;
    const int kmax = (qb * 128 + 127 < TT - 1) ? qb * 128 + 127 : TT - 1;
    const int ntile = kmax / 64 + 1;
    int kts = (qb * 128 - dmax) / 64; kts = kts < 0 ? 0 : kts;
    const bool wave_live = qrow0 < TT;
    u32x4 rkA[2], rvA[2], rkB[2], rvB[2];
    auto g_load = [&](int kt0, u32x4 (&rk)[2], u32x4 (&rv)[2]) {
#pragma unroll
        for (int i = 0; i < 2; ++i) { const int ch = tid + 512 * i, key = ch >> 4, part = ch & 15; int kr = kt0 + key; kr = kr < TT ? kr : TT - 1;
            rk[i] = *(const u32x4*)(p.KN() + (rb + kr) * 512 + h * 128 + part * 8);
            rv[i] = *(const u32x4*)(p.PROJ() + (rb + kr) * INW + O_V + h * 128 + part * 8); } };
    auto l_store = [&](char* buf, const u32x4 (&rk)[2], const u32x4 (&rv)[2]) {
#pragma unroll
        for (int i = 0; i < 2; ++i) { const int ch = tid + 512 * i, key = ch >> 4, part = ch & 15;
            *(u32x4*)(buf + key * AT_KROW + part * 16) = rk[i]; *(u32x4*)(buf + AT_V_OFF + key * AT_VROW + part * 16) = rv[i]; } };
    auto tile_compute = [&](int kt0, const char* buf) {
        if (wave_live && kt0 <= qrow0 + 31) {
            f32x16 St[2] = {};
#pragma unroll
            for (int sub = 0; sub < 2; ++sub)
#pragma unroll
                for (int s = 0; s < 4; ++s) { const bf16x8 kf = *(const bf16x8*)(buf + (sub * 32 + tk) * AT_KROW + (c * 64 + 16 * s + 8 * hh) * 2); St[sub] = MFMA32(kf, Qf[s], St[sub]); }
            const bool diag = kt0 + 63 > qrow0;
            const float bias0 = slope2 * (float)(kt0 + 4 * hh - tref);
#pragma unroll
            for (int sub = 0; sub < 2; ++sub)
#pragma unroll
                for (int i = 0; i < 16; ++i) St[sub][i] = fmaf(St[sub][i], c1, fmaf(slope2, (float)(sub * 32 + (i & 3) + 8 * (i >> 2)), bias0));
            if (diag) {
#pragma unroll
                for (int sub = 0; sub < 2; ++sub)
#pragma unroll
                    for (int i = 0; i < 16; ++i) { const int key = kt0 + sub * 32 + (i & 3) + 8 * (i >> 2) + 4 * hh; if (key > t) St[sub][i] = -INFINITY; }
            }
            float mx = -1e30f;
#pragma unroll
            for (int sub = 0; sub < 2; ++sub)
#pragma unroll
                for (int i = 0; i < 16; ++i) mx = fmaxf(mx, St[sub][i]);
            mx = fmaxf(mx, __shfl_xor(mx, 32));
            const float mn = fmaxf(m, mx), alpha = __builtin_amdgcn_exp2f(m - mn);
            m = mn; l *= alpha;
#pragma unroll
            for (int dt = 0; dt < 4; ++dt)
#pragma unroll
                for (int i = 0; i < 16; ++i) O[dt][i] *= alpha;
#pragma unroll
            for (int sub = 0; sub < 2; ++sub)
#pragma unroll
                for (int i = 0; i < 16; ++i) { const float pv = __builtin_amdgcn_exp2f(St[sub][i] - mn); St[sub][i] = pv; l += pv; }
            const int i16 = lane & 15, qq = i16 >> 2, pp = i16 & 3, blk = (lane >> 4) & 1;
#pragma unroll
            for (int sub = 0; sub < 2; ++sub)
#pragma unroll
                for (int s2 = 0; s2 < 2; ++s2) {
                    float pf8[8];
#pragma unroll
                    for (int j = 0; j < 8; ++j) pf8[j] = St[sub][8 * s2 + j];
                    const bf16x8 Pf = pack8(pf8);
                    const int keyb = sub * 32 + 16 * s2 + 4 * hh + qq;
#pragma unroll
                    for (int dt = 0; dt < 4; ++dt) {
                        const int colb = (dt * 32 + 16 * blk + 4 * pp) * 2;
                        const s16x4 lo = __builtin_amdgcn_ds_read_tr16_b64_v4i16((LAS s16x4*)(buf + AT_V_OFF + keyb * AT_VROW + colb));
                        const s16x4 hi = __builtin_amdgcn_ds_read_tr16_b64_v4i16((LAS s16x4*)(buf + AT_V_OFF + (keyb + 8) * AT_VROW + colb));
                        const bf16x8 Vf = __builtin_shufflevector(lo, hi, 0, 1, 2, 3, 4, 5, 6, 7);
                        O[dt] = MFMA32(Vf, Pf, O[dt]);
                    }
                }
        }
    };
    __syncthreads();
    g_load(kts * 64, rkA, rvA); l_store(smem, rkA, rvA);
    if (kts + 1 < ntile) g_load(kts * 64 + 64, rkA, rvA);
    __syncthreads();
    for (int kt = kts; kt < ntile; kt += 2) {
        if (kt + 2 < ntile) g_load(kt * 64 + 128, rkB, rvB);
        tile_compute(kt * 64, smem);
        if (kt + 1 < ntile) l_store(smem + AT_BUF, rkA, rvA);
        __syncthreads();
        if (kt + 1 < ntile) {
            if (kt + 3 < ntile) g_load(kt * 64 + 192, rkA, rvA);
            tile_compute(kt * 64 + 64, smem + AT_BUF);
            if (kt + 2 < ntile) l_store(smem, rkB, rvB);
        }
        __syncthreads();
    }
    l += __shfl_xor(l, 32);
    const float linv = 1.f / l;
    float* xch = (float*)(smem + AT_X_OFF) + qs * (128 * 32);
    if (c == 1) {
#pragma unroll
        for (int dt = 0; dt < 4; ++dt)
#pragma unroll
            for (int i = 0; i < 16; ++i) { const int dv = dt * 32 + (i & 3) + 8 * (i >> 2) + 4 * hh; xch[dv * 32 + tk] = O[dt][i] * linv; }
    }
    __syncthreads();
    if (c == 0) {
        float ss = 0.f;
#pragma unroll
        for (int dt = 0; dt < 4; ++dt)
#pragma unroll
            for (int i = 0; i < 16; ++i) { const int dv = dt * 32 + (i & 3) + 8 * (i >> 2) + 4 * hh; const float o = O[dt][i] * linv - lam * xch[dv * 32 + tk]; O[dt][i] = o; ss += o * o; }
        ss += __shfl_xor(ss, 32);
        const float rs = rsqrtf(ss * (1.f / 128.f) + 1e-6f) * (1.f - LAM_INIT);
        if (t < TT) {
#pragma unroll
            for (int dt = 0; dt < 4; ++dt)
#pragma unroll
                for (int q4 = 0; q4 < 4; ++q4) { const int dv = dt * 32 + 8 * q4 + 4 * hh; const f32x4 g = *(const f32x4*)(p.da_subln_g + dv);
                    u32x2 o; o.x = pk2(O[dt][4 * q4] * rs * g.x, O[dt][4 * q4 + 1] * rs * g.y); o.y = pk2(O[dt][4 * q4 + 2] * rs * g.z, O[dt][4 * q4 + 3] * rs * g.w);
                    *(u32x2*)(p.YO() + (rb + t) * DM + 512 + h * 128 + dv) = o; }
        }
    }
}
DI int alibi_dmax(const Params& p, int h, int lane) {
    float gq = fabsf(p.da_qn_g[lane]), gk = fabsf(p.da_kn_g[lane]);
#pragma unroll
    for (int o = 1; o < 64; o <<= 1) { gq = fmaxf(gq, __shfl_xor(gq, o)); gk = fmaxf(gk, __shfl_xor(gk, o)); }
    const float B = 8.f * gq * gk * LOG2E, slope2 = exp2f(-2.f * (h + 1)) * LOG2E;
    const float d = (2.f * B + 40.f) / slope2;
    return d > 1.0e6f ? 1000000 : (int)d + 1;
}
constexpr int AT_NQB = 33, AT_UNITS = NB * 4 * AT_NQB;

DI void sattn_unit(const Params& p, int unit, int lane) {
    const int split = unit & 15, bh = unit >> 4, b = bh >> 2, h = bh & 3;
    const int ps = lane >> 3, sub = lane & 7;
    const float c1 = 0.125f * LOG2E, slope2 = exp2f(-2.f * (h + 1)) * LOG2E;
    f32x4 q[4];
    {
        const bf16_t* qr = p.QN() + (size_t)(MPR + b) * 512 + h * 128;
#pragma unroll
        for (int i = 0; i < 4; ++i) { const u32x2 w = *(const u32x2*)(qr + i * 32 + sub * 4); q[i] = (f32x4){bflo(w.x) * c1, bfhi(w.x) * c1, bflo(w.y) * c1, bfhi(w.y) * c1}; }
    }
    float m0 = -1e30f, m1 = -1e30f, l0 = 0.f, l1 = 0.f;
    f32x4 O0[4], O1[4];
#pragma unroll
    for (int i = 0; i < 4; ++i) { O0[i] = (f32x4){0.f, 0.f, 0.f, 0.f}; O1[i] = (f32x4){0.f, 0.f, 0.f, 0.f}; }
    struct RowSet { f32x4 k[4], v[4]; };
    auto ld = [&](int it, RowSet& r) {
        const int pos = split * 512 + it * 8 + ps;
        const int phys = p.page_table[b * NPAGES + (pos >> 7)];
        const size_t ro = (((size_t)phys * PAGE + (pos & 127)) * 4 + h) * 128 + sub * 4;
#pragma unroll
        for (int i = 0; i < 4; ++i) r.k[i] = __builtin_nontemporal_load((const f32x4*)(p.cache_k + ro + i * 32));
#pragma unroll
        for (int i = 0; i < 4; ++i) r.v[i] = __builtin_nontemporal_load((const f32x4*)(p.cache_v + ro + i * 32));
    };
    auto step = [&](int it, const RowSet& r) {
        const int pos = split * 512 + it * 8 + ps;
        float s0 = r.k[0].x * q[0].x + r.k[0].y * q[0].y + r.k[0].z * q[0].z + r.k[0].w * q[0].w + r.k[1].x * q[1].x + r.k[1].y * q[1].y + r.k[1].z * q[1].z + r.k[1].w * q[1].w;
        float s1 = r.k[2].x * q[2].x + r.k[2].y * q[2].y + r.k[2].z * q[2].z + r.k[2].w * q[2].w + r.k[3].x * q[3].x + r.k[3].y * q[3].y + r.k[3].z * q[3].z + r.k[3].w * q[3].w;
        s0 += dpp_xor1(s0); s0 += dpp_xor2(s0); s0 += dpp_hmir(s0);
        s1 += dpp_xor1(s1); s1 += dpp_xor2(s1); s1 += dpp_hmir(s1);
        const float bias = slope2 * (float)(PAST - pos);
        s0 -= bias; s1 -= bias;
        const float n0 = fmaxf(m0, s0), a0 = __builtin_amdgcn_exp2f(m0 - n0), e0 = __builtin_amdgcn_exp2f(s0 - n0);
        const float n1 = fmaxf(m1, s1), a1 = __builtin_amdgcn_exp2f(m1 - n1), e1 = __builtin_amdgcn_exp2f(s1 - n1);
        m0 = n0; m1 = n1; l0 = l0 * a0 + e0; l1 = l1 * a1 + e1;
#pragma unroll
        for (int i = 0; i < 4; ++i) { O0[i] = O0[i] * a0 + r.v[i] * e0; O1[i] = O1[i] * a1 + r.v[i] * e1; }
    };
    RowSet A, B, C;
    ld(0, A); ld(1, B);
#pragma unroll 1
    for (int it = 0; it < 63; it += 3) {
        ld(it + 2, C); step(it, A);
        ld(it + 3, A); step(it + 1, B);
        if (it + 4 < 64) ld(it + 4, B);
        step(it + 2, C);
    }
    step(63, A);
    float ma0 = m0, ma1 = m1;
#pragma unroll
    for (int o = 8; o < 64; o <<= 1) { ma0 = fmaxf(ma0, __shfl_xor(ma0, o)); ma1 = fmaxf(ma1, __shfl_xor(ma1, o)); }
    const float sc0 = __builtin_amdgcn_exp2f(m0 - ma0), sc1 = __builtin_amdgcn_exp2f(m1 - ma1);
    l0 *= sc0; l1 *= sc1;
#pragma unroll
    for (int o = 8; o < 64; o <<= 1) { l0 += __shfl_xor(l0, o); l1 += __shfl_xor(l1, o); }
#pragma unroll
    for (int i = 0; i < 4; ++i)
#pragma unroll
        for (int e = 0; e < 4; ++e) { float x0 = O0[i][e] * sc0, x1 = O1[i][e] * sc1;
#pragma unroll
            for (int o = 8; o < 64; o <<= 1) { x0 += __shfl_xor(x0, o); x1 += __shfl_xor(x1, o); }
            O0[i][e] = x0; O1[i][e] = x1; }
    if (ps == 0) {
        float* d0 = p.PART() + ((size_t)unit * 2 + 0) * 130; float* d1 = d0 + 130;
        if (sub == 0) { d0[0] = ma0; d0[1] = l0; d1[0] = ma1; d1[1] = l1; }
#pragma unroll
        for (int i = 0; i < 4; ++i) { *(f32x2*)(d0 + 2 + i * 32 + sub * 4) = (f32x2){O0[i].x, O0[i].y}; *(f32x2*)(d0 + 2 + i * 32 + sub * 4 + 2) = (f32x2){O0[i].z, O0[i].w};
            *(f32x2*)(d1 + 2 + i * 32 + sub * 4) = (f32x2){O1[i].x, O1[i].y}; *(f32x2*)(d1 + 2 + i * 32 + sub * 4 + 2) = (f32x2){O1[i].z, O1[i].w}; }
    }
}
DI void sattn_combine(const Params& p, int bh, float lam, int lane) {
    const int b = bh >> 2, h = bh & 3, row = MPR + b;
    const float c1 = 0.125f * LOG2E;
    float o[2][2];
    const float v0 = bf2f(p.PROJ()[(size_t)row * INW + O_V + h * 128 + lane]), v1 = bf2f(p.PROJ()[(size_t)row * INW + O_V + h * 128 + 64 + lane]);
#pragma unroll
    for (int c = 0; c < 2; ++c) {
        const float qd = bf2f(p.QN()[(size_t)row * 512 + h * 128 + c * 64 + lane]), kd = bf2f(p.KN()[(size_t)row * 512 + h * 128 + c * 64 + lane]);
        const float sself = wave_sum(qd * kd) * c1;
        float mm = sself;
        for (int s = 0; s < SA_SPLITS; ++s) mm = fmaxf(mm, p.PART()[((size_t)(bh * 16 + s) * 2 + c) * 130]);
        const float pself = __builtin_amdgcn_exp2f(sself - mm);
        float lt = pself, a0 = pself * v0, a1 = pself * v1;
        for (int s = 0; s < SA_SPLITS; ++s) { const float* pp = p.PART() + ((size_t)(bh * 16 + s) * 2 + c) * 130; const float sc = __builtin_amdgcn_exp2f(pp[0] - mm);
            lt += pp[1] * sc; a0 += pp[2 + lane] * sc; a1 += pp[2 + 64 + lane] * sc; }
        o[c][0] = a0 / lt; o[c][1] = a1 / lt;
    }
    const float r0 = o[0][0] - lam * o[1][0], r1 = o[0][1] - lam * o[1][1];
    const float ss = wave_sum(r0 * r0 + r1 * r1);
    const float rs = rsqrtf(ss * (1.f / 128.f) + 1e-6f) * (1.f - LAM_INIT);
    p.YO()[(size_t)row * DM + 512 + h * 128 + lane] = (bf16_t)(pk2(r0 * rs * p.da_subln_g[lane], 0.f) & 0xffffu);
    p.YO()[(size_t)row * DM + 512 + h * 128 + 64 + lane] = (bf16_t)(pk2(r1 * rs * p.da_subln_g[64 + lane], 0.f) & 0xffffu);
}

struct EpiBr1 {
    const bf16_t* PROJ; bf16_t* MIX;
    DI void operator()(const AccT& acc, int brow, int bcol, int wr, int wc, int fr, int fq) const {
#pragma unroll
        for (int ai = 0; ai < 2; ++ai) {
            EPI_FENCE;
            u32x2 g[4][4];
#pragma unroll
            for (int m = 0; m < 4; ++m)
#pragma unroll
                for (int j = 0; j < 4; ++j) g[m][j] = *(const u32x2*)(PROJ + (size_t)EPI_ROW(ai, m) * INW + O_GA + EPI_COL(j >> 1, j & 1));
            EPI_FENCE;
#pragma unroll
            for (int m = 0; m < 4; ++m)
#pragma unroll
                for (int j = 0; j < 4; ++j) { const f32x4 a = acc[ai][j >> 1][m][j & 1]; const u32x2 gg = g[m][j];
                    u32x2 o; o.x = pk2(a.x * sigmoidf_(bflo(gg.x)), a.y * sigmoidf_(bfhi(gg.x))); o.y = pk2(a.z * sigmoidf_(bflo(gg.y)), a.w * sigmoidf_(bfhi(gg.y)));
                    *(u32x2*)(MIX + (size_t)EPI_ROW(ai, m) * DM + EPI_COL(j >> 1, j & 1)) = o; }
        }
    }
};
struct EpiBr2 {
    const bf16_t* PROJ; bf16_t* MIX;
    DI void operator()(const AccT& acc, int brow, int bcol, int wr, int wc, int fr, int fq) const {
#pragma unroll
        for (int ai = 0; ai < 2; ++ai) {
            EPI_FENCE;
            u32x2 g[4][4], f[4][4];
#pragma unroll
            for (int m = 0; m < 4; ++m)
#pragma unroll
                for (int j = 0; j < 4; ++j) { g[m][j] = *(const u32x2*)(PROJ + (size_t)EPI_ROW(ai, m) * INW + O_GB + EPI_COL(j >> 1, j & 1));
                    f[m][j] = *(const u32x2*)(MIX + (size_t)EPI_ROW(ai, m) * DM + EPI_COL(j >> 1, j & 1)); }
            EPI_FENCE;
#pragma unroll
            for (int m = 0; m < 4; ++m)
#pragma unroll
                for (int j = 0; j < 4; ++j) { const f32x4 a = acc[ai][j >> 1][m][j & 1]; const u32x2 gg = g[m][j], ff = f[m][j];
                    u32x2 o; o.x = pk2(bflo(ff.x) + a.x * sigmoidf_(bflo(gg.x)), bfhi(ff.x) + a.y * sigmoidf_(bfhi(gg.x))); o.y = pk2(bflo(ff.y) + a.z * sigmoidf_(bflo(gg.y)), bfhi(ff.y) + a.w * sigmoidf_(bfhi(gg.y)));
                    *(u32x2*)(MIX + (size_t)EPI_ROW(ai, m) * DM + EPI_COL(j >> 1, j & 1)) = o; }
        }
    }
};
struct EpiOut {
    const float* const* XPTR; float* H1; bf16_t* HB; float* SS2;
    DI void operator()(const AccT& acc, int brow, int bcol, int wr, int wc, int fr, int fq) const {
        const float* xr[2][4];
#pragma unroll
        for (int ai = 0; ai < 2; ++ai)
#pragma unroll
            for (int m = 0; m < 4; ++m) xr[ai][m] = XPTR[EPI_ROW(ai, m)];
#pragma unroll
        for (int ai = 0; ai < 2; ++ai) {
            EPI_FENCE;
            f32x4 x[4][4];
#pragma unroll
            for (int m = 0; m < 4; ++m)
#pragma unroll
                for (int j = 0; j < 4; ++j) x[m][j] = *(const f32x4*)(xr[ai][m] + EPI_COL(j >> 1, j & 1));
            EPI_FENCE;
#pragma unroll
            for (int m = 0; m < 4; ++m) {
                const int row = EPI_ROW(ai, m);
                float ss = 0.f;
#pragma unroll
                for (int j = 0; j < 4; ++j) { const int col = EPI_COL(j >> 1, j & 1);
                    const f32x4 v = acc[ai][j >> 1][m][j & 1] + x[m][j];
                    ss += v.x * v.x + v.y * v.y + v.z * v.z + v.w * v.w;
                    *(f32x4*)(H1 + (size_t)row * DM + col) = v;
                    u32x2 o; o.x = pk2(v.x, v.y); o.y = pk2(v.z, v.w);
                    *(u32x2*)(HB + (size_t)row * DM + col) = o; }
                ss += __shfl_xor(ss, 16); ss += __shfl_xor(ss, 32);
                if (fq == 0) atomicAdd(SS2 + row, ss);
            }
        }
    }
};
struct EpiQ {
    const float* SS2; bf16_t* QP;
    DI void operator()(const AccT& acc, int brow, int bcol, int wr, int wc, int fr, int fq) const {
        float ssv[2][4];
#pragma unroll
        for (int ai = 0; ai < 2; ++ai)
#pragma unroll
            for (int m = 0; m < 4; ++m) ssv[ai][m] = SS2[EPI_ROW(ai, m)];
        EPI_ROWS_BEGIN
            const float rs = rsqrtf(ssv[ai][m] * (1.f / DM) + 1e-6f);
            EPI_COLS_BEGIN
                const f32x4 v = a * rs;
                u32x2 o; o.x = pk2(v.x, v.y); o.y = pk2(v.z, v.w);
                *(u32x2*)(QP + (size_t)row * 2048 + col) = o;
            }
        }
    }
};

template <class F>
DI void skinny_gemm(const bf16_t* A, int lda, const bf16_t* Bt, int K, int N, char* smem, int bid, int nblk, int tid, F&& f) {
    const int wave = tid >> 6, lane = tid & 63, tk = lane & 31, hh = lane >> 5;
    const int ks = K / 128;
    for (int tile = bid; tile < N / 32; tile += nblk) {
        const int n0 = tile * 32;
        f32x16 acc = {};
        const bf16_t* ap = A + (size_t)(MPR + tk) * lda + 8 * hh + wave * ks * 16; const bf16_t* bp = Bt + (size_t)(n0 + tk) * K + 8 * hh + wave * ks * 16;
        if (ks == 4) {
            bf16x8 av[4], bv[4];
#pragma unroll
            for (int s2 = 0; s2 < 4; ++s2) { av[s2] = *(const bf16x8*)(ap + 16 * s2); bv[s2] = *(const bf16x8*)(bp + 16 * s2); }
#pragma unroll
            for (int s2 = 0; s2 < 4; ++s2) acc = MFMA32(av[s2], bv[s2], acc);
        } else {
            bf16x8 av[8], bv[8];
#pragma unroll
            for (int s2 = 0; s2 < 8; ++s2) { av[s2] = *(const bf16x8*)(ap + 16 * s2); bv[s2] = *(const bf16x8*)(bp + 16 * s2); }
#pragma unroll
            for (int s2 = 0; s2 < 8; ++s2) acc = MFMA32(av[s2], bv[s2], acc);
        }
        __syncthreads();
        float* part = (float*)smem + wave * 1024;
#pragma unroll
        for (int i = 0; i < 16; ++i) part[i * 64 + lane] = acc[i];
        __syncthreads();
#pragma unroll
        for (int ii = 0; ii < 2; ++ii) { const int i = 2 * wave + ii; float v = 0.f;
#pragma unroll
            for (int w = 0; w < 8; ++w) v += ((const float*)smem)[w * 1024 + i * 64 + lane];
            f(MPR + (i & 3) + 8 * (i >> 2) + 4 * hh, n0 + tk, v); }
    }
    __syncthreads();
}
DI unsigned short bf16_1(float x) { return (unsigned short)(pk2(x, 0.f) & 0xffffu); }

DI int fkey(float f, int idx, int mask) { int b = (__float_as_int(f) & ~mask) | idx; return b ^ ((b >> 31) & 0x7fffffff); }
DI int funkey(int k) { return k ^ ((k >> 31) & 0x7fffffff); }
template <int N> DI void bitonic_sort_desc(int (&a)[N]) {
#pragma unroll
    for (int k = 2; k <= N; k <<= 1)
#pragma unroll
        for (int j = k >> 1; j > 0; j >>= 1)
#pragma unroll
            for (int i = 0; i < N; ++i) { const int l = i ^ j;
                if (l > i) { const bool desc = ((i & k) == 0); const int mx = max(a[i], a[l]), mn = min(a[i], a[l]); a[i] = desc ? mx : mn; a[l] = desc ? mn : mx; } }
}
DI void merge_top16(int (&a)[16], const int (&b)[16]) {
#pragma unroll
    for (int i = 0; i < 16; ++i) a[i] = max(a[i], b[15 - i]);
#pragma unroll
    for (int j = 8; j > 0; j >>= 1)
#pragma unroll
        for (int i = 0; i < 16; ++i) { const int l = i ^ j; if (l > i) { const int mx = max(a[i], a[l]), mn = min(a[i], a[l]); a[i] = mx; a[l] = mn; } }
}
DI void top16_of_64(int (&g0)[16], int (&g1)[16], int (&g2)[16], int (&g3)[16], bool g0_sorted) {
    if (!g0_sorted) bitonic_sort_desc<16>(g0);
    bitonic_sort_desc<16>(g1); bitonic_sort_desc<16>(g2); bitonic_sort_desc<16>(g3);
    merge_top16(g0, g1); merge_top16(g2, g3); merge_top16(g0, g2);
}
DI void half_topk(const Params& p, const char* skl, int row, int hd, int c, int tk, int hh, int (&top)[16]) {
    bf16x8 Bq[8];
#pragma unroll
    for (int s = 0; s < 8; ++s) Bq[s] = *(const bf16x8*)(p.QP() + (size_t)row * 2048 + hd * 256 + c * 128 + 16 * s + 8 * hh);
    int g[4][16];
#pragma unroll
    for (int kt = 0; kt < 4; ++kt) {
        f32x16 acc = {};
#pragma unroll
        for (int s = 0; s < 8; ++s) { const bf16x8 ak = *(const bf16x8*)(skl + (c * 128 + kt * 32 + tk) * 272 + (16 * s + 8 * hh) * 2); acc = MFMA32(ak, Bq[s], acc); }
#pragma unroll
        for (int i = 0; i < 16; ++i) g[kt][i] = fkey(acc[i], kt * 32 + (i & 3) + 8 * (i >> 2) + 4 * hh, 0x7f);
        __builtin_amdgcn_sched_barrier(0);
    }
    bitonic_sort_desc<16>(g[0]); __builtin_amdgcn_sched_barrier(0);
    bitonic_sort_desc<16>(g[1]); __builtin_amdgcn_sched_barrier(0);
    merge_top16(g[0], g[1]); __builtin_amdgcn_sched_barrier(0);
    bitonic_sort_desc<16>(g[2]); __builtin_amdgcn_sched_barrier(0);
    bitonic_sort_desc<16>(g[3]); __builtin_amdgcn_sched_barrier(0);
    merge_top16(g[2], g[3]); merge_top16(g[0], g[2]);
    int oth[16];
#pragma unroll
    for (int i = 0; i < 16; ++i) oth[i] = __shfl_xor(g[0][i], 32);
    merge_top16(g[0], oth);
#pragma unroll
    for (int i = 0; i < 16; ++i) top[i] = g[0][i];
    __builtin_amdgcn_sched_barrier(0);
}
DI void topk_unit(const Params& p, const char* skl, char* lds_wave  , int unit, int lane) {
    const int tile = unit >> 3, hd = unit & 7, tk = lane & 31, hh = lane >> 5, row = tile * 32 + tk;
    int top[2][16];
    half_topk(p, skl, row, hd, 0, tk, hh, top[0]);
    half_topk(p, skl, row, hd, 1, tk, hh, top[1]);
    float v1[16], v2[16]; unsigned i1w[4] = {0, 0, 0, 0}, i2w[4] = {0, 0, 0, 0};
#pragma unroll
    for (int i = 0; i < 16; ++i) { const int b1 = funkey(top[0][i]), b2 = funkey(top[1][i]);
        v1[i] = __int_as_float(b1 & ~0x7f); v2[i] = __int_as_float(b2 & ~0x7f);
        i1w[i >> 2] |= (unsigned)(b1 & 0x7f) << (8 * (i & 3)); i2w[i >> 2] |= (unsigned)(b2 & 0x7f) << (8 * (i & 3)); }
    LAS unsigned* myl = (LAS unsigned*)lds_wave + lane * 8;
#pragma unroll
    for (int i = 0; i < 4; ++i) { myl[i] = i1w[i]; myl[4 + i] = i2w[i]; }
    int cg0[16], cg1[16], cg2[16], cg3[16];
    constexpr int NEG = (int)0x80000000;
#pragma unroll
    for (int j = 0; j < 16; ++j) cg0[j] = fkey(v1[0] + v2[j], j, 0xff);
    {
        int n = 0;
#pragma unroll
        for (int i = 1; i < 16; ++i)
#pragma unroll
            for (int j = 0; j < 16; ++j) if ((i + 1) * (j + 1) <= 16) { const int k = fkey(v1[i] + v2[j], i * 16 + j, 0xff);
                if (n < 16) cg1[n] = k; else if (n < 32) cg2[n - 16] = k; else cg3[n - 32] = k; ++n; }
#pragma unroll
        for (int i = 2; i < 16; ++i) cg3[i] = NEG;
    }
    __builtin_amdgcn_sched_barrier(0);
    bitonic_sort_desc<16>(cg0); __builtin_amdgcn_sched_barrier(0);
    bitonic_sort_desc<16>(cg1); __builtin_amdgcn_sched_barrier(0);
    merge_top16(cg0, cg1); __builtin_amdgcn_sched_barrier(0);
    bitonic_sort_desc<16>(cg2); __builtin_amdgcn_sched_barrier(0);
    bitonic_sort_desc<16>(cg3); __builtin_amdgcn_sched_barrier(0);
    merge_top16(cg2, cg3); merge_top16(cg0, cg2);
    float sc[16]; int cid[16];
#pragma unroll
    for (int i = 0; i < 16; ++i) { const int bb = funkey(cg0[i]); sc[i] = __int_as_float(bb & ~0xff); cid[i] = bb & 0xff; }
    float e[16], sum = 0.f;
#pragma unroll
    for (int i = 0; i < 16; ++i) { e[i] = __expf(sc[i] - sc[0]); sum += e[i]; }
    const float inv = 1.f / sum;
    __builtin_amdgcn_s_waitcnt(0xc07f); asm volatile("" ::: "memory");
    const LAS unsigned char* myb = (const LAS unsigned char*)myl;
    int eidx[16];
#pragma unroll
    for (int i = 0; i < 16; ++i) eidx[i] = (int)myb[cid[i] >> 4] * 128 + (int)myb[16 + (cid[i] & 15)];
    if (hh == 0 && row < MTOT) {
        int* io = p.IDX() + ((size_t)row * 8 + hd) * 16; float* go = p.GATE() + ((size_t)row * 8 + hd) * 16;
#pragma unroll
        for (int i = 0; i < 16; i += 4) { *(int4*)(io + i) = make_int4(eidx[i], eidx[i + 1], eidx[i + 2], eidx[i + 3]); *(f32x4*)(go + i) = (f32x4){e[i] * inv, e[i + 1] * inv, e[i + 2] * inv, e[i + 3] * inv}; }
    }
    __builtin_amdgcn_s_waitcnt(0xc07f); asm volatile("" ::: "memory");
}

DI void experts_row(const Params& p, int row, int lane) {
    const float rs = rsqrtf(p.SS2()[row] * (1.f / DM) + 1e-6f);
    float x[16];
    {
        float t0[8], t1[8]; unpack8(*(const u32x4*)(p.HB() + (size_t)row * DM + lane * 8), t0); unpack8(*(const u32x4*)(p.HB() + (size_t)row * DM + 512 + lane * 8), t1);
#pragma unroll
        for (int i = 0; i < 8; ++i) { x[i] = t0[i] * rs * p.norm2_g[lane * 8 + i]; x[8 + i] = t1[i] * rs * p.norm2_g[512 + lane * 8 + i]; }
    }
    float out[16];
#pragma unroll
    for (int i = 0; i < 16; ++i) out[i] = 0.f;
    for (int hd = 0; hd < 8; ++hd) {
        const int myidx = p.IDX()[((size_t)row * 8 + hd) * 16 + (lane & 15)];
        const float mygate = p.GATE()[((size_t)row * 8 + hd) * 16 + (lane & 15)];
        float hid = 0.f;
#pragma unroll 4
        for (int k = 0; k < 16; ++k) {
            const int e = __builtin_amdgcn_readlane(myidx, k);
            const bf16_t* ur = p.U16() + (size_t)e * DM;
            float u0[8], u1[8]; unpack8(*(const u32x4*)(ur + lane * 8), u0); unpack8(*(const u32x4*)(ur + 512 + lane * 8), u1);
            float d = 0.f;
#pragma unroll
            for (int i = 0; i < 8; ++i) d += x[i] * u0[i] + x[8 + i] * u1[i];
            d = wave_sum(d);
            hid = (lane & 15) == k ? d : hid;
        }
        const float cf = 0.5f * hid * (1.f + erff(hid * 0.70710678118654752f)) * mygate;
#pragma unroll 4
        for (int k = 0; k < 16; ++k) {
            const int e = __builtin_amdgcn_readlane(myidx, k);
            const float ck = __int_as_float(__builtin_amdgcn_readlane(__float_as_int(cf), k));
            const bf16_t* vr = p.V16() + (size_t)e * DM;
            float u0[8], u1[8]; unpack8(*(const u32x4*)(vr + lane * 8), u0); unpack8(*(const u32x4*)(vr + 512 + lane * 8), u1);
#pragma unroll
            for (int i = 0; i < 8; ++i) { out[i] += ck * u0[i]; out[8 + i] += ck * u1[i]; }
        }
    }
    float* dst = nullptr;
    if (row < MPR) { const int b = row / TT, t = row - b * TT; if (t >= NMETA) dst = p.out + OUT_YP + ((size_t)b * SEQ + (t - NMETA)) * DM; }
    else dst = p.out + OUT_YS + (size_t)(row - MPR) * DM;
    if (dst) {
        const float* h1 = p.H1() + (size_t)row * DM;
#pragma unroll
        for (int j = 0; j < 2; ++j) {
            const f32x4 a = *(const f32x4*)(h1 + j * 512 + lane * 8), b = *(const f32x4*)(h1 + j * 512 + lane * 8 + 4);
            *(f32x4*)(dst + j * 512 + lane * 8) = (f32x4){a.x + out[8 * j], a.y + out[8 * j + 1], a.z + out[8 * j + 2], a.w + out[8 * j + 3]};
            *(f32x4*)(dst + j * 512 + lane * 8 + 4) = (f32x4){b.x + out[8 * j + 4], b.y + out[8 * j + 5], b.z + out[8 * j + 6], b.w + out[8 * j + 7]};
        }
    }
}

constexpr int EX_NSL = 1, EX_SLSH = 14;
constexpr int EX_IDX_OFF = 0, EX_COEF_OFF = 64 * 128 * 2, EX_OFF_OFF = EX_COEF_OFF + 64 * 128 * 4, EX_LIST_OFF = EX_OFF_OFF + 64 * 32 * 2, EX_LDS = EX_LIST_OFF + 8 * 256 * 2;
DI float row16_rorsum(float v) {
    v += __builtin_amdgcn_update_dpp(0.f, v, 0x128, 0xF, 0xF, false);
    v += __builtin_amdgcn_update_dpp(0.f, v, 0x124, 0xF, 0xF, false);
    v += __builtin_amdgcn_update_dpp(0.f, v, 0x122, 0xF, 0xF, false);
    v += __builtin_amdgcn_update_dpp(0.f, v, 0x121, 0xF, 0xF, false);
    return v;
}
DI void unpack_fp8x16(const u32x4& w, float (&f)[16]) {
#pragma unroll
    for (int q = 0; q < 4; ++q) { const f32x2 lo = __builtin_amdgcn_cvt_pk_f32_fp8((int)w[q], false), hi = __builtin_amdgcn_cvt_pk_f32_fp8((int)w[q], true);
        f[4 * q] = lo.x; f[4 * q + 1] = lo.y; f[4 * q + 2] = hi.x; f[4 * q + 3] = hi.y; }
}
DI int peer_row_of(int ci) { return ci < NB * SEQ ? (ci >> 12) * TT + NMETA + (ci & 4095) : (ci < NB * SEQ + MS ? MPR + (ci - NB * SEQ) : -1); }
DI void experts_wave(const Params& p, char* smem, int wave_, int lane_, int ci0, int ntok, int xcc) {
    int wave = wave_, lane = lane_; asm volatile("" : "+v"(lane), "+v"(wave)); wave = __builtin_amdgcn_readfirstlane(wave);
    LAS unsigned short* idxs = (LAS unsigned short*)(smem + EX_IDX_OFF) + wave * 8 * 128;
    LAS float* coef = (LAS float*)(smem + EX_COEF_OFF) + wave * 8 * 128;
    LAS unsigned short* offs = (LAS unsigned short*)(smem + EX_OFF_OFF) + wave * 8 * 32;
    const unsigned char* U8 = (const unsigned char*)p.U16(); const unsigned char* V8 = (const unsigned char*)p.V16();
    float xr[2][16];
#pragma unroll
    for (int j = 0; j < 2; ++j) {
        const int row = j < ntok ? peer_row_of(ci0 + j) : -1;
        if (row >= 0) {
            const int e0 = p.IDX()[(size_t)row * 128 + lane], e1 = p.IDX()[(size_t)row * 128 + 64 + lane];
            const float g0 = p.GATE()[(size_t)row * 128 + lane], g1 = p.GATE()[(size_t)row * 128 + 64 + lane];
            const int s0 = e0 >> EX_SLSH, s1 = e1 >> EX_SLSH;
            int base = 0, pos0 = 0, pos1 = 0;
#pragma unroll
            for (int sl = 0; sl < EX_NSL; ++sl) {
                const unsigned long long m0 = __ballot(s0 == sl), m1 = __ballot(s1 == sl);
                const int c0 = __popcll(m0), c1 = __popcll(m1);
                const int r0 = __builtin_amdgcn_mbcnt_hi((unsigned)(m0 >> 32), __builtin_amdgcn_mbcnt_lo((unsigned)m0, 0));
                const int r1 = __builtin_amdgcn_mbcnt_hi((unsigned)(m1 >> 32), __builtin_amdgcn_mbcnt_lo((unsigned)m1, 0));
                if (s0 == sl) pos0 = base + r0;
                if (s1 == sl) pos1 = base + c0 + r1;
                if (lane == 0) offs[j * 32 + sl] = (unsigned short)base;
                base += c0 + c1;
            }
            if (lane == 0) offs[j * 32 + EX_NSL] = (unsigned short)base;
            idxs[j * 128 + pos0] = (unsigned short)e0; idxs[j * 128 + pos1] = (unsigned short)e1;
            coef[j * 128 + pos0] = g0; coef[j * 128 + pos1] = g1;
            const float rs = rsqrtf(p.SS2()[row] * (1.f / DM) + 1e-6f) * (1.f / U8_SCALE);
            float t0[8], t1[8]; unpack8(*(const u32x4*)(p.HB() + (size_t)row * DM + lane * 16), t0); unpack8(*(const u32x4*)(p.HB() + (size_t)row * DM + lane * 16 + 8), t1);
#pragma unroll
            for (int q = 0; q < 2; ++q) { const f32x4 ga = *(const f32x4*)(p.norm2_g + lane * 16 + 4 * q), gb = *(const f32x4*)(p.norm2_g + lane * 16 + 8 + 4 * q);
                xr[j][4 * q] = t0[4 * q] * rs * ga.x; xr[j][4 * q + 1] = t0[4 * q + 1] * rs * ga.y; xr[j][4 * q + 2] = t0[4 * q + 2] * rs * ga.z; xr[j][4 * q + 3] = t0[4 * q + 3] * rs * ga.w;
                xr[j][8 + 4 * q] = t1[4 * q] * rs * gb.x; xr[j][8 + 4 * q + 1] = t1[4 * q + 1] * rs * gb.y; xr[j][8 + 4 * q + 2] = t1[4 * q + 2] * rs * gb.z; xr[j][8 + 4 * q + 3] = t1[4 * q + 3] * rs * gb.w; }
        } else {
            if (lane <= EX_NSL) offs[j * 32 + lane] = 0;
#pragma unroll
            for (int i = 0; i < 16; ++i) xr[j][i] = 0.f;
        }
    }
    __builtin_amdgcn_s_waitcnt(0xc07f); asm volatile("" ::: "memory");
    LAS unsigned short* blist = (LAS unsigned short*)(smem + EX_LIST_OFF) + wave * 256;
    int nbat;
    {
        const int r = (lane >> 1) & (EX_NSL - 1), j = lane & 1, sl = (xcc + r) & (EX_NSL - 1);
        const int beg = offs[j * 32 + sl], cnt = lane < 2 * EX_NSL ? (int)offs[j * 32 + sl + 1] - beg : 0, nb = (cnt + 7) >> 3;
        int incl = nb;
#pragma unroll
        for (int o = 1; o < 64; o <<= 1) { const int t = __shfl_up(incl, o); if (lane >= o) incl += t; }
        nbat = __builtin_amdgcn_readlane(incl, 63);
        int w = incl - nb;
        for (int q = 0; q < nb; ++q) { const int k = beg + 8 * q, n = (cnt - 8 * q) < 8 ? (cnt - 8 * q) : 8; blist[w + q] = (unsigned short)(j | (k << 3) | ((n - 1) << 10)); }
    }
    __builtin_amdgcn_s_waitcnt(0xc07f); asm volatile("" ::: "memory");
    const int pid = lane >> 4;
    auto fetch = [&](const unsigned char* tab, int bi, u32x4 (&buf)[8]) {
        const int e = __builtin_amdgcn_readfirstlane((int)blist[bi]);
        const int j = e & 7, k = (e >> 3) & 127, n = (e >> 10) + 1;
#pragma unroll
        for (int i = 0; i < 8; ++i) { const int kk = k + (i < n ? i : n - 1);
            const int ex = __builtin_amdgcn_readfirstlane((int)idxs[j * 128 + kk]);
            buf[i] = *(const u32x4*)(tab + (size_t)ex * DM + lane * 16); }
    };
    auto u_consume = [&](int bi, const u32x4 (&buf)[8]) {
        const int e = __builtin_amdgcn_readfirstlane((int)blist[bi]);
        const int j = e & 7, k = (e >> 3) & 127, n = (e >> 10) + 1;
        float pp[8], x[16];
#pragma unroll
        for (int q = 0; q < 16; ++q) x[q] = j ? xr[1][q] : xr[0][q];
#pragma unroll
        for (int i = 0; i < 8; ++i) { float f[16]; unpack_fp8x16(buf[i], f); float d0 = 0.f, d1 = 0.f;
#pragma unroll
            for (int q = 0; q < 16; q += 2) { d0 += f[q] * x[q]; d1 += f[q + 1] * x[q + 1]; }
            pp[i] = d0 + d1; __builtin_amdgcn_sched_barrier(0); }
#pragma unroll
        for (int hb = 0; hb < 2; ++hb) {
            const bool b5 = lane & 32, b4 = lane & 16;
            const float a0 = b5 ? pp[4 * hb + 2] : pp[4 * hb], a1 = b5 ? pp[4 * hb + 3] : pp[4 * hb + 1], s0 = b5 ? pp[4 * hb] : pp[4 * hb + 2], s1 = b5 ? pp[4 * hb + 1] : pp[4 * hb + 3];
            const float q0 = a0 + __shfl_xor(s0, 32), q1 = a1 + __shfl_xor(s1, 32);
            const float c0 = b4 ? q1 : q0, d0 = b4 ? q0 : q1;
            float z = c0 + __shfl_xor(d0, 16);
            z = row16_rorsum(z);
            const int ip = 4 * hb + pid;
            if ((lane & 15) == 0 && ip < n) {
                const float g = coef[j * 128 + k + ip];
                coef[j * 128 + k + ip] = 0.5f * z * (1.f + erff(z * 0.70710678118654752f)) * g * (1.f / V8_SCALE);
            }
        }
    };
    {
        u32x4 bufA[8], bufB[8];
        if (nbat > 0) fetch(U8, 0, bufA);
#pragma unroll 1
        for (int bi = 0; bi < nbat; bi += 2) {
            if (bi + 1 < nbat) fetch(U8, bi + 1, bufB);
            u_consume(bi, bufA);
            if (bi + 2 < nbat) fetch(U8, bi + 2, bufA);
            if (bi + 1 < nbat) u_consume(bi + 1, bufB);
        }
    }
    __builtin_amdgcn_s_waitcnt(0xc07f); asm volatile("" ::: "memory");
    float acc[2][16];
#pragma unroll
    for (int j = 0; j < 2; ++j)
#pragma unroll
        for (int i = 0; i < 16; ++i) acc[j][i] = 0.f;
    auto v_consume = [&](int bi, const u32x4 (&buf)[8]) {
        const int e = __builtin_amdgcn_readfirstlane((int)blist[bi]);
        const int j = e & 7, k = (e >> 3) & 127, n = (e >> 10) + 1;
        float cc[8];
#pragma unroll
        for (int i = 0; i < 8; ++i) { const float c = __int_as_float(__builtin_amdgcn_readfirstlane(__float_as_int(coef[j * 128 + k + (i < n ? i : n - 1)]))); cc[i] = i < n ? c : 0.f; }
        float d[16];
#pragma unroll
        for (int q = 0; q < 16; ++q) d[q] = 0.f;
#pragma unroll
        for (int i = 0; i < 8; ++i) { float f[16]; unpack_fp8x16(buf[i], f);
#pragma unroll
            for (int q = 0; q < 16; ++q) d[q] += cc[i] * f[q];
            __builtin_amdgcn_sched_barrier(0); }
#pragma unroll
        for (int q = 0; q < 16; ++q) { acc[0][q] += j ? 0.f : d[q]; acc[1][q] += j ? d[q] : 0.f; }
    };
    {
        u32x4 bufA[8], bufB[8];
        if (nbat > 0) fetch(V8, 0, bufA);
#pragma unroll 1
        for (int bi = 0; bi < nbat; bi += 2) {
            if (bi + 1 < nbat) fetch(V8, bi + 1, bufB);
            v_consume(bi, bufA);
            if (bi + 2 < nbat) fetch(V8, bi + 2, bufA);
            if (bi + 1 < nbat) v_consume(bi + 1, bufB);
        }
    }
#pragma unroll
    for (int j = 0; j < 2; ++j) {
        const int ci = ci0 + j;
        const int row = j < ntok ? peer_row_of(ci) : -1;
        if (row >= 0) {
            float* dst = (ci < NB * SEQ ? p.out + OUT_YP + (size_t)ci * DM : p.out + OUT_YS + (size_t)(ci - NB * SEQ) * DM) + lane * 16;
            const float* h1 = p.H1() + (size_t)row * DM + lane * 16;
#pragma unroll
            for (int q = 0; q < 4; ++q) { const f32x4 a = *(const f32x4*)(h1 + 4 * q);
                *(f32x4*)(dst + 4 * q) = (f32x4){a.x + acc[j][4 * q], a.y + acc[j][4 * q + 1], a.z + acc[j][4 * q + 2], a.w + acc[j][4 * q + 3]}; }
        }
    }
}

typedef float f32x32 __attribute__((ext_vector_type(32)));
typedef unsigned u32x6 __attribute__((ext_vector_type(6)));
typedef unsigned u32x6_a8 __attribute__((ext_vector_type(6), aligned(8)));
constexpr int EX_UCF_OFF = EX_LDS, EX_LDS6 = EX_UCF_OFF + 8 * 256 * 4;
typedef u32x6 Row6;
DI f32x32 unpack_fp6x32(const Row6& r) { return __builtin_amdgcn_cvt_scalef32_pk32_f32_fp6(r, 1.0f); }
DI void experts_wave6(const Params& p, char* smem, int wave_, int lane_, int ci0, int ntok) {
    int wave = wave_, lane = lane_; asm volatile("" : "+v"(lane), "+v"(wave)); wave = __builtin_amdgcn_readfirstlane(wave);
    LAS unsigned short* idxs = (LAS unsigned short*)(smem + EX_IDX_OFF) + wave * 8 * 128;
    LAS float* coef = (LAS float*)(smem + EX_COEF_OFF) + wave * 8 * 128;
    LAS float* ucf = (LAS float*)(smem + EX_UCF_OFF) + wave * 256;
    const unsigned char* U6 = (const unsigned char*)p.U16(); const unsigned char* V6 = (const unsigned char*)p.V16();
    const int h = lane >> 5, lq = lane & 31;
#pragma unroll
    for (int j = 0; j < 2; ++j) {
        const int row = j < ntok ? peer_row_of(ci0 + j) : -1;
        int e0 = 0, e1 = 0; float g0 = 0.f, g1 = 0.f;
        if (row >= 0) { e0 = p.IDX()[(size_t)row * 128 + lane]; e1 = p.IDX()[(size_t)row * 128 + 64 + lane]; g0 = p.GATE()[(size_t)row * 128 + lane]; g1 = p.GATE()[(size_t)row * 128 + 64 + lane]; }
        idxs[j * 128 + lane] = (unsigned short)e0; idxs[j * 128 + 64 + lane] = (unsigned short)e1;
        coef[j * 128 + lane] = g0 * p.VSC()[e0]; coef[j * 128 + 64 + lane] = g1 * p.VSC()[e1];
        ucf[j * 128 + lane] = p.USC()[e0]; ucf[j * 128 + 64 + lane] = p.USC()[e1];
    }
    const int myrow = h < ntok ? peer_row_of(ci0 + h) : -1;
    float x[32];
    {
        const int rr = myrow >= 0 ? myrow : 0;
        const float rs = myrow >= 0 ? rsqrtf(p.SS2()[rr] * (1.f / DM) + 1e-6f) : 0.f;
#pragma unroll
        for (int q = 0; q < 4; ++q) { float t[8]; unpack8(*(const u32x4*)(p.HB() + (size_t)rr * DM + lq * 32 + q * 8), t);
            const f32x4 ga = *(const f32x4*)(p.norm2_g + lq * 32 + q * 8), gb = *(const f32x4*)(p.norm2_g + lq * 32 + q * 8 + 4);
            x[8 * q] = t[0] * rs * ga.x; x[8 * q + 1] = t[1] * rs * ga.y; x[8 * q + 2] = t[2] * rs * ga.z; x[8 * q + 3] = t[3] * rs * ga.w;
            x[8 * q + 4] = t[4] * rs * gb.x; x[8 * q + 5] = t[5] * rs * gb.y; x[8 * q + 6] = t[6] * rs * gb.z; x[8 * q + 7] = t[7] * rs * gb.w; }
    }
    __builtin_amdgcn_s_waitcnt(0xc07f); asm volatile("" ::: "memory");
    auto fetch = [&](const unsigned char* tab, int b, Row6 (&buf)[8]) {
        const u32x4 iv = *(LAS const u32x4*)(idxs + h * 128 + b * 8);
#pragma unroll
        for (int i = 0; i < 8; ++i) { const unsigned ex = (iv[i >> 1] >> ((i & 1) * 16)) & 0xffffu;
            const unsigned char* src = tab + (size_t)ex * 768 + lq * 24;
            buf[i] = *(const u32x6_a8*)src; }
    };
    auto u_consume = [&](int b, const Row6 (&buf)[8]) {
        float pp[8];
#pragma unroll
        for (int i = 0; i < 8; ++i) { Row6 w = buf[i]; if (i > 0) asm volatile("" : "+v"(w) : "v"(pp[i - 1]));
            const f32x32 f = unpack_fp6x32(w); float d0 = 0.f, d1 = 0.f;
#pragma unroll
            for (int q = 0; q < 32; q += 2) { d0 += f[q] * x[q]; d1 += f[q + 1] * x[q + 1]; }
            pp[i] = d0 + d1; __builtin_amdgcn_sched_barrier(0); }
        const bool b4 = lane & 16, b3 = lane & 8, b2 = lane & 4;
        float q4[4], q2[2];
#pragma unroll
        for (int i = 0; i < 4; ++i) { const float a = b4 ? pp[i + 4] : pp[i], sx = b4 ? pp[i] : pp[i + 4]; q4[i] = a + __shfl_xor(sx, 16); }
#pragma unroll
        for (int i = 0; i < 2; ++i) { const float a = b3 ? q4[i + 2] : q4[i], sx = b3 ? q4[i] : q4[i + 2]; q2[i] = a + __builtin_amdgcn_update_dpp(0.f, sx, 0x128, 0xF, 0xF, false); }
        float t;
        { const float a = b2 ? q2[1] : q2[0], sx = b2 ? q2[0] : q2[1]; t = a + dpp_hmir(sx); }
        t += dpp_xor1(t); t += dpp_xor2(t);
        if ((lane & 3) == 0) {
            const int ix = h * 128 + b * 8 + ((lane >> 4) & 1) * 4 + ((lane >> 3) & 1) * 2 + ((lane >> 2) & 1);
            const float z = t * ucf[ix];
            coef[ix] = 0.5f * z * (1.f + erff(z * 0.70710678118654752f)) * coef[ix];
        }
    };
    f32x32 acc;
#pragma unroll
    for (int i = 0; i < 32; ++i) acc[i] = 0.f;
    auto v_consume = [&](int b, const Row6 (&buf)[8]) {
        const f32x4 c0 = *(LAS const f32x4*)(coef + h * 128 + b * 8), c1 = *(LAS const f32x4*)(coef + h * 128 + b * 8 + 4);
#pragma unroll
        for (int i = 0; i < 8; ++i) { Row6 w = buf[i]; asm volatile("" : "+v"(w), "+v"(acc));
            const f32x32 f = unpack_fp6x32(w); const float c = i < 4 ? c0[i & 3] : c1[i & 3];
            acc += f * c;
            __builtin_amdgcn_sched_barrier(0); }
    };
    {
        Row6 bufA[8], bufB[8];
        fetch(U6, 0, bufA);
#pragma unroll 1
        for (int b = 0; b < 16; b += 2) {
            fetch(U6, b + 1, bufB);
            u_consume(b, bufA);
            if (b + 2 < 16) fetch(U6, b + 2, bufA); else fetch(V6, 0, bufA);
            u_consume(b + 1, bufB);
        }
        __builtin_amdgcn_s_waitcnt(0xc07f); asm volatile("" ::: "memory");
#pragma unroll 1
        for (int b = 0; b < 16; b += 2) {
            fetch(V6, b + 1, bufB);
            v_consume(b, bufA);
            if (b + 2 < 16) fetch(V6, b + 2, bufA);
            v_consume(b + 1, bufB);
        }
    }
    if (myrow >= 0) {
        const int ci = ci0 + h;
        float* dst = (ci < NB * SEQ ? p.out + OUT_YP + (size_t)ci * DM : p.out + OUT_YS + (size_t)(ci - NB * SEQ) * DM) + lq * 32;
        const float* h1 = p.H1() + (size_t)myrow * DM + lq * 32;
#pragma unroll
        for (int q = 0; q < 8; ++q) { const f32x4 a = *(const f32x4*)(h1 + 4 * q);
            *(f32x4*)(dst + 4 * q) = (f32x4){a.x + acc[4 * q], a.y + acc[4 * q + 1], a.z + acc[4 * q + 2], a.w + acc[4 * q + 3]}; }
    }
}
typedef u32x4 Row4;
DI f32x32 unpack_fp4x32(const Row4& r) {
    f32x32 f;
#define FP4_B(d, b) { const f32x2 t = __builtin_amdgcn_cvt_scalef32_pk_f32_fp4(r[d], 1.0f, b); f[8 * (d) + 2 * (b)] = t.x; f[8 * (d) + 2 * (b) + 1] = t.y; }
#define FP4_D(d) FP4_B(d, 0) FP4_B(d, 1) FP4_B(d, 2) FP4_B(d, 3)
    FP4_D(0) FP4_D(1) FP4_D(2) FP4_D(3)
#undef FP4_D
#undef FP4_B
    return f;
}
constexpr int EX_PART_OFF = 65536;
template <int MODE> DI void experts_wave4(const Params& p, char* smem, int wave_, int lane_, int ci0, int ntok) {
    int wave = wave_, lane = lane_; asm volatile("" : "+v"(lane), "+v"(wave)); wave = __builtin_amdgcn_readfirstlane(wave);
    LAS unsigned short* idxs = (LAS unsigned short*)(smem + EX_IDX_OFF) + wave * 8 * 128;
    LAS float* coef = (LAS float*)(smem + EX_COEF_OFF) + wave * 8 * 128;
    LAS float* ucf = (LAS float*)(smem + EX_UCF_OFF) + wave * 256;
    const unsigned char* U6 = (const unsigned char*)p.U16(); const unsigned char* V6 = (const unsigned char*)p.V16();
    const int h = lane >> 5, lq = lane & 31;
#pragma unroll
    for (int j = 0; j < 2; ++j) {
        const int row = j < ntok ? peer_row_of(ci0 + j) : -1;
        int e0 = 0, e1 = 0; float g0 = 0.f, g1 = 0.f;
        if (row >= 0) { e0 = p.IDX()[(size_t)row * 128 + lane]; e1 = p.IDX()[(size_t)row * 128 + 64 + lane]; g0 = p.GATE()[(size_t)row * 128 + lane]; g1 = p.GATE()[(size_t)row * 128 + 64 + lane]; }
        idxs[j * 128 + lane] = (unsigned short)e0; idxs[j * 128 + 64 + lane] = (unsigned short)e1;
        coef[j * 128 + lane] = g0 * p.VSC()[e0]; coef[j * 128 + 64 + lane] = g1 * p.VSC()[e1];
        ucf[j * 128 + lane] = p.USC()[e0]; ucf[j * 128 + 64 + lane] = p.USC()[e1];
    }
    const int myrow = h < ntok ? peer_row_of(ci0 + h) : -1;
    float x[32];
    {
        const int rr = myrow >= 0 ? myrow : 0;
        const float rs = myrow >= 0 ? rsqrtf(p.SS2()[rr] * (1.f / DM) + 1e-6f) : 0.f;
#pragma unroll
        for (int q = 0; q < 4; ++q) { float t[8]; unpack8(*(const u32x4*)(p.HB() + (size_t)rr * DM + lq * 32 + q * 8), t);
            const f32x4 ga = *(const f32x4*)(p.norm2_g + lq * 32 + q * 8), gb = *(const f32x4*)(p.norm2_g + lq * 32 + q * 8 + 4);
            x[8 * q] = t[0] * rs * ga.x; x[8 * q + 1] = t[1] * rs * ga.y; x[8 * q + 2] = t[2] * rs * ga.z; x[8 * q + 3] = t[3] * rs * ga.w;
            x[8 * q + 4] = t[4] * rs * gb.x; x[8 * q + 5] = t[5] * rs * gb.y; x[8 * q + 6] = t[6] * rs * gb.z; x[8 * q + 7] = t[7] * rs * gb.w; }
    }
    __builtin_amdgcn_s_waitcnt(0xc07f); asm volatile("" ::: "memory");
    auto fetch = [&](const unsigned char* tab, int b, Row4 (&buf)[8]) {
        const u32x4 iv = *(LAS const u32x4*)(idxs + h * 128 + b * 8);
#pragma unroll
        for (int i = 0; i < 8; ++i) { const unsigned ex = (iv[i >> 1] >> ((i & 1) * 16)) & 0xffffu;
            buf[i] = *(const u32x4*)(tab + (size_t)ex * 512 + lq * 16); }
    };
    auto u_consume = [&](int b, const Row4 (&buf)[8]) {
        float pp[8];
#pragma unroll
        for (int i = 0; i < 8; ++i) { Row4 w = buf[i]; if (i > 0) asm volatile("" : "+v"(w) : "v"(pp[i - 1]));
            const f32x32 f = unpack_fp4x32(w); f32x2 d = {0.f, 0.f}, e = {0.f, 0.f};
#pragma unroll
            for (int q = 0; q < 32; q += 4) { d = __builtin_elementwise_fma((f32x2){f[q], f[q + 1]}, (f32x2){x[q], x[q + 1]}, d); e = __builtin_elementwise_fma((f32x2){f[q + 2], f[q + 3]}, (f32x2){x[q + 2], x[q + 3]}, e); }
            d += e; pp[i] = d.x + d.y; __builtin_amdgcn_sched_barrier(0); }
        const bool b4 = lane & 16, b3 = lane & 8, b2 = lane & 4;
        float q4[4], q2[2];
#pragma unroll
        for (int i = 0; i < 4; ++i) { const float a = b4 ? pp[i + 4] : pp[i], sx = b4 ? pp[i] : pp[i + 4]; q4[i] = a + __shfl_xor(sx, 16); }
#pragma unroll
        for (int i = 0; i < 2; ++i) { const float a = b3 ? q4[i + 2] : q4[i], sx = b3 ? q4[i] : q4[i + 2]; q2[i] = a + __builtin_amdgcn_update_dpp(0.f, sx, 0x128, 0xF, 0xF, false); }
        float t;
        { const float a = b2 ? q2[1] : q2[0], sx = b2 ? q2[0] : q2[1]; t = a + dpp_hmir(sx); }
        t += dpp_xor1(t); t += dpp_xor2(t);
        if ((lane & 3) == 0) {
            const int ix = h * 128 + b * 8 + ((lane >> 4) & 1) * 4 + ((lane >> 3) & 1) * 2 + ((lane >> 2) & 1);
            const float z = t * ucf[ix];
            coef[ix] = 0.5f * z * (1.f + erff(z * 0.70710678118654752f)) * coef[ix];
        }
    };
    f32x32 acc;
#pragma unroll
    for (int i = 0; i < 32; ++i) acc[i] = 0.f;
    auto v_consume = [&](int b, const Row4 (&buf)[8]) {
        const f32x4 c0 = *(LAS const f32x4*)(coef + h * 128 + b * 8), c1 = *(LAS const f32x4*)(coef + h * 128 + b * 8 + 4);
#pragma unroll
        for (int i = 0; i < 8; ++i) { Row4 w = buf[i]; asm volatile("" : "+v"(w), "+v"(acc));
            const f32x32 f = unpack_fp4x32(w); const float c = i < 4 ? c0[i & 3] : c1[i & 3];
            acc += f * c;
            __builtin_amdgcn_sched_barrier(0); }
    };
    if constexpr (MODE == 0) {
        Row4 bufA[8], bufB[8], bufC[8];
        auto fetch_j = [&](int j, Row4 (&buf)[8]) { if (j < 32) fetch(j < 16 ? U6 : V6, j & 15, buf); };
        fetch_j(0, bufA); fetch_j(1, bufB);
#pragma unroll 1
        for (int j = 0; j < 15; j += 3) {
            fetch_j(j + 2, bufC); u_consume(j, bufA);
            fetch_j(j + 3, bufA); u_consume(j + 1, bufB);
            fetch_j(j + 4, bufB); u_consume(j + 2, bufC);
        }
        fetch_j(17, bufC); u_consume(15, bufA);
        __builtin_amdgcn_s_waitcnt(0xc07f); asm volatile("" ::: "memory");
#pragma unroll 1
        for (int j = 16; j < 31; j += 3) {
            fetch_j(j + 2, bufA); v_consume(j - 16, bufB);
            fetch_j(j + 3, bufB); v_consume(j - 15, bufC);
            fetch_j(j + 4, bufC); v_consume(j - 14, bufA);
        }
        v_consume(15, bufB);
    }
    else {
        Row4 bufA[8], bufB[8], bufC[8];
        const int b0 = 2 * wave;
        fetch(U6, b0, bufA); fetch(U6, b0 + 1, bufB); fetch(V6, b0, bufC);
        u_consume(b0, bufA);
        fetch(V6, b0 + 1, bufA);
        u_consume(b0 + 1, bufB);
        __builtin_amdgcn_s_waitcnt(0xc07f); asm volatile("" ::: "memory");
        v_consume(b0, bufC); v_consume(b0 + 1, bufA);
        if (h == 0) { LAS float* part = (LAS float*)(smem + EX_PART_OFF) + wave * 1024 + lq * 32;
#pragma unroll
            for (int q = 0; q < 8; ++q) *(LAS f32x4*)(part + 4 * q) = (f32x4){acc[4 * q], acc[4 * q + 1], acc[4 * q + 2], acc[4 * q + 3]}; }
        return;
    }
    if (myrow >= 0) {
        const int ci = ci0 + h;
        float* dst = (ci < NB * SEQ ? p.out + OUT_YP + (size_t)ci * DM : p.out + OUT_YS + (size_t)(ci - NB * SEQ) * DM) + lq * 32;
        const float* h1 = p.H1() + (size_t)myrow * DM + lq * 32;
#pragma unroll
        for (int q = 0; q < 8; ++q) { const f32x4 a = *(const f32x4*)(h1 + 4 * q);
            *(f32x4*)(dst + 4 * q) = (f32x4){a.x + acc[4 * q], a.y + acc[4 * q + 1], a.z + acc[4 * q + 2], a.w + acc[4 * q + 3]}; }
    }
}

#define XB_TMO      128
#define XB_XCNT(j)  (256  + 64 * (j))
#define XB_XSUB(j)  (1280 + 64 * (j))
#define XB_XGEN(j)  (2304 + 64 * (j))
#define XB_TOP      3328
#define XB_TOPGEN   3392
#define XCD_BAR_WORDS 3456
#define XB_SPIN_CAP (1u << 18)

__device__ __forceinline__ unsigned xb_ld(unsigned* p)              { return __hip_atomic_load(p, __ATOMIC_RELAXED, __HIP_MEMORY_SCOPE_AGENT); }
__device__ __forceinline__ unsigned xb_add(unsigned* p, unsigned v) { return __hip_atomic_fetch_add(p, v, __ATOMIC_RELAXED, __HIP_MEMORY_SCOPE_AGENT); }
__device__ __forceinline__ unsigned xb_xcc_id() { return (unsigned)__builtin_amdgcn_s_getreg((3 << 11) | 20) & 0xFu; }
#define XB_SPIN(cond, bar) do { unsigned _sp = 0; while (cond) { __builtin_amdgcn_s_sleep(1); \
    if ((++_sp & 255u) == 0u) { if (xb_ld(&(bar)[XB_TMO])) break; if (_sp > XB_SPIN_CAP) { atomicAdd(&(bar)[XB_TMO], 1u); break; } } } } while (0)

struct XcdBarrier {
    unsigned* bar; unsigned x;
    volatile LAS unsigned* st;
};
__device__ __forceinline__ XcdBarrier xcd_barrier_post(unsigned* bar, volatile LAS unsigned* st) {
    XcdBarrier b; b.bar = bar; b.x = xb_xcc_id(); b.st = st;
    if (threadIdx.x == 0) (void)xb_add(&bar[XB_XCNT(b.x)], 1u);
    return b;
}
__device__ __forceinline__ void xcd_barrier_complete(unsigned* bar, unsigned x, unsigned& nloc, unsigned& nx) {
    const unsigned G = gridDim.x * gridDim.y * gridDim.z;
    unsigned sum, cnt, mine, sp = 0u;
    for (;;) {
        sum = 0u; cnt = 0u; mine = 0u;
#pragma unroll
        for (unsigned j = 0; j < 16; ++j) { const unsigned c = xb_ld(&bar[XB_XCNT(j)]); sum += c; cnt += (c > 0u) ? 1u : 0u; mine = (j == x) ? c : mine; }
        if (sum == G) break;
        __builtin_amdgcn_s_sleep(1);
        if ((++sp & 255u) == 0u) { if (xb_ld(&bar[XB_TMO])) break; if (sp > XB_SPIN_CAP) { atomicAdd(&bar[XB_TMO], 1u); break; } }
    }
    nloc = mine > 0u ? mine : 1u; nx = cnt > 0u ? cnt : 1u;
}
__device__ __forceinline__ void xcd_barrier(const XcdBarrier& b) {
    asm volatile("s_waitcnt vmcnt(0)" ::: "memory");
    __syncthreads();
    if (threadIdx.x == 0) {
        unsigned* bar = b.bar;
        __builtin_amdgcn_s_waitcnt(0);
        unsigned nloc = b.st[0], nx = b.st[1];
        if (nloc == 0u) { xcd_barrier_complete(bar, b.x, nloc, nx); b.st[0] = nloc; b.st[1] = nx; }
        const unsigned old = xb_add(&bar[XB_XSUB(b.x)], 1u);
        const unsigned gen = old / nloc;
        if (old + 1u == (gen + 1u) * nloc) {
            __builtin_amdgcn_fence(__ATOMIC_RELEASE, "agent");
            asm volatile("s_waitcnt vmcnt(0)" ::: "memory");
            const unsigned og = xb_add(&bar[XB_TOP], 1u);
            const unsigned tg = og / nx;
            if (og + 1u == (tg + 1u) * nx) xb_add(&bar[XB_TOPGEN], 1u);
            else XB_SPIN(xb_ld(&bar[XB_TOPGEN]) == tg, bar);
            __builtin_amdgcn_fence(__ATOMIC_ACQUIRE, "agent");
            xb_add(&bar[XB_XGEN(b.x)], 1u);
            asm volatile("s_waitcnt vmcnt(0)" ::: "memory");
        } else {
            XB_SPIN(xb_ld(&bar[XB_XGEN(b.x)]) == gen, bar);
            __builtin_amdgcn_fence(__ATOMIC_ACQUIRE, "agent");
            asm volatile("s_waitcnt vmcnt(0)" ::: "memory");
        }
    }
    __syncthreads();
}

constexpr int NTHR = 512, NBLK = 256;
constexpr int LDS_MAIN = 159744, LDS_BYTES = LDS_MAIN + 64;
extern __shared__ __attribute__((aligned(16))) char dyn_smem[];

DI int pull_work(unsigned* q, char* smem, int tid, int step) {
    LAS int* bw = (LAS int*)(smem + LDS_MAIN + 32);
    __syncthreads();
    if (tid == 0) *bw = (int)__hip_atomic_fetch_add(q, (unsigned)step, __ATOMIC_RELAXED, __HIP_MEMORY_SCOPE_AGENT);
    __syncthreads();
    return *bw;
}

#define PH_IDS int tid = threadIdx.x; asm volatile("" : "+v"(tid)); const int wave = tid >> 6, lane = tid & 63, gw = bid * 8 + wave; (void)wave; (void)lane; (void)gw;
__global__ void __launch_bounds__(NTHR, 2) k_mega(Params p) {
    const int bid = blockIdx.x, nblk = gridDim.x, ngw = nblk * 8;
    char* smem = dyn_smem;
    if (threadIdx.x == 0) *(u32x4*)(smem + LDS_MAIN) = (u32x4){0u, 0u, 0u, 0u};
    __syncthreads();
    XcdBarrier bar = xcd_barrier_post(p.ctl(), (volatile LAS unsigned*)(smem + LDS_MAIN));
    { PH_IDS phase_convert(p, smem, 0, gw, ngw, wave, lane); }
    xcd_barrier(bar);
    { EpiProj e{p.RSTD1(), p.PROJ(), p.out}; g8::gemm_phase<false>(p.XB(), 1024, p.WIN_T(), 1024, MP / 256, INW / 256, (bf16_t*)smem, e, bid, nblk); }
    { PH_IDS constexpr int G1_REM = (MP / 256) * (INW / 256) % NBLK;
      if (bid >= G1_REM) phase_convert(p, smem, 1, (bid - G1_REM) * 8 + wave, (nblk - G1_REM) * 8, wave, lane); }
    xcd_barrier(bar);
    { PH_IDS phase_prep(p, smem, bid, nblk, gw, ngw, tid, lane); }
    xcd_barrier(bar);
    { PH_IDS unsigned short pre[48]; chunk_prefetch(p, bid, tid, pre); for (int u = bid; u < CK_UNITS; u += nblk) chunk_pass1(p, smem, u, u + nblk, pre, tid); }
    {
        asm volatile("s_waitcnt vmcnt(0)" ::: "memory");
        __syncthreads();
        unsigned* cnt = p.ctl() + CTL_P3A_DONE;
        if (threadIdx.x == 0) {
            __builtin_amdgcn_fence(__ATOMIC_RELEASE, "agent");
            asm volatile("s_waitcnt vmcnt(0)" ::: "memory");
            (void)xb_add(cnt, 1u);
            if (bid < 64) {
                XB_SPIN(xb_ld(cnt) < (unsigned)nblk, p.ctl());
                __builtin_amdgcn_fence(__ATOMIC_ACQUIRE, "agent");
                asm volatile("s_waitcnt vmcnt(0)" ::: "memory");
            }
        }
        if (bid < 64) __syncthreads();
    }
    {
        PH_IDS
        volatile LAS int* prog = (volatile LAS int*)(smem + LDS_MAIN + 48);
        if (tid == 0) *prog = 0;
        __syncthreads();
        if (bid < 64) {
            if (wave == 0) chunk_pass2(p, bid, lane, prog);
            else if (wave == 1) chunk_pass2_prefetch(p, bid, lane, prog);
            else {
                while (*prog < CK_N) {
                    int u = 0; if (lane == 0) u = (int)__hip_atomic_fetch_add(p.ctl() + CTL_Q_SATTN, 1u, __ATOMIC_RELAXED, __HIP_MEMORY_SCOPE_AGENT);
                    u = __builtin_amdgcn_readfirstlane(u);
                    if (u >= SA_UNITS) break;
                    sattn_unit(p, u, lane);
                }
            }
        }
        else if (bid >= 128) rwkv_sample_unit(p, (bid - 128) * 2 + (tid >> 8), tid & 255);
    }
    {
        PH_IDS
        const float lam = compute_lam(p, lane);
        for (;;) {
            const int idx = pull_work(p.ctl() + CTL_Q_ATTN, smem, tid, 1);
            if (idx >= AT_UNITS) break;
            const int qbi = idx >> 4, bh = idx & 15, qb = qbi < 32 ? 31 - qbi : 32;
            attn_unit(p, smem, bh >> 2, bh & 3, qb, lam, alibi_dmax(p, bh & 3, lane), tid);
        }
    }
    {
        PH_IDS
        for (;;) {
            const int u0 = pull_work(p.ctl() + CTL_Q_SATTN, smem, tid, 8);
            if (u0 >= SA_UNITS) break;
            if (u0 + wave < SA_UNITS) sattn_unit(p, u0 + wave, lane);
        }
    }
    xcd_barrier(bar);
    {
        PH_IDS
        for (int u = gw; u < 2 * CK_UNITS; u += ngw) chunk_pass3(p, u, lane);
        if (gw >= 64 && gw < 64 + MS) rwkv_post_row(p, MPR + gw - 64, lane);
        const float lam = compute_lam(p, lane);
        if (gw >= 64 + MS && gw < 64 + MS + MS * 4) sattn_combine(p, gw - 64 - MS, lam, lane);
    }
    xcd_barrier(bar);
    { PH_IDS
      skinny_gemm(p.YO(), 1024, p.WRW_T(), 512, 1024, smem, bid, nblk, tid, [&](int row, int col, float v) { p.MIXF()[(size_t)row * DM + col] = v * sigmoidf_(bf2f(p.PROJ()[(size_t)row * INW + O_GA + col])); });
      skinny_gemm(p.YO() + 512, 1024, p.WDA_T(), 512, 1024, smem, bid, nblk, tid, [&](int row, int col, float v) { p.MIX()[(size_t)row * DM + col] = bf16_1(p.MIXF()[(size_t)row * DM + col] + v * sigmoidf_(bf2f(p.PROJ()[(size_t)row * INW + O_GB + col]))); }); }
    { EpiBr1 e{p.PROJ(), p.MIX()}; g8::gemm_phase<true>(p.YO(), 1024, p.WRW_T(), 512, 64, 4, (bf16_t*)smem, e, bid, nblk); }
    { EpiBr2 e{p.PROJ(), p.MIX()}; g8::gemm_phase<true>(p.YO() + 512, 1024, p.WDA_T(), 512, 64, 4, (bf16_t*)smem, e, bid, nblk); }
    xcd_barrier(bar);
    { PH_IDS
      skinny_gemm(p.MIX(), 1024, p.WOUT_T(), 1024, 1024, smem, bid, nblk, tid, [&](int row, int col, float v) {
          const float h = p.x_sample[(size_t)(row - MPR) * DM + col] + v; p.H1()[(size_t)row * DM + col] = h; p.HB()[(size_t)row * DM + col] = bf16_1(h);
          float ss = h * h; ss += __shfl_xor(ss, 1); ss += __shfl_xor(ss, 2); ss += __shfl_xor(ss, 4); ss += __shfl_xor(ss, 8); ss += __shfl_xor(ss, 16);
          if ((lane & 31) == 0) atomicAdd(p.SS2() + row, ss); }); }
    { EpiOut e{p.XPTR(), p.H1(), p.HB(), p.SS2()}; g8::gemm_phase<true>(p.MIX(), 1024, p.WOUT_T(), 1024, 64, 4, (bf16_t*)smem, e, bid, nblk); }
    xcd_barrier(bar);
    { PH_IDS
      skinny_gemm(p.HB(), 1024, p.WQ_T(), 1024, 2048, smem, bid, nblk, tid, [&](int row, int col, float v) { p.QP()[(size_t)row * 2048 + col] = bf16_1(v * rsqrtf(p.SS2()[row] * (1.f / DM) + 1e-6f)); }); }
    { EpiQ e{p.SS2(), p.QP()}; g8::gemm_phase<true>(p.HB(), 1024, p.WQ_T(), 1024, 64, 8, (bf16_t*)smem, e, bid, nblk); }
    xcd_barrier(bar);
    {
        PH_IDS
        for (int ch = tid; ch < 256 * 16; ch += 512) { const int r = ch >> 4, cc = ch & 15; *(u32x4*)(smem + 16384 + r * 272 + cc * 16) = *(const u32x4*)(p.SK() + (size_t)r * 128 + cc * 8); }
        __syncthreads();
        for (int u = gw; u < (MTOT / 32) * 8; u += ngw) topk_unit(p, smem + 16384, smem + wave * 2048, u, lane);
        constexpr int TK_REM = (MTOT / 32) * 8 - 2 * NBLK * 8;
        if (gw >= TK_REM) { const int cw = gw - TK_REM, ncw = ngw - TK_REM;
            for (int it = cw; it < 32768; it += ncw) { if (it < 16384) convert_row_fp4(p.peer_u, (unsigned char*)p.U16(), p.USC(), it, lane); else convert_row_fp4(p.peer_v, (unsigned char*)p.V16(), p.VSC(), it - 16384, lane); } }
    }
    xcd_barrier(bar);
    {
        PH_IDS
#pragma unroll 1
        for (int pass = 0; pass < 4; ++pass) experts_wave4<0>(p, smem, wave, lane, bid * 64 + wave * 8 + 2 * pass, 2);
        if (bid < MS) {
            experts_wave4<1>(p, smem, wave, lane, NB * SEQ + bid, 1);
            __syncthreads();
            const LAS float* part = (const LAS float*)(smem + EX_PART_OFF) + 2 * tid;
            const size_t row = (size_t)MPR + bid;
            f32x2 s = *(const f32x2*)(p.H1() + row * DM + 2 * tid);
#pragma unroll
            for (int w = 0; w < 8; ++w) { const f32x2 t = *(const LAS f32x2*)(part + w * 1024); s += t; }
            *(f32x2*)(p.out + OUT_YS + (size_t)bid * DM + 2 * tid) = s;
        }
    }
}

extern "C" void kernel_launch(void* const* d_in, const int* in_sizes, int n_in, void* d_out, int out_size, void* d_ws, size_t ws_size, hipStream_t stream) {
    Params p{};
    p.x_prompt = (const float*)d_in[0]; p.x_sample = (const float*)d_in[1]; p.cache_k = (const float*)d_in[2]; p.cache_v = (const float*)d_in[3];
    p.state_wkv = (const float*)d_in[4]; p.state_shift = (const float*)d_in[5]; p.page_table = (const int*)d_in[6];
    p.meta = (const float*)d_in[7]; p.norm1_g = (const float*)d_in[8]; p.w_in = (const float*)d_in[9]; p.rw_mu = (const float*)d_in[10]; p.rw_w0 = (const float*)d_in[11];
    p.rw_w2 = (const float*)d_in[12]; p.rw_a0 = (const float*)d_in[13]; p.rw_a2 = (const float*)d_in[14]; p.rw_g2 = (const float*)d_in[15]; p.rw_kk = (const float*)d_in[16];
    p.rw_ka = (const float*)d_in[17]; p.rw_rk = (const float*)d_in[18]; p.rw_ln_g = (const float*)d_in[19]; p.rw_ln_b = (const float*)d_in[20]; p.w_rw_br = (const float*)d_in[21];
    p.da_qn_g = (const float*)d_in[22]; p.da_kn_g = (const float*)d_in[23]; p.da_lam = (const float*)d_in[24]; p.da_subln_g = (const float*)d_in[25]; p.w_da_br = (const float*)d_in[26];
    p.w_out = (const float*)d_in[27]; p.norm2_g = (const float*)d_in[28]; p.peer_wq = (const float*)d_in[29]; p.peer_subkeys = (const float*)d_in[30]; p.peer_u = (const float*)d_in[31];
    p.peer_v = (const float*)d_in[32];
    (void)in_sizes; (void)n_in; (void)out_size; (void)ws_size;
    p.out = (float*)d_out;
    p.ws = (char*)d_ws;
    static bool attr_done = false;
    if (!attr_done) { (void)hipFuncSetAttribute((const void*)k_mega, hipFuncAttributeMaxDynamicSharedMemorySize, LDS_BYTES); attr_done = true; }
    (void)hipMemsetAsync(p.ws + WO_ctl, 0, CTL_WORDS * 4, stream);
    k_mega<<<NBLK, NTHR, LDS_BYTES, stream>>>(p);
}
```
